# Optimizing an MI355X kernel written in HIP

```python
import math
import jax, jax.numpy as jnp
from jax import lax
import numpy as np

D_MODEL = 1024
BATCH = 4
SEQ = 8192
DEPTH = 2

GLA_HEADS = D_MODEL // 256
GLA_DK = 32
GLA_DV = 64
GLA_GATE_RANK = 16
GLA_TAU = 16.0
GLA_CHUNK = 16
NSA_HEADS = D_MODEL // 256
NSA_KV_HEADS = NSA_HEADS // 2
NSA_DH = 64
NSA_CMP_LEN = 32
NSA_CMP_STRIDE = 16
NSA_CMP_HIDDEN = 128
NSA_SEL_BLOCK = 64
NSA_SEL_TOPK = 16
NSA_SEL_LOCAL = 2
NSA_WINDOW = 512
NSA_QBLOCK = 128
SSD_HEADS = D_MODEL // 128
SSD_HEAD_DIM = 64
SSD_GROUPS = 2
SSD_STATE = 128
SSD_CONV = 4
SSD_CHUNK = 128
SSD_D_INNER = SSD_HEADS * SSD_HEAD_DIM
SSD_CONV_DIM = SSD_D_INNER + 2 * SSD_GROUPS * SSD_STATE

D_MIX = GLA_HEADS * GLA_DV + NSA_HEADS * NSA_DH + SSD_D_INNER
D_FF = 4 * D_MODEL
ROPE_THETA = 10000.0
NORM_EPS = 1e-6
NEG = -1e30
BIG = 1e30

IN_SPLITS = (
    GLA_HEADS * GLA_DK,
    GLA_HEADS * GLA_DK,
    GLA_HEADS * GLA_DV,
    GLA_GATE_RANK,
    GLA_HEADS * GLA_DV,
    NSA_HEADS * NSA_DH,
    6 * NSA_KV_HEADS * NSA_DH,
    3 * NSA_HEADS,
    SSD_D_INNER,
    SSD_CONV_DIM,
    SSD_HEADS,
)
D_IN = sum(IN_SPLITS)

kernel_name = "hybrid_gla_nsa_ssd_block"


def rms_norm(x, w):
    xf = x.astype(jnp.float32)
    y = xf * lax.rsqrt(jnp.mean(xf * xf, axis=-1, keepdims=True) + NORM_EPS)
    return (y * w.astype(jnp.float32)).astype(x.dtype)


def rope(x, pos):
    half = x.shape[-1] // 2
    inv = ROPE_THETA ** (-jnp.arange(half, dtype=jnp.float32) / half)
    ang = pos.astype(jnp.float32)[:, None] * inv[None, :]
    cos = jnp.cos(ang)[None, :, None, :]
    sin = jnp.sin(ang)[None, :, None, :]
    x1 = x[..., :half].astype(jnp.float32)
    x2 = x[..., half:].astype(jnp.float32)
    return jnp.concatenate([x1 * cos - x2 * sin, x2 * cos + x1 * sin], axis=-1).astype(x.dtype)


def gla_mixer(q, k, v, g_lr, r, w_gate2, b_gate, norm_w):
    f32 = jnp.float32
    Bsz, S, _ = q.shape
    H, dk, dv, C = GLA_HEADS, GLA_DK, GLA_DV, GLA_CHUNK
    nc = S // C
    log_a = jax.nn.log_sigmoid((g_lr @ w_gate2 + b_gate).astype(f32)) / GLA_TAU

    def chunks(t, d):
        return t.astype(f32).reshape(Bsz, nc, C, H, d).transpose(0, 3, 1, 2, 4)

    qc = chunks(q, dk) * (dk ** -0.5)
    kc = chunks(k, dk)
    vc = chunks(v, dv)
    bc = jnp.cumsum(chunks(log_a, dk), axis=3)
    causal = jnp.tril(jnp.ones((C, C), dtype=bool))
    diff = bc[..., :, None, :] - bc[..., None, :, :]
    decay = jnp.exp(jnp.where(causal[..., None], diff, -jnp.inf))
    attn = jnp.einsum('bhnid,bhnjd,bhnijd->bhnij', qc, kc, decay)
    o_intra = jnp.einsum('bhnij,bhnjd->bhnid', attn, vc)
    g_tot = bc[..., -1, :]
    u = jnp.einsum('bhnck,bhncv->bhnkv', kc * jnp.exp(g_tot[..., None, :] - bc), vc)

    def step(state, inp):
        g, uc = inp
        return jnp.exp(g)[..., None] * state + uc, state

    init = jnp.zeros((Bsz, H, dk, dv), f32)
    _, s_enter = lax.scan(step, init, (jnp.moveaxis(g_tot, 2, 0), jnp.moveaxis(u, 2, 0)))
    s_enter = jnp.moveaxis(s_enter, 0, 2)
    o_inter = jnp.einsum('bhnck,bhnkv->bhncv', qc * jnp.exp(bc), s_enter)
    o = (o_intra + o_inter).transpose(0, 2, 3, 1, 4).reshape(Bsz, S, H, dv)
    o = rms_norm(o, norm_w.reshape(H, dv)).reshape(Bsz, S, H * dv)
    return (o * jax.nn.silu(r.astype(f32))).astype(q.dtype)


def nsa_compress(t, pos_emb, w1, w2):
    Bsz, S, G, dh = t.shape
    nsub = NSA_CMP_LEN // NSA_CMP_STRIDE
    sub = t.reshape(Bsz, S // NSA_CMP_STRIDE, NSA_CMP_STRIDE, G, dh)
    n_cmp = S // NSA_CMP_STRIDE - nsub + 1
    blocks = jnp.concatenate([sub[:, i:i + n_cmp] for i in range(nsub)], axis=2)
    blocks = blocks + pos_emb[None, None, :, None, :]
    flat = blocks.transpose(0, 3, 1, 2, 4).reshape(Bsz, G, n_cmp, NSA_CMP_LEN * dh)
    return jax.nn.gelu(flat @ w1) @ w2


def nsa_mixer(q, kv, gates, pos, cmp_pos_k, cmp_w1_k, cmp_w2_k,
              cmp_pos_v, cmp_w1_v, cmp_w2_v, norm_w):
    f32 = jnp.float32
    Bsz, S, _ = q.shape
    H, G, dh = NSA_HEADS, NSA_KV_HEADS, NSA_DH
    R = H // G
    QB = NSA_QBLOCK
    out_dtype = q.dtype
    t_idx = jnp.arange(S)

    q = rope(q.reshape(Bsz, S, H, dh), pos)
    k_cmp, v_cmp, k_slc, v_slc, k_win, v_win = [
        t.reshape(Bsz, S, G, dh) for t in jnp.split(kv, 6, axis=-1)]
    k_cmp, k_slc, k_win = rope(k_cmp, pos), rope(k_slc, pos), rope(k_win, pos)
    qg = q.reshape(Bsz, S, G, R, dh).transpose(0, 2, 3, 1, 4).astype(f32) * (dh ** -0.5)

    kc = nsa_compress(k_cmp, cmp_pos_k, cmp_w1_k, cmp_w2_k).astype(f32)
    vc = nsa_compress(v_cmp, cmp_pos_v, cmp_w1_v, cmp_w2_v).astype(f32)
    n_cmp = kc.shape[2]
    cmp_start = jnp.arange(n_cmp) * NSA_CMP_STRIDE
    cmp_mask = (cmp_start + NSA_CMP_LEN - 1)[None, :] <= t_idx[:, None]
    s_cmp = jnp.einsum('bgrsd,bgnd->bgrsn', qg, kc)
    p_cmp = jax.nn.softmax(jnp.where(cmp_mask, s_cmp, NEG), axis=-1)
    p_cmp = jnp.where(cmp_mask, p_cmp, 0.0)
    o_cmp = jnp.einsum('bgrsn,bgnd->bgrsd', p_cmp, vc)

    n_slc = S // NSA_SEL_BLOCK
    slc_start = jnp.arange(n_slc) * NSA_SEL_BLOCK
    overlap = ((cmp_start[:, None] < slc_start[None, :] + NSA_SEL_BLOCK)
               & (cmp_start[:, None] + NSA_CMP_LEN > slc_start[None, :])).astype(f32)
    imp = jnp.einsum('bgrsn,nj->bgsj', p_cmp, overlap)
    q_blk = t_idx // NSA_SEL_BLOCK
    j = jnp.arange(n_slc)
    forced = (j[None, :] == 0) | ((j[None, :] <= q_blk[:, None])
                                  & (j[None, :] > q_blk[:, None] - NSA_SEL_LOCAL))
    future = j[None, :] > q_blk[:, None]
    imp = jnp.where(forced, BIG, jnp.where(future, NEG, imp))
    n_top = min(NSA_SEL_TOPK, n_slc)
    top_val, top_idx = lax.top_k(imp, n_top)
    top_ok = top_val > 0.5 * NEG

    kb = k_slc.astype(f32).transpose(0, 2, 1, 3).reshape(Bsz, G, n_slc, NSA_SEL_BLOCK, dh)
    vb = v_slc.astype(f32).transpose(0, 2, 1, 3).reshape(Bsz, G, n_slc, NSA_SEL_BLOCK, dh)
    nq = S // QB
    qs = jnp.moveaxis(qg.reshape(Bsz, G, R, nq, QB, dh), 3, 0)
    idx_s = jnp.moveaxis(top_idx.reshape(Bsz, G, nq, QB, n_top), 2, 0)
    ok_s = jnp.moveaxis(top_ok.reshape(Bsz, G, nq, QB, n_top), 2, 0)
    tq = t_idx.reshape(nq, QB)
    bi = jnp.arange(Bsz)[:, None, None, None]
    gi = jnp.arange(G)[None, :, None, None]
    offs = jnp.arange(NSA_SEL_BLOCK)

    def sel_block(args):
        qb, ib, okb, tb = args
        kg = kb[bi, gi, ib]
        vg = vb[bi, gi, ib]
        kpos = ib[..., None] * NSA_SEL_BLOCK + offs
        m = okb[..., None] & (kpos <= tb[None, None, :, None, None])
        s = jnp.einsum('bgrqd,bgqnkd->bgrqnk', qb, kg)
        s = jnp.where(m[:, :, None], s, NEG)
        p = jax.nn.softmax(s.reshape(Bsz, G, R, QB, -1), axis=-1).reshape(s.shape)
        return jnp.einsum('bgrqnk,bgqnkd->bgrqd', p, vg)

    o_slc = lax.map(sel_block, (qs, idx_s, ok_s, tq))
    o_slc = jnp.moveaxis(o_slc, 0, 3).reshape(Bsz, G, R, S, dh)

    pad = NSA_WINDOW // QB

    def band(t):
        tb_ = t.astype(f32).transpose(0, 2, 1, 3).reshape(Bsz, G, nq, QB, dh)
        tb_ = jnp.pad(tb_, ((0, 0), (0, 0), (pad, 0), (0, 0), (0, 0)))
        return jnp.concatenate([tb_[:, :, i:i + nq] for i in range(pad + 1)], axis=3)

    kw, vw = band(k_win), band(v_win)
    qw = qg.reshape(Bsz, G, R, nq, QB, dh)
    kpos_w = (jnp.arange(nq)[:, None] - pad) * QB + jnp.arange((pad + 1) * QB)[None, :]
    dist = tq[:, :, None] - kpos_w[:, None, :]
    wmask = (kpos_w[:, None, :] >= 0) & (dist >= 0) & (dist < NSA_WINDOW)
    s_w = jnp.einsum('bgrwqd,bgwkd->bgrwqk', qw, kw)
    p_w = jax.nn.softmax(jnp.where(wmask, s_w, NEG), axis=-1)
    o_win = jnp.einsum('bgrwqk,bgwkd->bgrwqd', p_w, vw).reshape(Bsz, G, R, S, dh)

    gt = jax.nn.sigmoid(gates.astype(f32)).reshape(Bsz, S, G, R, 3).transpose(0, 2, 3, 1, 4)
    o = gt[..., 0:1] * o_cmp + gt[..., 1:2] * o_slc + gt[..., 2:3] * o_win
    o = o.transpose(0, 3, 1, 2, 4).reshape(Bsz, S, H, dh)
    o = rms_norm(o, norm_w.reshape(H, dh))
    return o.reshape(Bsz, S, H * dh).astype(out_dtype)


def ssd_mixer(z, xbc, dt, conv_w, conv_b, dt_bias, a_log, d_skip, norm_w):
    f32 = jnp.float32
    Bsz, S, _ = z.shape
    H, P, G, N, L = SSD_HEADS, SSD_HEAD_DIM, SSD_GROUPS, SSD_STATE, SSD_CHUNK
    nc = S // L
    xbc = lax.conv_general_dilated(
        xbc, conv_w[:, None, :].astype(xbc.dtype), window_strides=(1,),
        padding=[(SSD_CONV - 1, 0)], dimension_numbers=('NWC', 'WIO', 'NWC'),
        feature_group_count=SSD_CONV_DIM) + conv_b
    xbc = jax.nn.silu(xbc.astype(f32))
    xs, Bm, Cm = jnp.split(xbc, [SSD_D_INNER, SSD_D_INNER + G * N], axis=-1)
    xs = xs.reshape(Bsz, S, H, P)
    hpg = H // G
    Bm = jnp.repeat(Bm.reshape(Bsz, S, G, N), hpg, axis=2)
    Cm = jnp.repeat(Cm.reshape(Bsz, S, G, N), hpg, axis=2)
    dt = jax.nn.softplus(dt.astype(f32) + dt_bias.astype(f32))
    A = -jnp.exp(a_log.astype(f32))
    xdt = (xs * dt[..., None]).reshape(Bsz, nc, L, H, P)
    Bc = Bm.reshape(Bsz, nc, L, H, N)
    Cc = Cm.reshape(Bsz, nc, L, H, N)
    acs = jnp.cumsum((dt * A).reshape(Bsz, nc, L, H).transpose(0, 3, 1, 2), axis=-1)
    causal = jnp.tril(jnp.ones((L, L), dtype=bool))
    seg = jnp.exp(jnp.where(causal, acs[..., :, None] - acs[..., None, :], -jnp.inf))
    cb = jnp.einsum('bclhn,bcshn->bhcls', Cc, Bc)
    y_diag = jnp.einsum('bhcls,bcshp->bclhp', cb * seg, xdt)
    decay_states = jnp.exp(acs[..., -1:] - acs)
    states = jnp.einsum('bclhn,bhcl,bclhp->bchpn', Bc, decay_states, xdt)
    chunk_decay = jnp.exp(acs[..., -1])

    def step(h, inp):
        dec, st = inp
        return dec[..., None, None] * h + st, h

    init = jnp.zeros((Bsz, H, P, N), f32)
    _, h_enter = lax.scan(step, init, (jnp.moveaxis(chunk_decay, 2, 0), jnp.moveaxis(states, 1, 0)))
    h_enter = jnp.moveaxis(h_enter, 0, 1)
    y_off = jnp.einsum('bclhn,bchpn,bhcl->bclhp', Cc, h_enter, jnp.exp(acs))
    y = (y_diag + y_off).reshape(Bsz, S, H, P) + d_skip.astype(f32)[:, None] * xs
    y = y.reshape(Bsz, S, H * P) * jax.nn.silu(z.astype(f32))
    y = rms_norm(y.reshape(Bsz, S, G, H * P // G), norm_w.reshape(G, -1)).reshape(Bsz, S, H * P)
    return y.astype(z.dtype)


def setup_inputs(seed: int = 0) -> dict:
    key = jax.random.key(seed)
    ks = iter(jax.random.split(key, 32))
    f32 = jnp.float32
    Ld = DEPTH

    def nrm(shape, scale):
        return jax.random.normal(next(ks), shape, f32) * scale

    def gain(shape):
        return 1.0 + nrm(shape, 0.02)

    cmp_in = NSA_CMP_LEN * NSA_DH
    x = jax.random.normal(next(ks), (BATCH, SEQ, D_MODEL), f32)
    dt0 = jnp.exp(jax.random.uniform(next(ks), (Ld, SSD_HEADS), f32,
                                     math.log(1e-3), math.log(1e-1)))
    dt_bias = dt0 + jnp.log(-jnp.expm1(-dt0))
    a_log = jnp.log(jax.random.uniform(next(ks), (Ld, SSD_HEADS), f32, 1.0, 16.0))
    return {
        "x": x,
        "norm1_w": gain((Ld, D_MODEL)),
        "w_in": nrm((Ld, D_MODEL, D_IN), D_MODEL ** -0.5),
        "gla_gate_w2": nrm((Ld, GLA_GATE_RANK, GLA_HEADS * GLA_DK), GLA_GATE_RANK ** -0.5),
        "gla_gate_b": nrm((Ld, GLA_HEADS * GLA_DK), 0.1),
        "gla_norm_w": gain((Ld, GLA_HEADS * GLA_DV)),
        "nsa_cmp_pos_k": nrm((Ld, NSA_CMP_LEN, NSA_DH), 0.1),
        "nsa_cmp_w1_k": nrm((Ld, cmp_in, NSA_CMP_HIDDEN), cmp_in ** -0.5),
        "nsa_cmp_w2_k": nrm((Ld, NSA_CMP_HIDDEN, NSA_DH), NSA_CMP_HIDDEN ** -0.5),
        "nsa_cmp_pos_v": nrm((Ld, NSA_CMP_LEN, NSA_DH), 0.1),
        "nsa_cmp_w1_v": nrm((Ld, cmp_in, NSA_CMP_HIDDEN), cmp_in ** -0.5),
        "nsa_cmp_w2_v": nrm((Ld, NSA_CMP_HIDDEN, NSA_DH), NSA_CMP_HIDDEN ** -0.5),
        "nsa_norm_w": gain((Ld, NSA_HEADS * NSA_DH)),
        "ssd_conv_w": nrm((Ld, SSD_CONV, SSD_CONV_DIM), SSD_CONV ** -0.5),
        "ssd_conv_b": nrm((Ld, SSD_CONV_DIM), 0.02),
        "ssd_dt_bias": dt_bias,
        "ssd_a_log": a_log,
        "ssd_d": gain((Ld, SSD_HEADS)),
        "ssd_norm_w": gain((Ld, SSD_D_INNER)),
        "w_out": nrm((Ld, D_MIX, D_MODEL), D_MIX ** -0.5),
        "norm2_w": gain((Ld, D_MODEL)),
        "w_up": nrm((Ld, D_MODEL, D_FF), D_MODEL ** -0.5),
        "w_down": nrm((Ld, D_FF, D_MODEL), 0.5 * D_FF ** -0.5),
        "final_norm_w": gain((D_MODEL,)),
    }


def reference(x, norm1_w, w_in, gla_gate_w2, gla_gate_b, gla_norm_w,
              nsa_cmp_pos_k, nsa_cmp_w1_k, nsa_cmp_w2_k,
              nsa_cmp_pos_v, nsa_cmp_w1_v, nsa_cmp_w2_v, nsa_norm_w,
              ssd_conv_w, ssd_conv_b, ssd_dt_bias, ssd_a_log, ssd_d, ssd_norm_w,
              w_out, norm2_w, w_up, w_down, final_norm_w):
    S = x.shape[1]
    pos = jnp.arange(S)
    split_at = np.cumsum(IN_SPLITS)[:-1].tolist()
    h = x
    for l in range(DEPTH):
        u = rms_norm(h, norm1_w[l])
        proj = u @ w_in[l]
        (gq, gk, gv, glr, gr, nq_, nkv, ngate, sz, sxbc, sdt) = jnp.split(proj, split_at, axis=-1)
        y_gla = gla_mixer(gq, gk, gv, glr, gr, gla_gate_w2[l], gla_gate_b[l], gla_norm_w[l])
        y_nsa = nsa_mixer(nq_, nkv, ngate, pos,
                          nsa_cmp_pos_k[l], nsa_cmp_w1_k[l], nsa_cmp_w2_k[l],
                          nsa_cmp_pos_v[l], nsa_cmp_w1_v[l], nsa_cmp_w2_v[l], nsa_norm_w[l])
        y_ssd = ssd_mixer(sz, sxbc, sdt, ssd_conv_w[l], ssd_conv_b[l], ssd_dt_bias[l],
                          ssd_a_log[l], ssd_d[l], ssd_norm_w[l])
        mix = jnp.concatenate([y_gla, y_nsa, y_ssd], axis=-1)
        h = h + mix @ w_out[l]
        u = rms_norm(h, norm2_w[l])
        h = h + jnp.square(jax.nn.relu(u @ w_up[l])) @ w_down[l]
    return rms_norm(h, final_norm_w)
```

```cpp
#include <hip/hip_runtime.h>
#include <hip/hip_cooperative_groups.h>
#include <cstdio>
#include <cstdint>
namespace cg = cooperative_groups;

#ifndef MK_MULTI_LAUNCH
#define MK_MULTI_LAUNCH 0
#endif

#define LAS __attribute__((address_space(3)))
typedef _Float16 h16;
typedef _Float16 h16x8 __attribute__((ext_vector_type(8)));
typedef _Float16 h16x4 __attribute__((ext_vector_type(4)));
typedef _Float16 h16x2 __attribute__((ext_vector_type(2)));
typedef float f32x4 __attribute__((ext_vector_type(4)));
typedef float f32x2 __attribute__((ext_vector_type(2)));
typedef unsigned u32x4 __attribute__((ext_vector_type(4)));
typedef unsigned u32x2 __attribute__((ext_vector_type(2)));

constexpr int BATCH = 4, SEQ = 8192, DM = 1024, MTOK = BATCH * SEQ, DEPTH = 2;
constexpr int DIN = 3364, PN = 3584, DFF = 4096;
constexpr float EPS = 1e-6f;
constexpr int C_GQ = 0, C_GK = 128, C_GV = 256, C_GR = 512, C_NQ = 768, C_NKV = 1024, C_SZ = 1792, C_SX = 2304, C_SM = 3328;
constexpr int C_KCMP = C_NKV, C_VCMP = C_NKV + 128, C_KSLC = C_NKV + 256, C_VSLC = C_NKV + 384, C_KWIN = C_NKV + 512, C_VWIN = C_NKV + 640;
constexpr int PSM_W = 64;

constexpr size_t MiB = 1u << 20;
constexpr size_t WS_WIN = 2 * MiB;
constexpr size_t WS_WOUT = 16 * MiB;
constexpr size_t WS_WUP = 20 * MiB;
constexpr size_t WS_WDN = 36 * MiB;
constexpr size_t WS_W1T = 52 * MiB;
constexpr size_t WS_W2T = 54 * MiB;
constexpr size_t WS_B1 = 54 * MiB + 256 * 1024;
constexpr size_t WS_ROPE = 55 * MiB;
constexpr size_t WS_XN = 60 * MiB;
constexpr size_t WS_PROJ = 124 * MiB;
constexpr size_t WS_HID = 124 * MiB;
constexpr size_t WS_XBCC = 348 * MiB;
constexpr size_t WS_SSDST = 412 * MiB;
constexpr size_t WS_GLAST = 476 * MiB;
constexpr size_t WS_PSM = 492 * MiB;
constexpr size_t WS_KC = 500 * MiB;
constexpr size_t WS_VC = 500 * MiB + 512 * 1024;
constexpr size_t WS_SSQ = 501 * MiB;
constexpr size_t WS_DTV = 502 * MiB;
constexpr size_t WS_ACS = 503 * MiB;
constexpr size_t WS_CD = 504 * MiB;
constexpr size_t WS_GLAG = 504 * MiB + 64 * 1024;
constexpr size_t WS_END = 505 * MiB;

constexpr int LDS_BYTES = 147456;
extern __shared__ __attribute__((aligned(16))) unsigned char g_lds[];

struct Params { const float* in[24]; float* out; unsigned char* ws; int ph_lo, ph_hi; };

__constant__ float ROPE_INV[32] = {
 1.000000000e+00f, 7.498942614e-01f, 5.623413324e-01f, 4.216965139e-01f, 3.162277639e-01f, 2.371373773e-01f, 1.778279394e-01f, 1.333521307e-01f,
 1.000000015e-01f, 7.498941571e-02f, 5.623413250e-02f, 4.216965288e-02f, 3.162277490e-02f, 2.371373773e-02f, 1.778279431e-02f, 1.333521493e-02f,
 9.999999776e-03f, 7.498941850e-03f, 5.623413250e-03f, 4.216964822e-03f, 3.162277630e-03f, 2.371373586e-03f, 1.778279431e-03f, 1.333521446e-03f,
 1.000000047e-03f, 7.498942432e-04f, 5.623413017e-04f, 4.216965172e-04f, 3.162277571e-04f, 2.371373703e-04f, 1.778279402e-04f, 1.333521504e-04f };

__device__ __forceinline__ f32x4 mfma16(h16x8 a, h16x8 b, f32x4 c) { return __builtin_amdgcn_mfma_f32_16x16x32_f16(a, b, c, 0, 0, 0); }
__device__ __forceinline__ float wave_sum(float v) {
#pragma unroll
    for (int o = 1; o < 64; o <<= 1) v += __shfl_xor(v, o);
    return v;
}
__device__ __forceinline__ float sigmoidf_(float x) { return 1.f / (1.f + __expf(-x)); }
__device__ __forceinline__ float siluf_(float x) { return x / (1.f + __expf(-x)); }
__device__ __forceinline__ float softplusf_(float x) { return fmaxf(x, 0.f) + log1pf(__expf(-fabsf(x))); }
__device__ __forceinline__ unsigned pkh(float lo, float hi) { h16x2 v = {(h16)lo, (h16)hi}; return __builtin_bit_cast(unsigned, v); }

__device__ __forceinline__ int opaque_tid() { int t = threadIdx.x; asm volatile("" : "+v"(t)); return t; }
namespace pg8 {
typedef unsigned short bf16_t;
constexpr int BM = 256, BK = 64, HALF = 128, HTB = HALF * BK * 2, STAGE_BYTES = 8 * HTB, NXCD = 8, WGM = 8;
__host__ __device__ __forceinline__ int lds_byte(int r, int c) { const int st = (r >> 4) * 2 + (c >> 5), rr = r & 15, cc = c & 31, ob = rr * 64 + cc * 2; return st * 1024 + (ob ^ (((ob >> 9) & 1) << 5)); }
__host__ __device__ __forceinline__ void stage_rc(int b, int& R, int& C) { const int st = b / 1024, sb = b % 1024, swz = sb ^ (((sb >> 9) & 1) << 5); R = (st >> 1) * 16 + swz / 64; C = (st & 1) * 32 + (swz % 64) / 2; }
__host__ __device__ __forceinline__ int perm32(int rho) { const int n = rho >> 4, i = rho & 15; return 8 * (i >> 2) + 4 * n + (i & 3); }
struct Unit { int pm, pn; };
struct Gemm { const bf16_t* A; const bf16_t* Bt; int M, N, K; };
struct StaticOrder {
    int nM, nN, nwg, G, c;
    __device__ void init(int M, int N, int G_, int c_) { nM = M / BM; nN = N / BM; nwg = nM * nN; G = G_; c = c_; }
    __device__ bool next(int i, Unit& u) const {
        const long L = (long)i * G + c; if (L >= nwg) return false;
        int wgid = (int)L; { const int q = nwg / NXCD, r = nwg % NXCD, xcd = wgid % NXCD, off = wgid / NXCD; wgid = (xcd < r ? xcd * (q + 1) : r * (q + 1) + (xcd - r) * q) + off; }
        const int nig = WGM * nN, gid = wgid / nig, fm = gid * WGM, gsz = (nM - fm) < WGM ? (nM - fm) : WGM;
        u.pm = fm + ((wgid % nig) % gsz); u.pn = (wgid % nig) / gsz; return true;
    }
};
struct EpiProj {
    static constexpr bool PERM = true;
    h16* O; float* PSM;
    __device__ __forceinline__ void operator()(const f32x4 (&acc)[2][2][4][2], const Unit& u, int wr, int wc, int fr, int fq) const {
        const int row0 = u.pm * BM + wr * 64 + fr, col0 = u.pn * BM + wc * 32 + 8 * fq;
#pragma unroll
        for (int ai = 0; ai < 2; ++ai)
#pragma unroll
            for (int m = 0; m < 4; ++m) { const int row = row0 + ai * HALF + m * 16;
#pragma unroll
                for (int bj = 0; bj < 2; ++bj) { const f32x4 v0 = acc[ai][bj][m][0], v1 = acc[ai][bj][m][1]; const int c = col0 + bj * HALF;
                    u32x4 w; w.x = pkh(v0[0], v0[1]); w.y = pkh(v0[2], v0[3]); w.z = pkh(v1[0], v1[1]); w.w = pkh(v1[2], v1[3]);
                    *(u32x4*)(O + (size_t)row * PN + c) = w;
                    if (c >= C_SM && c < C_SM + PSM_W) { float* p = PSM + (size_t)row * PSM_W + (c - C_SM); *(f32x4*)p = v0; *(f32x4*)(p + 4) = v1; } } }
    }
};
struct EpiHid {
    static constexpr bool PERM = true;
    h16* O;
    __device__ __forceinline__ void operator()(const f32x4 (&acc)[2][2][4][2], const Unit& u, int wr, int wc, int fr, int fq) const {
        const int row0 = u.pm * BM + wr * 64 + fr, col0 = u.pn * BM + wc * 32 + 8 * fq;
#pragma unroll
        for (int ai = 0; ai < 2; ++ai)
#pragma unroll
            for (int m = 0; m < 4; ++m) { const int row = row0 + ai * HALF + m * 16;
#pragma unroll
                for (int bj = 0; bj < 2; ++bj) { f32x4 v0 = acc[ai][bj][m][0], v1 = acc[ai][bj][m][1];
#pragma unroll
                    for (int e = 0; e < 4; ++e) { float a = fmaxf(v0[e], 0.f), b = fmaxf(v1[e], 0.f); v0[e] = a * a; v1[e] = b * b; }
                    u32x4 w; w.x = pkh(v0[0], v0[1]); w.y = pkh(v0[2], v0[3]); w.z = pkh(v1[0], v1[1]); w.w = pkh(v1[2], v1[3]);
                    *(u32x4*)(O + (size_t)row * DFF + col0 + bj * HALF) = w; } }
    }
};
struct EpiRes {
    static constexpr bool PERM = false;
    const float* base; float* out;
    __device__ __forceinline__ void operator()(const f32x4 (&acc)[2][2][4][2], const Unit& u, int wr, int wc, int fr, int fq) const {
        const int col0 = u.pn * BM + wc * 32 + 4 * fq;
#pragma unroll
        for (int ai = 0; ai < 2; ++ai)
#pragma unroll
            for (int m = 0; m < 4; ++m) { const size_t off = (size_t)(u.pm * BM + ai * HALF + wr * 64 + m * 16 + fr) * DM + col0;
#pragma unroll
                for (int bj = 0; bj < 2; ++bj)
#pragma unroll
                    for (int n = 0; n < 2; ++n) { const f32x4 bs = *(const f32x4*)(base + off + bj * HALF + n * 16); *(f32x4*)(out + off + bj * HALF + n * 16) = bs + acc[ai][bj][m][n]; } }
    }
};

template <class Epi>
__device__ __forceinline__ void gemm_phase(LAS unsigned char* lds, const Gemm g, const StaticOrder& S, const Epi& E) {
    const int tid = opaque_tid(), wid = __builtin_amdgcn_readfirstlane(tid >> 6), lane = tid & 63, wr = wid >> 2, wc = wid & 3, fr = lane & 15, fq = lane >> 4;
    const int K = g.K, nt = K / BK;
    unsigned voffA[2], voffB[2];
#pragma unroll
    for (int i = 0; i < 2; ++i) { int R, C; stage_rc(tid * 16 + i * 8192, R, C); const int Rb = Epi::PERM ? ((R & ~31) + perm32(R & 31)) : R;
        voffA[i] = (unsigned)(R * K + C) * 2u; voffB[i] = (unsigned)(Rb * K + C) * 2u; }
    const size_t kstep = (size_t)(BK * 2);
    const size_t hstep = (size_t)HALF * K * 2;
    const size_t tstep = 2 * hstep;
    const unsigned ldsw = (unsigned)wid * 1024u;
    const int aoff = lds_byte(wr * 64 + fr, fq * 8), boff = lds_byte(wc * 32 + fr, fq * 8);
#define PG8_SA(b, h) (((b) * 2 + (h)) * HTB)
#define PG8_SB(b, h) ((4 + (b) * 2 + (h)) * HTB)
#define PG8_STAGE(bufoff, gbase, voff) do { _Pragma("unroll") for (int _i = 0; _i < 2; ++_i) \
        __builtin_amdgcn_global_load_lds((const unsigned*)((const char*)(gbase) + (voff)[_i]), (LAS unsigned*)(lds + (bufoff) + ldsw + _i * 8192), 16, 0, 0); } while (0)
#define PG8_LDA(dst, b, h) do { _Pragma("unroll") for (int m = 0; m < 4; ++m) _Pragma("unroll") for (int k = 0; k < 2; ++k) dst[m][k] = *(const LAS h16x8*)(lds + PG8_SA(b, h) + aoff + m * 2048 + k * 1024); } while (0)
#define PG8_LDB(dst, b, h) do { _Pragma("unroll") for (int n = 0; n < 2; ++n) _Pragma("unroll") for (int k = 0; k < 2; ++k) dst[n][k] = *(const LAS h16x8*)(lds + PG8_SB(b, h) + boff + n * 2048 + k * 1024); } while (0)
#define PG8_MMA(ai, bj, At, Bt) do { __builtin_amdgcn_s_setprio(1); _Pragma("unroll") for (int m = 0; m < 4; ++m) _Pragma("unroll") for (int n = 0; n < 2; ++n) _Pragma("unroll") for (int k = 0; k < 2; ++k) \
        acc[ai][bj][m][n] = __builtin_amdgcn_mfma_f32_16x16x32_f16(Bt[n][k], At[m][k], acc[ai][bj][m][n], 0, 0, 0); __builtin_amdgcn_s_setprio(0); } while (0)
#define PG8_WAIT_V(n) asm volatile("s_waitcnt vmcnt(" #n ")" ::: "memory")
#define PG8_WAIT_L(n) asm volatile("s_waitcnt lgkmcnt(" #n ")" ::: "memory")
#define PG8_BAR __builtin_amdgcn_s_barrier()
#define PG8_SCHED __builtin_amdgcn_sched_barrier(0)
    Unit cur, nxt; int ui = 0;
    if (!S.next(0, cur)) return;
    f32x4 acc[2][2][4][2];
#pragma unroll
    for (int a = 0; a < 2; ++a)
#pragma unroll
        for (int b = 0; b < 2; ++b)
#pragma unroll
            for (int m = 0; m < 4; ++m)
#pragma unroll
                for (int n = 0; n < 2; ++n) acc[a][b][m][n] = (f32x4){0.f, 0.f, 0.f, 0.f};
    h16x8 At[4][2], B0[2][2], B1[2][2];
    const char* cA = (const char*)g.A + (size_t)cur.pm * tstep; const char* cB = (const char*)g.Bt + (size_t)cur.pn * tstep;
    PG8_STAGE(PG8_SB(0, 0), cB, voffB); PG8_STAGE(PG8_SB(0, 1), cB + hstep, voffB); PG8_STAGE(PG8_SA(0, 0), cA, voffA); PG8_STAGE(PG8_SA(0, 1), cA + hstep, voffA);
    if (wr == 1) PG8_BAR;
    PG8_WAIT_V(2); PG8_BAR;
    PG8_STAGE(PG8_SB(1, 0), cB + kstep, voffB); PG8_STAGE(PG8_SA(1, 0), cA + kstep, voffA); PG8_STAGE(PG8_SB(1, 1), cB + hstep + kstep, voffB);
    PG8_WAIT_V(6); PG8_BAR;
    for (;;) {
        const bool has_next = S.next(ui + 1, nxt);
        const char* nA = has_next ? (const char*)g.A + (size_t)nxt.pm * tstep : cA; const char* nB = has_next ? (const char*)g.Bt + (size_t)nxt.pn * tstep : cB;
        for (int t = 0; t < nt; t += 2) {
            const bool last = (t == nt - 2);
            const char* a1 = cA + (size_t)(t + 1) * kstep;
            const char* a2 = last ? nA : cA + (size_t)(t + 2) * kstep; const char* b2 = last ? nB : cB + (size_t)(t + 2) * kstep;
            const char* a3 = a2 + kstep; const char* b3 = b2 + kstep;
            PG8_LDB(B0, 0, 0); PG8_LDB(B1, 0, 1); PG8_SCHED; PG8_LDA(At, 0, 0); PG8_STAGE(PG8_SA(1, 1), a1 + hstep, voffA);
            PG8_WAIT_V(8); PG8_WAIT_L(0); PG8_BAR; PG8_MMA(0, 0, At, B0); PG8_MMA(0, 1, At, B1); PG8_BAR; PG8_SCHED;
            PG8_LDA(At, 0, 1); PG8_STAGE(PG8_SB(0, 0), b2, voffB); PG8_STAGE(PG8_SB(0, 1), b2 + hstep, voffB); PG8_STAGE(PG8_SA(0, 0), a2, voffA);
            PG8_WAIT_V(8); PG8_WAIT_L(0); PG8_BAR; PG8_MMA(1, 0, At, B0); PG8_MMA(1, 1, At, B1); PG8_BAR; PG8_SCHED;
            PG8_LDB(B0, 1, 0); PG8_LDB(B1, 1, 1); PG8_SCHED; PG8_LDA(At, 1, 0); PG8_STAGE(PG8_SA(0, 1), a2 + hstep, voffA);
            PG8_WAIT_V(8); PG8_WAIT_L(0); PG8_BAR; PG8_MMA(0, 0, At, B0); PG8_MMA(0, 1, At, B1); PG8_BAR; PG8_SCHED;
            PG8_LDA(At, 1, 1); PG8_STAGE(PG8_SB(1, 0), b3, voffB); PG8_STAGE(PG8_SB(1, 1), b3 + hstep, voffB); PG8_STAGE(PG8_SA(1, 0), a3, voffA);
            PG8_WAIT_V(8); PG8_WAIT_L(0); PG8_BAR; PG8_MMA(1, 0, At, B0); PG8_MMA(1, 1, At, B1); PG8_BAR; PG8_SCHED;
        }
        if (wr == 0) PG8_BAR;
        E(acc, cur, wr, wc, fr, fq);
        if (!has_next) break;
#pragma unroll
        for (int a = 0; a < 2; ++a)
#pragma unroll
            for (int b = 0; b < 2; ++b)
#pragma unroll
                for (int m = 0; m < 4; ++m)
#pragma unroll
                    for (int n = 0; n < 2; ++n) acc[a][b][m][n] = (f32x4){0.f, 0.f, 0.f, 0.f};
        cur = nxt; cA = nA; cB = nB; ++ui;
        if (wr == 1) PG8_BAR;
    }
    PG8_WAIT_V(0);
    PG8_BAR;
#undef PG8_SA
#undef PG8_SB
#undef PG8_STAGE
#undef PG8_LDA
#undef PG8_LDB
#undef PG8_MMA
#undef PG8_WAIT_V
#undef PG8_WAIT_L
#undef PG8_BAR
#undef PG8_SCHED
}
}

#define TIDS const int tid = opaque_tid(); const int lane = tid & 63; const int wave = __builtin_amdgcn_readfirstlane(tid >> 6); (void)lane; (void)wave;
struct Ctx {
    const float* in[24]; float* out; unsigned char* ws;
    int G, bid;
    h16 *WIN, *WOUT, *WUP, *WDN, *W1T, *W2T, *XN, *PROJ, *HID, *XBCC, *KC, *VC;
    float *B1, *ROPE, *SSDST, *GLAST, *PSM, *SSQ, *DTV, *ACS, *CD, *GLAG;
};
__device__ __forceinline__ void make_ctx(Ctx& C, const Params* kp0) {
    const Params* kp = kp0; asm volatile("" : "+s"(kp));
#pragma unroll
    for (int i = 0; i < 24; ++i) C.in[i] = kp->in[i];
    C.out = kp->out; unsigned char* ws = kp->ws; C.ws = ws; C.G = gridDim.x; C.bid = blockIdx.x;
    C.WIN = (h16*)(ws + WS_WIN); C.WOUT = (h16*)(ws + WS_WOUT); C.WUP = (h16*)(ws + WS_WUP); C.WDN = (h16*)(ws + WS_WDN); C.W1T = (h16*)(ws + WS_W1T); C.W2T = (h16*)(ws + WS_W2T);
    C.XN = (h16*)(ws + WS_XN); C.PROJ = (h16*)(ws + WS_PROJ); C.HID = (h16*)(ws + WS_HID); C.XBCC = (h16*)(ws + WS_XBCC); C.KC = (h16*)(ws + WS_KC); C.VC = (h16*)(ws + WS_VC);
    C.B1 = (float*)(ws + WS_B1); C.ROPE = (float*)(ws + WS_ROPE); C.SSDST = (float*)(ws + WS_SSDST); C.GLAST = (float*)(ws + WS_GLAST); C.PSM = (float*)(ws + WS_PSM);
    C.SSQ = (float*)(ws + WS_SSQ); C.DTV = (float*)(ws + WS_DTV); C.ACS = (float*)(ws + WS_ACS); C.CD = (float*)(ws + WS_CD); C.GLAG = (float*)(ws + WS_GLAG);
}

__device__ __forceinline__ int win_src_col(int n) {
    if (n < 512) return n;
    if (n < 768) return n - 512 + 528;
    if (n < 1024) return n - 768 + 784;
    if (n < 1792) return n - 1024 + 1040;
    if (n < 2304) return n - 1792 + 1820;
    if (n < 3328) return n - 2304 + 2332;
    const int r = n - 3328;
    if (r < 16) return 512 + r;
    if (r < 28) return 1808 + (r - 16);
    if (r < 36) return 3356 + (r - 28);
    return -1;
}
template <bool MAPW>
__device__ __forceinline__ void transpose_item(const float* W, int K, int Nsrc, int Ndst, h16* WT, const float* kscale, float* scr, int item, int lane) {
    const int nblk = Ndst / 32, kb = item / nblk, nb = item % nblk, k0 = 64 * kb, n0 = 32 * nb;
    const int nd = n0 + (lane & 31); const int sc = MAPW ? win_src_col(nd) : nd;
#pragma unroll 8
    for (int i = 0; i < 32; ++i) { const int kk = 2 * i + (lane >> 5); float v = 0.f;
        if (sc >= 0) { v = W[(size_t)(k0 + kk) * Nsrc + sc]; if (kscale) v *= kscale[k0 + kk]; }
        scr[kk * 33 + (lane & 31)] = v; }
    asm volatile("s_waitcnt lgkmcnt(0)" ::: "memory");
    const int c = lane & 7;
#pragma unroll
    for (int j = 0; j < 4; ++j) { const int n = (lane >> 3) + 8 * j; const float* s = scr + (8 * c) * 33 + n;
        u32x4 o; o.x = pkh(s[0 * 33], s[1 * 33]); o.y = pkh(s[2 * 33], s[3 * 33]); o.z = pkh(s[4 * 33], s[5 * 33]); o.w = pkh(s[6 * 33], s[7 * 33]);
        *(u32x4*)(WT + (size_t)(n0 + n) * K + k0 + 8 * c) = o; }
    asm volatile("s_waitcnt lgkmcnt(0)" ::: "memory");
}
__device__ __forceinline__ void rms_row_to_h16(const float* xrow, h16* orow, int lane) {
    const f32x4* xr = (const f32x4*)xrow + lane; f32x4 v[4]; float s = 0.f;
#pragma unroll
    for (int j = 0; j < 4; ++j) { v[j] = xr[64 * j]; s += (v[j].x * v[j].x + v[j].y * v[j].y) + (v[j].z * v[j].z + v[j].w * v[j].w); }
    const float rs = 1.0f / sqrtf(wave_sum(s) * (1.f / DM) + EPS);
    u32x2* o8 = (u32x2*)orow + lane;
#pragma unroll
    for (int j = 0; j < 4; ++j) { u32x2 w; w.x = pkh(v[j].x * rs, v[j].y * rs); w.y = pkh(v[j].z * rs, v[j].w * rs); o8[64 * j] = w; }
}
__device__ __forceinline__ void sincos_acc(float angf, float& c, float& s) {
    const double x = (double)angf; const double n = __builtin_rint(x * 0.63661977236758134308);
    const double r = __builtin_fma(-n, 1.5707963267948966192, x) - n * 6.123233995736766036e-17;
    const double r2 = r * r;
    double sp = -7.6471637318198164759e-13; sp = sp * r2 + 1.6059043836821614599e-10; sp = sp * r2 - 2.5052108385441718775e-08; sp = sp * r2 + 2.7557319223985890653e-06;
    sp = sp * r2 - 1.9841269841269841270e-04; sp = sp * r2 + 8.3333333333333333333e-03; sp = sp * r2 - 1.6666666666666666667e-01; const double sn = r + r * r2 * sp;
    double cp = 4.7794773323873852974e-14; cp = cp * r2 - 1.1470745597729724714e-11; cp = cp * r2 + 2.0876756987868098979e-09; cp = cp * r2 - 2.7557319223985890653e-07;
    cp = cp * r2 + 2.4801587301587301587e-05; cp = cp * r2 - 1.3888888888888888889e-03; cp = cp * r2 + 4.1666666666666666667e-02; cp = cp * r2 - 0.5; const double cs = 1.0 + r2 * cp;
    const int q = ((int)n) & 3;
    const double so = (q == 0) ? sn : (q == 1) ? cs : (q == 2) ? -sn : -cs;
    const double co = (q == 0) ? cs : (q == 1) ? -sn : (q == 2) ? -cs : sn;
    c = (float)co; s = (float)so;
}
__device__ __forceinline__ void phase_prep(const Ctx& C) {
    TIDS
    float* scr = (float*)(g_lds) + wave * (64 * 33);
    const int gw = C.bid * 8 + wave, NGW = C.G * 8;
    constexpr int I_IN = 16 * (PN / 32), I_OUT = 16 * 32, I_UP = 16 * 128, I_DN = 64 * 32, I_W1 = 32 * 4, I_W2 = 2 * 2;
    constexpr int PER_L = I_IN + I_OUT + I_UP + I_DN + 2 * I_W1 + 2 * I_W2;
    for (int it = gw; it < DEPTH * PER_L; it += NGW) {
        const int l = it / PER_L; int r = it % PER_L;
        if (r < I_IN) { transpose_item<true>(C.in[2] + (size_t)l * DM * DIN, DM, DIN, PN, C.WIN + (size_t)l * PN * DM, C.in[1] + l * DM, scr, r, lane); continue; } r -= I_IN;
        if (r < I_OUT) { transpose_item<false>(C.in[19] + (size_t)l * DM * DM, DM, DM, DM, C.WOUT + (size_t)l * DM * DM, nullptr, scr, r, lane); continue; } r -= I_OUT;
        if (r < I_UP) { transpose_item<false>(C.in[21] + (size_t)l * DM * DFF, DM, DFF, DFF, C.WUP + (size_t)l * DFF * DM, C.in[20] + l * DM, scr, r, lane); continue; } r -= I_UP;
        if (r < I_DN) { transpose_item<false>(C.in[22] + (size_t)l * DFF * DM, DFF, DM, DM, C.WDN + (size_t)l * DM * DFF, nullptr, scr, r, lane); continue; } r -= I_DN;
        if (r < 2 * I_W1) { const int kv = r / I_W1; transpose_item<false>(C.in[kv ? 10 : 7] + (size_t)l * 2048 * 128, 2048, 128, 128, C.W1T + (size_t)(l * 2 + kv) * 128 * 2048, nullptr, scr, r % I_W1, lane); continue; } r -= 2 * I_W1;
        { const int kv = r / I_W2; transpose_item<false>(C.in[kv ? 11 : 8] + (size_t)l * 128 * 64, 128, 64, 64, C.W2T + (size_t)(l * 2 + kv) * 64 * 128, nullptr, scr, r % I_W2, lane); }
    }
    for (int it = gw; it < DEPTH * 2 * 128; it += NGW) {
        const int l = it / 256, kv = (it / 128) & 1, j = it & 127;
        const float* pos = C.in[kv ? 9 : 6] + (size_t)l * 2048; const float* w1 = C.in[kv ? 10 : 7] + (size_t)l * 2048 * 128;
        float s = 0.f;
        for (int f = lane; f < 2048; f += 64) s += pos[f] * w1[(size_t)f * 128 + j];
        s = wave_sum(s);
        if (lane == 0) C.B1[it] = s;
    }
    for (int e = C.bid * 512 + tid; e < SEQ * 32; e += C.G * 512) {
        const int pos = e >> 5, i = e & 31; const float ang = (float)pos * ROPE_INV[i];
        float cs, sn; sincos_acc(ang, cs, sn); C.ROPE[2 * e] = cs; C.ROPE[2 * e + 1] = sn;
    }
    for (int m = gw; m < MTOK; m += NGW) rms_row_to_h16(C.in[0] + (size_t)m * DM, C.XN + (size_t)m * DM, lane);
}

__device__ __forceinline__ void phase_tok(const Ctx& C, int l) {
    TIDS
    const int gw = C.bid * 8 + wave, NGW = C.G * 8;
    const float* cw = C.in[13] + (size_t)l * 4 * 1024; const float* cb = C.in[14] + (size_t)l * 1024; const float* dtb = C.in[15] + l * 8;
    for (int m = gw; m < MTOK; m += NGW) {
        const int t = m & (SEQ - 1);
        h16* prow = C.PROJ + (size_t)m * PN;
#pragma unroll
        for (int it = 0; it < 5; ++it) { const int pi = lane + 64 * it, hd = pi >> 5, i = pi & 31;
            const int base = (hd < 4) ? (C_NQ + hd * 64) : (hd < 6) ? (C_KCMP + (hd - 4) * 64) : (hd < 8) ? (C_KSLC + (hd - 6) * 64) : (C_KWIN + (hd - 8) * 64);
            const float cs = C.ROPE[2 * (t * 32 + i)], sn = C.ROPE[2 * (t * 32 + i) + 1];
            const float x1 = (float)prow[base + i], x2 = (float)prow[base + 32 + i]; const float sc = (hd < 4) ? 0.125f : 1.f;
            prow[base + i] = (h16)((x1 * cs - x2 * sn) * sc); prow[base + 32 + i] = (h16)((x2 * cs + x1 * sn) * sc); }
        { const int ch = lane * 16; float a[16];
#pragma unroll
            for (int e = 0; e < 16; ++e) a[e] = cb[ch + e];
#pragma unroll
            for (int i = 0; i < 4; ++i) { const int tt = t - 3 + i; if (tt < 0) continue;
                const h16* src = C.PROJ + (size_t)(m - 3 + i) * PN + C_SX + ch; const h16x8 x0 = *(const h16x8*)src, x1 = *(const h16x8*)(src + 8);
#pragma unroll
                for (int e = 0; e < 8; ++e) { a[e] += cw[i * 1024 + ch + e] * (float)x0[e]; a[8 + e] += cw[i * 1024 + ch + 8 + e] * (float)x1[e]; } }
            u32x4 o0, o1; o0.x = pkh(siluf_(a[0]), siluf_(a[1])); o0.y = pkh(siluf_(a[2]), siluf_(a[3])); o0.z = pkh(siluf_(a[4]), siluf_(a[5])); o0.w = pkh(siluf_(a[6]), siluf_(a[7]));
            o1.x = pkh(siluf_(a[8]), siluf_(a[9])); o1.y = pkh(siluf_(a[10]), siluf_(a[11])); o1.z = pkh(siluf_(a[12]), siluf_(a[13])); o1.w = pkh(siluf_(a[14]), siluf_(a[15]));
            h16* dst = C.XBCC + (size_t)m * 1024 + ch; *(u32x4*)dst = o0; *(u32x4*)(dst + 8) = o1; }
        if (lane < 8) C.DTV[(size_t)m * 8 + lane] = softplusf_(C.PSM[(size_t)m * PSM_W + 28 + lane] + dtb[lane]);
    }
}

__device__ __forceinline__ float gelu_tanh(float x) { const float u = 0.7978845608028654f * (x + 0.044715f * x * x * x); const float e = __expf(2.f * u); const float th = 1.f - 2.f / (e + 1.f); return 0.5f * x * (1.f + th); }
__device__ __forceinline__ void nsa_compress_unit(const Ctx& C, int l, int u) {
    const int kv = u >> 8, b = (u >> 6) & 3, g = (u >> 5) & 1, mt = u & 31;
    TIDS
    const int w = wave, cc = lane & 15, quad = lane >> 4;
    h16* Hs = (h16*)g_lds;
    const int n = mt * 16 + cc;
    const h16* W1T = C.W1T + (size_t)(l * 2 + kv) * 128 * 2048; const h16* W2T = C.W2T + (size_t)(l * 2 + kv) * 64 * 128; const float* B1 = C.B1 + (l * 2 + kv) * 128;
    const int col = (kv ? C_VCMP : C_KCMP) + g * 64 + quad * 8;
    f32x4 acc = {0.f, 0.f, 0.f, 0.f};
    const h16* brow = W1T + (size_t)(w * 16 + cc) * 2048 + quad * 8;
#pragma unroll 4
    for (int kk = 0; kk < 64; ++kk) {
        int tok = 16 * n + (kk >> 1); tok = tok < SEQ ? tok : SEQ - 1;
        const h16x8 a = *(const h16x8*)(C.PROJ + (size_t)(b * SEQ + tok) * PN + col + (kk & 1) * 32);
        const h16x8 bb = *(const h16x8*)(brow + kk * 32);
        acc = mfma16(a, bb, acc);
    }
    { const float bias = B1[w * 16 + cc];
#pragma unroll
        for (int j = 0; j < 4; ++j) Hs[(quad * 4 + j) * 136 + w * 16 + cc] = (h16)gelu_tanh(acc[j] + bias); }
    __syncthreads();
    if (w < 4) {
        f32x4 o = {0.f, 0.f, 0.f, 0.f};
#pragma unroll
        for (int kk = 0; kk < 4; ++kk) { const h16x8 a = *(const h16x8*)(Hs + cc * 136 + kk * 32 + quad * 8); const h16x8 bb = *(const h16x8*)(W2T + (size_t)(w * 16 + cc) * 128 + kk * 32 + quad * 8); o = mfma16(a, bb, o); }
        h16* dst = (kv ? C.VC : C.KC) + (size_t)((b * 2 + g) * 512 + mt * 16) * 64;
#pragma unroll
        for (int j = 0; j < 4; ++j) dst[(quad * 4 + j) * 64 + w * 16 + cc] = (h16)o[j];
    }
    __syncthreads();
}

__device__ __forceinline__ void ssd_states_unit(const Ctx& C, int l, int u) {
    const int b = u >> 9, c = (u >> 3) & 63, h = u & 7, g = h >> 2;
    TIDS
    const int w = wave, cc = lane & 15, quad = lane >> 4;
    const size_t row0 = (size_t)b * SEQ + c * 128;
    float* acs = (float*)g_lds; float* dtl = acs + 128; float* wl = acs + 256;
    h16* XT = (h16*)(g_lds + 2048);
    h16* BT = (h16*)(g_lds + 2048 + 17408);
    const float A = -__expf(C.in[16][l * 8 + h]);
    if (tid < 128) dtl[tid] = C.DTV[(row0 + tid) * 8 + h];
    __syncthreads();
    if (tid < 128) { float s = 0.f; for (int i = 0; i <= tid; ++i) s += dtl[i] * A; acs[tid] = s; }
    __syncthreads();
    if (tid < 128) { const float tot = acs[127]; wl[tid] = __expf(tot - acs[tid]) * dtl[tid]; C.ACS[(row0 + tid) * 8 + h] = acs[tid]; if (tid == 127) C.CD[(b * 64 + c) * 8 + h] = __expf(tot); }
    __syncthreads();
#pragma unroll
    for (int i = 0; i < 2; ++i) { const int ch = tid + 512 * i, tok = ch >> 3, c8 = ch & 7; const h16x8 v = *(const h16x8*)(C.XBCC + (row0 + tok) * 1024 + h * 64 + c8 * 8);
#pragma unroll
        for (int e = 0; e < 8; ++e) XT[(c8 * 8 + e) * 136 + tok] = v[e]; }
#pragma unroll
    for (int i = 0; i < 4; ++i) { const int ch = tid + 512 * i, tok = ch >> 4, c16 = ch & 15; const h16x8 v = *(const h16x8*)(C.XBCC + (row0 + tok) * 1024 + 512 + g * 128 + c16 * 8); const float ww = wl[tok];
#pragma unroll
        for (int e = 0; e < 8; ++e) BT[(c16 * 8 + e) * 136 + tok] = (h16)((float)v[e] * ww); }
    __syncthreads();
    const int mi = w & 3;
    float* dst = C.SSDST + (size_t)((b * 64 + c) * 8 + h) * 8192;
#pragma unroll
    for (int q = 0; q < 4; ++q) { const int ni = (w >> 2) * 4 + q; f32x4 acc = {0.f, 0.f, 0.f, 0.f};
#pragma unroll
        for (int kk = 0; kk < 4; ++kk) { const h16x8 a = *(const h16x8*)(XT + (mi * 16 + cc) * 136 + kk * 32 + quad * 8); const h16x8 bb = *(const h16x8*)(BT + (ni * 16 + cc) * 136 + kk * 32 + quad * 8); acc = mfma16(a, bb, acc); }
#pragma unroll
        for (int j = 0; j < 4; ++j) dst[(mi * 16 + quad * 4 + j) * 128 + ni * 16 + cc] = acc[j]; }
    __syncthreads();
}

__device__ __forceinline__ void ssd_y_unit(const Ctx& C, int l, int u) {
    const int b = u >> 9, c = (u >> 3) & 63, h = u & 7, g = h >> 2;
    TIDS
    const int w = wave, cc = lane & 15, quad = lane >> 4;
    const size_t row0 = (size_t)b * SEQ + c * 128;
    float* acs = (float*)g_lds; float* dtl = acs + 128;
    h16* Cm = (h16*)(g_lds + 2048);
    h16* Bm = (h16*)(g_lds + 2048 + 34816);
    h16* XT = (h16*)(g_lds + 2048 + 2 * 34816);
    h16* HE = (h16*)(g_lds + 2048 + 2 * 34816 + 17408);
    if (tid < 128) { acs[tid] = C.ACS[(row0 + tid) * 8 + h]; dtl[tid] = C.DTV[(row0 + tid) * 8 + h]; }
#pragma unroll
    for (int i = 0; i < 4; ++i) { const int ch = tid + 512 * i, tok = ch >> 4, c16 = ch & 15; const h16* src = C.XBCC + (row0 + tok) * 1024 + 512 + g * 128 + c16 * 8;
        *(h16x8*)(Bm + tok * 136 + c16 * 8) = *(const h16x8*)src; *(h16x8*)(Cm + tok * 136 + c16 * 8) = *(const h16x8*)(src + 256); }
#pragma unroll
    for (int i = 0; i < 2; ++i) { const int ch = tid + 512 * i, tok = ch >> 3, c8 = ch & 7; const h16x8 v = *(const h16x8*)(C.XBCC + (row0 + tok) * 1024 + h * 64 + c8 * 8);
#pragma unroll
        for (int e = 0; e < 8; ++e) XT[(c8 * 8 + e) * 136 + tok] = v[e]; }
    { const float* src = C.SSDST + (size_t)((b * 64 + c) * 8 + h) * 8192;
#pragma unroll
        for (int i = 0; i < 4; ++i) { const int e4 = tid + 512 * i, p = e4 >> 5, n4 = e4 & 31; const f32x4 v = *(const f32x4*)(src + e4 * 4);
            h16x4 o = {(h16)v.x, (h16)v.y, (h16)v.z, (h16)v.w}; *(h16x4*)(HE + p * 136 + n4 * 4) = o; } }
    __syncthreads();
    f32x4 cbt[8];
#pragma unroll
    for (int ni = 0; ni < 8; ++ni) { f32x4 acc = {0.f, 0.f, 0.f, 0.f};
#pragma unroll
        for (int kk = 0; kk < 4; ++kk) { const h16x8 a = *(const h16x8*)(Cm + (w * 16 + cc) * 136 + kk * 32 + quad * 8); const h16x8 bb = *(const h16x8*)(Bm + (ni * 16 + cc) * 136 + kk * 32 + quad * 8); acc = mfma16(a, bb, acc); }
        cbt[ni] = acc; }
    __syncthreads();
#pragma unroll
    for (int ni = 0; ni < 8; ++ni) { const int s = ni * 16 + cc; const float as_ = acs[s], ds_ = dtl[s];
#pragma unroll
        for (int j = 0; j < 4; ++j) { const int lr = w * 16 + quad * 4 + j; const float v = (s <= lr) ? cbt[ni][j] * __expf(acs[lr] - as_) * ds_ : 0.f; Bm[lr * 136 + s] = (h16)v; } }
    __syncthreads();
    const float Dh = C.in[17][l * 8 + h];
    float ssq[4] = {0.f, 0.f, 0.f, 0.f};
#pragma unroll
    for (int ni = 0; ni < 4; ++ni) { f32x4 acc = {0.f, 0.f, 0.f, 0.f};
#pragma unroll
        for (int kk = 0; kk < 4; ++kk) { const h16x8 a = *(const h16x8*)(Cm + (w * 16 + cc) * 136 + kk * 32 + quad * 8); const h16x8 bb = *(const h16x8*)(HE + (ni * 16 + cc) * 136 + kk * 32 + quad * 8); acc = mfma16(a, bb, acc); }
#pragma unroll
        for (int j = 0; j < 4; ++j) acc[j] *= __expf(acs[w * 16 + quad * 4 + j]);
#pragma unroll
        for (int kk = 0; kk < 4; ++kk) { const h16x8 a = *(const h16x8*)(Bm + (w * 16 + cc) * 136 + kk * 32 + quad * 8); const h16x8 bb = *(const h16x8*)(XT + (ni * 16 + cc) * 136 + kk * 32 + quad * 8); acc = mfma16(a, bb, acc); }
        const int p = ni * 16 + cc;
#pragma unroll
        for (int j = 0; j < 4; ++j) { const int lr = w * 16 + quad * 4 + j; const float x = (float)XT[p * 136 + lr];
            const float z = (float)C.PROJ[(row0 + lr) * PN + C_SZ + h * 64 + p]; const h16 yh = (h16)((acc[j] + Dh * x) * siluf_(z));
            C.XN[(row0 + lr) * 1024 + 512 + h * 64 + p] = yh; const float yr = (float)yh; ssq[j] += yr * yr; } }
#pragma unroll
    for (int j = 0; j < 4; ++j) { float s = ssq[j]; s += __shfl_xor(s, 1); s += __shfl_xor(s, 2); s += __shfl_xor(s, 4); s += __shfl_xor(s, 8);
        if (cc == 0) C.SSQ[(row0 + w * 16 + quad * 4 + j) * 8 + h] = s; }
    __syncthreads();
}

template <int PASS>
__device__ __forceinline__ void gla_block_unit(const Ctx& C, int l, int bu) {
    TIDS
    const int w = wave; const int wu = bu * 8 + w;
    const int bh = wu >> 7, seg = wu & 127, b = bh >> 2, h = bh & 3;
    const size_t row0 = (size_t)b * SEQ + seg * 64;
    float* as_ = (float*)(g_lds) + w * 1536; float* qs = as_ + 512; float* ks = as_ + 1024;
    const int k = lane & 31, half = lane >> 5;
    float w2r[16];
#pragma unroll
    for (int r = 0; r < 16; ++r) w2r[r] = C.in[3][(size_t)l * 16 * 128 + r * 128 + h * 32 + k];
    const float bk = C.in[4][l * 128 + h * 32 + k];
    float S[32];
    float* gst = C.GLAST + (size_t)(bh * 128 + seg) * 2048;
    if (PASS == 1) {
#pragma unroll
        for (int kk = 0; kk < 32; ++kk) S[kk] = gst[kk * 64 + lane];
    } else {
#pragma unroll
        for (int kk = 0; kk < 32; ++kk) S[kk] = 0.f;
    }
    float gtot = 1.f;
    const float gnw = C.in[5][l * 256 + h * 64 + lane];
    for (int bt = 0; bt < 4; ++bt) {
#pragma unroll 1
        for (int it = 0; it < 8; ++it) { const int tok = 2 * it + half; const size_t row = row0 + bt * 16 + tok;
            const f32x4* gp = (const f32x4*)(C.PSM + row * PSM_W); float z = bk;
#pragma unroll
            for (int r4 = 0; r4 < 4; ++r4) { const f32x4 gv = gp[r4]; z += gv.x * w2r[4 * r4] + gv.y * w2r[4 * r4 + 1] + gv.z * w2r[4 * r4 + 2] + gv.w * w2r[4 * r4 + 3]; }
            const float la = -softplusf_(-z) * (1.f / 16.f); const float a = __expf(la);
            as_[tok * 32 + k] = a; gtot *= a;
            qs[tok * 32 + k] = (float)C.PROJ[row * PN + C_GQ + h * 32 + k] * 0.17677669529663687f;
            ks[tok * 32 + k] = (float)C.PROJ[row * PN + C_GK + h * 32 + k]; }
        __syncthreads();
#pragma unroll 1
        for (int tok = 0; tok < 16; ++tok) { const size_t row = row0 + bt * 16 + tok;
            const float v = (float)C.PROJ[row * PN + C_GV + h * 64 + lane]; float acc = 0.f;
#pragma unroll
            for (int k4 = 0; k4 < 8; ++k4) { const f32x4 a4 = *(const f32x4*)(as_ + tok * 32 + 4 * k4), kk4 = *(const f32x4*)(ks + tok * 32 + 4 * k4);
#pragma unroll
                for (int e = 0; e < 4; ++e) S[4 * k4 + e] = a4[e] * S[4 * k4 + e] + kk4[e] * v;
                if (PASS == 1) { const f32x4 q4 = *(const f32x4*)(qs + tok * 32 + 4 * k4);
#pragma unroll
                    for (int e = 0; e < 4; ++e) acc += q4[e] * S[4 * k4 + e]; } }
            if (PASS == 1) { const float ssq = wave_sum(acc * acc); const float rs = 1.0f / sqrtf(ssq * (1.f / 64.f) + EPS);
                const float r = (float)C.PROJ[row * PN + C_GR + h * 64 + lane];
                C.XN[row * 1024 + h * 64 + lane] = (h16)(acc * rs * gnw * siluf_(r)); } }
        __syncthreads();
    }
    if (PASS == 0) {
#pragma unroll
        for (int kk = 0; kk < 32; ++kk) gst[kk * 64 + lane] = S[kk];
        gtot *= __shfl_xor(gtot, 32);
        if (lane < 32) C.GLAG[(size_t)(bh * 128 + seg) * 32 + lane] = gtot;
    }
}

__device__ __forceinline__ void phase_scans(const Ctx& C) {
    TIDS
    for (int e = C.bid * 512 + tid; e < BATCH * 8 * 8192; e += C.G * 512) {
        const int bh = e >> 13, b = bh >> 3, h = bh & 7, pn = e & 8191;
        float* p = C.SSDST + (size_t)(b * 64 * 8 + h) * 8192 + pn; const float* cd = C.CD + b * 64 * 8 + h;
        float st = 0.f;
        for (int c0 = 0; c0 < 64; c0 += 8) { float v[8], d[8];
#pragma unroll
            for (int i = 0; i < 8; ++i) { v[i] = p[(size_t)(c0 + i) * 8 * 8192]; d[i] = cd[(c0 + i) * 8]; }
#pragma unroll
            for (int i = 0; i < 8; ++i) { p[(size_t)(c0 + i) * 8 * 8192] = st; st = d[i] * st + v[i]; } }
    }
    for (int e = C.bid * 512 + tid; e < 16 * 2048; e += C.G * 512) {
        const int bh = e >> 11, kv = e & 2047, k = kv >> 6;
        float* p = C.GLAST + (size_t)bh * 128 * 2048 + kv; const float* gg = C.GLAG + (size_t)bh * 128 * 32 + k;
        float st = 0.f;
        for (int s0 = 0; s0 < 128; s0 += 8) { float v[8], d[8];
#pragma unroll
            for (int i = 0; i < 8; ++i) { v[i] = p[(size_t)(s0 + i) * 2048]; d[i] = gg[(s0 + i) * 32]; }
#pragma unroll
            for (int i = 0; i < 8; ++i) { p[(size_t)(s0 + i) * 2048] = st; st = d[i] * st + v[i]; } }
    }
}

struct FlashState { float m, l; f32x4 O[4]; };
template <int MODE>
__device__ __forceinline__ void flash_tile(FlashState& st, const h16* Ks, const h16* VT, const h16x8 (&qf)[2], int kv0, int tq, bool selbit, int cc, int quad) {
    f32x4 s[4];
#pragma unroll
    for (int mt = 0; mt < 4; ++mt) { f32x4 a = {0.f, 0.f, 0.f, 0.f};
#pragma unroll
        for (int ks = 0; ks < 2; ++ks) { const h16x8 kf = *(const h16x8*)(Ks + (mt * 16 + cc) * 72 + ks * 32 + quad * 8); a = mfma16(kf, qf[ks], a); }
        s[mt] = a; }
    float tmax = -INFINITY;
#pragma unroll
    for (int mt = 0; mt < 4; ++mt)
#pragma unroll
        for (int j = 0; j < 4; ++j) { const int kp = kv0 + mt * 16 + quad * 4 + j;
            const bool ok = (MODE == 0) ? (selbit && kp <= tq) : (kp <= tq && kp > tq - 512);
            const float v = ok ? s[mt][j] : -INFINITY; s[mt][j] = v; tmax = fmaxf(tmax, v); }
    tmax = fmaxf(tmax, __shfl_xor(tmax, 16)); tmax = fmaxf(tmax, __shfl_xor(tmax, 32));
    const float mnew = fmaxf(st.m, tmax); const float muse = (mnew == -INFINITY) ? 0.f : mnew;
    const float alpha = __expf(st.m - muse);
    float psum = 0.f;
#pragma unroll
    for (int mt = 0; mt < 4; ++mt)
#pragma unroll
        for (int j = 0; j < 4; ++j) { const float p = __expf(s[mt][j] - muse); s[mt][j] = p; psum += p; }
    st.l = st.l * alpha + psum; st.m = mnew;
#pragma unroll
    for (int md = 0; md < 4; ++md) st.O[md] *= alpha;
    h16x8 pf[2];
#pragma unroll
    for (int k2 = 0; k2 < 2; ++k2) pf[k2] = (h16x8){(h16)s[2 * k2][0], (h16)s[2 * k2][1], (h16)s[2 * k2][2], (h16)s[2 * k2][3], (h16)s[2 * k2 + 1][0], (h16)s[2 * k2 + 1][1], (h16)s[2 * k2 + 1][2], (h16)s[2 * k2 + 1][3]};
#pragma unroll
    for (int md = 0; md < 4; ++md)
#pragma unroll
        for (int k2 = 0; k2 < 2; ++k2) { const h16* vp = VT + (md * 16 + cc) * 72 + 32 * k2 + quad * 4; const h16x4 lo = *(const h16x4*)vp, hi = *(const h16x4*)(vp + 16);
            const h16x8 vf = {lo[0], lo[1], lo[2], lo[3], hi[0], hi[1], hi[2], hi[3]}; st.O[md] = mfma16(vf, pf[k2], st.O[md]); }
}
__device__ __forceinline__ void stage_kv(h16* Ks, h16* VT, const h16* ksrc, const h16* vsrc, size_t stride, int tid, bool do_v) {
    const int key = tid >> 3, c8 = tid & 7;
    const h16x8 kx = *(const h16x8*)(ksrc + (size_t)key * stride + c8 * 8);
    *(h16x8*)(Ks + key * 72 + c8 * 8) = kx;
    if (do_v) { const h16x8 vx = *(const h16x8*)(vsrc + (size_t)key * stride + c8 * 8);
#pragma unroll
        for (int e = 0; e < 8; ++e) VT[(c8 * 8 + e) * 72 + key] = vx[e]; }
}
__device__ __forceinline__ void nsa_attn_unit(const Ctx& C, int l, int b, int g, int qb) {
    TIDS
    const int w = wave, cc = lane & 15, quad = lane >> 4;
    const int r = cc >> 3, ti = cc & 7, tloc = 8 * w + ti, tq = 64 * qb + tloc, h = 2 * g + r;
    const size_t rowq = (size_t)b * SEQ + tq;
    h16* Ks = (h16*)g_lds; h16* VT = (h16*)(g_lds + 9216);
    float* imp = (float*)(g_lds + 18432);
    unsigned* sel = (unsigned*)(g_lds + 18432 + 32768);
    unsigned* uni = sel + 256;
    h16x8 qf[2];
#pragma unroll
    for (int ks = 0; ks < 2; ++ks) qf[ks] = *(const h16x8*)(C.PROJ + rowq * PN + C_NQ + h * 64 + ks * 32 + quad * 8);
    const h16* kcb = C.KC + (size_t)(b * 2 + g) * 512 * 64; const h16* vcb = C.VC + (size_t)(b * 2 + g) * 512 * 64;
    const int ncmp = 4 * qb + 3, ntile_c = (ncmp + 63) >> 6;
    float m1 = -INFINITY, l1 = 0.f;
    for (int tc = 0; tc < ntile_c; ++tc) {
        __syncthreads();
        stage_kv(Ks, VT, kcb + (size_t)tc * 64 * 64, vcb, 64, tid, false);
        __syncthreads();
        f32x4 s[4]; float tmax = -INFINITY;
#pragma unroll
        for (int mt = 0; mt < 4; ++mt) { f32x4 a = {0.f, 0.f, 0.f, 0.f};
#pragma unroll
            for (int ks = 0; ks < 2; ++ks) { const h16x8 kf = *(const h16x8*)(Ks + (mt * 16 + cc) * 72 + ks * 32 + quad * 8); a = mfma16(kf, qf[ks], a); }
#pragma unroll
            for (int j = 0; j < 4; ++j) { const int n = tc * 64 + mt * 16 + quad * 4 + j; const float v = (16 * n + 31 <= tq) ? a[j] : -INFINITY; a[j] = v; tmax = fmaxf(tmax, v); }
            s[mt] = a; }
        tmax = fmaxf(tmax, __shfl_xor(tmax, 16)); tmax = fmaxf(tmax, __shfl_xor(tmax, 32));
        const float mnew = fmaxf(m1, tmax), muse = (mnew == -INFINITY) ? 0.f : mnew;
        float ps = 0.f;
#pragma unroll
        for (int mt = 0; mt < 4; ++mt)
#pragma unroll
            for (int j = 0; j < 4; ++j) ps += __expf(s[mt][j] - muse);
        l1 = l1 * __expf(m1 - muse) + ps; m1 = mnew;
    }
    l1 += __shfl_xor(l1, 16); l1 += __shfl_xor(l1, 32);
    const float inv1 = (l1 > 0.f) ? 1.f / l1 : 0.f; const float m1u = (m1 == -INFINITY) ? 0.f : m1;
    f32x4 Oc[4];
#pragma unroll
    for (int md = 0; md < 4; ++md) Oc[md] = (f32x4){0.f, 0.f, 0.f, 0.f};
    float carry_q3 = 0.f;
    for (int tc = 0; tc < ntile_c; ++tc) {
        __syncthreads();
        stage_kv(Ks, VT, kcb + (size_t)tc * 64 * 64, vcb + (size_t)tc * 64 * 64, 64, tid, true);
        __syncthreads();
        f32x4 s[4];
#pragma unroll
        for (int mt = 0; mt < 4; ++mt) { f32x4 a = {0.f, 0.f, 0.f, 0.f};
#pragma unroll
            for (int ks = 0; ks < 2; ++ks) { const h16x8 kf = *(const h16x8*)(Ks + (mt * 16 + cc) * 72 + ks * 32 + quad * 8); a = mfma16(kf, qf[ks], a); }
#pragma unroll
            for (int j = 0; j < 4; ++j) { const int n = tc * 64 + mt * 16 + quad * 4 + j; a[j] = (16 * n + 31 <= tq) ? __expf(a[j] - m1u) * inv1 : 0.f; }
            s[mt] = a;
            const float s4 = (a[0] + a[1]) + (a[2] + a[3]); const float p3 = a[3];
            const float fromprev = __shfl(p3, (lane + 48) & 63);
            const float fromq3 = __shfl(p3, cc + 48);
            float val = s4 + ((quad == 0) ? carry_q3 : fromprev);
            carry_q3 = fromq3;
            val += __shfl_xor(val, 8);
            if (r == 0) imp[tloc * 128 + tc * 16 + mt * 4 + quad] = val; }
        h16x8 pf[2];
#pragma unroll
        for (int k2 = 0; k2 < 2; ++k2) pf[k2] = (h16x8){(h16)s[2 * k2][0], (h16)s[2 * k2][1], (h16)s[2 * k2][2], (h16)s[2 * k2][3], (h16)s[2 * k2 + 1][0], (h16)s[2 * k2 + 1][1], (h16)s[2 * k2 + 1][2], (h16)s[2 * k2 + 1][3]};
#pragma unroll
        for (int md = 0; md < 4; ++md)
#pragma unroll
            for (int k2 = 0; k2 < 2; ++k2) { const h16* vp = VT + (md * 16 + cc) * 72 + 32 * k2 + quad * 4; const h16x4 lo = *(const h16x4*)vp, hi = *(const h16x4*)(vp + 16);
                const h16x8 vf = {lo[0], lo[1], lo[2], lo[3], hi[0], hi[1], hi[2], hi[3]}; Oc[md] = mfma16(vf, pf[k2], Oc[md]); }
    }
    __syncthreads();
    if (qb < 16) {
        if (tid < 64) { const unsigned mlo = (qb >= 31) ? 0xffffffffu : ((2u << qb) - 1u); sel[tid * 4 + 0] = mlo; sel[tid * 4 + 1] = 0u; sel[tid * 4 + 2] = 0u; sel[tid * 4 + 3] = 0u; }
    } else {
        const int jhi = qb - 2;
        for (int t8 = 0; t8 < 8; ++t8) { const int row = 8 * w + t8; const float* ir = imp + row * 128;
            const int j1 = lane, j2 = lane + 64; const bool ok1 = (j1 >= 1 && j1 <= jhi), ok2 = (j2 <= jhi);
            const float v1 = ok1 ? ir[j1] : -1.f, v2 = ok2 ? ir[j2] : -1.f; int c1 = 0, c2 = 0;
            for (int jj = 0; jj < 128; jj += 4) { const f32x4 x = *(const f32x4*)(ir + jj);
#pragma unroll
                for (int e = 0; e < 4; ++e) { const int jp = jj + e; const float xv = (jp >= 1 && jp <= jhi) ? x[e] : -1.f;
                    c1 += ((xv > v1) || (xv == v1 && jp < j1)) ? 1 : 0; c2 += ((xv > v2) || (xv == v2 && jp < j2)) ? 1 : 0; } }
            const unsigned long long blo = __ballot(ok1 && c1 < 13), bhi = __ballot(ok2 && c2 < 13);
            if (lane == 0) { unsigned wds[4] = {(unsigned)blo, (unsigned)(blo >> 32), (unsigned)bhi, (unsigned)(bhi >> 32)};
                wds[0] |= 1u; wds[(qb - 1) >> 5] |= 1u << ((qb - 1) & 31); wds[qb >> 5] |= 1u << (qb & 31);
                sel[row * 4 + 0] = wds[0]; sel[row * 4 + 1] = wds[1]; sel[row * 4 + 2] = wds[2]; sel[row * 4 + 3] = wds[3]; } }
    }
    __syncthreads();
    if (tid < 4) { unsigned o = 0u; for (int i = 0; i < 64; ++i) o |= sel[i * 4 + tid]; uni[tid] = o; }
    __syncthreads();
    unsigned selw[4], uniw[4];
#pragma unroll
    for (int i = 0; i < 4; ++i) { selw[i] = sel[tloc * 4 + i]; uniw[i] = uni[i]; }
    FlashState fs; fs.m = -INFINITY; fs.l = 0.f;
#pragma unroll
    for (int md = 0; md < 4; ++md) fs.O[md] = (f32x4){0.f, 0.f, 0.f, 0.f};
    const h16* kslc = C.PROJ + (size_t)b * SEQ * PN + C_KSLC + g * 64; const h16* vslc = C.PROJ + (size_t)b * SEQ * PN + C_VSLC + g * 64;
    for (int j = 0; j <= qb; ++j) {
        const unsigned uw = (j < 32) ? uniw[0] : (j < 64) ? uniw[1] : (j < 96) ? uniw[2] : uniw[3];
        if (!((uw >> (j & 31)) & 1u)) continue;
        __syncthreads();
        stage_kv(Ks, VT, kslc + (size_t)j * 64 * PN, vslc + (size_t)j * 64 * PN, PN, tid, true);
        __syncthreads();
        const unsigned sw = (j < 32) ? selw[0] : (j < 64) ? selw[1] : (j < 96) ? selw[2] : selw[3];
        flash_tile<0>(fs, Ks, VT, qf, j * 64, tq, ((sw >> (j & 31)) & 1u) != 0u, cc, quad);
    }
    float ls = fs.l; ls += __shfl_xor(ls, 16); ls += __shfl_xor(ls, 32); const float invs = (ls > 0.f) ? 1.f / ls : 0.f;
    f32x4 Os[4];
#pragma unroll
    for (int md = 0; md < 4; ++md) Os[md] = fs.O[md] * invs;
    fs.m = -INFINITY; fs.l = 0.f;
#pragma unroll
    for (int md = 0; md < 4; ++md) fs.O[md] = (f32x4){0.f, 0.f, 0.f, 0.f};
    const h16* kwin = C.PROJ + (size_t)b * SEQ * PN + C_KWIN + g * 64; const h16* vwin = C.PROJ + (size_t)b * SEQ * PN + C_VWIN + g * 64;
    for (int j = (qb >= 8 ? qb - 8 : 0); j <= qb; ++j) {
        __syncthreads();
        stage_kv(Ks, VT, kwin + (size_t)j * 64 * PN, vwin + (size_t)j * 64 * PN, PN, tid, true);
        __syncthreads();
        flash_tile<1>(fs, Ks, VT, qf, j * 64, tq, true, cc, quad);
    }
    float lw = fs.l; lw += __shfl_xor(lw, 16); lw += __shfl_xor(lw, 32); const float invw = (lw > 0.f) ? 1.f / lw : 0.f;
    const float* gp = C.PSM + rowq * PSM_W + 16 + h * 3;
    const float g0 = sigmoidf_(gp[0]), g1 = sigmoidf_(gp[1]), g2 = sigmoidf_(gp[2]) * invw;
    float ssq = 0.f; f32x4 o[4];
#pragma unroll
    for (int md = 0; md < 4; ++md) { o[md] = g0 * Oc[md] + g1 * Os[md] + g2 * fs.O[md]; ssq += (o[md][0] * o[md][0] + o[md][1] * o[md][1]) + (o[md][2] * o[md][2] + o[md][3] * o[md][3]); }
    ssq += __shfl_xor(ssq, 16); ssq += __shfl_xor(ssq, 32);
    const float rs = 1.0f / sqrtf(ssq * (1.f / 64.f) + EPS);
    const float* nw = C.in[12] + l * 256 + h * 64;
#pragma unroll
    for (int md = 0; md < 4; ++md) { const int d = md * 16 + quad * 4; u32x2 wv; wv.x = pkh(o[md][0] * rs * nw[d], o[md][1] * rs * nw[d + 1]); wv.y = pkh(o[md][2] * rs * nw[d + 2], o[md][3] * rs * nw[d + 3]);
        *(u32x2*)(C.XN + rowq * 1024 + 256 + h * 64 + d) = wv; }
    __syncthreads();
}

__device__ __forceinline__ void phase_ssdnorm(const Ctx& C, int l) {
    TIDS
    const int gw = C.bid * 8 + wave, NGW = C.G * 8; const float* nw = C.in[18] + l * 512 + lane * 8;
    for (int m = gw; m < MTOK; m += NGW) { const int g = lane >> 5; const f32x4 q = *(const f32x4*)(C.SSQ + (size_t)m * 8 + g * 4);
        const float rs = 1.0f / sqrtf(((q.x + q.y) + (q.z + q.w)) * (1.f / 256.f) + EPS);
        h16* p = C.XN + (size_t)m * 1024 + 512 + lane * 8; const h16x8 v = *(const h16x8*)p;
        u32x4 o; o.x = pkh((float)v[0] * rs * nw[0], (float)v[1] * rs * nw[1]); o.y = pkh((float)v[2] * rs * nw[2], (float)v[3] * rs * nw[3]);
        o.z = pkh((float)v[4] * rs * nw[4], (float)v[5] * rs * nw[5]); o.w = pkh((float)v[6] * rs * nw[6], (float)v[7] * rs * nw[7]); *(u32x4*)p = o; }
}
__device__ __forceinline__ void phase_norm(const Ctx& C, const float* src, h16* dst) {
    TIDS
    const int gw = C.bid * 8 + wave, NGW = C.G * 8;
    for (int m = gw; m < MTOK; m += NGW) rms_row_to_h16(src + (size_t)m * DM, dst + (size_t)m * DM, lane);
}
__device__ __forceinline__ void phase_final(const Ctx& C) {
    TIDS
    const int gw = C.bid * 8 + wave, NGW = C.G * 8; const f32x4* fw = (const f32x4*)C.in[23] + lane;
    for (int m = gw; m < MTOK; m += NGW) { f32x4* xr = (f32x4*)(C.out + (size_t)m * DM) + lane; f32x4 v[4]; float s = 0.f;
#pragma unroll
        for (int j = 0; j < 4; ++j) { v[j] = xr[64 * j]; s += (v[j].x * v[j].x + v[j].y * v[j].y) + (v[j].z * v[j].z + v[j].w * v[j].w); }
        const float rs = 1.0f / sqrtf(wave_sum(s) * (1.f / DM) + EPS);
#pragma unroll
        for (int j = 0; j < 4; ++j) xr[64 * j] = v[j] * rs * fw[64 * j]; }
}

constexpr int N_PHASES = 1 + 11 * DEPTH;
#ifndef PHM
#define PHM 0xffffffffu
#endif
#define EN(k) ((PHM >> (k)) & 1u)
template <int ph> __device__ __forceinline__ void run_phase(const Params* kp) {
    Ctx C; make_ctx(C, kp);
    LAS unsigned char* ldsl = (LAS unsigned char*)g_lds;
    if constexpr (ph == 0) { if (EN(0)) phase_prep(C); return; }
    constexpr int l = (ph - 1) / 11, s = (ph - 1) % 11;
    if (s == 0) { if (EN(1)) { pg8::Gemm g{(const pg8::bf16_t*)C.XN, (const pg8::bf16_t*)(C.WIN + (size_t)l * PN * DM), MTOK, PN, DM}; pg8::StaticOrder S; S.init(MTOK, PN, C.G, C.bid);
        pg8::EpiProj E{C.PROJ, C.PSM}; pg8::gemm_phase<pg8::EpiProj>(ldsl, g, S, E); } }
    else if (s == 1) { if (EN(2)) phase_tok(C, l); }
    else if (s == 2) { for (int u = C.bid; u < 512 + 2048 + 256; u += C.G) { if (u < 512) { if (EN(3)) nsa_compress_unit(C, l, u); } else if (u < 2560) { if (EN(4)) ssd_states_unit(C, l, u - 512); } else { if (EN(5)) gla_block_unit<0>(C, l, u - 2560); } } }
    else if (s == 3) { if (EN(6)) phase_scans(C);
        if (EN(7)) for (int v = C.bid; v < 1024; v += C.G) { const int bg = (v & 255) >> 5, sidx = v & 31, k = v >> 8;
            const int qb = (k == 0) ? sidx : (k == 1) ? 63 - sidx : (k == 2) ? 64 + sidx : 127 - sidx; nsa_attn_unit(C, l, bg >> 1, bg & 1, qb); } }
    else if (s == 4) { for (int u = C.bid; u < 2048 + 256; u += C.G) { if (u < 2048) { if (EN(8)) ssd_y_unit(C, l, u); } else { if (EN(9)) gla_block_unit<1>(C, l, u - 2048); } } }
    else if (s == 5) { if (EN(10)) phase_ssdnorm(C, l); }
    else if (s == 6) { if (EN(11)) { pg8::Gemm g{(const pg8::bf16_t*)C.XN, (const pg8::bf16_t*)(C.WOUT + (size_t)l * DM * DM), MTOK, DM, DM}; pg8::StaticOrder S; S.init(MTOK, DM, C.G, C.bid);
        pg8::EpiRes E{l == 0 ? C.in[0] : C.out, C.out}; pg8::gemm_phase<pg8::EpiRes>(ldsl, g, S, E); } }
    else if (s == 7) { if (EN(12)) phase_norm(C, C.out, C.XN); }
    else if (s == 8) { if (EN(13)) { pg8::Gemm g{(const pg8::bf16_t*)C.XN, (const pg8::bf16_t*)(C.WUP + (size_t)l * DFF * DM), MTOK, DFF, DM}; pg8::StaticOrder S; S.init(MTOK, DFF, C.G, C.bid);
        pg8::EpiHid E{C.HID}; pg8::gemm_phase<pg8::EpiHid>(ldsl, g, S, E); } }
    else if (s == 9) { if (EN(14)) { pg8::Gemm g{(const pg8::bf16_t*)C.HID, (const pg8::bf16_t*)(C.WDN + (size_t)l * DM * DFF), MTOK, DM, DFF}; pg8::StaticOrder S; S.init(MTOK, DM, C.G, C.bid);
        pg8::EpiRes E{C.out, C.out}; pg8::gemm_phase<pg8::EpiRes>(ldsl, g, S, E); } }
    else { if (EN(15)) { if (l + 1 < DEPTH) phase_norm(C, C.out, C.XN); else phase_final(C); } }
}
template <int PH> __device__ __forceinline__ void phase_seq(const Params* kp, int lo, int hi, cg::grid_group& grid) {
    if constexpr (PH < N_PHASES) {
        if (lo <= PH && PH < hi) { run_phase<PH>(kp); if (PH + 1 < hi) grid.sync(); }
        phase_seq<PH + 1>(kp, lo, hi, grid);
    }
}
__global__ void __launch_bounds__(512, 2) fwd_kernel(Params P) {
    const Params* kp = (const Params*)__builtin_amdgcn_kernarg_segment_ptr();
    cg::grid_group grid = cg::this_grid();
    phase_seq<0>(kp, P.ph_lo, P.ph_hi, grid);
}

extern "C" void kernel_launch(void* const* d_in, const int* in_sizes, int n_in, void* d_out, int out_size, void* d_ws, size_t ws_size, hipStream_t stream) {
    static int grid = 0;
    if (grid == 0) {
        if (n_in != 24 || in_sizes[0] != MTOK * DM || out_size != MTOK * DM || ws_size < WS_END) { fprintf(stderr, "kernel_launch: unexpected shapes (n_in %d, ws %zu)\n", n_in, ws_size); grid = -1; return; }
        int dev = 0, cus = 0, per_cu = 0;
        hipGetDevice(&dev); hipDeviceGetAttribute(&cus, hipDeviceAttributeMultiprocessorCount, dev);
        hipFuncSetAttribute((const void*)fwd_kernel, hipFuncAttributeMaxDynamicSharedMemorySize, LDS_BYTES);
        hipOccupancyMaxActiveBlocksPerMultiprocessor(&per_cu, (const void*)fwd_kernel, 512, LDS_BYTES);
        (void)hipGetLastError();
        if (per_cu < 1) { fprintf(stderr, "kernel_launch: occupancy query says %d blocks/CU\n", per_cu); grid = -1; return; }
        grid = cus;
    }
    if (grid < 0) return;
    Params p{};
    for (int i = 0; i < 24; ++i) p.in[i] = (const float*)d_in[i];
    p.out = (float*)d_out; p.ws = (unsigned char*)d_ws;
#if MK_MULTI_LAUNCH
    for (int ph = 0; ph < N_PHASES; ++ph) { p.ph_lo = ph; p.ph_hi = ph + 1; hipLaunchKernelGGL(fwd_kernel, dim3(grid), dim3(512), LDS_BYTES, stream, p); }
#else
    p.ph_lo = 0; p.ph_hi = N_PHASES;
    void* args[] = {&p};
    hipError_t e = hipLaunchCooperativeKernel((const void*)fwd_kernel, dim3(grid), dim3(512), args, LDS_BYTES, stream);
    if (e != hipSuccess) fprintf(stderr, "cooperative launch failed: %s (grid %d)\n", hipGetErrorString(e), grid);
#endif
}
```

```cpp
#include <hip/hip_runtime.h>
#include <hip/hip_cooperative_groups.h>
#include <cstdio>
#include <cstdint>
namespace cg = cooperative_groups;

#ifndef MK_MULTI_LAUNCH
#define MK_MULTI_LAUNCH 0
#endif

#define LAS __attribute__((address_space(3)))
typedef _Float16 h16;
typedef _Float16 h16x8 __attribute__((ext_vector_type(8)));
typedef _Float16 h16x4 __attribute__((ext_vector_type(4)));
typedef _Float16 h16x2 __attribute__((ext_vector_type(2)));
typedef float f32x4 __attribute__((ext_vector_type(4)));
typedef float f32x2 __attribute__((ext_vector_type(2)));
typedef unsigned u32x4 __attribute__((ext_vector_type(4)));
typedef unsigned u32x2 __attribute__((ext_vector_type(2)));

constexpr int BATCH = 4, SEQ = 8192, DM = 1024, MTOK = BATCH * SEQ, DEPTH = 2;
constexpr int DIN = 3364, PN = 3584, DFF = 4096;
constexpr float EPS = 1e-6f;
constexpr int C_GQ = 0, C_GK = 128, C_GV = 256, C_GR = 512, C_NQ = 768, C_NKV = 1024, C_SZ = 1792, C_SX = 2304, C_SM = 3328;
constexpr int C_KCMP = C_NKV, C_VCMP = C_NKV + 128, C_KSLC = C_NKV + 256, C_VSLC = C_NKV + 384, C_KWIN = C_NKV + 512, C_VWIN = C_NKV + 640;
constexpr int PSM_W = 64;

constexpr size_t MiB = 1u << 20;
constexpr size_t WS_WIN = 2 * MiB;
constexpr size_t WS_WOUT = 16 * MiB;
constexpr size_t WS_WUP = 20 * MiB;
constexpr size_t WS_WDN = 36 * MiB;
constexpr size_t WS_W1T = 52 * MiB;
constexpr size_t WS_W2T = 54 * MiB;
constexpr size_t WS_B1 = 54 * MiB + 256 * 1024;
constexpr size_t WS_ROPE = 55 * MiB;
constexpr size_t WS_XN = 60 * MiB;
constexpr size_t WS_PROJ = 124 * MiB;
constexpr size_t WS_HID = 124 * MiB;
constexpr size_t WS_XBCC = 348 * MiB;
constexpr size_t WS_SSDST = 412 * MiB;
constexpr size_t WS_GLAST = 476 * MiB;
constexpr size_t WS_PSM = 492 * MiB;
constexpr size_t WS_KC = 500 * MiB;
constexpr size_t WS_VC = 500 * MiB + 512 * 1024;
constexpr size_t WS_SSQ = 501 * MiB;
constexpr size_t WS_DTV = 502 * MiB;
constexpr size_t WS_ACS = 503 * MiB;
constexpr size_t WS_CD = 504 * MiB;
constexpr size_t WS_GLAG = 504 * MiB + 64 * 1024;
constexpr size_t WS_END = 505 * MiB;

constexpr int LDS_BYTES = 147456;
extern __shared__ __attribute__((aligned(16))) unsigned char g_lds[];

struct Params { const float* in[24]; float* out; unsigned char* ws; int ph_lo, ph_hi; };

__constant__ float ROPE_INV[32] = {
 1.000000000e+00f, 7.498942614e-01f, 5.623413324e-01f, 4.216965139e-01f, 3.162277639e-01f, 2.371373773e-01f, 1.778279394e-01f, 1.333521307e-01f,
 1.000000015e-01f, 7.498941571e-02f, 5.623413250e-02f, 4.216965288e-02f, 3.162277490e-02f, 2.371373773e-02f, 1.778279431e-02f, 1.333521493e-02f,
 9.999999776e-03f, 7.498941850e-03f, 5.623413250e-03f, 4.216964822e-03f, 3.162277630e-03f, 2.371373586e-03f, 1.778279431e-03f, 1.333521446e-03f,
 1.000000047e-03f, 7.498942432e-04f, 5.623413017e-04f, 4.216965172e-04f, 3.162277571e-04f, 2.371373703e-04f, 1.778279402e-04f, 1.333521504e-04f };

__device__ __forceinline__ f32x4 mfma16(h16x8 a, h16x8 b, f32x4 c) { return __builtin_amdgcn_mfma_f32_16x16x32_f16(a, b, c, 0, 0, 0); }
__device__ __forceinline__ float wave_sum(float v) {
#pragma unroll
    for (int o = 1; o < 64; o <<= 1) v += __shfl_xor(v, o);
    return v;
}
__device__ __forceinline__ float sigmoidf_(float x) { return 1.f / (1.f + __expf(-x)); }
__device__ __forceinline__ float siluf_(float x) { return x / (1.f + __expf(-x)); }
__device__ __forceinline__ float softplusf_(float x) { return fmaxf(x, 0.f) + log1pf(__expf(-fabsf(x))); }
__device__ __forceinline__ unsigned pkh(float lo, float hi) { h16x2 v = {(h16)lo, (h16)hi}; return __builtin_bit_cast(unsigned, v); }

__device__ __forceinline__ int opaque_tid() { int t = threadIdx.x; asm volatile("" : "+v"(t)); return t; }
namespace pg8 {
typedef unsigned short bf16_t;
constexpr int BM = 256, BK = 64, HALF = 128, HTB = HALF * BK * 2, STAGE_BYTES = 8 * HTB, NXCD = 8, WGM = 8;
__host__ __device__ __forceinline__ int lds_byte(int r, int c) { const int st = (r >> 4) * 2 + (c >> 5), rr = r & 15, cc = c & 31, ob = rr * 64 + cc * 2; return st * 1024 + (ob ^ (((ob >> 9) & 1) << 5)); }
__host__ __device__ __forceinline__ void stage_rc(int b, int& R, int& C) { const int st = b / 1024, sb = b % 1024, swz = sb ^ (((sb >> 9) & 1) << 5); R = (st >> 1) * 16 + swz / 64; C = (st & 1) * 32 + (swz % 64) / 2; }
__host__ __device__ __forceinline__ int perm32(int rho) { const int n = rho >> 4, i = rho & 15; return 8 * (i >> 2) + 4 * n + (i & 3); }
struct Unit { int pm, pn; };
struct Gemm { const bf16_t* A; const bf16_t* Bt; int M, N, K; };
struct StaticOrder {
    int nM, nN, nwg, G, c;
    __device__ void init(int M, int N, int G_, int c_) { nM = M / BM; nN = N / BM; nwg = nM * nN; G = G_; c = c_; }
    __device__ bool next(int i, Unit& u) const {
        const long L = (long)i * G + c; if (L >= nwg) return false;
        int wgid = (int)L; { const int q = nwg / NXCD, r = nwg % NXCD, xcd = wgid % NXCD, off = wgid / NXCD; wgid = (xcd < r ? xcd * (q + 1) : r * (q + 1) + (xcd - r) * q) + off; }
        const int nig = WGM * nN, gid = wgid / nig, fm = gid * WGM, gsz = (nM - fm) < WGM ? (nM - fm) : WGM;
        u.pm = fm + ((wgid % nig) % gsz); u.pn = (wgid % nig) / gsz; return true;
    }
};
struct EpiProj {
    static constexpr bool PERM = true;
    h16* O; float* PSM;
    __device__ __forceinline__ void operator()(const f32x4 (&acc)[2][2][4][2], const Unit& u, int wr, int wc, int fr, int fq) const {
        const int row0 = u.pm * BM + wr * 64 + fr, col0 = u.pn * BM + wc * 32 + 8 * fq;
#pragma unroll
        for (int ai = 0; ai < 2; ++ai)
#pragma unroll
            for (int m = 0; m < 4; ++m) { const int row = row0 + ai * HALF + m * 16;
#pragma unroll
                for (int bj = 0; bj < 2; ++bj) { const f32x4 v0 = acc[ai][bj][m][0], v1 = acc[ai][bj][m][1]; const int c = col0 + bj * HALF;
                    u32x4 w; w.x = pkh(v0[0], v0[1]); w.y = pkh(v0[2], v0[3]); w.z = pkh(v1[0], v1[1]); w.w = pkh(v1[2], v1[3]);
                    *(u32x4*)(O + (size_t)row * PN + c) = w;
                    if (c >= C_SM && c < C_SM + PSM_W) { float* p = PSM + (size_t)row * PSM_W + (c - C_SM); *(f32x4*)p = v0; *(f32x4*)(p + 4) = v1; } } }
    }
};
struct EpiHid {
    static constexpr bool PERM = true;
    h16* O;
    __device__ __forceinline__ void operator()(const f32x4 (&acc)[2][2][4][2], const Unit& u, int wr, int wc, int fr, int fq) const {
        const int row0 = u.pm * BM + wr * 64 + fr, col0 = u.pn * BM + wc * 32 + 8 * fq;
#pragma unroll
        for (int ai = 0; ai < 2; ++ai)
#pragma unroll
            for (int m = 0; m < 4; ++m) { const int row = row0 + ai * HALF + m * 16;
#pragma unroll
                for (int bj = 0; bj < 2; ++bj) { f32x4 v0 = acc[ai][bj][m][0], v1 = acc[ai][bj][m][1];
#pragma unroll
                    for (int e = 0; e < 4; ++e) { float a = fmaxf(v0[e], 0.f), b = fmaxf(v1[e], 0.f); v0[e] = a * a; v1[e] = b * b; }
                    u32x4 w; w.x = pkh(v0[0], v0[1]); w.y = pkh(v0[2], v0[3]); w.z = pkh(v1[0], v1[1]); w.w = pkh(v1[2], v1[3]);
                    *(u32x4*)(O + (size_t)row * DFF + col0 + bj * HALF) = w; } }
    }
};
struct EpiRes {
    static constexpr bool PERM = false;
    const float* base; float* out;
    __device__ __forceinline__ void operator()(const f32x4 (&acc)[2][2][4][2], const Unit& u, int wr, int wc, int fr, int fq) const {
        const int col0 = u.pn * BM + wc * 32 + 4 * fq;
#pragma unroll
        for (int ai = 0; ai < 2; ++ai)
#pragma unroll
            for (int m = 0; m < 4; ++m) { const size_t off = (size_t)(u.pm * BM + ai * HALF + wr * 64 + m * 16 + fr) * DM + col0;
#pragma unroll
                for (int bj = 0; bj < 2; ++bj)
#pragma unroll
                    for (int n = 0; n < 2; ++n) { const f32x4 bs = *(const f32x4*)(base + off + bj * HALF + n * 16); *(f32x4*)(out + off + bj * HALF + n * 16) = bs + acc[ai][bj][m][n]; } }
    }
};

template <class Epi>
__device__ __forceinline__ void gemm_phase(LAS unsigned char* lds, const Gemm g, const StaticOrder& S, const Epi& E) {
    const int tid = opaque_tid(), wid = __builtin_amdgcn_readfirstlane(tid >> 6), lane = tid & 63, wr = wid >> 2, wc = wid & 3, fr = lane & 15, fq = lane >> 4;
    const int K = g.K, nt = K / BK;
    unsigned voffA[2], voffB[2];
#pragma unroll
    for (int i = 0; i < 2; ++i) { int R, C; stage_rc(tid * 16 + i * 8192, R, C); const int Rb = Epi::PERM ? ((R & ~31) + perm32(R & 31)) : R;
        voffA[i] = (unsigned)(R * K + C) * 2u; voffB[i] = (unsigned)(Rb * K + C) * 2u; }
    const size_t kstep = (size_t)(BK * 2);
    const size_t hstep = (size_t)HALF * K * 2;
    const size_t tstep = 2 * hstep;
    const unsigned ldsw = (unsigned)wid * 1024u;
    const int aoff = lds_byte(wr * 64 + fr, fq * 8), boff = lds_byte(wc * 32 + fr, fq * 8);
#define PG8_SA(b, h) (((b) * 2 + (h)) * HTB)
#define PG8_SB(b, h) ((4 + (b) * 2 + (h)) * HTB)
#define PG8_STAGE(bufoff, gbase, voff) do { _Pragma("unroll") for (int _i = 0; _i < 2; ++_i) \
        __builtin_amdgcn_global_load_lds((const unsigned*)((const char*)(gbase) + (voff)[_i]), (LAS unsigned*)(lds + (bufoff) + ldsw + _i * 8192), 16, 0, 0); } while (0)
#define PG8_LDA(dst, b, h) do { _Pragma("unroll") for (int m = 0; m < 4; ++m) _Pragma("unroll") for (int k = 0; k < 2; ++k) dst[m][k] = *(const LAS h16x8*)(lds + PG8_SA(b, h) + aoff + m * 2048 + k * 1024); } while (0)
#define PG8_LDB(dst, b, h) do { _Pragma("unroll") for (int n = 0; n < 2; ++n) _Pragma("unroll") for (int k = 0; k < 2; ++k) dst[n][k] = *(const LAS h16x8*)(lds + PG8_SB(b, h) + boff + n * 2048 + k * 1024); } while (0)
#define PG8_MMA(ai, bj, At, Bt) do { __builtin_amdgcn_s_setprio(1); _Pragma("unroll") for (int m = 0; m < 4; ++m) _Pragma("unroll") for (int n = 0; n < 2; ++n) _Pragma("unroll") for (int k = 0; k < 2; ++k) \
        acc[ai][bj][m][n] = __builtin_amdgcn_mfma_f32_16x16x32_f16(Bt[n][k], At[m][k], acc[ai][bj][m][n], 0, 0, 0); __builtin_amdgcn_s_setprio(0); } while (0)
#define PG8_WAIT_V(n) asm volatile("s_waitcnt vmcnt(" #n ")" ::: "memory")
#define PG8_WAIT_L(n) asm volatile("s_waitcnt lgkmcnt(" #n ")" ::: "memory")
#define PG8_BAR __builtin_amdgcn_s_barrier()
#define PG8_SCHED __builtin_amdgcn_sched_barrier(0)
    Unit cur, nxt; int ui = 0;
    if (!S.next(0, cur)) return;
    f32x4 acc[2][2][4][2];
#pragma unroll
    for (int a = 0; a < 2; ++a)
#pragma unroll
        for (int b = 0; b < 2; ++b)
#pragma unroll
            for (int m = 0; m < 4; ++m)
#pragma unroll
                for (int n = 0; n < 2; ++n) acc[a][b][m][n] = (f32x4){0.f, 0.f, 0.f, 0.f};
    h16x8 At[4][2], B0[2][2], B1[2][2];
    const char* cA = (const char*)g.A + (size_t)cur.pm * tstep; const char* cB = (const char*)g.Bt + (size_t)cur.pn * tstep;
    PG8_STAGE(PG8_SB(0, 0), cB, voffB); PG8_STAGE(PG8_SB(0, 1), cB + hstep, voffB); PG8_STAGE(PG8_SA(0, 0), cA, voffA); PG8_STAGE(PG8_SA(0, 1), cA + hstep, voffA);
    if (wr == 1) PG8_BAR;
    PG8_WAIT_V(2); PG8_BAR;
    PG8_STAGE(PG8_SB(1, 0), cB + kstep, voffB); PG8_STAGE(PG8_SA(1, 0), cA + kstep, voffA); PG8_STAGE(PG8_SB(1, 1), cB + hstep + kstep, voffB);
    PG8_WAIT_V(6); PG8_BAR;
    for (;;) {
        const bool has_next = S.next(ui + 1, nxt);
        const char* nA = has_next ? (const char*)g.A + (size_t)nxt.pm * tstep : cA; const char* nB = has_next ? (const char*)g.Bt + (size_t)nxt.pn * tstep : cB;
        for (int t = 0; t < nt; t += 2) {
            const bool last = (t == nt - 2);
            const char* a1 = cA + (size_t)(t + 1) * kstep;
            const char* a2 = last ? nA : cA + (size_t)(t + 2) * kstep; const char* b2 = last ? nB : cB + (size_t)(t + 2) * kstep;
            const char* a3 = a2 + kstep; const char* b3 = b2 + kstep;
            PG8_LDB(B0, 0, 0); PG8_LDB(B1, 0, 1); PG8_SCHED; PG8_LDA(At, 0, 0); PG8_STAGE(PG8_SA(1, 1), a1 + hstep, voffA);
            PG8_WAIT_V(8); PG8_WAIT_L(0); PG8_BAR; PG8_MMA(0, 0, At, B0); PG8_MMA(0, 1, At, B1); PG8_BAR; PG8_SCHED;
            PG8_LDA(At, 0, 1); PG8_STAGE(PG8_SB(0, 0), b2, voffB); PG8_STAGE(PG8_SB(0, 1), b2 + hstep, voffB); PG8_STAGE(PG8_SA(0, 0), a2, voffA);
            PG8_WAIT_V(8); PG8_WAIT_L(0); PG8_BAR; PG8_MMA(1, 0, At, B0); PG8_MMA(1, 1, At, B1); PG8_BAR; PG8_SCHED;
            PG8_LDB(B0, 1, 0); PG8_LDB(B1, 1, 1); PG8_SCHED; PG8_LDA(At, 1, 0); PG8_STAGE(PG8_SA(0, 1), a2 + hstep, voffA);
            PG8_WAIT_V(8); PG8_WAIT_L(0); PG8_BAR; PG8_MMA(0, 0, At, B0); PG8_MMA(0, 1, At, B1); PG8_BAR; PG8_SCHED;
            PG8_LDA(At, 1, 1); PG8_STAGE(PG8_SB(1, 0), b3, voffB); PG8_STAGE(PG8_SB(1, 1), b3 + hstep, voffB); PG8_STAGE(PG8_SA(1, 0), a3, voffA);
            PG8_WAIT_V(8); PG8_WAIT_L(0); PG8_BAR; PG8_MMA(1, 0, At, B0); PG8_MMA(1, 1, At, B1); PG8_BAR; PG8_SCHED;
        }
        if (wr == 0) PG8_BAR;
        E(acc, cur, wr, wc, fr, fq);
        if (!has_next) break;
#pragma unroll
        for (int a = 0; a < 2; ++a)
#pragma unroll
            for (int b = 0; b < 2; ++b)
#pragma unroll
                for (int m = 0; m < 4; ++m)
#pragma unroll
                    for (int n = 0; n < 2; ++n) acc[a][b][m][n] = (f32x4){0.f, 0.f, 0.f, 0.f};
        cur = nxt; cA = nA; cB = nB; ++ui;
        if (wr == 1) PG8_BAR;
    }
    PG8_WAIT_V(0);
    PG8_BAR;
#undef PG8_SA
#undef PG8_SB
#undef PG8_STAGE
#undef PG8_LDA
#undef PG8_LDB
#undef PG8_MMA
#undef PG8_WAIT_V
#undef PG8_WAIT_L
#undef PG8_BAR
#undef PG8_SCHED
}
}


#define XB_TMO      128
#define XB_XCNT(j)  (256  + 64 * (j))
#define XB_XSUB(j)  (1280 + 64 * (j))
#define XB_XGEN(j)  (2304 + 64 * (j))
#define XB_TOP      3328
#define XB_TOPGEN   3392
#define XCD_BAR_WORDS 3456
#define XB_SPIN_CAP (1u << 18)
__device__ __forceinline__ unsigned xb_ld(unsigned* p)              { return __hip_atomic_load(p, __ATOMIC_RELAXED, __HIP_MEMORY_SCOPE_AGENT); }
__device__ __forceinline__ unsigned xb_add(unsigned* p, unsigned v) { return __hip_atomic_fetch_add(p, v, __ATOMIC_RELAXED, __HIP_MEMORY_SCOPE_AGENT); }
__device__ __forceinline__ unsigned xb_xcc_id() { return (unsigned)__builtin_amdgcn_s_getreg((3 << 11) | 20) & 0xFu; }
#define XB_SPIN(cond, bar) do { unsigned _sp = 0; while (cond) { __builtin_amdgcn_s_sleep(1); \
    if ((++_sp & 255u) == 0u) { if (xb_ld(&(bar)[XB_TMO])) break; if (_sp > XB_SPIN_CAP) { atomicAdd(&(bar)[XB_TMO], 1u); break; } } } } while (0)
struct XcdBarrier { unsigned* bar; unsigned x; volatile LAS unsigned* st; };
__device__ __forceinline__ XcdBarrier xcd_barrier_post(unsigned* bar, volatile LAS unsigned* st) {
    XcdBarrier b; b.bar = bar; b.x = xb_xcc_id(); b.st = st;
    if (threadIdx.x == 0) (void)xb_add(&bar[XB_XCNT(b.x)], 1u);
    return b;
}
__device__ __forceinline__ void xcd_barrier_complete(unsigned* bar, unsigned x, unsigned& nloc, unsigned& nx) {
    const unsigned G = gridDim.x * gridDim.y * gridDim.z;
    unsigned sum, cnt, mine, sp = 0u;
    for (;;) {
        sum = 0u; cnt = 0u; mine = 0u;
#pragma unroll
        for (unsigned j = 0; j < 16; ++j) { const unsigned c = xb_ld(&bar[XB_XCNT(j)]); sum += c; cnt += (c > 0u) ? 1u : 0u; mine = (j == x) ? c : mine; }
        if (sum == G) break;
        __builtin_amdgcn_s_sleep(1);
        if ((++sp & 255u) == 0u) { if (xb_ld(&bar[XB_TMO])) break; if (sp > XB_SPIN_CAP) { atomicAdd(&bar[XB_TMO], 1u); break; } }
    }
    nloc = mine > 0u ? mine : 1u; nx = cnt > 0u ? cnt : 1u;
}
__device__ __forceinline__ void xcd_barrier(const XcdBarrier& b) {
    asm volatile("s_waitcnt vmcnt(0)" ::: "memory");
    __syncthreads();
    if (threadIdx.x == 0) {
        unsigned* bar = b.bar;
        __builtin_amdgcn_s_waitcnt(0);
        unsigned nloc = b.st[0], nx = b.st[1];
        if (nloc == 0u) { xcd_barrier_complete(bar, b.x, nloc, nx); b.st[0] = nloc; b.st[1] = nx; }
        const unsigned old = xb_add(&bar[XB_XSUB(b.x)], 1u);
        const unsigned gen = old / nloc;
        if (old + 1u == (gen + 1u) * nloc) {
            __builtin_amdgcn_fence(__ATOMIC_RELEASE, "agent");
            asm volatile("s_waitcnt vmcnt(0)" ::: "memory");
            const unsigned og = xb_add(&bar[XB_TOP], 1u);
            const unsigned tg = og / nx;
            if (og + 1u == (tg + 1u) * nx) xb_add(&bar[XB_TOPGEN], 1u);
            else XB_SPIN(xb_ld(&bar[XB_TOPGEN]) == tg, bar);
            __builtin_amdgcn_fence(__ATOMIC_ACQUIRE, "agent");
            xb_add(&bar[XB_XGEN(b.x)], 1u);
            asm volatile("s_waitcnt vmcnt(0)" ::: "memory");
        } else {
            XB_SPIN(xb_ld(&bar[XB_XGEN(b.x)]) == gen, bar);
            __builtin_amdgcn_fence(__ATOMIC_ACQUIRE, "agent");
            asm volatile("s_waitcnt vmcnt(0)" ::: "memory");
        }
    }
    __syncthreads();
}

#define TIDS const int tid = opaque_tid(); const int lane = tid & 63; const int wave = __builtin_amdgcn_readfirstlane(tid >> 6); (void)lane; (void)wave;
struct Ctx {
    const float* in[24]; float* out; unsigned char* ws;
    int G, bid;
    h16 *WIN, *WOUT, *WUP, *WDN, *W1T, *W2T, *XN, *PROJ, *HID, *XBCC, *KC, *VC;
    float *B1, *ROPE, *SSDST, *GLAST, *PSM, *SSQ, *DTV, *ACS, *CD, *GLAG;
};
__device__ __forceinline__ void make_ctx(Ctx& C, const Params* kp0) {
    const Params* kp = kp0; asm volatile("" : "+s"(kp));
#pragma unroll
    for (int i = 0; i < 24; ++i) C.in[i] = kp->in[i];
    C.out = kp->out; unsigned char* ws = kp->ws; C.ws = ws; C.G = gridDim.x; C.bid = blockIdx.x;
    C.WIN = (h16*)(ws + WS_WIN); C.WOUT = (h16*)(ws + WS_WOUT); C.WUP = (h16*)(ws + WS_WUP); C.WDN = (h16*)(ws + WS_WDN); C.W1T = (h16*)(ws + WS_W1T); C.W2T = (h16*)(ws + WS_W2T);
    C.XN = (h16*)(ws + WS_XN); C.PROJ = (h16*)(ws + WS_PROJ); C.HID = (h16*)(ws + WS_HID); C.XBCC = (h16*)(ws + WS_XBCC); C.KC = (h16*)(ws + WS_KC); C.VC = (h16*)(ws + WS_VC);
    C.B1 = (float*)(ws + WS_B1); C.ROPE = (float*)(ws + WS_ROPE); C.SSDST = (float*)(ws + WS_SSDST); C.GLAST = (float*)(ws + WS_GLAST); C.PSM = (float*)(ws + WS_PSM);
    C.SSQ = (float*)(ws + WS_SSQ); C.DTV = (float*)(ws + WS_DTV); C.ACS = (float*)(ws + WS_ACS); C.CD = (float*)(ws + WS_CD); C.GLAG = (float*)(ws + WS_GLAG);
}

__device__ __forceinline__ int win_src_col(int n) {
    if (n < 512) return n;
    if (n < 768) return n - 512 + 528;
    if (n < 1024) return n - 768 + 784;
    if (n < 1792) return n - 1024 + 1040;
    if (n < 2304) return n - 1792 + 1820;
    if (n < 3328) return n - 2304 + 2332;
    const int r = n - 3328;
    if (r < 16) return 512 + r;
    if (r < 28) return 1808 + (r - 16);
    if (r < 36) return 3356 + (r - 28);
    return -1;
}
template <bool MAPW>
__device__ __forceinline__ void transpose_item(const float* W, int K, int Nsrc, int Ndst, h16* WT, const float* kscale, float* scr, int item, int lane) {
    const int nblk = Ndst / 32, kb = item / nblk, nb = item % nblk, k0 = 64 * kb, n0 = 32 * nb;
    const int nd = n0 + (lane & 31); const int sc = MAPW ? win_src_col(nd) : nd;
#pragma unroll 8
    for (int i = 0; i < 32; ++i) { const int kk = 2 * i + (lane >> 5); float v = 0.f;
        if (sc >= 0) { v = W[(size_t)(k0 + kk) * Nsrc + sc]; if (kscale) v *= kscale[k0 + kk]; }
        scr[kk * 33 + (lane & 31)] = v; }
    asm volatile("s_waitcnt lgkmcnt(0)" ::: "memory");
    const int c = lane & 7;
#pragma unroll
    for (int j = 0; j < 4; ++j) { const int n = (lane >> 3) + 8 * j; const float* s = scr + (8 * c) * 33 + n;
        u32x4 o; o.x = pkh(s[0 * 33], s[1 * 33]); o.y = pkh(s[2 * 33], s[3 * 33]); o.z = pkh(s[4 * 33], s[5 * 33]); o.w = pkh(s[6 * 33], s[7 * 33]);
        *(u32x4*)(WT + (size_t)(n0 + n) * K + k0 + 8 * c) = o; }
    asm volatile("s_waitcnt lgkmcnt(0)" ::: "memory");
}
__device__ __forceinline__ void rms_row_to_h16(const float* xrow, h16* orow, int lane) {
    const f32x4* xr = (const f32x4*)xrow + lane; f32x4 v[4]; float s = 0.f;
#pragma unroll
    for (int j = 0; j < 4; ++j) { v[j] = xr[64 * j]; s += (v[j].x * v[j].x + v[j].y * v[j].y) + (v[j].z * v[j].z + v[j].w * v[j].w); }
    const float rs = 1.0f / sqrtf(wave_sum(s) * (1.f / DM) + EPS);
    u32x2* o8 = (u32x2*)orow + lane;
#pragma unroll
    for (int j = 0; j < 4; ++j) { u32x2 w; w.x = pkh(v[j].x * rs, v[j].y * rs); w.y = pkh(v[j].z * rs, v[j].w * rs); o8[64 * j] = w; }
}
__device__ __forceinline__ void sincos_acc(float angf, float& c, float& s) {
    const double x = (double)angf; const double n = __builtin_rint(x * 0.63661977236758134308);
    const double r = __builtin_fma(-n, 1.5707963267948966192, x) - n * 6.123233995736766036e-17;
    const double r2 = r * r;
    double sp = -7.6471637318198164759e-13; sp = sp * r2 + 1.6059043836821614599e-10; sp = sp * r2 - 2.5052108385441718775e-08; sp = sp * r2 + 2.7557319223985890653e-06;
    sp = sp * r2 - 1.9841269841269841270e-04; sp = sp * r2 + 8.3333333333333333333e-03; sp = sp * r2 - 1.6666666666666666667e-01; const double sn = r + r * r2 * sp;
    double cp = 4.7794773323873852974e-14; cp = cp * r2 - 1.1470745597729724714e-11; cp = cp * r2 + 2.0876756987868098979e-09; cp = cp * r2 - 2.7557319223985890653e-07;
    cp = cp * r2 + 2.4801587301587301587e-05; cp = cp * r2 - 1.3888888888888888889e-03; cp = cp * r2 + 4.1666666666666666667e-02; cp = cp * r2 - 0.5; const double cs = 1.0 + r2 * cp;
    const int q = ((int)n) & 3;
    const double so = (q == 0) ? sn : (q == 1) ? cs : (q == 2) ? -sn : -cs;
    const double co = (q == 0) ? cs : (q == 1) ? -sn : (q == 2) ? -cs : sn;
    c = (float)co; s = (float)so;
}
__device__ __forceinline__ void phase_prep(const Ctx& C) {
    TIDS
    float* scr = (float*)(g_lds) + wave * (64 * 33);
    const int gw = C.bid * 8 + wave, NGW = C.G * 8;
    constexpr int I_IN = 16 * (PN / 32), I_OUT = 16 * 32, I_UP = 16 * 128, I_DN = 64 * 32, I_W1 = 32 * 4, I_W2 = 2 * 2;
    constexpr int PER_L = I_IN + I_OUT + I_UP + I_DN + 2 * I_W1 + 2 * I_W2;
    for (int it = gw; it < DEPTH * PER_L; it += NGW) {
        const int l = it / PER_L; int r = it % PER_L;
        if (r < I_IN) { transpose_item<true>(C.in[2] + (size_t)l * DM * DIN, DM, DIN, PN, C.WIN + (size_t)l * PN * DM, C.in[1] + l * DM, scr, r, lane); continue; } r -= I_IN;
        if (r < I_OUT) { transpose_item<false>(C.in[19] + (size_t)l * DM * DM, DM, DM, DM, C.WOUT + (size_t)l * DM * DM, nullptr, scr, r, lane); continue; } r -= I_OUT;
        if (r < I_UP) { transpose_item<false>(C.in[21] + (size_t)l * DM * DFF, DM, DFF, DFF, C.WUP + (size_t)l * DFF * DM, C.in[20] + l * DM, scr, r, lane); continue; } r -= I_UP;
        if (r < I_DN) { transpose_item<false>(C.in[22] + (size_t)l * DFF * DM, DFF, DM, DM, C.WDN + (size_t)l * DM * DFF, nullptr, scr, r, lane); continue; } r -= I_DN;
        if (r < 2 * I_W1) { const int kv = r / I_W1; transpose_item<false>(C.in[kv ? 10 : 7] + (size_t)l * 2048 * 128, 2048, 128, 128, C.W1T + (size_t)(l * 2 + kv) * 128 * 2048, nullptr, scr, r % I_W1, lane); continue; } r -= 2 * I_W1;
        { const int kv = r / I_W2; transpose_item<false>(C.in[kv ? 11 : 8] + (size_t)l * 128 * 64, 128, 64, 64, C.W2T + (size_t)(l * 2 + kv) * 64 * 128, nullptr, scr, r % I_W2, lane); }
    }
    for (int it = gw; it < DEPTH * 2 * 128; it += NGW) {
        const int l = it / 256, kv = (it / 128) & 1, j = it & 127;
        const float* pos = C.in[kv ? 9 : 6] + (size_t)l * 2048; const float* w1 = C.in[kv ? 10 : 7] + (size_t)l * 2048 * 128;
        float s = 0.f;
        for (int f = lane; f < 2048; f += 64) s += pos[f] * w1[(size_t)f * 128 + j];
        s = wave_sum(s);
        if (lane == 0) C.B1[it] = s;
    }
    for (int e = C.bid * 512 + tid; e < SEQ * 32; e += C.G * 512) {
        const int pos = e >> 5, i = e & 31; const float ang = (float)pos * ROPE_INV[i];
        float cs, sn; sincos_acc(ang, cs, sn); C.ROPE[2 * e] = cs; C.ROPE[2 * e + 1] = sn;
    }
    for (int m = gw; m < MTOK; m += NGW) rms_row_to_h16(C.in[0] + (size_t)m * DM, C.XN + (size_t)m * DM, lane);
}

__device__ __forceinline__ void phase_tok(const Ctx& C, int l) {
    TIDS
    const int gw = C.bid * 8 + wave, NGW = C.G * 8;
    const float* cw = C.in[13] + (size_t)l * 4 * 1024; const float* cb = C.in[14] + (size_t)l * 1024; const float* dtb = C.in[15] + l * 8;
    for (int m = gw; m < MTOK; m += NGW) {
        const int t = m & (SEQ - 1);
        h16* prow = C.PROJ + (size_t)m * PN;
#pragma unroll
        for (int it = 0; it < 5; ++it) { const int pi = lane + 64 * it, hd = pi >> 5, i = pi & 31;
            const int base = (hd < 4) ? (C_NQ + hd * 64) : (hd < 6) ? (C_KCMP + (hd - 4) * 64) : (hd < 8) ? (C_KSLC + (hd - 6) * 64) : (C_KWIN + (hd - 8) * 64);
            const float cs = C.ROPE[2 * (t * 32 + i)], sn = C.ROPE[2 * (t * 32 + i) + 1];
            const float x1 = (float)prow[base + i], x2 = (float)prow[base + 32 + i]; const float sc = (hd < 4) ? 0.125f : 1.f;
            prow[base + i] = (h16)((x1 * cs - x2 * sn) * sc); prow[base + 32 + i] = (h16)((x2 * cs + x1 * sn) * sc); }
        { const int ch = lane * 16; float a[16];
#pragma unroll
            for (int e = 0; e < 16; ++e) a[e] = cb[ch + e];
#pragma unroll
            for (int i = 0; i < 4; ++i) { const int tt = t - 3 + i; if (tt < 0) continue;
                const h16* src = C.PROJ + (size_t)(m - 3 + i) * PN + C_SX + ch; const h16x8 x0 = *(const h16x8*)src, x1 = *(const h16x8*)(src + 8);
#pragma unroll
                for (int e = 0; e < 8; ++e) { a[e] += cw[i * 1024 + ch + e] * (float)x0[e]; a[8 + e] += cw[i * 1024 + ch + 8 + e] * (float)x1[e]; } }
            u32x4 o0, o1; o0.x = pkh(siluf_(a[0]), siluf_(a[1])); o0.y = pkh(siluf_(a[2]), siluf_(a[3])); o0.z = pkh(siluf_(a[4]), siluf_(a[5])); o0.w = pkh(siluf_(a[6]), siluf_(a[7]));
            o1.x = pkh(siluf_(a[8]), siluf_(a[9])); o1.y = pkh(siluf_(a[10]), siluf_(a[11])); o1.z = pkh(siluf_(a[12]), siluf_(a[13])); o1.w = pkh(siluf_(a[14]), siluf_(a[15]));
            h16* dst = C.XBCC + (size_t)m * 1024 + ch; *(u32x4*)dst = o0; *(u32x4*)(dst + 8) = o1; }
        if (lane < 8) C.DTV[(size_t)m * 8 + lane] = softplusf_(C.PSM[(size_t)m * PSM_W + 28 + lane] + dtb[lane]);
    }
}

__device__ __forceinline__ float gelu_tanh(float x) { const float u = 0.7978845608028654f * (x + 0.044715f * x * x * x); const float e = __expf(2.f * u); const float th = 1.f - 2.f / (e + 1.f); return 0.5f * x * (1.f + th); }
__device__ __forceinline__ void nsa_compress_unit(const Ctx& C, int l, int u) {
    const int kv = u >> 8, b = (u >> 6) & 3, g = (u >> 5) & 1, mt = u & 31;
    TIDS
    const int w = wave, cc = lane & 15, quad = lane >> 4;
    h16* Hs = (h16*)g_lds;
    const int n = mt * 16 + cc;
    const h16* W1T = C.W1T + (size_t)(l * 2 + kv) * 128 * 2048; const h16* W2T = C.W2T + (size_t)(l * 2 + kv) * 64 * 128; const float* B1 = C.B1 + (l * 2 + kv) * 128;
    const int col = (kv ? C_VCMP : C_KCMP) + g * 64 + quad * 8;
    f32x4 acc = {0.f, 0.f, 0.f, 0.f};
    const h16* brow = W1T + (size_t)(w * 16 + cc) * 2048 + quad * 8;
#pragma unroll 4
    for (int kk = 0; kk < 64; ++kk) {
        int tok = 16 * n + (kk >> 1); tok = tok < SEQ ? tok : SEQ - 1;
        const h16x8 a = *(const h16x8*)(C.PROJ + (size_t)(b * SEQ + tok) * PN + col + (kk & 1) * 32);
        const h16x8 bb = *(const h16x8*)(brow + kk * 32);
        acc = mfma16(a, bb, acc);
    }
    { const float bias = B1[w * 16 + cc];
#pragma unroll
        for (int j = 0; j < 4; ++j) Hs[(quad * 4 + j) * 136 + w * 16 + cc] = (h16)gelu_tanh(acc[j] + bias); }
    __syncthreads();
    if (w < 4) {
        f32x4 o = {0.f, 0.f, 0.f, 0.f};
#pragma unroll
        for (int kk = 0; kk < 4; ++kk) { const h16x8 a = *(const h16x8*)(Hs + cc * 136 + kk * 32 + quad * 8); const h16x8 bb = *(const h16x8*)(W2T + (size_t)(w * 16 + cc) * 128 + kk * 32 + quad * 8); o = mfma16(a, bb, o); }
        h16* dst = (kv ? C.VC : C.KC) + (size_t)((b * 2 + g) * 512 + mt * 16) * 64;
#pragma unroll
        for (int j = 0; j < 4; ++j) dst[(quad * 4 + j) * 64 + w * 16 + cc] = (h16)o[j];
    }
    __syncthreads();
}

__device__ __forceinline__ void ssd_states_unit(const Ctx& C, int l, int u) {
    const int b = u >> 9, c = (u >> 3) & 63, h = u & 7, g = h >> 2;
    TIDS
    const int w = wave, cc = lane & 15, quad = lane >> 4;
    const size_t row0 = (size_t)b * SEQ + c * 128;
    float* acs = (float*)g_lds; float* dtl = acs + 128; float* wl = acs + 256;
    h16* XT = (h16*)(g_lds + 2048);
    h16* BT = (h16*)(g_lds + 2048 + 17408);
    const float A = -__expf(C.in[16][l * 8 + h]);
    if (tid < 128) dtl[tid] = C.DTV[(row0 + tid) * 8 + h];
    __syncthreads();
    if (tid < 128) { float s = 0.f; for (int i = 0; i <= tid; ++i) s += dtl[i] * A; acs[tid] = s; }
    __syncthreads();
    if (tid < 128) { const float tot = acs[127]; wl[tid] = __expf(tot - acs[tid]) * dtl[tid]; C.ACS[(row0 + tid) * 8 + h] = acs[tid]; if (tid == 127) C.CD[(b * 64 + c) * 8 + h] = __expf(tot); }
    __syncthreads();
#pragma unroll
    for (int i = 0; i < 2; ++i) { const int ch = tid + 512 * i, tok = ch >> 3, c8 = ch & 7; const h16x8 v = *(const h16x8*)(C.XBCC + (row0 + tok) * 1024 + h * 64 + c8 * 8);
#pragma unroll
        for (int e = 0; e < 8; ++e) XT[(c8 * 8 + e) * 136 + tok] = v[e]; }
#pragma unroll
    for (int i = 0; i < 4; ++i) { const int ch = tid + 512 * i, tok = ch >> 4, c16 = ch & 15; const h16x8 v = *(const h16x8*)(C.XBCC + (row0 + tok) * 1024 + 512 + g * 128 + c16 * 8); const float ww = wl[tok];
#pragma unroll
        for (int e = 0; e < 8; ++e) BT[(c16 * 8 + e) * 136 + tok] = (h16)((float)v[e] * ww); }
    __syncthreads();
    const int mi = w & 3;
    float* dst = C.SSDST + (size_t)((b * 64 + c) * 8 + h) * 8192;
#pragma unroll
    for (int q = 0; q < 4; ++q) { const int ni = (w >> 2) * 4 + q; f32x4 acc = {0.f, 0.f, 0.f, 0.f};
#pragma unroll
        for (int kk = 0; kk < 4; ++kk) { const h16x8 a = *(const h16x8*)(XT + (mi * 16 + cc) * 136 + kk * 32 + quad * 8); const h16x8 bb = *(const h16x8*)(BT + (ni * 16 + cc) * 136 + kk * 32 + quad * 8); acc = mfma16(a, bb, acc); }
#pragma unroll
        for (int j = 0; j < 4; ++j) dst[(mi * 16 + quad * 4 + j) * 128 + ni * 16 + cc] = acc[j]; }
    __syncthreads();
}

__device__ __forceinline__ void ssd_y_unit(const Ctx& C, int l, int u) {
    const int b = u >> 9, c = (u >> 3) & 63, h = u & 7, g = h >> 2;
    TIDS
    const int w = wave, cc = lane & 15, quad = lane >> 4;
    const size_t row0 = (size_t)b * SEQ + c * 128;
    float* acs = (float*)g_lds; float* dtl = acs + 128;
    h16* Cm = (h16*)(g_lds + 2048);
    h16* Bm = (h16*)(g_lds + 2048 + 34816);
    h16* XT = (h16*)(g_lds + 2048 + 2 * 34816);
    h16* HE = (h16*)(g_lds + 2048 + 2 * 34816 + 17408);
    if (tid < 128) { acs[tid] = C.ACS[(row0 + tid) * 8 + h]; dtl[tid] = C.DTV[(row0 + tid) * 8 + h]; }
#pragma unroll
    for (int i = 0; i < 4; ++i) { const int ch = tid + 512 * i, tok = ch >> 4, c16 = ch & 15; const h16* src = C.XBCC + (row0 + tok) * 1024 + 512 + g * 128 + c16 * 8;
        *(h16x8*)(Bm + tok * 136 + c16 * 8) = *(const h16x8*)src; *(h16x8*)(Cm + tok * 136 + c16 * 8) = *(const h16x8*)(src + 256); }
#pragma unroll
    for (int i = 0; i < 2; ++i) { const int ch = tid + 512 * i, tok = ch >> 3, c8 = ch & 7; const h16x8 v = *(const h16x8*)(C.XBCC + (row0 + tok) * 1024 + h * 64 + c8 * 8);
#pragma unroll
        for (int e = 0; e < 8; ++e) XT[(c8 * 8 + e) * 136 + tok] = v[e]; }
    { const float* src = C.SSDST + (size_t)((b * 64 + c) * 8 + h) * 8192;
#pragma unroll
        for (int i = 0; i < 4; ++i) { const int e4 = tid + 512 * i, p = e4 >> 5, n4 = e4 & 31; const f32x4 v = *(const f32x4*)(src + e4 * 4);
            h16x4 o = {(h16)v.x, (h16)v.y, (h16)v.z, (h16)v.w}; *(h16x4*)(HE + p * 136 + n4 * 4) = o; } }
    __syncthreads();
    f32x4 cbt[8];
#pragma unroll
    for (int ni = 0; ni < 8; ++ni) { f32x4 acc = {0.f, 0.f, 0.f, 0.f};
#pragma unroll
        for (int kk = 0; kk < 4; ++kk) { const h16x8 a = *(const h16x8*)(Cm + (w * 16 + cc) * 136 + kk * 32 + quad * 8); const h16x8 bb = *(const h16x8*)(Bm + (ni * 16 + cc) * 136 + kk * 32 + quad * 8); acc = mfma16(a, bb, acc); }
        cbt[ni] = acc; }
    __syncthreads();
#pragma unroll
    for (int ni = 0; ni < 8; ++ni) { const int s = ni * 16 + cc; const float as_ = acs[s], ds_ = dtl[s];
#pragma unroll
        for (int j = 0; j < 4; ++j) { const int lr = w * 16 + quad * 4 + j; const float v = (s <= lr) ? cbt[ni][j] * __expf(acs[lr] - as_) * ds_ : 0.f; Bm[lr * 136 + s] = (h16)v; } }
    __syncthreads();
    const float Dh = C.in[17][l * 8 + h];
    float ssq[4] = {0.f, 0.f, 0.f, 0.f};
#pragma unroll
    for (int ni = 0; ni < 4; ++ni) { f32x4 acc = {0.f, 0.f, 0.f, 0.f};
#pragma unroll
        for (int kk = 0; kk < 4; ++kk) { const h16x8 a = *(const h16x8*)(Cm + (w * 16 + cc) * 136 + kk * 32 + quad * 8); const h16x8 bb = *(const h16x8*)(HE + (ni * 16 + cc) * 136 + kk * 32 + quad * 8); acc = mfma16(a, bb, acc); }
#pragma unroll
        for (int j = 0; j < 4; ++j) acc[j] *= __expf(acs[w * 16 + quad * 4 + j]);
#pragma unroll
        for (int kk = 0; kk < 4; ++kk) { const h16x8 a = *(const h16x8*)(Bm + (w * 16 + cc) * 136 + kk * 32 + quad * 8); const h16x8 bb = *(const h16x8*)(XT + (ni * 16 + cc) * 136 + kk * 32 + quad * 8); acc = mfma16(a, bb, acc); }
        const int p = ni * 16 + cc;
#pragma unroll
        for (int j = 0; j < 4; ++j) { const int lr = w * 16 + quad * 4 + j; const float x = (float)XT[p * 136 + lr];
            const float z = (float)C.PROJ[(row0 + lr) * PN + C_SZ + h * 64 + p]; const h16 yh = (h16)((acc[j] + Dh * x) * siluf_(z));
            C.XN[(row0 + lr) * 1024 + 512 + h * 64 + p] = yh; const float yr = (float)yh; ssq[j] += yr * yr; } }
#pragma unroll
    for (int j = 0; j < 4; ++j) { float s = ssq[j]; s += __shfl_xor(s, 1); s += __shfl_xor(s, 2); s += __shfl_xor(s, 4); s += __shfl_xor(s, 8);
        if (cc == 0) C.SSQ[(row0 + w * 16 + quad * 4 + j) * 8 + h] = s; }
    __syncthreads();
}

template <int PASS>
__device__ __forceinline__ void gla_block_unit(const Ctx& C, int l, int bu) {
    TIDS
    const int w = wave; const int wu = bu * 8 + w;
    const int bh = wu >> 7, seg = wu & 127, b = bh >> 2, h = bh & 3;
    const size_t row0 = (size_t)b * SEQ + seg * 64;
    float* as_ = (float*)(g_lds) + w * 1536; float* qs = as_ + 512; float* ks = as_ + 1024;
    const int k = lane & 31, half = lane >> 5;
    float w2r[16];
#pragma unroll
    for (int r = 0; r < 16; ++r) w2r[r] = C.in[3][(size_t)l * 16 * 128 + r * 128 + h * 32 + k];
    const float bk = C.in[4][l * 128 + h * 32 + k];
    float S[32];
    float* gst = C.GLAST + (size_t)(bh * 128 + seg) * 2048;
    if (PASS == 1) {
#pragma unroll
        for (int kk = 0; kk < 32; ++kk) S[kk] = gst[kk * 64 + lane];
    } else {
#pragma unroll
        for (int kk = 0; kk < 32; ++kk) S[kk] = 0.f;
    }
    float gtot = 1.f;
    const float gnw = C.in[5][l * 256 + h * 64 + lane];
    for (int bt = 0; bt < 4; ++bt) {
#pragma unroll 1
        for (int it = 0; it < 8; ++it) { const int tok = 2 * it + half; const size_t row = row0 + bt * 16 + tok;
            const f32x4* gp = (const f32x4*)(C.PSM + row * PSM_W); float z = bk;
#pragma unroll
            for (int r4 = 0; r4 < 4; ++r4) { const f32x4 gv = gp[r4]; z += gv.x * w2r[4 * r4] + gv.y * w2r[4 * r4 + 1] + gv.z * w2r[4 * r4 + 2] + gv.w * w2r[4 * r4 + 3]; }
            const float la = -softplusf_(-z) * (1.f / 16.f); const float a = __expf(la);
            as_[tok * 32 + k] = a; gtot *= a;
            qs[tok * 32 + k] = (float)C.PROJ[row * PN + C_GQ + h * 32 + k] * 0.17677669529663687f;
            ks[tok * 32 + k] = (float)C.PROJ[row * PN + C_GK + h * 32 + k]; }
        __syncthreads();
#pragma unroll 1
        for (int tok = 0; tok < 16; ++tok) { const size_t row = row0 + bt * 16 + tok;
            const float v = (float)C.PROJ[row * PN + C_GV + h * 64 + lane]; float acc = 0.f;
#pragma unroll
            for (int k4 = 0; k4 < 8; ++k4) { const f32x4 a4 = *(const f32x4*)(as_ + tok * 32 + 4 * k4), kk4 = *(const f32x4*)(ks + tok * 32 + 4 * k4);
#pragma unroll
                for (int e = 0; e < 4; ++e) S[4 * k4 + e] = a4[e] * S[4 * k4 + e] + kk4[e] * v;
                if (PASS == 1) { const f32x4 q4 = *(const f32x4*)(qs + tok * 32 + 4 * k4);
#pragma unroll
                    for (int e = 0; e < 4; ++e) acc += q4[e] * S[4 * k4 + e]; } }
            if (PASS == 1) { const float ssq = wave_sum(acc * acc); const float rs = 1.0f / sqrtf(ssq * (1.f / 64.f) + EPS);
                const float r = (float)C.PROJ[row * PN + C_GR + h * 64 + lane];
                C.XN[row * 1024 + h * 64 + lane] = (h16)(acc * rs * gnw * siluf_(r)); } }
        __syncthreads();
    }
    if (PASS == 0) {
#pragma unroll
        for (int kk = 0; kk < 32; ++kk) gst[kk * 64 + lane] = S[kk];
        gtot *= __shfl_xor(gtot, 32);
        if (lane < 32) C.GLAG[(size_t)(bh * 128 + seg) * 32 + lane] = gtot;
    }
}

__device__ __forceinline__ void phase_scans(const Ctx& C) {
    TIDS
    for (int e = C.bid * 512 + tid; e < BATCH * 8 * 8192; e += C.G * 512) {
        const int bh = e >> 13, b = bh >> 3, h = bh & 7, pn = e & 8191;
        float* p = C.SSDST + (size_t)(b * 64 * 8 + h) * 8192 + pn; const float* cd = C.CD + b * 64 * 8 + h;
        float st = 0.f;
        for (int c0 = 0; c0 < 64; c0 += 8) { float v[8], d[8];
#pragma unroll
            for (int i = 0; i < 8; ++i) { v[i] = p[(size_t)(c0 + i) * 8 * 8192]; d[i] = cd[(c0 + i) * 8]; }
#pragma unroll
            for (int i = 0; i < 8; ++i) { p[(size_t)(c0 + i) * 8 * 8192] = st; st = d[i] * st + v[i]; } }
    }
    for (int e = C.bid * 512 + tid; e < 16 * 2048; e += C.G * 512) {
        const int bh = e >> 11, kv = e & 2047, k = kv >> 6;
        float* p = C.GLAST + (size_t)bh * 128 * 2048 + kv; const float* gg = C.GLAG + (size_t)bh * 128 * 32 + k;
        float st = 0.f;
        for (int s0 = 0; s0 < 128; s0 += 8) { float v[8], d[8];
#pragma unroll
            for (int i = 0; i < 8; ++i) { v[i] = p[(size_t)(s0 + i) * 2048]; d[i] = gg[(s0 + i) * 32]; }
#pragma unroll
            for (int i = 0; i < 8; ++i) { p[(size_t)(s0 + i) * 2048] = st; st = d[i] * st + v[i]; } }
    }
}

struct FlashState { float m, l; f32x4 O[4]; };
template <int MODE>
__device__ __forceinline__ void flash_tile(FlashState& st, const h16* Ks, const h16* VT, const h16x8 (&qf)[2], int kv0, int tq, bool selbit, int cc, int quad) {
    f32x4 s[4];
#pragma unroll
    for (int mt = 0; mt < 4; ++mt) { f32x4 a = {0.f, 0.f, 0.f, 0.f};
#pragma unroll
        for (int ks = 0; ks < 2; ++ks) { const h16x8 kf = *(const h16x8*)(Ks + (mt * 16 + cc) * 72 + ks * 32 + quad * 8); a = mfma16(kf, qf[ks], a); }
        s[mt] = a; }
    float tmax = -INFINITY;
#pragma unroll
    for (int mt = 0; mt < 4; ++mt)
#pragma unroll
        for (int j = 0; j < 4; ++j) { const int kp = kv0 + mt * 16 + quad * 4 + j;
            const bool ok = (MODE == 0) ? (selbit && kp <= tq) : (kp <= tq && kp > tq - 512);
            const float v = ok ? s[mt][j] : -INFINITY; s[mt][j] = v; tmax = fmaxf(tmax, v); }
    tmax = fmaxf(tmax, __shfl_xor(tmax, 16)); tmax = fmaxf(tmax, __shfl_xor(tmax, 32));
    const float mnew = fmaxf(st.m, tmax); const float muse = (mnew == -INFINITY) ? 0.f : mnew;
    const float alpha = __expf(st.m - muse);
    float psum = 0.f;
#pragma unroll
    for (int mt = 0; mt < 4; ++mt)
#pragma unroll
        for (int j = 0; j < 4; ++j) { const float p = __expf(s[mt][j] - muse); s[mt][j] = p; psum += p; }
    st.l = st.l * alpha + psum; st.m = mnew;
#pragma unroll
    for (int md = 0; md < 4; ++md) st.O[md] *= alpha;
    h16x8 pf[2];
#pragma unroll
    for (int k2 = 0; k2 < 2; ++k2) pf[k2] = (h16x8){(h16)s[2 * k2][0], (h16)s[2 * k2][1], (h16)s[2 * k2][2], (h16)s[2 * k2][3], (h16)s[2 * k2 + 1][0], (h16)s[2 * k2 + 1][1], (h16)s[2 * k2 + 1][2], (h16)s[2 * k2 + 1][3]};
#pragma unroll
    for (int md = 0; md < 4; ++md)
#pragma unroll
        for (int k2 = 0; k2 < 2; ++k2) { const h16* vp = VT + (md * 16 + cc) * 72 + 32 * k2 + quad * 4; const h16x4 lo = *(const h16x4*)vp, hi = *(const h16x4*)(vp + 16);
            const h16x8 vf = {lo[0], lo[1], lo[2], lo[3], hi[0], hi[1], hi[2], hi[3]}; st.O[md] = mfma16(vf, pf[k2], st.O[md]); }
}
__device__ __forceinline__ void stage_kv(h16* Ks, h16* VT, const h16* ksrc, const h16* vsrc, size_t stride, int tid, bool do_v) {
    const int key = tid >> 3, c8 = tid & 7;
    const h16x8 kx = *(const h16x8*)(ksrc + (size_t)key * stride + c8 * 8);
    *(h16x8*)(Ks + key * 72 + c8 * 8) = kx;
    if (do_v) { const h16x8 vx = *(const h16x8*)(vsrc + (size_t)key * stride + c8 * 8);
#pragma unroll
        for (int e = 0; e < 8; ++e) VT[(c8 * 8 + e) * 72 + key] = vx[e]; }
}
__device__ __forceinline__ void nsa_attn_unit(const Ctx& C, int l, int b, int g, int qb) {
    TIDS
    const int w = wave, cc = lane & 15, quad = lane >> 4;
    const int r = cc >> 3, ti = cc & 7, tloc = 8 * w + ti, tq = 64 * qb + tloc, h = 2 * g + r;
    const size_t rowq = (size_t)b * SEQ + tq;
    h16* Ks = (h16*)g_lds; h16* VT = (h16*)(g_lds + 9216);
    float* imp = (float*)(g_lds + 18432);
    unsigned* sel = (unsigned*)(g_lds + 18432 + 32768);
    unsigned* uni = sel + 256;
    h16x8 qf[2];
#pragma unroll
    for (int ks = 0; ks < 2; ++ks) qf[ks] = *(const h16x8*)(C.PROJ + rowq * PN + C_NQ + h * 64 + ks * 32 + quad * 8);
    const h16* kcb = C.KC + (size_t)(b * 2 + g) * 512 * 64; const h16* vcb = C.VC + (size_t)(b * 2 + g) * 512 * 64;
    const int ncmp = 4 * qb + 3, ntile_c = (ncmp + 63) >> 6;
    float m1 = -INFINITY, l1 = 0.f;
    for (int tc = 0; tc < ntile_c; ++tc) {
        __syncthreads();
        stage_kv(Ks, VT, kcb + (size_t)tc * 64 * 64, vcb, 64, tid, false);
        __syncthreads();
        f32x4 s[4]; float tmax = -INFINITY;
#pragma unroll
        for (int mt = 0; mt < 4; ++mt) { f32x4 a = {0.f, 0.f, 0.f, 0.f};
#pragma unroll
            for (int ks = 0; ks < 2; ++ks) { const h16x8 kf = *(const h16x8*)(Ks + (mt * 16 + cc) * 72 + ks * 32 + quad * 8); a = mfma16(kf, qf[ks], a); }
#pragma unroll
            for (int j = 0; j < 4; ++j) { const int n = tc * 64 + mt * 16 + quad * 4 + j; const float v = (16 * n + 31 <= tq) ? a[j] : -INFINITY; a[j] = v; tmax = fmaxf(tmax, v); }
            s[mt] = a; }
        tmax = fmaxf(tmax, __shfl_xor(tmax, 16)); tmax = fmaxf(tmax, __shfl_xor(tmax, 32));
        const float mnew = fmaxf(m1, tmax), muse = (mnew == -INFINITY) ? 0.f : mnew;
        float ps = 0.f;
#pragma unroll
        for (int mt = 0; mt < 4; ++mt)
#pragma unroll
            for (int j = 0; j < 4; ++j) ps += __expf(s[mt][j] - muse);
        l1 = l1 * __expf(m1 - muse) + ps; m1 = mnew;
    }
    l1 += __shfl_xor(l1, 16); l1 += __shfl_xor(l1, 32);
    const float inv1 = (l1 > 0.f) ? 1.f / l1 : 0.f; const float m1u = (m1 == -INFINITY) ? 0.f : m1;
    f32x4 Oc[4];
#pragma unroll
    for (int md = 0; md < 4; ++md) Oc[md] = (f32x4){0.f, 0.f, 0.f, 0.f};
    float carry_q3 = 0.f;
    for (int tc = 0; tc < ntile_c; ++tc) {
        __syncthreads();
        stage_kv(Ks, VT, kcb + (size_t)tc * 64 * 64, vcb + (size_t)tc * 64 * 64, 64, tid, true);
        __syncthreads();
        f32x4 s[4];
#pragma unroll
        for (int mt = 0; mt < 4; ++mt) { f32x4 a = {0.f, 0.f, 0.f, 0.f};
#pragma unroll
            for (int ks = 0; ks < 2; ++ks) { const h16x8 kf = *(const h16x8*)(Ks + (mt * 16 + cc) * 72 + ks * 32 + quad * 8); a = mfma16(kf, qf[ks], a); }
#pragma unroll
            for (int j = 0; j < 4; ++j) { const int n = tc * 64 + mt * 16 + quad * 4 + j; a[j] = (16 * n + 31 <= tq) ? __expf(a[j] - m1u) * inv1 : 0.f; }
            s[mt] = a;
            const float s4 = (a[0] + a[1]) + (a[2] + a[3]); const float p3 = a[3];
            const float fromprev = __shfl(p3, (lane + 48) & 63);
            const float fromq3 = __shfl(p3, cc + 48);
            float val = s4 + ((quad == 0) ? carry_q3 : fromprev);
            carry_q3 = fromq3;
            val += __shfl_xor(val, 8);
            if (r == 0) imp[tloc * 128 + tc * 16 + mt * 4 + quad] = val; }
        h16x8 pf[2];
#pragma unroll
        for (int k2 = 0; k2 < 2; ++k2) pf[k2] = (h16x8){(h16)s[2 * k2][0], (h16)s[2 * k2][1], (h16)s[2 * k2][2], (h16)s[2 * k2][3], (h16)s[2 * k2 + 1][0], (h16)s[2 * k2 + 1][1], (h16)s[2 * k2 + 1][2], (h16)s[2 * k2 + 1][3]};
#pragma unroll
        for (int md = 0; md < 4; ++md)
#pragma unroll
            for (int k2 = 0; k2 < 2; ++k2) { const h16* vp = VT + (md * 16 + cc) * 72 + 32 * k2 + quad * 4; const h16x4 lo = *(const h16x4*)vp, hi = *(const h16x4*)(vp + 16);
                const h16x8 vf = {lo[0], lo[1], lo[2], lo[3], hi[0], hi[1], hi[2], hi[3]}; Oc[md] = mfma16(vf, pf[k2], Oc[md]); }
    }
    __syncthreads();
    if (qb < 16) {
        if (tid < 64) { const unsigned mlo = (qb >= 31) ? 0xffffffffu : ((2u << qb) - 1u); sel[tid * 4 + 0] = mlo; sel[tid * 4 + 1] = 0u; sel[tid * 4 + 2] = 0u; sel[tid * 4 + 3] = 0u; }
    } else {
        const int jhi = qb - 2;
        for (int t8 = 0; t8 < 8; ++t8) { const int row = 8 * w + t8; const float* ir = imp + row * 128;
            const int j1 = lane, j2 = lane + 64; const bool ok1 = (j1 >= 1 && j1 <= jhi), ok2 = (j2 <= jhi);
            const float v1 = ok1 ? ir[j1] : -1.f, v2 = ok2 ? ir[j2] : -1.f; int c1 = 0, c2 = 0;
            for (int jj = 0; jj < 128; jj += 4) { const f32x4 x = *(const f32x4*)(ir + jj);
#pragma unroll
                for (int e = 0; e < 4; ++e) { const int jp = jj + e; const float xv = (jp >= 1 && jp <= jhi) ? x[e] : -1.f;
                    c1 += ((xv > v1) || (xv == v1 && jp < j1)) ? 1 : 0; c2 += ((xv > v2) || (xv == v2 && jp < j2)) ? 1 : 0; } }
            const unsigned long long blo = __ballot(ok1 && c1 < 13), bhi = __ballot(ok2 && c2 < 13);
            if (lane == 0) { unsigned wds[4] = {(unsigned)blo, (unsigned)(blo >> 32), (unsigned)bhi, (unsigned)(bhi >> 32)};
                wds[0] |= 1u; wds[(qb - 1) >> 5] |= 1u << ((qb - 1) & 31); wds[qb >> 5] |= 1u << (qb & 31);
                sel[row * 4 + 0] = wds[0]; sel[row * 4 + 1] = wds[1]; sel[row * 4 + 2] = wds[2]; sel[row * 4 + 3] = wds[3]; } }
    }
    __syncthreads();
    if (tid < 4) { unsigned o = 0u; for (int i = 0; i < 64; ++i) o |= sel[i * 4 + tid]; uni[tid] = o; }
    __syncthreads();
    unsigned selw[4], uniw[4];
#pragma unroll
    for (int i = 0; i < 4; ++i) { selw[i] = sel[tloc * 4 + i]; uniw[i] = uni[i]; }
    FlashState fs; fs.m = -INFINITY; fs.l = 0.f;
#pragma unroll
    for (int md = 0; md < 4; ++md) fs.O[md] = (f32x4){0.f, 0.f, 0.f, 0.f};
    const h16* kslc = C.PROJ + (size_t)b * SEQ * PN + C_KSLC + g * 64; const h16* vslc = C.PROJ + (size_t)b * SEQ * PN + C_VSLC + g * 64;
    for (int j = 0; j <= qb; ++j) {
        const unsigned uw = (j < 32) ? uniw[0] : (j < 64) ? uniw[1] : (j < 96) ? uniw[2] : uniw[3];
        if (!((uw >> (j & 31)) & 1u)) continue;
        __syncthreads();
        stage_kv(Ks, VT, kslc + (size_t)j * 64 * PN, vslc + (size_t)j * 64 * PN, PN, tid, true);
        __syncthreads();
        const unsigned sw = (j < 32) ? selw[0] : (j < 64) ? selw[1] : (j < 96) ? selw[2] : selw[3];
        flash_tile<0>(fs, Ks, VT, qf, j * 64, tq, ((sw >> (j & 31)) & 1u) != 0u, cc, quad);
    }
    float ls = fs.l; ls += __shfl_xor(ls, 16); ls += __shfl_xor(ls, 32); const float invs = (ls > 0.f) ? 1.f / ls : 0.f;
    f32x4 Os[4];
#pragma unroll
    for (int md = 0; md < 4; ++md) Os[md] = fs.O[md] * invs;
    fs.m = -INFINITY; fs.l = 0.f;
#pragma unroll
    for (int md = 0; md < 4; ++md) fs.O[md] = (f32x4){0.f, 0.f, 0.f, 0.f};
    const h16* kwin = C.PROJ + (size_t)b * SEQ * PN + C_KWIN + g * 64; const h16* vwin = C.PROJ + (size_t)b * SEQ * PN + C_VWIN + g * 64;
    for (int j = (qb >= 8 ? qb - 8 : 0); j <= qb; ++j) {
        __syncthreads();
        stage_kv(Ks, VT, kwin + (size_t)j * 64 * PN, vwin + (size_t)j * 64 * PN, PN, tid, true);
        __syncthreads();
        flash_tile<1>(fs, Ks, VT, qf, j * 64, tq, true, cc, quad);
    }
    float lw = fs.l; lw += __shfl_xor(lw, 16); lw += __shfl_xor(lw, 32); const float invw = (lw > 0.f) ? 1.f / lw : 0.f;
    const float* gp = C.PSM + rowq * PSM_W + 16 + h * 3;
    const float g0 = sigmoidf_(gp[0]), g1 = sigmoidf_(gp[1]), g2 = sigmoidf_(gp[2]) * invw;
    float ssq = 0.f; f32x4 o[4];
#pragma unroll
    for (int md = 0; md < 4; ++md) { o[md] = g0 * Oc[md] + g1 * Os[md] + g2 * fs.O[md]; ssq += (o[md][0] * o[md][0] + o[md][1] * o[md][1]) + (o[md][2] * o[md][2] + o[md][3] * o[md][3]); }
    ssq += __shfl_xor(ssq, 16); ssq += __shfl_xor(ssq, 32);
    const float rs = 1.0f / sqrtf(ssq * (1.f / 64.f) + EPS);
    const float* nw = C.in[12] + l * 256 + h * 64;
#pragma unroll
    for (int md = 0; md < 4; ++md) { const int d = md * 16 + quad * 4; u32x2 wv; wv.x = pkh(o[md][0] * rs * nw[d], o[md][1] * rs * nw[d + 1]); wv.y = pkh(o[md][2] * rs * nw[d + 2], o[md][3] * rs * nw[d + 3]);
        *(u32x2*)(C.XN + rowq * 1024 + 256 + h * 64 + d) = wv; }
    __syncthreads();
}

__device__ __forceinline__ void phase_ssdnorm(const Ctx& C, int l) {
    TIDS
    const int gw = C.bid * 8 + wave, NGW = C.G * 8; const float* nw = C.in[18] + l * 512 + lane * 8;
    for (int m = gw; m < MTOK; m += NGW) { const int g = lane >> 5; const f32x4 q = *(const f32x4*)(C.SSQ + (size_t)m * 8 + g * 4);
        const float rs = 1.0f / sqrtf(((q.x + q.y) + (q.z + q.w)) * (1.f / 256.f) + EPS);
        h16* p = C.XN + (size_t)m * 1024 + 512 + lane * 8; const h16x8 v = *(const h16x8*)p;
        u32x4 o; o.x = pkh((float)v[0] * rs * nw[0], (float)v[1] * rs * nw[1]); o.y = pkh((float)v[2] * rs * nw[2], (float)v[3] * rs * nw[3]);
        o.z = pkh((float)v[4] * rs * nw[4], (float)v[5] * rs * nw[5]); o.w = pkh((float)v[6] * rs * nw[6], (float)v[7] * rs * nw[7]); *(u32x4*)p = o; }
}
__device__ __forceinline__ void phase_norm(const Ctx& C, const float* src, h16* dst) {
    TIDS
    const int gw = C.bid * 8 + wave, NGW = C.G * 8;
    for (int m = gw; m < MTOK; m += NGW) rms_row_to_h16(src + (size_t)m * DM, dst + (size_t)m * DM, lane);
}
__device__ __forceinline__ void phase_final(const Ctx& C) {
    TIDS
    const int gw = C.bid * 8 + wave, NGW = C.G * 8; const f32x4* fw = (const f32x4*)C.in[23] + lane;
    for (int m = gw; m < MTOK; m += NGW) { f32x4* xr = (f32x4*)(C.out + (size_t)m * DM) + lane; f32x4 v[4]; float s = 0.f;
#pragma unroll
        for (int j = 0; j < 4; ++j) { v[j] = xr[64 * j]; s += (v[j].x * v[j].x + v[j].y * v[j].y) + (v[j].z * v[j].z + v[j].w * v[j].w); }
        const float rs = 1.0f / sqrtf(wave_sum(s) * (1.f / DM) + EPS);
#pragma unroll
        for (int j = 0; j < 4; ++j) xr[64 * j] = v[j] * rs * fw[64 * j]; }
}

constexpr int N_PHASES = 1 + 11 * DEPTH;
#ifndef PHM
#define PHM 0xffffffffu
#endif
#define EN(k) ((PHM >> (k)) & 1u)
#ifndef PROBE_PH
#define PROBE_PH -1
#define PROBE_REPS 1
#endif
#define REPN(ph) ((ph) == PROBE_PH ? PROBE_REPS : 1)
template <int ph> __device__ __forceinline__ void run_phase(const Params* kp) {
    Ctx C; make_ctx(C, kp);
    LAS unsigned char* ldsl = (LAS unsigned char*)g_lds;
    if constexpr (ph == 0) { if (EN(0)) phase_prep(C); return; }
    constexpr int l = (ph - 1) / 11, s = (ph - 1) % 11;
    if (s == 0) { if (EN(1)) { pg8::Gemm g{(const pg8::bf16_t*)C.XN, (const pg8::bf16_t*)(C.WIN + (size_t)l * PN * DM), MTOK, PN, DM}; pg8::StaticOrder S; S.init(MTOK, PN, C.G, C.bid);
        pg8::EpiProj E{C.PROJ, C.PSM}; pg8::gemm_phase<pg8::EpiProj>(ldsl, g, S, E); } }
    else if (s == 1) { if (EN(2)) phase_tok(C, l); }
    else if (s == 2) { for (int u = C.bid; u < 512 + 2048 + 256; u += C.G) { if (u < 512) { if (EN(3)) nsa_compress_unit(C, l, u); } else if (u < 2560) { if (EN(4)) ssd_states_unit(C, l, u - 512); } else { if (EN(5)) gla_block_unit<0>(C, l, u - 2560); } } }
    else if (s == 3) { if (EN(6)) phase_scans(C);
        if (EN(7)) for (int v = C.bid; v < 1024; v += C.G) { const int bg = (v & 255) >> 5, sidx = v & 31, k = v >> 8;
            const int qb = (k == 0) ? sidx : (k == 1) ? 63 - sidx : (k == 2) ? 64 + sidx : 127 - sidx; nsa_attn_unit(C, l, bg >> 1, bg & 1, qb); } }
    else if (s == 4) { for (int u = C.bid; u < 2048 + 256; u += C.G) { if (u < 2048) { if (EN(8)) ssd_y_unit(C, l, u); } else { if (EN(9)) gla_block_unit<1>(C, l, u - 2048); } } }
    else if (s == 5) { if (EN(10)) phase_ssdnorm(C, l); }
    else if (s == 6) { if (EN(11)) { pg8::Gemm g{(const pg8::bf16_t*)C.XN, (const pg8::bf16_t*)(C.WOUT + (size_t)l * DM * DM), MTOK, DM, DM}; pg8::StaticOrder S; S.init(MTOK, DM, C.G, C.bid);
        pg8::EpiRes E{l == 0 ? C.in[0] : C.out, C.out}; pg8::gemm_phase<pg8::EpiRes>(ldsl, g, S, E); } }
    else if (s == 7) { if (EN(12)) phase_norm(C, C.out, C.XN); }
    else if (s == 8) { if (EN(13)) { pg8::Gemm g{(const pg8::bf16_t*)C.XN, (const pg8::bf16_t*)(C.WUP + (size_t)l * DFF * DM), MTOK, DFF, DM}; pg8::StaticOrder S; S.init(MTOK, DFF, C.G, C.bid);
        pg8::EpiHid E{C.HID}; pg8::gemm_phase<pg8::EpiHid>(ldsl, g, S, E); } }
    else if (s == 9) { if (EN(14)) { pg8::Gemm g{(const pg8::bf16_t*)C.HID, (const pg8::bf16_t*)(C.WDN + (size_t)l * DM * DFF), MTOK, DM, DFF}; pg8::StaticOrder S; S.init(MTOK, DM, C.G, C.bid);
        pg8::EpiRes E{C.out, C.out}; pg8::gemm_phase<pg8::EpiRes>(ldsl, g, S, E); } }
    else { if (EN(15)) { if (l + 1 < DEPTH) phase_norm(C, C.out, C.XN); else phase_final(C); } }
}
constexpr int LDS_MISC = 131072;
template <int PH> __device__ __forceinline__ void phase_seq(const Params* kp, int lo, int hi, cg::grid_group& grid, const XcdBarrier& bar) {
    if constexpr (PH < N_PHASES) {
        if (lo <= PH && PH < hi) {
            for (int rep = 0; rep < REPN(PH); ++rep) run_phase<PH>(kp);
            if (PH + 1 < hi) { if (PH == 0) grid.sync(); else xcd_barrier(bar); }
        }
        phase_seq<PH + 1>(kp, lo, hi, grid, bar);
    }
}
__global__ void __launch_bounds__(512, 2) fwd_kernel(Params P) {
    const Params* kp = (const Params*)__builtin_amdgcn_kernarg_segment_ptr();
    cg::grid_group grid = cg::this_grid();
    volatile LAS unsigned* st = (volatile LAS unsigned*)((LAS unsigned char*)g_lds + LDS_MISC);
    if (threadIdx.x < 2) st[threadIdx.x] = 0u;
    __syncthreads();
    const XcdBarrier bar = xcd_barrier_post((unsigned*)P.ws, st);
    phase_seq<0>(kp, P.ph_lo, P.ph_hi, grid, bar);
}

extern "C" void kernel_launch(void* const* d_in, const int* in_sizes, int n_in, void* d_out, int out_size, void* d_ws, size_t ws_size, hipStream_t stream) {
    static int grid = 0;
    if (grid == 0) {
        if (n_in != 24 || in_sizes[0] != MTOK * DM || out_size != MTOK * DM || ws_size < WS_END) { fprintf(stderr, "kernel_launch: unexpected shapes (n_in %d, ws %zu)\n", n_in, ws_size); grid = -1; return; }
        int dev = 0, cus = 0, per_cu = 0;
        hipGetDevice(&dev); hipDeviceGetAttribute(&cus, hipDeviceAttributeMultiprocessorCount, dev);
        hipFuncSetAttribute((const void*)fwd_kernel, hipFuncAttributeMaxDynamicSharedMemorySize, LDS_BYTES);
        hipOccupancyMaxActiveBlocksPerMultiprocessor(&per_cu, (const void*)fwd_kernel, 512, LDS_BYTES);
        (void)hipGetLastError();
        if (per_cu < 1) { fprintf(stderr, "kernel_launch: occupancy query says %d blocks/CU\n", per_cu); grid = -1; return; }
        grid = cus;
    }
    if (grid < 0) return;
    (void)hipMemsetAsync(d_ws, 0, 16384, stream);
    Params p{};
    for (int i = 0; i < 24; ++i) p.in[i] = (const float*)d_in[i];
    p.out = (float*)d_out; p.ws = (unsigned char*)d_ws;
#if MK_MULTI_LAUNCH
    for (int ph = 0; ph < N_PHASES; ++ph) { p.ph_lo = ph; p.ph_hi = ph + 1; hipLaunchKernelGGL(fwd_kernel, dim3(grid), dim3(512), LDS_BYTES, stream, p); }
#else
    p.ph_lo = 0; p.ph_hi = N_PHASES;
    void* args[] = {&p};
    hipError_t e = hipLaunchCooperativeKernel((const void*)fwd_kernel, dim3(grid), dim3(512), args, LDS_BYTES, stream);
    if (e != hipSuccess) fprintf(stderr, "cooperative launch failed: %s (grid %d)\n", hipGetErrorString(e), grid);
#endif
}
```

```cpp
#include <hip/hip_runtime.h>
#include <hip/hip_cooperative_groups.h>
#include <cstdio>
#include <cstdint>
namespace cg = cooperative_groups;

#ifndef MK_MULTI_LAUNCH
#define MK_MULTI_LAUNCH 0
#endif

#define LAS __attribute__((address_space(3)))
typedef _Float16 h16;
typedef _Float16 h16x8 __attribute__((ext_vector_type(8)));
typedef _Float16 h16x4 __attribute__((ext_vector_type(4)));
typedef _Float16 h16x2 __attribute__((ext_vector_type(2)));
typedef float f32x4 __attribute__((ext_vector_type(4)));
typedef float f32x2 __attribute__((ext_vector_type(2)));
typedef unsigned u32x4 __attribute__((ext_vector_type(4)));
typedef unsigned u32x2 __attribute__((ext_vector_type(2)));

constexpr int BATCH = 4, SEQ = 8192, DM = 1024, MTOK = BATCH * SEQ, DEPTH = 2;
constexpr int DIN = 3364, PN = 3584, DFF = 4096;
constexpr float EPS = 1e-6f;
constexpr int C_GQ = 0, C_GK = 128, C_GV = 256, C_GR = 512, C_NQ = 768, C_NKV = 1024, C_SZ = 1792, C_SX = 2304, C_SM = 3328;
constexpr int C_KCMP = C_NKV, C_VCMP = C_NKV + 128, C_KSLC = C_NKV + 256, C_VSLC = C_NKV + 384, C_KWIN = C_NKV + 512, C_VWIN = C_NKV + 640;
constexpr int PSM_W = 64;

constexpr size_t MiB = 1u << 20;
constexpr size_t WS_WIN = 2 * MiB;
constexpr size_t WS_WOUT = 16 * MiB;
constexpr size_t WS_WUP = 20 * MiB;
constexpr size_t WS_WDN = 36 * MiB;
constexpr size_t WS_W1T = 52 * MiB;
constexpr size_t WS_W2T = 54 * MiB;
constexpr size_t WS_B1 = 54 * MiB + 256 * 1024;
constexpr size_t WS_ROPE = 55 * MiB;
constexpr size_t WS_XN = 60 * MiB;
constexpr size_t WS_PROJ = 124 * MiB;
constexpr size_t WS_HID = 124 * MiB;
constexpr size_t WS_XBCC = 348 * MiB;
constexpr size_t WS_SSDST = 412 * MiB;
constexpr size_t WS_GLAST = 476 * MiB;
constexpr size_t WS_PSM = 492 * MiB;
constexpr size_t WS_KC = 500 * MiB;
constexpr size_t WS_VC = 500 * MiB + 512 * 1024;
constexpr size_t WS_SSQ = 501 * MiB;
constexpr size_t WS_DTV = 502 * MiB;
constexpr size_t WS_ACS = 503 * MiB;
constexpr size_t WS_CD = 504 * MiB;
constexpr size_t WS_GLAG = 504 * MiB + 64 * 1024;
constexpr size_t WS_END = 505 * MiB;

constexpr int LDS_BYTES = 147456;
extern __shared__ __attribute__((aligned(16))) unsigned char g_lds[];

struct Params { const float* in[24]; float* out; unsigned char* ws; int ph_lo, ph_hi; };

__constant__ float ROPE_INV[32] = {
 1.000000000e+00f, 7.498942614e-01f, 5.623413324e-01f, 4.216965139e-01f, 3.162277639e-01f, 2.371373773e-01f, 1.778279394e-01f, 1.333521307e-01f,
 1.000000015e-01f, 7.498941571e-02f, 5.623413250e-02f, 4.216965288e-02f, 3.162277490e-02f, 2.371373773e-02f, 1.778279431e-02f, 1.333521493e-02f,
 9.999999776e-03f, 7.498941850e-03f, 5.623413250e-03f, 4.216964822e-03f, 3.162277630e-03f, 2.371373586e-03f, 1.778279431e-03f, 1.333521446e-03f,
 1.000000047e-03f, 7.498942432e-04f, 5.623413017e-04f, 4.216965172e-04f, 3.162277571e-04f, 2.371373703e-04f, 1.778279402e-04f, 1.333521504e-04f };

__device__ __forceinline__ f32x4 mfma16(h16x8 a, h16x8 b, f32x4 c) { return __builtin_amdgcn_mfma_f32_16x16x32_f16(a, b, c, 0, 0, 0); }
__device__ __forceinline__ float wave_sum(float v) {
#pragma unroll
    for (int o = 1; o < 64; o <<= 1) v += __shfl_xor(v, o);
    return v;
}
__device__ __forceinline__ float sigmoidf_(float x) { return 1.f / (1.f + __expf(-x)); }
__device__ __forceinline__ float siluf_(float x) { return x / (1.f + __expf(-x)); }
__device__ __forceinline__ float softplusf_(float x) { return fmaxf(x, 0.f) + log1pf(__expf(-fabsf(x))); }
__device__ __forceinline__ unsigned pkh(float lo, float hi) { h16x2 v = {(h16)lo, (h16)hi}; return __builtin_bit_cast(unsigned, v); }

__device__ __forceinline__ int opaque_tid() { int t = threadIdx.x; asm volatile("" : "+v"(t)); return t; }
namespace pg8 {
typedef unsigned short bf16_t;
constexpr int BM = 256, BK = 64, HALF = 128, HTB = HALF * BK * 2, STAGE_BYTES = 8 * HTB, NXCD = 8, WGM = 8;
__host__ __device__ __forceinline__ int lds_byte(int r, int c) { const int st = (r >> 4) * 2 + (c >> 5), rr = r & 15, cc = c & 31, ob = rr * 64 + cc * 2; return st * 1024 + (ob ^ (((ob >> 9) & 1) << 5)); }
__host__ __device__ __forceinline__ void stage_rc(int b, int& R, int& C) { const int st = b / 1024, sb = b % 1024, swz = sb ^ (((sb >> 9) & 1) << 5); R = (st >> 1) * 16 + swz / 64; C = (st & 1) * 32 + (swz % 64) / 2; }
__host__ __device__ __forceinline__ int perm32(int rho) { const int n = rho >> 4, i = rho & 15; return 8 * (i >> 2) + 4 * n + (i & 3); }
struct Unit { int pm, pn; };
struct Gemm { const bf16_t* A; const bf16_t* Bt; int M, N, K; };
struct StaticOrder {
    int nM, nN, nwg, G, c;
    __device__ void init(int M, int N, int G_, int c_) { nM = M / BM; nN = N / BM; nwg = nM * nN; G = G_; c = c_; }
    __device__ bool next(int i, Unit& u) const {
        const long L = (long)i * G + c; if (L >= nwg) return false;
        int wgid = (int)L; { const int q = nwg / NXCD, r = nwg % NXCD, xcd = wgid % NXCD, off = wgid / NXCD; wgid = (xcd < r ? xcd * (q + 1) : r * (q + 1) + (xcd - r) * q) + off; }
        const int nig = WGM * nN, gid = wgid / nig, fm = gid * WGM, gsz = (nM - fm) < WGM ? (nM - fm) : WGM;
        u.pm = fm + ((wgid % nig) % gsz); u.pn = (wgid % nig) / gsz; return true;
    }
};
struct EpiProj {
    static constexpr bool PERM = true;
    h16* O; float* PSM;
    __device__ __forceinline__ void operator()(const f32x4 (&acc)[2][2][4][2], const Unit& u, int wr, int wc, int fr, int fq) const {
        const int row0 = u.pm * BM + wr * 64 + fr, col0 = u.pn * BM + wc * 32 + 8 * fq;
#pragma unroll
        for (int ai = 0; ai < 2; ++ai)
#pragma unroll
            for (int m = 0; m < 4; ++m) { const int row = row0 + ai * HALF + m * 16;
#pragma unroll
                for (int bj = 0; bj < 2; ++bj) { const f32x4 v0 = acc[ai][bj][m][0], v1 = acc[ai][bj][m][1]; const int c = col0 + bj * HALF;
                    u32x4 w; w.x = pkh(v0[0], v0[1]); w.y = pkh(v0[2], v0[3]); w.z = pkh(v1[0], v1[1]); w.w = pkh(v1[2], v1[3]);
                    *(u32x4*)(O + (size_t)row * PN + c) = w;
                    if (c >= C_SM && c < C_SM + PSM_W) { float* p = PSM + (size_t)row * PSM_W + (c - C_SM); *(f32x4*)p = v0; *(f32x4*)(p + 4) = v1; } } }
    }
};
struct EpiHid {
    static constexpr bool PERM = true;
    h16* O;
    __device__ __forceinline__ void operator()(const f32x4 (&acc)[2][2][4][2], const Unit& u, int wr, int wc, int fr, int fq) const {
        const int row0 = u.pm * BM + wr * 64 + fr, col0 = u.pn * BM + wc * 32 + 8 * fq;
#pragma unroll
        for (int ai = 0; ai < 2; ++ai)
#pragma unroll
            for (int m = 0; m < 4; ++m) { const int row = row0 + ai * HALF + m * 16;
#pragma unroll
                for (int bj = 0; bj < 2; ++bj) { f32x4 v0 = acc[ai][bj][m][0], v1 = acc[ai][bj][m][1];
#pragma unroll
                    for (int e = 0; e < 4; ++e) { float a = fmaxf(v0[e], 0.f), b = fmaxf(v1[e], 0.f); v0[e] = a * a; v1[e] = b * b; }
                    u32x4 w; w.x = pkh(v0[0], v0[1]); w.y = pkh(v0[2], v0[3]); w.z = pkh(v1[0], v1[1]); w.w = pkh(v1[2], v1[3]);
                    *(u32x4*)(O + (size_t)row * DFF + col0 + bj * HALF) = w; } }
    }
};
struct EpiRes {
    static constexpr bool PERM = false;
    const float* base; float* out;
    __device__ __forceinline__ void operator()(const f32x4 (&acc)[2][2][4][2], const Unit& u, int wr, int wc, int fr, int fq) const {
        const int col0 = u.pn * BM + wc * 32 + 4 * fq;
#pragma unroll
        for (int ai = 0; ai < 2; ++ai)
#pragma unroll
            for (int m = 0; m < 4; ++m) { const size_t off = (size_t)(u.pm * BM + ai * HALF + wr * 64 + m * 16 + fr) * DM + col0;
#pragma unroll
                for (int bj = 0; bj < 2; ++bj)
#pragma unroll
                    for (int n = 0; n < 2; ++n) { const f32x4 bs = *(const f32x4*)(base + off + bj * HALF + n * 16); *(f32x4*)(out + off + bj * HALF + n * 16) = bs + acc[ai][bj][m][n]; } }
    }
};

template <class Epi>
__device__ __forceinline__ void gemm_phase(LAS unsigned char* lds, const Gemm g, const StaticOrder& S, const Epi& E) {
    const int tid = opaque_tid(), wid = __builtin_amdgcn_readfirstlane(tid >> 6), lane = tid & 63, wr = wid >> 2, wc = wid & 3, fr = lane & 15, fq = lane >> 4;
    const int K = g.K, nt = K / BK;
    unsigned voffA[2], voffB[2];
#pragma unroll
    for (int i = 0; i < 2; ++i) { int R, C; stage_rc(tid * 16 + i * 8192, R, C); const int Rb = Epi::PERM ? ((R & ~31) + perm32(R & 31)) : R;
        voffA[i] = (unsigned)(R * K + C) * 2u; voffB[i] = (unsigned)(Rb * K + C) * 2u; }
    const size_t kstep = (size_t)(BK * 2);
    const size_t hstep = (size_t)HALF * K * 2;
    const size_t tstep = 2 * hstep;
    const unsigned ldsw = (unsigned)wid * 1024u;
    const int aoff = lds_byte(wr * 64 + fr, fq * 8), boff = lds_byte(wc * 32 + fr, fq * 8);
#define PG8_SA(b, h) (((b) * 2 + (h)) * HTB)
#define PG8_SB(b, h) ((4 + (b) * 2 + (h)) * HTB)
#define PG8_STAGE(bufoff, gbase, voff) do { _Pragma("unroll") for (int _i = 0; _i < 2; ++_i) \
        __builtin_amdgcn_global_load_lds((const unsigned*)((const char*)(gbase) + (voff)[_i]), (LAS unsigned*)(lds + (bufoff) + ldsw + _i * 8192), 16, 0, 0); } while (0)
#define PG8_LDA(dst, b, h) do { _Pragma("unroll") for (int m = 0; m < 4; ++m) _Pragma("unroll") for (int k = 0; k < 2; ++k) dst[m][k] = *(const LAS h16x8*)(lds + PG8_SA(b, h) + aoff + m * 2048 + k * 1024); } while (0)
#define PG8_LDB(dst, b, h) do { _Pragma("unroll") for (int n = 0; n < 2; ++n) _Pragma("unroll") for (int k = 0; k < 2; ++k) dst[n][k] = *(const LAS h16x8*)(lds + PG8_SB(b, h) + boff + n * 2048 + k * 1024); } while (0)
#define PG8_MMA(ai, bj, At, Bt) do { __builtin_amdgcn_s_setprio(1); _Pragma("unroll") for (int m = 0; m < 4; ++m) _Pragma("unroll") for (int n = 0; n < 2; ++n) _Pragma("unroll") for (int k = 0; k < 2; ++k) \
        acc[ai][bj][m][n] = __builtin_amdgcn_mfma_f32_16x16x32_f16(Bt[n][k], At[m][k], acc[ai][bj][m][n], 0, 0, 0); __builtin_amdgcn_s_setprio(0); } while (0)
#define PG8_WAIT_V(n) asm volatile("s_waitcnt vmcnt(" #n ")" ::: "memory")
#define PG8_WAIT_L(n) asm volatile("s_waitcnt lgkmcnt(" #n ")" ::: "memory")
#define PG8_BAR __builtin_amdgcn_s_barrier()
#define PG8_SCHED __builtin_amdgcn_sched_barrier(0)
    Unit cur, nxt; int ui = 0;
    if (!S.next(0, cur)) return;
    f32x4 acc[2][2][4][2];
#pragma unroll
    for (int a = 0; a < 2; ++a)
#pragma unroll
        for (int b = 0; b < 2; ++b)
#pragma unroll
            for (int m = 0; m < 4; ++m)
#pragma unroll
                for (int n = 0; n < 2; ++n) acc[a][b][m][n] = (f32x4){0.f, 0.f, 0.f, 0.f};
    h16x8 At[4][2], B0[2][2], B1[2][2];
    const char* cA = (const char*)g.A + (size_t)cur.pm * tstep; const char* cB = (const char*)g.Bt + (size_t)cur.pn * tstep;
    PG8_STAGE(PG8_SB(0, 0), cB, voffB); PG8_STAGE(PG8_SB(0, 1), cB + hstep, voffB); PG8_STAGE(PG8_SA(0, 0), cA, voffA); PG8_STAGE(PG8_SA(0, 1), cA + hstep, voffA);
    if (wr == 1) PG8_BAR;
    PG8_WAIT_V(2); PG8_BAR;
    PG8_STAGE(PG8_SB(1, 0), cB + kstep, voffB); PG8_STAGE(PG8_SA(1, 0), cA + kstep, voffA); PG8_STAGE(PG8_SB(1, 1), cB + hstep + kstep, voffB);
    PG8_WAIT_V(6); PG8_BAR;
    for (;;) {
        const bool has_next = S.next(ui + 1, nxt);
        const char* nA = has_next ? (const char*)g.A + (size_t)nxt.pm * tstep : cA; const char* nB = has_next ? (const char*)g.Bt + (size_t)nxt.pn * tstep : cB;
        for (int t = 0; t < nt; t += 2) {
            const bool last = (t == nt - 2);
            const char* a1 = cA + (size_t)(t + 1) * kstep;
            const char* a2 = last ? nA : cA + (size_t)(t + 2) * kstep; const char* b2 = last ? nB : cB + (size_t)(t + 2) * kstep;
            const char* a3 = a2 + kstep; const char* b3 = b2 + kstep;
            PG8_LDB(B0, 0, 0); PG8_LDB(B1, 0, 1); PG8_SCHED; PG8_LDA(At, 0, 0); PG8_STAGE(PG8_SA(1, 1), a1 + hstep, voffA);
            PG8_WAIT_V(8); PG8_WAIT_L(0); PG8_BAR; PG8_MMA(0, 0, At, B0); PG8_MMA(0, 1, At, B1); PG8_BAR; PG8_SCHED;
            PG8_LDA(At, 0, 1); PG8_STAGE(PG8_SB(0, 0), b2, voffB); PG8_STAGE(PG8_SB(0, 1), b2 + hstep, voffB); PG8_STAGE(PG8_SA(0, 0), a2, voffA);
            PG8_WAIT_V(8); PG8_WAIT_L(0); PG8_BAR; PG8_MMA(1, 0, At, B0); PG8_MMA(1, 1, At, B1); PG8_BAR; PG8_SCHED;
            PG8_LDB(B0, 1, 0); PG8_LDB(B1, 1, 1); PG8_SCHED; PG8_LDA(At, 1, 0); PG8_STAGE(PG8_SA(0, 1), a2 + hstep, voffA);
            PG8_WAIT_V(8); PG8_WAIT_L(0); PG8_BAR; PG8_MMA(0, 0, At, B0); PG8_MMA(0, 1, At, B1); PG8_BAR; PG8_SCHED;
            PG8_LDA(At, 1, 1); PG8_STAGE(PG8_SB(1, 0), b3, voffB); PG8_STAGE(PG8_SB(1, 1), b3 + hstep, voffB); PG8_STAGE(PG8_SA(1, 0), a3, voffA);
            PG8_WAIT_V(8); PG8_WAIT_L(0); PG8_BAR; PG8_MMA(1, 0, At, B0); PG8_MMA(1, 1, At, B1); PG8_BAR; PG8_SCHED;
        }
        if (wr == 0) PG8_BAR;
        E(acc, cur, wr, wc, fr, fq);
        if (!has_next) break;
#pragma unroll
        for (int a = 0; a < 2; ++a)
#pragma unroll
            for (int b = 0; b < 2; ++b)
#pragma unroll
                for (int m = 0; m < 4; ++m)
#pragma unroll
                    for (int n = 0; n < 2; ++n) acc[a][b][m][n] = (f32x4){0.f, 0.f, 0.f, 0.f};
        cur = nxt; cA = nA; cB = nB; ++ui;
        if (wr == 1) PG8_BAR;
    }
    PG8_WAIT_V(0);
    PG8_BAR;
#undef PG8_SA
#undef PG8_SB
#undef PG8_STAGE
#undef PG8_LDA
#undef PG8_LDB
#undef PG8_MMA
#undef PG8_WAIT_V
#undef PG8_WAIT_L
#undef PG8_BAR
#undef PG8_SCHED
}
}


#define XB_TMO      128
#define XB_XCNT(j)  (256  + 64 * (j))
#define XB_XSUB(j)  (1280 + 64 * (j))
#define XB_XGEN(j)  (2304 + 64 * (j))
#define XB_TOP      3328
#define XB_TOPGEN   3392
#define XCD_BAR_WORDS 3456
#define XB_SPIN_CAP (1u << 18)
__device__ __forceinline__ unsigned xb_ld(unsigned* p)              { return __hip_atomic_load(p, __ATOMIC_RELAXED, __HIP_MEMORY_SCOPE_AGENT); }
__device__ __forceinline__ unsigned xb_add(unsigned* p, unsigned v) { return __hip_atomic_fetch_add(p, v, __ATOMIC_RELAXED, __HIP_MEMORY_SCOPE_AGENT); }
__device__ __forceinline__ unsigned xb_xcc_id() { return (unsigned)__builtin_amdgcn_s_getreg((3 << 11) | 20) & 0xFu; }
#define XB_SPIN(cond, bar) do { unsigned _sp = 0; while (cond) { __builtin_amdgcn_s_sleep(1); \
    if ((++_sp & 255u) == 0u) { if (xb_ld(&(bar)[XB_TMO])) break; if (_sp > XB_SPIN_CAP) { atomicAdd(&(bar)[XB_TMO], 1u); break; } } } } while (0)
struct XcdBarrier { unsigned* bar; unsigned x; volatile LAS unsigned* st; };
__device__ __forceinline__ XcdBarrier xcd_barrier_post(unsigned* bar, volatile LAS unsigned* st) {
    XcdBarrier b; b.bar = bar; b.x = xb_xcc_id(); b.st = st;
    if (threadIdx.x == 0) (void)xb_add(&bar[XB_XCNT(b.x)], 1u);
    return b;
}
__device__ __forceinline__ void xcd_barrier_complete(unsigned* bar, unsigned x, unsigned& nloc, unsigned& nx) {
    const unsigned G = gridDim.x * gridDim.y * gridDim.z;
    unsigned sum, cnt, mine, sp = 0u;
    for (;;) {
        sum = 0u; cnt = 0u; mine = 0u;
#pragma unroll
        for (unsigned j = 0; j < 16; ++j) { const unsigned c = xb_ld(&bar[XB_XCNT(j)]); sum += c; cnt += (c > 0u) ? 1u : 0u; mine = (j == x) ? c : mine; }
        if (sum == G) break;
        __builtin_amdgcn_s_sleep(1);
        if ((++sp & 255u) == 0u) { if (xb_ld(&bar[XB_TMO])) break; if (sp > XB_SPIN_CAP) { atomicAdd(&bar[XB_TMO], 1u); break; } }
    }
    nloc = mine > 0u ? mine : 1u; nx = cnt > 0u ? cnt : 1u;
}
__device__ __forceinline__ void xcd_barrier(const XcdBarrier& b) {
    asm volatile("s_waitcnt vmcnt(0)" ::: "memory");
    __syncthreads();
    if (threadIdx.x == 0) {
        unsigned* bar = b.bar;
        __builtin_amdgcn_s_waitcnt(0);
        unsigned nloc = b.st[0], nx = b.st[1];
        if (nloc == 0u) { xcd_barrier_complete(bar, b.x, nloc, nx); b.st[0] = nloc; b.st[1] = nx; }
        const unsigned old = xb_add(&bar[XB_XSUB(b.x)], 1u);
        const unsigned gen = old / nloc;
        if (old + 1u == (gen + 1u) * nloc) {
            __builtin_amdgcn_fence(__ATOMIC_RELEASE, "agent");
            asm volatile("s_waitcnt vmcnt(0)" ::: "memory");
            const unsigned og = xb_add(&bar[XB_TOP], 1u);
            const unsigned tg = og / nx;
            if (og + 1u == (tg + 1u) * nx) xb_add(&bar[XB_TOPGEN], 1u);
            else XB_SPIN(xb_ld(&bar[XB_TOPGEN]) == tg, bar);
            __builtin_amdgcn_fence(__ATOMIC_ACQUIRE, "agent");
            xb_add(&bar[XB_XGEN(b.x)], 1u);
            asm volatile("s_waitcnt vmcnt(0)" ::: "memory");
        } else {
            XB_SPIN(xb_ld(&bar[XB_XGEN(b.x)]) == gen, bar);
            __builtin_amdgcn_fence(__ATOMIC_ACQUIRE, "agent");
            asm volatile("s_waitcnt vmcnt(0)" ::: "memory");
        }
    }
    __syncthreads();
}

#define TIDS const int tid = opaque_tid(); const int lane = tid & 63; const int wave = __builtin_amdgcn_readfirstlane(tid >> 6); (void)lane; (void)wave;
struct Ctx {
    const float* in[24]; float* out; unsigned char* ws;
    int G, bid;
    h16 *WIN, *WOUT, *WUP, *WDN, *W1T, *W2T, *XN, *PROJ, *HID, *XBCC, *KC, *VC;
    float *B1, *ROPE, *SSDST, *GLAST, *PSM, *SSQ, *DTV, *ACS, *CD, *GLAG;
};
__device__ __forceinline__ void make_ctx(Ctx& C, const Params* kp0) {
    const Params* kp = kp0; asm volatile("" : "+s"(kp));
#pragma unroll
    for (int i = 0; i < 24; ++i) C.in[i] = kp->in[i];
    C.out = kp->out; unsigned char* ws = kp->ws; C.ws = ws; C.G = gridDim.x; C.bid = blockIdx.x;
    C.WIN = (h16*)(ws + WS_WIN); C.WOUT = (h16*)(ws + WS_WOUT); C.WUP = (h16*)(ws + WS_WUP); C.WDN = (h16*)(ws + WS_WDN); C.W1T = (h16*)(ws + WS_W1T); C.W2T = (h16*)(ws + WS_W2T);
    C.XN = (h16*)(ws + WS_XN); C.PROJ = (h16*)(ws + WS_PROJ); C.HID = (h16*)(ws + WS_HID); C.XBCC = (h16*)(ws + WS_XBCC); C.KC = (h16*)(ws + WS_KC); C.VC = (h16*)(ws + WS_VC);
    C.B1 = (float*)(ws + WS_B1); C.ROPE = (float*)(ws + WS_ROPE); C.SSDST = (float*)(ws + WS_SSDST); C.GLAST = (float*)(ws + WS_GLAST); C.PSM = (float*)(ws + WS_PSM);
    C.SSQ = (float*)(ws + WS_SSQ); C.DTV = (float*)(ws + WS_DTV); C.ACS = (float*)(ws + WS_ACS); C.CD = (float*)(ws + WS_CD); C.GLAG = (float*)(ws + WS_GLAG);
}

__device__ __forceinline__ int win_src_col(int n) {
    if (n < 512) return n;
    if (n < 768) return n - 512 + 528;
    if (n < 1024) return n - 768 + 784;
    if (n < 1792) return n - 1024 + 1040;
    if (n < 2304) return n - 1792 + 1820;
    if (n < 3328) return n - 2304 + 2332;
    const int r = n - 3328;
    if (r < 16) return 512 + r;
    if (r < 28) return 1808 + (r - 16);
    if (r < 36) return 3356 + (r - 28);
    return -1;
}
template <bool MAPW>
__device__ __forceinline__ void transpose_item(const float* W, int K, int Nsrc, int Ndst, h16* WT, const float* kscale, float* scr, int item, int lane) {
    const int nblk = Ndst / 32, kb = item / nblk, nb = item % nblk, k0 = 64 * kb, n0 = 32 * nb;
    const int nd = n0 + (lane & 31); const int sc = MAPW ? win_src_col(nd) : nd;
#pragma unroll 8
    for (int i = 0; i < 32; ++i) { const int kk = 2 * i + (lane >> 5); float v = 0.f;
        if (sc >= 0) { v = W[(size_t)(k0 + kk) * Nsrc + sc]; if (kscale) v *= kscale[k0 + kk]; }
        scr[kk * 33 + (lane & 31)] = v; }
    asm volatile("s_waitcnt lgkmcnt(0)" ::: "memory");
    const int c = lane & 7;
#pragma unroll
    for (int j = 0; j < 4; ++j) { const int n = (lane >> 3) + 8 * j; const float* s = scr + (8 * c) * 33 + n;
        u32x4 o; o.x = pkh(s[0 * 33], s[1 * 33]); o.y = pkh(s[2 * 33], s[3 * 33]); o.z = pkh(s[4 * 33], s[5 * 33]); o.w = pkh(s[6 * 33], s[7 * 33]);
        *(u32x4*)(WT + (size_t)(n0 + n) * K + k0 + 8 * c) = o; }
    asm volatile("s_waitcnt lgkmcnt(0)" ::: "memory");
}
__device__ __forceinline__ void rms_row_to_h16(const float* xrow, h16* orow, int lane) {
    const f32x4* xr = (const f32x4*)xrow + lane; f32x4 v[4]; float s = 0.f;
#pragma unroll
    for (int j = 0; j < 4; ++j) { v[j] = xr[64 * j]; s += (v[j].x * v[j].x + v[j].y * v[j].y) + (v[j].z * v[j].z + v[j].w * v[j].w); }
    const float rs = 1.0f / sqrtf(wave_sum(s) * (1.f / DM) + EPS);
    u32x2* o8 = (u32x2*)orow + lane;
#pragma unroll
    for (int j = 0; j < 4; ++j) { u32x2 w; w.x = pkh(v[j].x * rs, v[j].y * rs); w.y = pkh(v[j].z * rs, v[j].w * rs); o8[64 * j] = w; }
}
__device__ __forceinline__ void sincos_acc(float angf, float& c, float& s) {
    const double x = (double)angf; const double n = __builtin_rint(x * 0.63661977236758134308);
    const double r = __builtin_fma(-n, 1.5707963267948966192, x) - n * 6.123233995736766036e-17;
    const double r2 = r * r;
    double sp = -7.6471637318198164759e-13; sp = sp * r2 + 1.6059043836821614599e-10; sp = sp * r2 - 2.5052108385441718775e-08; sp = sp * r2 + 2.7557319223985890653e-06;
    sp = sp * r2 - 1.9841269841269841270e-04; sp = sp * r2 + 8.3333333333333333333e-03; sp = sp * r2 - 1.6666666666666666667e-01; const double sn = r + r * r2 * sp;
    double cp = 4.7794773323873852974e-14; cp = cp * r2 - 1.1470745597729724714e-11; cp = cp * r2 + 2.0876756987868098979e-09; cp = cp * r2 - 2.7557319223985890653e-07;
    cp = cp * r2 + 2.4801587301587301587e-05; cp = cp * r2 - 1.3888888888888888889e-03; cp = cp * r2 + 4.1666666666666666667e-02; cp = cp * r2 - 0.5; const double cs = 1.0 + r2 * cp;
    const int q = ((int)n) & 3;
    const double so = (q == 0) ? sn : (q == 1) ? cs : (q == 2) ? -sn : -cs;
    const double co = (q == 0) ? cs : (q == 1) ? -sn : (q == 2) ? -cs : sn;
    c = (float)co; s = (float)so;
}
__device__ __forceinline__ void phase_prep(const Ctx& C) {
    TIDS
    float* scr = (float*)(g_lds) + wave * (64 * 33);
    const int gw = C.bid * 8 + wave, NGW = C.G * 8;
    constexpr int I_IN = 16 * (PN / 32), I_OUT = 16 * 32, I_UP = 16 * 128, I_DN = 64 * 32, I_W1 = 32 * 4, I_W2 = 2 * 2;
    constexpr int PER_L = I_IN + I_OUT + I_UP + I_DN + 2 * I_W1 + 2 * I_W2;
    for (int it = gw; it < DEPTH * PER_L; it += NGW) {
        const int l = it / PER_L; int r = it % PER_L;
        if (r < I_IN) { transpose_item<true>(C.in[2] + (size_t)l * DM * DIN, DM, DIN, PN, C.WIN + (size_t)l * PN * DM, C.in[1] + l * DM, scr, r, lane); continue; } r -= I_IN;
        if (r < I_OUT) { transpose_item<false>(C.in[19] + (size_t)l * DM * DM, DM, DM, DM, C.WOUT + (size_t)l * DM * DM, nullptr, scr, r, lane); continue; } r -= I_OUT;
        if (r < I_UP) { transpose_item<false>(C.in[21] + (size_t)l * DM * DFF, DM, DFF, DFF, C.WUP + (size_t)l * DFF * DM, C.in[20] + l * DM, scr, r, lane); continue; } r -= I_UP;
        if (r < I_DN) { transpose_item<false>(C.in[22] + (size_t)l * DFF * DM, DFF, DM, DM, C.WDN + (size_t)l * DM * DFF, nullptr, scr, r, lane); continue; } r -= I_DN;
        if (r < 2 * I_W1) { const int kv = r / I_W1; transpose_item<false>(C.in[kv ? 10 : 7] + (size_t)l * 2048 * 128, 2048, 128, 128, C.W1T + (size_t)(l * 2 + kv) * 128 * 2048, nullptr, scr, r % I_W1, lane); continue; } r -= 2 * I_W1;
        { const int kv = r / I_W2; transpose_item<false>(C.in[kv ? 11 : 8] + (size_t)l * 128 * 64, 128, 64, 64, C.W2T + (size_t)(l * 2 + kv) * 64 * 128, nullptr, scr, r % I_W2, lane); }
    }
    for (int it = gw; it < DEPTH * 2 * 128; it += NGW) {
        const int l = it / 256, kv = (it / 128) & 1, j = it & 127;
        const float* pos = C.in[kv ? 9 : 6] + (size_t)l * 2048; const float* w1 = C.in[kv ? 10 : 7] + (size_t)l * 2048 * 128;
        float s = 0.f;
        for (int f = lane; f < 2048; f += 64) s += pos[f] * w1[(size_t)f * 128 + j];
        s = wave_sum(s);
        if (lane == 0) C.B1[it] = s;
    }
    for (int e = C.bid * 512 + tid; e < SEQ * 32; e += C.G * 512) {
        const int pos = e >> 5, i = e & 31; const float ang = (float)pos * ROPE_INV[i];
        float cs, sn; sincos_acc(ang, cs, sn); C.ROPE[2 * e] = cs; C.ROPE[2 * e + 1] = sn;
    }
    for (int m = gw; m < MTOK; m += NGW) rms_row_to_h16(C.in[0] + (size_t)m * DM, C.XN + (size_t)m * DM, lane);
}

__device__ __forceinline__ void phase_tok(const Ctx& C, int l) {
    TIDS
    const int gw = C.bid * 8 + wave, NGW = C.G * 8;
    const float* cw = C.in[13] + (size_t)l * 4 * 1024; const float* cb = C.in[14] + (size_t)l * 1024; const float* dtb = C.in[15] + l * 8;
    for (int m = gw; m < MTOK; m += NGW) {
        const int t = m & (SEQ - 1);
        h16* prow = C.PROJ + (size_t)m * PN;
#pragma unroll
        for (int it = 0; it < 5; ++it) { const int pi = lane + 64 * it, hd = pi >> 5, i = pi & 31;
            const int base = (hd < 4) ? (C_NQ + hd * 64) : (hd < 6) ? (C_KCMP + (hd - 4) * 64) : (hd < 8) ? (C_KSLC + (hd - 6) * 64) : (C_KWIN + (hd - 8) * 64);
            const float cs = C.ROPE[2 * (t * 32 + i)], sn = C.ROPE[2 * (t * 32 + i) + 1];
            const float x1 = (float)prow[base + i], x2 = (float)prow[base + 32 + i]; const float sc = (hd < 4) ? 0.18033688011112042f : 1.f;
            prow[base + i] = (h16)((x1 * cs - x2 * sn) * sc); prow[base + 32 + i] = (h16)((x2 * cs + x1 * sn) * sc); }
        { const int ch = lane * 16; float a[16];
#pragma unroll
            for (int e = 0; e < 16; ++e) a[e] = cb[ch + e];
#pragma unroll
            for (int i = 0; i < 4; ++i) { const int tt = t - 3 + i; if (tt < 0) continue;
                const h16* src = C.PROJ + (size_t)(m - 3 + i) * PN + C_SX + ch; const h16x8 x0 = *(const h16x8*)src, x1 = *(const h16x8*)(src + 8);
#pragma unroll
                for (int e = 0; e < 8; ++e) { a[e] += cw[i * 1024 + ch + e] * (float)x0[e]; a[8 + e] += cw[i * 1024 + ch + 8 + e] * (float)x1[e]; } }
            u32x4 o0, o1; o0.x = pkh(siluf_(a[0]), siluf_(a[1])); o0.y = pkh(siluf_(a[2]), siluf_(a[3])); o0.z = pkh(siluf_(a[4]), siluf_(a[5])); o0.w = pkh(siluf_(a[6]), siluf_(a[7]));
            o1.x = pkh(siluf_(a[8]), siluf_(a[9])); o1.y = pkh(siluf_(a[10]), siluf_(a[11])); o1.z = pkh(siluf_(a[12]), siluf_(a[13])); o1.w = pkh(siluf_(a[14]), siluf_(a[15]));
            h16* dst = C.XBCC + (size_t)m * 1024 + ch; *(u32x4*)dst = o0; *(u32x4*)(dst + 8) = o1; }
        if (lane < 8) C.DTV[(size_t)m * 8 + lane] = softplusf_(C.PSM[(size_t)m * PSM_W + 28 + lane] + dtb[lane]);
    }
}

__device__ __forceinline__ float gelu_tanh(float x) { const float u = 0.7978845608028654f * (x + 0.044715f * x * x * x); const float e = __expf(2.f * u); const float th = 1.f - 2.f / (e + 1.f); return 0.5f * x * (1.f + th); }
__device__ __forceinline__ void nsa_compress_unit(const Ctx& C, int l, int u) {
    const int kv = u >> 8, b = (u >> 6) & 3, g = (u >> 5) & 1, mt = u & 31;
    TIDS
    const int w = wave, cc = lane & 15, quad = lane >> 4;
    h16* Hs = (h16*)g_lds;
    const int n = mt * 16 + cc;
    const h16* W1T = C.W1T + (size_t)(l * 2 + kv) * 128 * 2048; const h16* W2T = C.W2T + (size_t)(l * 2 + kv) * 64 * 128; const float* B1 = C.B1 + (l * 2 + kv) * 128;
    const int col = (kv ? C_VCMP : C_KCMP) + g * 64 + quad * 8;
    f32x4 acc = {0.f, 0.f, 0.f, 0.f};
    const h16* brow = W1T + (size_t)(w * 16 + cc) * 2048 + quad * 8;
#pragma unroll 4
    for (int kk = 0; kk < 64; ++kk) {
        int tok = 16 * n + (kk >> 1); tok = tok < SEQ ? tok : SEQ - 1;
        const h16x8 a = *(const h16x8*)(C.PROJ + (size_t)(b * SEQ + tok) * PN + col + (kk & 1) * 32);
        const h16x8 bb = *(const h16x8*)(brow + kk * 32);
        acc = mfma16(a, bb, acc);
    }
    { const float bias = B1[w * 16 + cc];
#pragma unroll
        for (int j = 0; j < 4; ++j) Hs[(quad * 4 + j) * 136 + w * 16 + cc] = (h16)gelu_tanh(acc[j] + bias); }
    __syncthreads();
    if (w < 4) {
        f32x4 o = {0.f, 0.f, 0.f, 0.f};
#pragma unroll
        for (int kk = 0; kk < 4; ++kk) { const h16x8 a = *(const h16x8*)(Hs + cc * 136 + kk * 32 + quad * 8); const h16x8 bb = *(const h16x8*)(W2T + (size_t)(w * 16 + cc) * 128 + kk * 32 + quad * 8); o = mfma16(a, bb, o); }
        h16* dst = (kv ? C.VC : C.KC) + (size_t)((b * 2 + g) * 512 + mt * 16) * 64;
#pragma unroll
        for (int j = 0; j < 4; ++j) dst[(quad * 4 + j) * 64 + w * 16 + cc] = (h16)o[j];
    }
    __syncthreads();
}

__device__ __forceinline__ void ssd_states_unit(const Ctx& C, int l, int u) {
    const int b = u >> 9, c = (u >> 3) & 63, h = u & 7, g = h >> 2;
    TIDS
    const int w = wave, cc = lane & 15, quad = lane >> 4;
    const size_t row0 = (size_t)b * SEQ + c * 128;
    float* acs = (float*)g_lds; float* dtl = acs + 128; float* wl = acs + 256;
    h16* XT = (h16*)(g_lds + 2048);
    h16* BT = (h16*)(g_lds + 2048 + 17408);
    const float A = -__expf(C.in[16][l * 8 + h]);
    if (tid < 128) dtl[tid] = C.DTV[(row0 + tid) * 8 + h];
    __syncthreads();
    if (tid < 128) { float s = 0.f; for (int i = 0; i <= tid; ++i) s += dtl[i] * A; acs[tid] = s; }
    __syncthreads();
    if (tid < 128) { const float tot = acs[127]; wl[tid] = __expf(tot - acs[tid]) * dtl[tid]; C.ACS[(row0 + tid) * 8 + h] = acs[tid]; if (tid == 127) C.CD[(b * 64 + c) * 8 + h] = __expf(tot); }
    __syncthreads();
#pragma unroll
    for (int i = 0; i < 2; ++i) { const int ch = tid + 512 * i, tok = ch >> 3, c8 = ch & 7; const h16x8 v = *(const h16x8*)(C.XBCC + (row0 + tok) * 1024 + h * 64 + c8 * 8);
#pragma unroll
        for (int e = 0; e < 8; ++e) XT[(c8 * 8 + e) * 136 + tok] = v[e]; }
#pragma unroll
    for (int i = 0; i < 4; ++i) { const int ch = tid + 512 * i, tok = ch >> 4, c16 = ch & 15; const h16x8 v = *(const h16x8*)(C.XBCC + (row0 + tok) * 1024 + 512 + g * 128 + c16 * 8); const float ww = wl[tok];
#pragma unroll
        for (int e = 0; e < 8; ++e) BT[(c16 * 8 + e) * 136 + tok] = (h16)((float)v[e] * ww); }
    __syncthreads();
    const int mi = w & 3;
    float* dst = C.SSDST + (size_t)((b * 64 + c) * 8 + h) * 8192;
#pragma unroll
    for (int q = 0; q < 4; ++q) { const int ni = (w >> 2) * 4 + q; f32x4 acc = {0.f, 0.f, 0.f, 0.f};
#pragma unroll
        for (int kk = 0; kk < 4; ++kk) { const h16x8 a = *(const h16x8*)(XT + (mi * 16 + cc) * 136 + kk * 32 + quad * 8); const h16x8 bb = *(const h16x8*)(BT + (ni * 16 + cc) * 136 + kk * 32 + quad * 8); acc = mfma16(a, bb, acc); }
#pragma unroll
        for (int j = 0; j < 4; ++j) dst[(mi * 16 + quad * 4 + j) * 128 + ni * 16 + cc] = acc[j]; }
    __syncthreads();
}

__device__ __forceinline__ void ssd_y_unit(const Ctx& C, int l, int u) {
    const int b = u >> 9, c = (u >> 3) & 63, h = u & 7, g = h >> 2;
    TIDS
    const int w = wave, cc = lane & 15, quad = lane >> 4;
    const size_t row0 = (size_t)b * SEQ + c * 128;
    float* acs = (float*)g_lds; float* dtl = acs + 128;
    h16* Cm = (h16*)(g_lds + 2048);
    h16* Bm = (h16*)(g_lds + 2048 + 34816);
    h16* XT = (h16*)(g_lds + 2048 + 2 * 34816);
    h16* HE = (h16*)(g_lds + 2048 + 2 * 34816 + 17408);
    if (tid < 128) { acs[tid] = C.ACS[(row0 + tid) * 8 + h]; dtl[tid] = C.DTV[(row0 + tid) * 8 + h]; }
#pragma unroll
    for (int i = 0; i < 4; ++i) { const int ch = tid + 512 * i, tok = ch >> 4, c16 = ch & 15; const h16* src = C.XBCC + (row0 + tok) * 1024 + 512 + g * 128 + c16 * 8;
        *(h16x8*)(Bm + tok * 136 + c16 * 8) = *(const h16x8*)src; *(h16x8*)(Cm + tok * 136 + c16 * 8) = *(const h16x8*)(src + 256); }
#pragma unroll
    for (int i = 0; i < 2; ++i) { const int ch = tid + 512 * i, tok = ch >> 3, c8 = ch & 7; const h16x8 v = *(const h16x8*)(C.XBCC + (row0 + tok) * 1024 + h * 64 + c8 * 8);
#pragma unroll
        for (int e = 0; e < 8; ++e) XT[(c8 * 8 + e) * 136 + tok] = v[e]; }
    { const float* src = C.SSDST + (size_t)((b * 64 + c) * 8 + h) * 8192;
#pragma unroll
        for (int i = 0; i < 4; ++i) { const int e4 = tid + 512 * i, p = e4 >> 5, n4 = e4 & 31; const f32x4 v = *(const f32x4*)(src + e4 * 4);
            h16x4 o = {(h16)v.x, (h16)v.y, (h16)v.z, (h16)v.w}; *(h16x4*)(HE + p * 136 + n4 * 4) = o; } }
    __syncthreads();
    f32x4 cbt[8];
#pragma unroll
    for (int ni = 0; ni < 8; ++ni) { f32x4 acc = {0.f, 0.f, 0.f, 0.f};
#pragma unroll
        for (int kk = 0; kk < 4; ++kk) { const h16x8 a = *(const h16x8*)(Cm + (w * 16 + cc) * 136 + kk * 32 + quad * 8); const h16x8 bb = *(const h16x8*)(Bm + (ni * 16 + cc) * 136 + kk * 32 + quad * 8); acc = mfma16(a, bb, acc); }
        cbt[ni] = acc; }
    __syncthreads();
#pragma unroll
    for (int ni = 0; ni < 8; ++ni) { const int s = ni * 16 + cc; const float as_ = acs[s], ds_ = dtl[s];
#pragma unroll
        for (int j = 0; j < 4; ++j) { const int lr = w * 16 + quad * 4 + j; const float v = (s <= lr) ? cbt[ni][j] * __expf(acs[lr] - as_) * ds_ : 0.f; Bm[lr * 136 + s] = (h16)v; } }
    __syncthreads();
    const float Dh = C.in[17][l * 8 + h];
    float ssq[4] = {0.f, 0.f, 0.f, 0.f};
#pragma unroll
    for (int ni = 0; ni < 4; ++ni) { f32x4 acc = {0.f, 0.f, 0.f, 0.f};
#pragma unroll
        for (int kk = 0; kk < 4; ++kk) { const h16x8 a = *(const h16x8*)(Cm + (w * 16 + cc) * 136 + kk * 32 + quad * 8); const h16x8 bb = *(const h16x8*)(HE + (ni * 16 + cc) * 136 + kk * 32 + quad * 8); acc = mfma16(a, bb, acc); }
#pragma unroll
        for (int j = 0; j < 4; ++j) acc[j] *= __expf(acs[w * 16 + quad * 4 + j]);
#pragma unroll
        for (int kk = 0; kk < 4; ++kk) { const h16x8 a = *(const h16x8*)(Bm + (w * 16 + cc) * 136 + kk * 32 + quad * 8); const h16x8 bb = *(const h16x8*)(XT + (ni * 16 + cc) * 136 + kk * 32 + quad * 8); acc = mfma16(a, bb, acc); }
        const int p = ni * 16 + cc;
#pragma unroll
        for (int j = 0; j < 4; ++j) { const int lr = w * 16 + quad * 4 + j; const float x = (float)XT[p * 136 + lr];
            const float z = (float)C.PROJ[(row0 + lr) * PN + C_SZ + h * 64 + p]; const h16 yh = (h16)((acc[j] + Dh * x) * siluf_(z));
            C.XN[(row0 + lr) * 1024 + 512 + h * 64 + p] = yh; const float yr = (float)yh; ssq[j] += yr * yr; } }
#pragma unroll
    for (int j = 0; j < 4; ++j) { float s = ssq[j]; s += __shfl_xor(s, 1); s += __shfl_xor(s, 2); s += __shfl_xor(s, 4); s += __shfl_xor(s, 8);
        if (cc == 0) C.SSQ[(row0 + w * 16 + quad * 4 + j) * 8 + h] = s; }
    __syncthreads();
}

template <int PASS>
__device__ __forceinline__ void gla_block_unit(const Ctx& C, int l, int bu) {
    TIDS
    const int w = wave; const int wu = bu * 8 + w;
    const int bh = wu >> 7, seg = wu & 127, b = bh >> 2, h = bh & 3;
    const size_t row0 = (size_t)b * SEQ + seg * 64;
    float* as_ = (float*)(g_lds) + w * 1536; float* qs = as_ + 512; float* ks = as_ + 1024;
    const int k = lane & 31, half = lane >> 5;
    float w2r[16];
#pragma unroll
    for (int r = 0; r < 16; ++r) w2r[r] = C.in[3][(size_t)l * 16 * 128 + r * 128 + h * 32 + k];
    const float bk = C.in[4][l * 128 + h * 32 + k];
    float S[32];
    float* gst = C.GLAST + (size_t)(bh * 128 + seg) * 2048;
    if (PASS == 1) {
#pragma unroll
        for (int kk = 0; kk < 32; ++kk) S[kk] = gst[kk * 64 + lane];
    } else {
#pragma unroll
        for (int kk = 0; kk < 32; ++kk) S[kk] = 0.f;
    }
    float gtot = 1.f;
    const float gnw = C.in[5][l * 256 + h * 64 + lane];
    for (int bt = 0; bt < 4; ++bt) {
#pragma unroll 1
        for (int it = 0; it < 8; ++it) { const int tok = 2 * it + half; const size_t row = row0 + bt * 16 + tok;
            const f32x4* gp = (const f32x4*)(C.PSM + row * PSM_W); float z = bk;
#pragma unroll
            for (int r4 = 0; r4 < 4; ++r4) { const f32x4 gv = gp[r4]; z += gv.x * w2r[4 * r4] + gv.y * w2r[4 * r4 + 1] + gv.z * w2r[4 * r4 + 2] + gv.w * w2r[4 * r4 + 3]; }
            const float la = -softplusf_(-z) * (1.f / 16.f); const float a = __expf(la);
            as_[tok * 32 + k] = a; gtot *= a;
            qs[tok * 32 + k] = (float)C.PROJ[row * PN + C_GQ + h * 32 + k] * 0.17677669529663687f;
            ks[tok * 32 + k] = (float)C.PROJ[row * PN + C_GK + h * 32 + k]; }
        __syncthreads();
#pragma unroll 1
        for (int tok = 0; tok < 16; ++tok) { const size_t row = row0 + bt * 16 + tok;
            const float v = (float)C.PROJ[row * PN + C_GV + h * 64 + lane]; float acc = 0.f;
#pragma unroll
            for (int k4 = 0; k4 < 8; ++k4) { const f32x4 a4 = *(const f32x4*)(as_ + tok * 32 + 4 * k4), kk4 = *(const f32x4*)(ks + tok * 32 + 4 * k4);
#pragma unroll
                for (int e = 0; e < 4; ++e) S[4 * k4 + e] = a4[e] * S[4 * k4 + e] + kk4[e] * v;
                if (PASS == 1) { const f32x4 q4 = *(const f32x4*)(qs + tok * 32 + 4 * k4);
#pragma unroll
                    for (int e = 0; e < 4; ++e) acc += q4[e] * S[4 * k4 + e]; } }
            if (PASS == 1) { const float ssq = wave_sum(acc * acc); const float rs = 1.0f / sqrtf(ssq * (1.f / 64.f) + EPS);
                const float r = (float)C.PROJ[row * PN + C_GR + h * 64 + lane];
                C.XN[row * 1024 + h * 64 + lane] = (h16)(acc * rs * gnw * siluf_(r)); } }
        __syncthreads();
    }
    if (PASS == 0) {
#pragma unroll
        for (int kk = 0; kk < 32; ++kk) gst[kk * 64 + lane] = S[kk];
        gtot *= __shfl_xor(gtot, 32);
        if (lane < 32) C.GLAG[(size_t)(bh * 128 + seg) * 32 + lane] = gtot;
    }
}

__device__ __forceinline__ void phase_scans(const Ctx& C) {
    TIDS
    for (int e = C.bid * 512 + tid; e < BATCH * 8 * 8192; e += C.G * 512) {
        const int bh = e >> 13, b = bh >> 3, h = bh & 7, pn = e & 8191;
        float* p = C.SSDST + (size_t)(b * 64 * 8 + h) * 8192 + pn; const float* cd = C.CD + b * 64 * 8 + h;
        float st = 0.f;
        for (int c0 = 0; c0 < 64; c0 += 8) { float v[8], d[8];
#pragma unroll
            for (int i = 0; i < 8; ++i) { v[i] = p[(size_t)(c0 + i) * 8 * 8192]; d[i] = cd[(c0 + i) * 8]; }
#pragma unroll
            for (int i = 0; i < 8; ++i) { p[(size_t)(c0 + i) * 8 * 8192] = st; st = d[i] * st + v[i]; } }
    }
    for (int e = C.bid * 512 + tid; e < 16 * 2048; e += C.G * 512) {
        const int bh = e >> 11, kv = e & 2047, k = kv >> 6;
        float* p = C.GLAST + (size_t)bh * 128 * 2048 + kv; const float* gg = C.GLAG + (size_t)bh * 128 * 32 + k;
        float st = 0.f;
        for (int s0 = 0; s0 < 128; s0 += 8) { float v[8], d[8];
#pragma unroll
            for (int i = 0; i < 8; ++i) { v[i] = p[(size_t)(s0 + i) * 2048]; d[i] = gg[(s0 + i) * 32]; }
#pragma unroll
            for (int i = 0; i < 8; ++i) { p[(size_t)(s0 + i) * 2048] = st; st = d[i] * st + v[i]; } }
    }
}

__device__ __forceinline__ h16x4 tr_read(const h16* p) { typedef short s16x4 __attribute__((ext_vector_type(4))); return __builtin_bit_cast(h16x4, __builtin_amdgcn_ds_read_tr16_b64_v4i16((LAS s16x4*)p)); }
__device__ __forceinline__ float ex2(float x) { return __builtin_amdgcn_exp2f(x); }
struct FlashState { float m, l; f32x4 O[4]; };
constexpr int KV_LD = 72, KV_TILE = 64 * KV_LD;
__device__ __forceinline__ void qk_tile(f32x4 (&s)[4], const h16* Ks, const h16x8 (&qf)[2], int cc, int quad) {
#pragma unroll
    for (int mt = 0; mt < 4; ++mt) { f32x4 a = {0.f, 0.f, 0.f, 0.f};
#pragma unroll
        for (int ks = 0; ks < 2; ++ks) { const h16x8 kf = *(const h16x8*)(Ks + (mt * 16 + cc) * KV_LD + ks * 32 + quad * 8); a = mfma16(kf, qf[ks], a); }
        s[mt] = a; }
}
__device__ __forceinline__ void pv_tile(f32x4 (&O)[4], const h16* Vs, const f32x4 (&p)[4], int cc, int quad) {
    h16x8 pf[2];
#pragma unroll
    for (int k2 = 0; k2 < 2; ++k2) pf[k2] = (h16x8){(h16)p[2 * k2][0], (h16)p[2 * k2][1], (h16)p[2 * k2][2], (h16)p[2 * k2][3], (h16)p[2 * k2 + 1][0], (h16)p[2 * k2 + 1][1], (h16)p[2 * k2 + 1][2], (h16)p[2 * k2 + 1][3]};
#pragma unroll
    for (int md = 0; md < 4; ++md)
#pragma unroll
        for (int k2 = 0; k2 < 2; ++k2) { const h16* vp = Vs + (32 * k2 + 4 * quad + (cc >> 2)) * KV_LD + md * 16 + 4 * (cc & 3);
            const h16x4 lo = tr_read(vp), hi = tr_read(vp + 16 * KV_LD);
            const h16x8 vf = {lo[0], lo[1], lo[2], lo[3], hi[0], hi[1], hi[2], hi[3]}; O[md] = mfma16(vf, pf[k2], O[md]); }
}
template <int MODE>
__device__ __forceinline__ void flash_tile(FlashState& st, const h16* Ks, const h16* Vs, const h16x8 (&qf)[2], int kv0, int tq, bool selbit, int cc, int quad) {
    f32x4 s[4]; qk_tile(s, Ks, qf, cc, quad);
    float tmax = -INFINITY;
#pragma unroll
    for (int mt = 0; mt < 4; ++mt)
#pragma unroll
        for (int j = 0; j < 4; ++j) { const int kp = kv0 + mt * 16 + quad * 4 + j;
            const bool ok = (MODE == 0) ? (selbit && kp <= tq) : (kp <= tq && kp > tq - 512);
            const float v = ok ? s[mt][j] : -INFINITY; s[mt][j] = v; tmax = fmaxf(tmax, v); }
    tmax = fmaxf(tmax, __shfl_xor(tmax, 16)); tmax = fmaxf(tmax, __shfl_xor(tmax, 32));
    const float mnew = fmaxf(st.m, tmax); const float muse = (mnew == -INFINITY) ? 0.f : mnew;
    const float alpha = ex2(st.m - muse);
    float psum = 0.f;
#pragma unroll
    for (int mt = 0; mt < 4; ++mt)
#pragma unroll
        for (int j = 0; j < 4; ++j) { const float p = ex2(s[mt][j] - muse); s[mt][j] = p; psum += p; }
    st.l = st.l * alpha + psum; st.m = mnew;
#pragma unroll
    for (int md = 0; md < 4; ++md) st.O[md] *= alpha;
    pv_tile(st.O, Vs, s, cc, quad);
}
template <bool NEEDV, class SrcFn, class CompFn>
__device__ __forceinline__ void kv_pipeline(int n, int tid, h16* Kb, h16* Vb, SrcFn src, CompFn comp) {
    if (n <= 0) return;
    const int key = tid >> 3, c8 = tid & 7; const int loff = key * KV_LD + c8 * 8;
    h16x8 kr, vr = {};
    { const h16 *kp, *vp; size_t stride; src(0, kp, vp, stride); kr = *(const h16x8*)(kp + (size_t)key * stride + c8 * 8); if (NEEDV) vr = *(const h16x8*)(vp + (size_t)key * stride + c8 * 8); }
    *(h16x8*)(Kb + loff) = kr; if (NEEDV) *(h16x8*)(Vb + loff) = vr;
    __syncthreads();
    for (int i = 0; i < n; ++i) {
        const int cur = i & 1; const bool more = (i + 1 < n);
        if (more) { const h16 *kp, *vp; size_t stride; src(i + 1, kp, vp, stride); kr = *(const h16x8*)(kp + (size_t)key * stride + c8 * 8); if (NEEDV) vr = *(const h16x8*)(vp + (size_t)key * stride + c8 * 8); }
        comp(i, Kb + cur * KV_TILE, Vb + cur * KV_TILE);
        if (more) { *(h16x8*)(Kb + (cur ^ 1) * KV_TILE + loff) = kr; if (NEEDV) *(h16x8*)(Vb + (cur ^ 1) * KV_TILE + loff) = vr; }
        __syncthreads();
    }
}
__device__ __forceinline__ void nsa_attn_unit(const Ctx& C, int l, int b, int g, int qb) {
    TIDS
    const int w = wave, cc = lane & 15, quad = lane >> 4;
    const int r = cc >> 3, ti = cc & 7, tloc = 8 * w + ti, tq = 64 * qb + tloc, h = 2 * g + r;
    const size_t rowq = (size_t)b * SEQ + tq;
    h16* Kb = (h16*)g_lds; h16* Vb = (h16*)(g_lds + 2 * KV_TILE * 2);
    float* imp = (float*)(g_lds + 36864);
    unsigned* sel = (unsigned*)(g_lds + 36864 + 32768);
    unsigned* uni = sel + 256;
    unsigned char* lst = (unsigned char*)(uni + 8);
    h16x8 qf[2];
#pragma unroll
    for (int ks = 0; ks < 2; ++ks) qf[ks] = *(const h16x8*)(C.PROJ + rowq * PN + C_NQ + h * 64 + ks * 32 + quad * 8);
    const h16* kcb = C.KC + (size_t)(b * 2 + g) * 512 * 64; const h16* vcb = C.VC + (size_t)(b * 2 + g) * 512 * 64;
    const int ncmp = 4 * qb + 3, ntile_c = (ncmp + 63) >> 6;
    auto src_cmp = [&](int i, const h16*& kp, const h16*& vp, size_t& stride) { kp = kcb + (size_t)i * 64 * 64; vp = vcb + (size_t)i * 64 * 64; stride = 64; };
    float m1 = -INFINITY, l1 = 0.f;
    kv_pipeline<false>(ntile_c, tid, Kb, Vb, src_cmp, [&](int tc, const h16* Ks, const h16*) {
        f32x4 s[4]; qk_tile(s, Ks, qf, cc, quad); float tmax = -INFINITY;
#pragma unroll
        for (int mt = 0; mt < 4; ++mt)
#pragma unroll
            for (int j = 0; j < 4; ++j) { const int n = tc * 64 + mt * 16 + quad * 4 + j; const float v = (16 * n + 31 <= tq) ? s[mt][j] : -INFINITY; s[mt][j] = v; tmax = fmaxf(tmax, v); }
        tmax = fmaxf(tmax, __shfl_xor(tmax, 16)); tmax = fmaxf(tmax, __shfl_xor(tmax, 32));
        const float mnew = fmaxf(m1, tmax), muse = (mnew == -INFINITY) ? 0.f : mnew;
        float ps = 0.f;
#pragma unroll
        for (int mt = 0; mt < 4; ++mt)
#pragma unroll
            for (int j = 0; j < 4; ++j) ps += ex2(s[mt][j] - muse);
        l1 = l1 * ex2(m1 - muse) + ps; m1 = mnew; });
    l1 += __shfl_xor(l1, 16); l1 += __shfl_xor(l1, 32);
    const float inv1 = (l1 > 0.f) ? 1.f / l1 : 0.f; const float m1u = (m1 == -INFINITY) ? 0.f : m1;
    f32x4 Oc[4];
#pragma unroll
    for (int md = 0; md < 4; ++md) Oc[md] = (f32x4){0.f, 0.f, 0.f, 0.f};
    float carry_q3 = 0.f;
    kv_pipeline<true>(ntile_c, tid, Kb, Vb, src_cmp, [&](int tc, const h16* Ks, const h16* Vs) {
        f32x4 s[4]; qk_tile(s, Ks, qf, cc, quad);
#pragma unroll
        for (int mt = 0; mt < 4; ++mt) { f32x4 a = s[mt];
#pragma unroll
            for (int j = 0; j < 4; ++j) { const int n = tc * 64 + mt * 16 + quad * 4 + j; a[j] = (16 * n + 31 <= tq) ? ex2(a[j] - m1u) * inv1 : 0.f; }
            s[mt] = a;
            const float s4 = (a[0] + a[1]) + (a[2] + a[3]); const float p3 = a[3];
            const float fromprev = __shfl(p3, (lane + 48) & 63);
            const float fromq3 = __shfl(p3, cc + 48);
            float val = s4 + ((quad == 0) ? carry_q3 : fromprev);
            carry_q3 = fromq3;
            val += __shfl_xor(val, 8);
            if (r == 0) imp[tloc * 128 + tc * 16 + mt * 4 + quad] = val; }
        pv_tile(Oc, Vs, s, cc, quad); });
    if (qb < 16) {
        if (tid < 64) { const unsigned mlo = (2u << qb) - 1u; sel[tid * 4 + 0] = mlo; sel[tid * 4 + 1] = 0u; sel[tid * 4 + 2] = 0u; sel[tid * 4 + 3] = 0u; }
    } else {
        const int jhi = qb - 2;
        const unsigned long long lt = __lanemask_lt();
        for (int t8 = 0; t8 < 8; ++t8) { const int row = 8 * w + t8; const float* ir = imp + row * 128;
            const int j1 = lane, j2 = lane + 64; const bool ok1 = (j1 >= 1 && j1 <= jhi), ok2 = (j2 <= jhi);
            const unsigned u1 = ok1 ? __float_as_uint(ir[j1]) + 1u : 0u, u2 = ok2 ? __float_as_uint(ir[j2]) + 1u : 0u;
            unsigned prefix = 0u;
            for (int bit = 30; bit >= 0; --bit) { const unsigned test = prefix | (1u << bit);
                const int cnt = __popcll(__ballot(u1 >= test)) + __popcll(__ballot(u2 >= test)); if (cnt >= 13) prefix = test; }
            const bool gt1 = u1 > prefix, gt2 = u2 > prefix, eq1 = u1 == prefix, eq2 = u2 == prefix;
            const unsigned long long bg1 = __ballot(gt1), bg2 = __ballot(gt2), be1 = __ballot(eq1), be2 = __ballot(eq2);
            const int need = 13 - __popcll(bg1) - __popcll(bg2);
            const bool s1 = gt1 || (eq1 && __popcll(be1 & lt) < need), s2 = gt2 || (eq2 && (__popcll(be1) + __popcll(be2 & lt)) < need);
            unsigned long long blo = __ballot(s1) | 1ull, bhi = __ballot(s2);
            { const int f0 = qb - 1, f1 = qb; if (f0 < 64) blo |= 1ull << f0; else bhi |= 1ull << (f0 - 64); if (f1 < 64) blo |= 1ull << f1; else bhi |= 1ull << (f1 - 64); }
            if (lane == 0) { sel[row * 4 + 0] = (unsigned)blo; sel[row * 4 + 1] = (unsigned)(blo >> 32); sel[row * 4 + 2] = (unsigned)bhi; sel[row * 4 + 3] = (unsigned)(bhi >> 32); } }
    }
    __syncthreads();
    if (w == 0) {
        unsigned o0 = sel[lane * 4 + 0], o1 = sel[lane * 4 + 1], o2 = sel[lane * 4 + 2], o3 = sel[lane * 4 + 3];
#pragma unroll
        for (int sft = 1; sft < 64; sft <<= 1) { o0 |= __shfl_xor(o0, sft); o1 |= __shfl_xor(o1, sft); o2 |= __shfl_xor(o2, sft); o3 |= __shfl_xor(o3, sft); }
        const unsigned long long mlo = ((unsigned long long)o1 << 32) | o0, mhi = ((unsigned long long)o3 << 32) | o2;
        const unsigned long long lt = __lanemask_lt(); const int nlo = __popcll(mlo);
        if ((mlo >> lane) & 1ull) lst[__popcll(mlo & lt)] = (unsigned char)lane;
        if ((mhi >> lane) & 1ull) lst[nlo + __popcll(mhi & lt)] = (unsigned char)(64 + lane);
        if (lane == 0) uni[4] = (unsigned)(nlo + __popcll(mhi));
    }
    __syncthreads();
    const unsigned long long selLo = ((unsigned long long)sel[tloc * 4 + 1] << 32) | sel[tloc * 4 + 0], selHi = ((unsigned long long)sel[tloc * 4 + 3] << 32) | sel[tloc * 4 + 2];
    const int nlist = (int)uni[4];
    FlashState fs; fs.m = -INFINITY; fs.l = 0.f;
#pragma unroll
    for (int md = 0; md < 4; ++md) fs.O[md] = (f32x4){0.f, 0.f, 0.f, 0.f};
    const h16* kslc = C.PROJ + (size_t)b * SEQ * PN + C_KSLC + g * 64; const h16* vslc = C.PROJ + (size_t)b * SEQ * PN + C_VSLC + g * 64;
    kv_pipeline<true>(nlist, tid, Kb, Vb,
        [&](int i, const h16*& kp, const h16*& vp, size_t& stride) { const int j = lst[i]; kp = kslc + (size_t)j * 64 * PN; vp = vslc + (size_t)j * 64 * PN; stride = PN; },
        [&](int i, const h16* Ks, const h16* Vs) { const int j = lst[i];
            const unsigned long long sw = (j < 64) ? selLo : selHi; const bool sb = ((sw >> (j & 63)) & 1ull) != 0ull;
            if (__any(sb)) flash_tile<0>(fs, Ks, Vs, qf, j * 64, tq, sb, cc, quad); });
    float ls = fs.l; ls += __shfl_xor(ls, 16); ls += __shfl_xor(ls, 32); const float invs = (ls > 0.f) ? 1.f / ls : 0.f;
    f32x4 Os[4];
#pragma unroll
    for (int md = 0; md < 4; ++md) Os[md] = fs.O[md] * invs;
    fs.m = -INFINITY; fs.l = 0.f;
#pragma unroll
    for (int md = 0; md < 4; ++md) fs.O[md] = (f32x4){0.f, 0.f, 0.f, 0.f};
    const h16* kwin = C.PROJ + (size_t)b * SEQ * PN + C_KWIN + g * 64; const h16* vwin = C.PROJ + (size_t)b * SEQ * PN + C_VWIN + g * 64;
    const int jw0 = (qb >= 8 ? qb - 8 : 0);
    kv_pipeline<true>(qb - jw0 + 1, tid, Kb, Vb,
        [&](int i, const h16*& kp, const h16*& vp, size_t& stride) { const int j = jw0 + i; kp = kwin + (size_t)j * 64 * PN; vp = vwin + (size_t)j * 64 * PN; stride = PN; },
        [&](int i, const h16* Ks, const h16* Vs) { flash_tile<1>(fs, Ks, Vs, qf, (jw0 + i) * 64, tq, true, cc, quad); });
    float lw = fs.l; lw += __shfl_xor(lw, 16); lw += __shfl_xor(lw, 32); const float invw = (lw > 0.f) ? 1.f / lw : 0.f;
    const float* gp = C.PSM + rowq * PSM_W + 16 + h * 3;
    const float g0 = sigmoidf_(gp[0]), g1 = sigmoidf_(gp[1]), g2 = sigmoidf_(gp[2]) * invw;
    float ssq = 0.f; f32x4 o[4];
#pragma unroll
    for (int md = 0; md < 4; ++md) { o[md] = g0 * Oc[md] + g1 * Os[md] + g2 * fs.O[md]; ssq += (o[md][0] * o[md][0] + o[md][1] * o[md][1]) + (o[md][2] * o[md][2] + o[md][3] * o[md][3]); }
    ssq += __shfl_xor(ssq, 16); ssq += __shfl_xor(ssq, 32);
    const float rs = 1.0f / sqrtf(ssq * (1.f / 64.f) + EPS);
    const float* nw = C.in[12] + l * 256 + h * 64;
#pragma unroll
    for (int md = 0; md < 4; ++md) { const int d = md * 16 + quad * 4; u32x2 wv; wv.x = pkh(o[md][0] * rs * nw[d], o[md][1] * rs * nw[d + 1]); wv.y = pkh(o[md][2] * rs * nw[d + 2], o[md][3] * rs * nw[d + 3]);
        *(u32x2*)(C.XN + rowq * 1024 + 256 + h * 64 + d) = wv; }
}

__device__ __forceinline__ void phase_ssdnorm(const Ctx& C, int l) {
    TIDS
    const int gw = C.bid * 8 + wave, NGW = C.G * 8; const float* nw = C.in[18] + l * 512 + lane * 8;
    for (int m = gw; m < MTOK; m += NGW) { const int g = lane >> 5; const f32x4 q = *(const f32x4*)(C.SSQ + (size_t)m * 8 + g * 4);
        const float rs = 1.0f / sqrtf(((q.x + q.y) + (q.z + q.w)) * (1.f / 256.f) + EPS);
        h16* p = C.XN + (size_t)m * 1024 + 512 + lane * 8; const h16x8 v = *(const h16x8*)p;
        u32x4 o; o.x = pkh((float)v[0] * rs * nw[0], (float)v[1] * rs * nw[1]); o.y = pkh((float)v[2] * rs * nw[2], (float)v[3] * rs * nw[3]);
        o.z = pkh((float)v[4] * rs * nw[4], (float)v[5] * rs * nw[5]); o.w = pkh((float)v[6] * rs * nw[6], (float)v[7] * rs * nw[7]); *(u32x4*)p = o; }
}
__device__ __forceinline__ void phase_norm(const Ctx& C, const float* src, h16* dst) {
    TIDS
    const int gw = C.bid * 8 + wave, NGW = C.G * 8;
    for (int m = gw; m < MTOK; m += NGW) rms_row_to_h16(src + (size_t)m * DM, dst + (size_t)m * DM, lane);
}
__device__ __forceinline__ void phase_final(const Ctx& C) {
    TIDS
    const int gw = C.bid * 8 + wave, NGW = C.G * 8; const f32x4* fw = (const f32x4*)C.in[23] + lane;
    for (int m = gw; m < MTOK; m += NGW) { f32x4* xr = (f32x4*)(C.out + (size_t)m * DM) + lane; f32x4 v[4]; float s = 0.f;
#pragma unroll
        for (int j = 0; j < 4; ++j) { v[j] = xr[64 * j]; s += (v[j].x * v[j].x + v[j].y * v[j].y) + (v[j].z * v[j].z + v[j].w * v[j].w); }
        const float rs = 1.0f / sqrtf(wave_sum(s) * (1.f / DM) + EPS);
#pragma unroll
        for (int j = 0; j < 4; ++j) xr[64 * j] = v[j] * rs * fw[64 * j]; }
}

constexpr int N_PHASES = 1 + 11 * DEPTH;
#ifndef PHM
#define PHM 0xffffffffu
#endif
#define EN(k) ((PHM >> (k)) & 1u)
#ifndef PROBE_PH
#define PROBE_PH -1
#define PROBE_REPS 1
#endif
#define REPN(ph) ((ph) == PROBE_PH ? PROBE_REPS : 1)
template <int ph> __device__ __forceinline__ void run_phase(const Params* kp, int rep) {
    Ctx C; make_ctx(C, kp);
    LAS unsigned char* ldsl = (LAS unsigned char*)g_lds;
    if constexpr (ph == 0) { if (EN(0)) phase_prep(C); return; }
    constexpr int l = (ph - 1) / 11, s = (ph - 1) % 11;
    if (s == 0) { if (EN(1)) { pg8::Gemm g{(const pg8::bf16_t*)C.XN, (const pg8::bf16_t*)(C.WIN + (size_t)l * PN * DM), MTOK, PN, DM}; pg8::StaticOrder S; S.init(MTOK, PN, C.G, C.bid);
        pg8::EpiProj E{C.PROJ, C.PSM}; pg8::gemm_phase<pg8::EpiProj>(ldsl, g, S, E); } }
    else if (s == 1) { if (EN(2)) phase_tok(C, l); }
    else if (s == 2) { for (int u = C.bid; u < 512 + 2048 + 256; u += C.G) { if (u < 512) { if (EN(3)) nsa_compress_unit(C, l, u); } else if (u < 2560) { if (EN(4)) ssd_states_unit(C, l, u - 512); } else { if (EN(5)) gla_block_unit<0>(C, l, u - 2560); } } }
    else if (s == 3) { if (EN(6) && rep == 0) phase_scans(C);
        if (EN(7)) for (int v = C.bid; v < 1024; v += C.G) { const int bg = (v & 255) >> 5, sidx = v & 31, k = v >> 8;
            const int qb = (k == 0) ? sidx : (k == 1) ? 63 - sidx : (k == 2) ? 64 + sidx : 127 - sidx; nsa_attn_unit(C, l, bg >> 1, bg & 1, qb); } }
    else if (s == 4) { for (int u = C.bid; u < 2048 + 256; u += C.G) { if (u < 2048) { if (EN(8)) ssd_y_unit(C, l, u); } else { if (EN(9)) gla_block_unit<1>(C, l, u - 2048); } } }
    else if (s == 5) { if (EN(10)) phase_ssdnorm(C, l); }
    else if (s == 6) { if (EN(11)) { pg8::Gemm g{(const pg8::bf16_t*)C.XN, (const pg8::bf16_t*)(C.WOUT + (size_t)l * DM * DM), MTOK, DM, DM}; pg8::StaticOrder S; S.init(MTOK, DM, C.G, C.bid);
        pg8::EpiRes E{l == 0 ? C.in[0] : C.out, C.out}; pg8::gemm_phase<pg8::EpiRes>(ldsl, g, S, E); } }
    else if (s == 7) { if (EN(12)) phase_norm(C, C.out, C.XN); }
    else if (s == 8) { if (EN(13)) { pg8::Gemm g{(const pg8::bf16_t*)C.XN, (const pg8::bf16_t*)(C.WUP + (size_t)l * DFF * DM), MTOK, DFF, DM}; pg8::StaticOrder S; S.init(MTOK, DFF, C.G, C.bid);
        pg8::EpiHid E{C.HID}; pg8::gemm_phase<pg8::EpiHid>(ldsl, g, S, E); } }
    else if (s == 9) { if (EN(14)) { pg8::Gemm g{(const pg8::bf16_t*)C.HID, (const pg8::bf16_t*)(C.WDN + (size_t)l * DM * DFF), MTOK, DM, DFF}; pg8::StaticOrder S; S.init(MTOK, DM, C.G, C.bid);
        pg8::EpiRes E{C.out, C.out}; pg8::gemm_phase<pg8::EpiRes>(ldsl, g, S, E); } }
    else { if (EN(15)) { if (l + 1 < DEPTH) phase_norm(C, C.out, C.XN); else phase_final(C); } }
}
constexpr int LDS_MISC = 131072;
template <int PH> __device__ __forceinline__ void phase_seq(const Params* kp, int lo, int hi, cg::grid_group& grid, const XcdBarrier& bar) {
    if constexpr (PH < N_PHASES) {
        if (lo <= PH && PH < hi) {
            for (int rep = 0; rep < REPN(PH); ++rep) run_phase<PH>(kp, rep);
            if (PH + 1 < hi) { if (PH == 0) grid.sync(); else xcd_barrier(bar); }
        }
        phase_seq<PH + 1>(kp, lo, hi, grid, bar);
    }
}
__global__ void __launch_bounds__(512, 2) fwd_kernel(Params P) {
    const Params* kp = (const Params*)__builtin_amdgcn_kernarg_segment_ptr();
    cg::grid_group grid = cg::this_grid();
    volatile LAS unsigned* st = (volatile LAS unsigned*)((LAS unsigned char*)g_lds + LDS_MISC);
    if (threadIdx.x < 2) st[threadIdx.x] = 0u;
    __syncthreads();
    const XcdBarrier bar = xcd_barrier_post((unsigned*)P.ws, st);
    phase_seq<0>(kp, P.ph_lo, P.ph_hi, grid, bar);
}

extern "C" void kernel_launch(void* const* d_in, const int* in_sizes, int n_in, void* d_out, int out_size, void* d_ws, size_t ws_size, hipStream_t stream) {
    static int grid = 0;
    if (grid == 0) {
        if (n_in != 24 || in_sizes[0] != MTOK * DM || out_size != MTOK * DM || ws_size < WS_END) { fprintf(stderr, "kernel_launch: unexpected shapes (n_in %d, ws %zu)\n", n_in, ws_size); grid = -1; return; }
        int dev = 0, cus = 0, per_cu = 0;
        hipGetDevice(&dev); hipDeviceGetAttribute(&cus, hipDeviceAttributeMultiprocessorCount, dev);
        hipFuncSetAttribute((const void*)fwd_kernel, hipFuncAttributeMaxDynamicSharedMemorySize, LDS_BYTES);
        hipOccupancyMaxActiveBlocksPerMultiprocessor(&per_cu, (const void*)fwd_kernel, 512, LDS_BYTES);
        (void)hipGetLastError();
        if (per_cu < 1) { fprintf(stderr, "kernel_launch: occupancy query says %d blocks/CU\n", per_cu); grid = -1; return; }
        grid = cus;
    }
    if (grid < 0) return;
    (void)hipMemsetAsync(d_ws, 0, 16384, stream);
    Params p{};
    for (int i = 0; i < 24; ++i) p.in[i] = (const float*)d_in[i];
    p.out = (float*)d_out; p.ws = (unsigned char*)d_ws;
#if MK_MULTI_LAUNCH
    for (int ph = 0; ph < N_PHASES; ++ph) { p.ph_lo = ph; p.ph_hi = ph + 1; hipLaunchKernelGGL(fwd_kernel, dim3(grid), dim3(512), LDS_BYTES, stream, p); }
#else
    p.ph_lo = 0; p.ph_hi = N_PHASES;
    void* args[] = {&p};
    hipError_t e = hipLaunchCooperativeKernel((const void*)fwd_kernel, dim3(grid), dim3(512), args, LDS_BYTES, stream);
    if (e != hipSuccess) fprintf(stderr, "cooperative launch failed: %s (grid %d)\n", hipGetErrorString(e), grid);
#endif
}
```

```cpp
#include <hip/hip_runtime.h>
#include <hip/hip_cooperative_groups.h>
#include <cstdio>
#include <cstdint>
namespace cg = cooperative_groups;

#ifndef MK_MULTI_LAUNCH
#define MK_MULTI_LAUNCH 0
#endif

#define LAS __attribute__((address_space(3)))
typedef _Float16 h16;
typedef _Float16 h16x8 __attribute__((ext_vector_type(8)));
typedef _Float16 h16x4 __attribute__((ext_vector_type(4)));
typedef _Float16 h16x2 __attribute__((ext_vector_type(2)));
typedef float f32x4 __attribute__((ext_vector_type(4)));
typedef float f32x2 __attribute__((ext_vector_type(2)));
typedef unsigned u32x4 __attribute__((ext_vector_type(4)));
typedef unsigned u32x2 __attribute__((ext_vector_type(2)));

constexpr int BATCH = 4, SEQ = 8192, DM = 1024, MTOK = BATCH * SEQ, DEPTH = 2;
constexpr int DIN = 3364, PN = 3584, DFF = 4096;
constexpr float EPS = 1e-6f;
constexpr int C_GQ = 0, C_GK = 128, C_GV = 256, C_GR = 512, C_NQ = 768, C_NKV = 1024, C_SZ = 1792, C_SX = 2304, C_SM = 3328;
constexpr int C_KCMP = C_NKV, C_VCMP = C_NKV + 128, C_KSLC = C_NKV + 256, C_VSLC = C_NKV + 384, C_KWIN = C_NKV + 512, C_VWIN = C_NKV + 640;
constexpr int PSM_W = 64;

constexpr size_t MiB = 1u << 20;
constexpr size_t WS_WIN = 2 * MiB;
constexpr size_t WS_WOUT = 16 * MiB;
constexpr size_t WS_WUP = 20 * MiB;
constexpr size_t WS_WDN = 36 * MiB;
constexpr size_t WS_W1T = 52 * MiB;
constexpr size_t WS_W2T = 54 * MiB;
constexpr size_t WS_B1 = 54 * MiB + 256 * 1024;
constexpr size_t WS_ROPE = 55 * MiB;
constexpr size_t WS_XN = 60 * MiB;
constexpr size_t WS_PROJ = 124 * MiB;
constexpr size_t WS_HID = 124 * MiB;
constexpr size_t WS_XBCC = 348 * MiB;
constexpr size_t WS_SSDST = 412 * MiB;
constexpr size_t WS_GLAST = 476 * MiB;
constexpr size_t WS_PSM = 492 * MiB;
constexpr size_t WS_KC = 500 * MiB;
constexpr size_t WS_VC = 500 * MiB + 512 * 1024;
constexpr size_t WS_SSQ = 501 * MiB;
constexpr size_t WS_DTV = 502 * MiB;
constexpr size_t WS_ACS = 503 * MiB;
constexpr size_t WS_CD = 504 * MiB;
constexpr size_t WS_GLAG = 504 * MiB + 64 * 1024;
constexpr size_t WS_END = 505 * MiB;

constexpr int LDS_BYTES = 147456;
extern __shared__ __attribute__((aligned(16))) unsigned char g_lds[];

struct Params { const float* in[24]; float* out; unsigned char* ws; int ph_lo, ph_hi; };

__constant__ float ROPE_INV[32] = {
 1.000000000e+00f, 7.498942614e-01f, 5.623413324e-01f, 4.216965139e-01f, 3.162277639e-01f, 2.371373773e-01f, 1.778279394e-01f, 1.333521307e-01f,
 1.000000015e-01f, 7.498941571e-02f, 5.623413250e-02f, 4.216965288e-02f, 3.162277490e-02f, 2.371373773e-02f, 1.778279431e-02f, 1.333521493e-02f,
 9.999999776e-03f, 7.498941850e-03f, 5.623413250e-03f, 4.216964822e-03f, 3.162277630e-03f, 2.371373586e-03f, 1.778279431e-03f, 1.333521446e-03f,
 1.000000047e-03f, 7.498942432e-04f, 5.623413017e-04f, 4.216965172e-04f, 3.162277571e-04f, 2.371373703e-04f, 1.778279402e-04f, 1.333521504e-04f };

__device__ __forceinline__ f32x4 mfma16(h16x8 a, h16x8 b, f32x4 c) { return __builtin_amdgcn_mfma_f32_16x16x32_f16(a, b, c, 0, 0, 0); }
__device__ __forceinline__ float wave_sum(float v) {
#pragma unroll
    for (int o = 1; o < 64; o <<= 1) v += __shfl_xor(v, o);
    return v;
}
__device__ __forceinline__ float ex2(float x) { return __builtin_amdgcn_exp2f(x); }
__device__ __forceinline__ float sigmoidf_(float x) { return 1.f / (1.f + __expf(-x)); }
__device__ __forceinline__ float siluf_(float x) { return x / (1.f + __expf(-x)); }
__device__ __forceinline__ float softplusf_(float x) { return fmaxf(x, 0.f) + log1pf(__expf(-fabsf(x))); }
__device__ __forceinline__ unsigned pkh(float lo, float hi) { h16x2 v = {(h16)lo, (h16)hi}; return __builtin_bit_cast(unsigned, v); }

__device__ __forceinline__ int opaque_tid() { int t = threadIdx.x; asm volatile("" : "+v"(t)); return t; }
namespace pg8 {
typedef unsigned short bf16_t;
constexpr int BM = 256, BK = 64, HALF = 128, HTB = HALF * BK * 2, STAGE_BYTES = 8 * HTB, NXCD = 8, WGM = 8;
__host__ __device__ __forceinline__ int lds_byte(int r, int c) { const int st = (r >> 4) * 2 + (c >> 5), rr = r & 15, cc = c & 31, ob = rr * 64 + cc * 2; return st * 1024 + (ob ^ (((ob >> 9) & 1) << 5)); }
__host__ __device__ __forceinline__ void stage_rc(int b, int& R, int& C) { const int st = b / 1024, sb = b % 1024, swz = sb ^ (((sb >> 9) & 1) << 5); R = (st >> 1) * 16 + swz / 64; C = (st & 1) * 32 + (swz % 64) / 2; }
__host__ __device__ __forceinline__ int perm32(int rho) { const int n = rho >> 4, i = rho & 15; return 8 * (i >> 2) + 4 * n + (i & 3); }
struct Unit { int pm, pn; };
struct Gemm { const bf16_t* A; const bf16_t* Bt; int M, N, K; };
struct StaticOrder {
    int nM, nN, nwg, G, c;
    __device__ void init(int M, int N, int G_, int c_) { nM = M / BM; nN = N / BM; nwg = nM * nN; G = G_; c = c_; }
    __device__ bool next(int i, Unit& u) const {
        const long L = (long)i * G + c; if (L >= nwg) return false;
        int wgid = (int)L; { const int q = nwg / NXCD, r = nwg % NXCD, xcd = wgid % NXCD, off = wgid / NXCD; wgid = (xcd < r ? xcd * (q + 1) : r * (q + 1) + (xcd - r) * q) + off; }
        const int nig = WGM * nN, gid = wgid / nig, fm = gid * WGM, gsz = (nM - fm) < WGM ? (nM - fm) : WGM;
        u.pm = fm + ((wgid % nig) % gsz); u.pn = (wgid % nig) / gsz; return true;
    }
};
struct EpiProj {
    static constexpr bool PERM = true;
    h16* O; float* PSM;
    __device__ __forceinline__ void operator()(const f32x4 (&acc)[2][2][4][2], const Unit& u, int wr, int wc, int fr, int fq) const {
        const int row0 = u.pm * BM + wr * 64 + fr, col0 = u.pn * BM + wc * 32 + 8 * fq;
#pragma unroll
        for (int ai = 0; ai < 2; ++ai)
#pragma unroll
            for (int m = 0; m < 4; ++m) { const int row = row0 + ai * HALF + m * 16;
#pragma unroll
                for (int bj = 0; bj < 2; ++bj) { const f32x4 v0 = acc[ai][bj][m][0], v1 = acc[ai][bj][m][1]; const int c = col0 + bj * HALF;
                    u32x4 w; w.x = pkh(v0[0], v0[1]); w.y = pkh(v0[2], v0[3]); w.z = pkh(v1[0], v1[1]); w.w = pkh(v1[2], v1[3]);
                    *(u32x4*)(O + (size_t)row * PN + c) = w;
                    if (c >= C_SM && c < C_SM + PSM_W) { float* p = PSM + (size_t)row * PSM_W + (c - C_SM); *(f32x4*)p = v0; *(f32x4*)(p + 4) = v1; } } }
    }
};
struct EpiHid {
    static constexpr bool PERM = true;
    h16* O;
    __device__ __forceinline__ void operator()(const f32x4 (&acc)[2][2][4][2], const Unit& u, int wr, int wc, int fr, int fq) const {
        const int row0 = u.pm * BM + wr * 64 + fr, col0 = u.pn * BM + wc * 32 + 8 * fq;
#pragma unroll
        for (int ai = 0; ai < 2; ++ai)
#pragma unroll
            for (int m = 0; m < 4; ++m) { const int row = row0 + ai * HALF + m * 16;
#pragma unroll
                for (int bj = 0; bj < 2; ++bj) { f32x4 v0 = acc[ai][bj][m][0], v1 = acc[ai][bj][m][1];
#pragma unroll
                    for (int e = 0; e < 4; ++e) { float a = fmaxf(v0[e], 0.f), b = fmaxf(v1[e], 0.f); v0[e] = a * a; v1[e] = b * b; }
                    u32x4 w; w.x = pkh(v0[0], v0[1]); w.y = pkh(v0[2], v0[3]); w.z = pkh(v1[0], v1[1]); w.w = pkh(v1[2], v1[3]);
                    *(u32x4*)(O + (size_t)row * DFF + col0 + bj * HALF) = w; } }
    }
};
struct EpiRes {
    static constexpr bool PERM = false;
    const float* base; float* out;
    __device__ __forceinline__ void operator()(const f32x4 (&acc)[2][2][4][2], const Unit& u, int wr, int wc, int fr, int fq) const {
        const int col0 = u.pn * BM + wc * 32 + 4 * fq;
#pragma unroll
        for (int ai = 0; ai < 2; ++ai)
#pragma unroll
            for (int m = 0; m < 4; ++m) { const size_t off = (size_t)(u.pm * BM + ai * HALF + wr * 64 + m * 16 + fr) * DM + col0;
#pragma unroll
                for (int bj = 0; bj < 2; ++bj)
#pragma unroll
                    for (int n = 0; n < 2; ++n) { const f32x4 bs = *(const f32x4*)(base + off + bj * HALF + n * 16); *(f32x4*)(out + off + bj * HALF + n * 16) = bs + acc[ai][bj][m][n]; } }
    }
};

template <class Epi>
__device__ __forceinline__ void gemm_phase(LAS unsigned char* lds, const Gemm g, const StaticOrder& S, const Epi& E) {
    const int tid = opaque_tid(), wid = __builtin_amdgcn_readfirstlane(tid >> 6), lane = tid & 63, wr = wid >> 2, wc = wid & 3, fr = lane & 15, fq = lane >> 4;
    const int K = g.K, nt = K / BK;
    unsigned voffA[2], voffB[2];
#pragma unroll
    for (int i = 0; i < 2; ++i) { int R, C; stage_rc(tid * 16 + i * 8192, R, C); const int Rb = Epi::PERM ? ((R & ~31) + perm32(R & 31)) : R;
        voffA[i] = (unsigned)(R * K + C) * 2u; voffB[i] = (unsigned)(Rb * K + C) * 2u; }
    const size_t kstep = (size_t)(BK * 2);
    const size_t hstep = (size_t)HALF * K * 2;
    const size_t tstep = 2 * hstep;
    const unsigned ldsw = (unsigned)wid * 1024u;
    const int aoff = lds_byte(wr * 64 + fr, fq * 8), boff = lds_byte(wc * 32 + fr, fq * 8);
#define PG8_SA(b, h) (((b) * 2 + (h)) * HTB)
#define PG8_SB(b, h) ((4 + (b) * 2 + (h)) * HTB)
#define PG8_STAGE(bufoff, gbase, voff) do { _Pragma("unroll") for (int _i = 0; _i < 2; ++_i) \
        __builtin_amdgcn_global_load_lds((const unsigned*)((const char*)(gbase) + (voff)[_i]), (LAS unsigned*)(lds + (bufoff) + ldsw + _i * 8192), 16, 0, 0); } while (0)
#define PG8_LDA(dst, b, h) do { _Pragma("unroll") for (int m = 0; m < 4; ++m) _Pragma("unroll") for (int k = 0; k < 2; ++k) dst[m][k] = *(const LAS h16x8*)(lds + PG8_SA(b, h) + aoff + m * 2048 + k * 1024); } while (0)
#define PG8_LDB(dst, b, h) do { _Pragma("unroll") for (int n = 0; n < 2; ++n) _Pragma("unroll") for (int k = 0; k < 2; ++k) dst[n][k] = *(const LAS h16x8*)(lds + PG8_SB(b, h) + boff + n * 2048 + k * 1024); } while (0)
#define PG8_MMA(ai, bj, At, Bt) do { __builtin_amdgcn_s_setprio(1); _Pragma("unroll") for (int m = 0; m < 4; ++m) _Pragma("unroll") for (int n = 0; n < 2; ++n) _Pragma("unroll") for (int k = 0; k < 2; ++k) \
        acc[ai][bj][m][n] = __builtin_amdgcn_mfma_f32_16x16x32_f16(Bt[n][k], At[m][k], acc[ai][bj][m][n], 0, 0, 0); __builtin_amdgcn_s_setprio(0); } while (0)
#define PG8_WAIT_V(n) asm volatile("s_waitcnt vmcnt(" #n ")" ::: "memory")
#define PG8_WAIT_L(n) asm volatile("s_waitcnt lgkmcnt(" #n ")" ::: "memory")
#define PG8_BAR __builtin_amdgcn_s_barrier()
#define PG8_SCHED __builtin_amdgcn_sched_barrier(0)
    Unit cur, nxt; int ui = 0;
    if (!S.next(0, cur)) return;
    f32x4 acc[2][2][4][2];
#pragma unroll
    for (int a = 0; a < 2; ++a)
#pragma unroll
        for (int b = 0; b < 2; ++b)
#pragma unroll
            for (int m = 0; m < 4; ++m)
#pragma unroll
                for (int n = 0; n < 2; ++n) acc[a][b][m][n] = (f32x4){0.f, 0.f, 0.f, 0.f};
    h16x8 At[4][2], B0[2][2], B1[2][2];
    const char* cA = (const char*)g.A + (size_t)cur.pm * tstep; const char* cB = (const char*)g.Bt + (size_t)cur.pn * tstep;
    PG8_STAGE(PG8_SB(0, 0), cB, voffB); PG8_STAGE(PG8_SB(0, 1), cB + hstep, voffB); PG8_STAGE(PG8_SA(0, 0), cA, voffA); PG8_STAGE(PG8_SA(0, 1), cA + hstep, voffA);
    if (wr == 1) PG8_BAR;
    PG8_WAIT_V(2); PG8_BAR;
    PG8_STAGE(PG8_SB(1, 0), cB + kstep, voffB); PG8_STAGE(PG8_SA(1, 0), cA + kstep, voffA); PG8_STAGE(PG8_SB(1, 1), cB + hstep + kstep, voffB);
    PG8_WAIT_V(6); PG8_BAR;
    for (;;) {
        const bool has_next = S.next(ui + 1, nxt);
        const char* nA = has_next ? (const char*)g.A + (size_t)nxt.pm * tstep : cA; const char* nB = has_next ? (const char*)g.Bt + (size_t)nxt.pn * tstep : cB;
        for (int t = 0; t < nt; t += 2) {
            const bool last = (t == nt - 2);
            const char* a1 = cA + (size_t)(t + 1) * kstep;
            const char* a2 = last ? nA : cA + (size_t)(t + 2) * kstep; const char* b2 = last ? nB : cB + (size_t)(t + 2) * kstep;
            const char* a3 = a2 + kstep; const char* b3 = b2 + kstep;
            PG8_LDB(B0, 0, 0); PG8_LDB(B1, 0, 1); PG8_SCHED; PG8_LDA(At, 0, 0); PG8_STAGE(PG8_SA(1, 1), a1 + hstep, voffA);
            PG8_WAIT_V(8); PG8_WAIT_L(0); PG8_BAR; PG8_MMA(0, 0, At, B0); PG8_MMA(0, 1, At, B1); PG8_BAR; PG8_SCHED;
            PG8_LDA(At, 0, 1); PG8_STAGE(PG8_SB(0, 0), b2, voffB); PG8_STAGE(PG8_SB(0, 1), b2 + hstep, voffB); PG8_STAGE(PG8_SA(0, 0), a2, voffA);
            PG8_WAIT_V(8); PG8_WAIT_L(0); PG8_BAR; PG8_MMA(1, 0, At, B0); PG8_MMA(1, 1, At, B1); PG8_BAR; PG8_SCHED;
            PG8_LDB(B0, 1, 0); PG8_LDB(B1, 1, 1); PG8_SCHED; PG8_LDA(At, 1, 0); PG8_STAGE(PG8_SA(0, 1), a2 + hstep, voffA);
            PG8_WAIT_V(8); PG8_WAIT_L(0); PG8_BAR; PG8_MMA(0, 0, At, B0); PG8_MMA(0, 1, At, B1); PG8_BAR; PG8_SCHED;
            PG8_LDA(At, 1, 1); PG8_STAGE(PG8_SB(1, 0), b3, voffB); PG8_STAGE(PG8_SB(1, 1), b3 + hstep, voffB); PG8_STAGE(PG8_SA(1, 0), a3, voffA);
            PG8_WAIT_V(8); PG8_WAIT_L(0); PG8_BAR; PG8_MMA(1, 0, At, B0); PG8_MMA(1, 1, At, B1); PG8_BAR; PG8_SCHED;
        }
        if (wr == 0) PG8_BAR;
        E(acc, cur, wr, wc, fr, fq);
        if (!has_next) break;
#pragma unroll
        for (int a = 0; a < 2; ++a)
#pragma unroll
            for (int b = 0; b < 2; ++b)
#pragma unroll
                for (int m = 0; m < 4; ++m)
#pragma unroll
                    for (int n = 0; n < 2; ++n) acc[a][b][m][n] = (f32x4){0.f, 0.f, 0.f, 0.f};
        cur = nxt; cA = nA; cB = nB; ++ui;
        if (wr == 1) PG8_BAR;
    }
    PG8_WAIT_V(0);
    PG8_BAR;
#undef PG8_SA
#undef PG8_SB
#undef PG8_STAGE
#undef PG8_LDA
#undef PG8_LDB
#undef PG8_MMA
#undef PG8_WAIT_V
#undef PG8_WAIT_L
#undef PG8_BAR
#undef PG8_SCHED
}
}


#define XB_TMO      128
#define XB_XCNT(j)  (256  + 64 * (j))
#define XB_XSUB(j)  (1280 + 64 * (j))
#define XB_XGEN(j)  (2304 + 64 * (j))
#define XB_TOP      3328
#define XB_TOPGEN   3392
#define XCD_BAR_WORDS 3456
#define XB_SPIN_CAP (1u << 18)
__device__ __forceinline__ unsigned xb_ld(unsigned* p)              { return __hip_atomic_load(p, __ATOMIC_RELAXED, __HIP_MEMORY_SCOPE_AGENT); }
__device__ __forceinline__ unsigned xb_add(unsigned* p, unsigned v) { return __hip_atomic_fetch_add(p, v, __ATOMIC_RELAXED, __HIP_MEMORY_SCOPE_AGENT); }
__device__ __forceinline__ unsigned xb_xcc_id() { return (unsigned)__builtin_amdgcn_s_getreg((3 << 11) | 20) & 0xFu; }
#define XB_SPIN(cond, bar) do { unsigned _sp = 0; while (cond) { __builtin_amdgcn_s_sleep(1); \
    if ((++_sp & 255u) == 0u) { if (xb_ld(&(bar)[XB_TMO])) break; if (_sp > XB_SPIN_CAP) { atomicAdd(&(bar)[XB_TMO], 1u); break; } } } } while (0)
struct XcdBarrier { unsigned* bar; unsigned x; volatile LAS unsigned* st; };
__device__ __forceinline__ XcdBarrier xcd_barrier_post(unsigned* bar, volatile LAS unsigned* st) {
    XcdBarrier b; b.bar = bar; b.x = xb_xcc_id(); b.st = st;
    if (threadIdx.x == 0) (void)xb_add(&bar[XB_XCNT(b.x)], 1u);
    return b;
}
__device__ __forceinline__ void xcd_barrier_complete(unsigned* bar, unsigned x, unsigned& nloc, unsigned& nx) {
    const unsigned G = gridDim.x * gridDim.y * gridDim.z;
    unsigned sum, cnt, mine, sp = 0u;
    for (;;) {
        sum = 0u; cnt = 0u; mine = 0u;
#pragma unroll
        for (unsigned j = 0; j < 16; ++j) { const unsigned c = xb_ld(&bar[XB_XCNT(j)]); sum += c; cnt += (c > 0u) ? 1u : 0u; mine = (j == x) ? c : mine; }
        if (sum == G) break;
        __builtin_amdgcn_s_sleep(1);
        if ((++sp & 255u) == 0u) { if (xb_ld(&bar[XB_TMO])) break; if (sp > XB_SPIN_CAP) { atomicAdd(&bar[XB_TMO], 1u); break; } }
    }
    nloc = mine > 0u ? mine : 1u; nx = cnt > 0u ? cnt : 1u;
}
__device__ __forceinline__ void xcd_barrier(const XcdBarrier& b) {
    asm volatile("s_waitcnt vmcnt(0)" ::: "memory");
    __syncthreads();
    if (threadIdx.x == 0) {
        unsigned* bar = b.bar;
        __builtin_amdgcn_s_waitcnt(0);
        unsigned nloc = b.st[0], nx = b.st[1];
        if (nloc == 0u) { xcd_barrier_complete(bar, b.x, nloc, nx); b.st[0] = nloc; b.st[1] = nx; }
        const unsigned old = xb_add(&bar[XB_XSUB(b.x)], 1u);
        const unsigned gen = old / nloc;
        if (old + 1u == (gen + 1u) * nloc) {
            __builtin_amdgcn_fence(__ATOMIC_RELEASE, "agent");
            asm volatile("s_waitcnt vmcnt(0)" ::: "memory");
            const unsigned og = xb_add(&bar[XB_TOP], 1u);
            const unsigned tg = og / nx;
            if (og + 1u == (tg + 1u) * nx) xb_add(&bar[XB_TOPGEN], 1u);
            else XB_SPIN(xb_ld(&bar[XB_TOPGEN]) == tg, bar);
            __builtin_amdgcn_fence(__ATOMIC_ACQUIRE, "agent");
            xb_add(&bar[XB_XGEN(b.x)], 1u);
            asm volatile("s_waitcnt vmcnt(0)" ::: "memory");
        } else {
            XB_SPIN(xb_ld(&bar[XB_XGEN(b.x)]) == gen, bar);
            __builtin_amdgcn_fence(__ATOMIC_ACQUIRE, "agent");
            asm volatile("s_waitcnt vmcnt(0)" ::: "memory");
        }
    }
    __syncthreads();
}

#define TIDS const int tid = opaque_tid(); const int lane = tid & 63; const int wave = __builtin_amdgcn_readfirstlane(tid >> 6); (void)lane; (void)wave;
struct Ctx {
    const float* in[24]; float* out; unsigned char* ws;
    int G, bid;
    h16 *WIN, *WOUT, *WUP, *WDN, *W1T, *W2T, *XN, *PROJ, *HID, *XBCC, *KC, *VC;
    float *B1, *ROPE, *SSDST, *GLAST, *PSM, *SSQ, *DTV, *ACS, *CD, *GLAG;
};
__device__ __forceinline__ void make_ctx(Ctx& C, const Params* kp0) {
    const Params* kp = kp0; asm volatile("" : "+s"(kp));
#pragma unroll
    for (int i = 0; i < 24; ++i) C.in[i] = kp->in[i];
    C.out = kp->out; unsigned char* ws = kp->ws; C.ws = ws; C.G = gridDim.x; C.bid = blockIdx.x;
    C.WIN = (h16*)(ws + WS_WIN); C.WOUT = (h16*)(ws + WS_WOUT); C.WUP = (h16*)(ws + WS_WUP); C.WDN = (h16*)(ws + WS_WDN); C.W1T = (h16*)(ws + WS_W1T); C.W2T = (h16*)(ws + WS_W2T);
    C.XN = (h16*)(ws + WS_XN); C.PROJ = (h16*)(ws + WS_PROJ); C.HID = (h16*)(ws + WS_HID); C.XBCC = (h16*)(ws + WS_XBCC); C.KC = (h16*)(ws + WS_KC); C.VC = (h16*)(ws + WS_VC);
    C.B1 = (float*)(ws + WS_B1); C.ROPE = (float*)(ws + WS_ROPE); C.SSDST = (float*)(ws + WS_SSDST); C.GLAST = (float*)(ws + WS_GLAST); C.PSM = (float*)(ws + WS_PSM);
    C.SSQ = (float*)(ws + WS_SSQ); C.DTV = (float*)(ws + WS_DTV); C.ACS = (float*)(ws + WS_ACS); C.CD = (float*)(ws + WS_CD); C.GLAG = (float*)(ws + WS_GLAG);
}

__device__ __forceinline__ int win_src_col(int n) {
    if (n < 512) return n;
    if (n < 768) return n - 512 + 528;
    if (n < 1024) return n - 768 + 784;
    if (n < 1792) return n - 1024 + 1040;
    if (n < 2304) return n - 1792 + 1820;
    if (n < 3328) return n - 2304 + 2332;
    const int r = n - 3328;
    if (r < 16) return 512 + r;
    if (r < 28) return 1808 + (r - 16);
    if (r < 36) return 3356 + (r - 28);
    return -1;
}
template <bool MAPW>
__device__ __forceinline__ void transpose_item(const float* W, int K, int Nsrc, int Ndst, h16* WT, const float* kscale, float* scr, int item, int lane) {
    const int nblk = Ndst / 32, kb = item / nblk, nb = item % nblk, k0 = 64 * kb, n0 = 32 * nb;
    const int nd = n0 + (lane & 31); const int sc = MAPW ? win_src_col(nd) : nd;
#pragma unroll 8
    for (int i = 0; i < 32; ++i) { const int kk = 2 * i + (lane >> 5); float v = 0.f;
        if (sc >= 0) { v = W[(size_t)(k0 + kk) * Nsrc + sc]; if (kscale) v *= kscale[k0 + kk]; }
        scr[kk * 33 + (lane & 31)] = v; }
    asm volatile("s_waitcnt lgkmcnt(0)" ::: "memory");
    const int c = lane & 7;
#pragma unroll
    for (int j = 0; j < 4; ++j) { const int n = (lane >> 3) + 8 * j; const float* s = scr + (8 * c) * 33 + n;
        u32x4 o; o.x = pkh(s[0 * 33], s[1 * 33]); o.y = pkh(s[2 * 33], s[3 * 33]); o.z = pkh(s[4 * 33], s[5 * 33]); o.w = pkh(s[6 * 33], s[7 * 33]);
        *(u32x4*)(WT + (size_t)(n0 + n) * K + k0 + 8 * c) = o; }
    asm volatile("s_waitcnt lgkmcnt(0)" ::: "memory");
}
__device__ __forceinline__ void rms_row_to_h16(const float* xrow, h16* orow, int lane) {
    const f32x4* xr = (const f32x4*)xrow + lane; f32x4 v[4]; float s = 0.f;
#pragma unroll
    for (int j = 0; j < 4; ++j) { v[j] = xr[64 * j]; s += (v[j].x * v[j].x + v[j].y * v[j].y) + (v[j].z * v[j].z + v[j].w * v[j].w); }
    const float rs = 1.0f / sqrtf(wave_sum(s) * (1.f / DM) + EPS);
    u32x2* o8 = (u32x2*)orow + lane;
#pragma unroll
    for (int j = 0; j < 4; ++j) { u32x2 w; w.x = pkh(v[j].x * rs, v[j].y * rs); w.y = pkh(v[j].z * rs, v[j].w * rs); o8[64 * j] = w; }
}
__device__ __forceinline__ void sincos_acc(float angf, float& c, float& s) {
    const double x = (double)angf; const double n = __builtin_rint(x * 0.63661977236758134308);
    const double r = __builtin_fma(-n, 1.5707963267948966192, x) - n * 6.123233995736766036e-17;
    const double r2 = r * r;
    double sp = -7.6471637318198164759e-13; sp = sp * r2 + 1.6059043836821614599e-10; sp = sp * r2 - 2.5052108385441718775e-08; sp = sp * r2 + 2.7557319223985890653e-06;
    sp = sp * r2 - 1.9841269841269841270e-04; sp = sp * r2 + 8.3333333333333333333e-03; sp = sp * r2 - 1.6666666666666666667e-01; const double sn = r + r * r2 * sp;
    double cp = 4.7794773323873852974e-14; cp = cp * r2 - 1.1470745597729724714e-11; cp = cp * r2 + 2.0876756987868098979e-09; cp = cp * r2 - 2.7557319223985890653e-07;
    cp = cp * r2 + 2.4801587301587301587e-05; cp = cp * r2 - 1.3888888888888888889e-03; cp = cp * r2 + 4.1666666666666666667e-02; cp = cp * r2 - 0.5; const double cs = 1.0 + r2 * cp;
    const int q = ((int)n) & 3;
    const double so = (q == 0) ? sn : (q == 1) ? cs : (q == 2) ? -sn : -cs;
    const double co = (q == 0) ? cs : (q == 1) ? -sn : (q == 2) ? -cs : sn;
    c = (float)co; s = (float)so;
}
__device__ __forceinline__ void phase_prep(const Ctx& C) {
    TIDS
    float* scr = (float*)(g_lds) + wave * (64 * 33);
    const int gw = C.bid * 8 + wave, NGW = C.G * 8;
    constexpr int I_IN = 16 * (PN / 32), I_OUT = 16 * 32, I_UP = 16 * 128, I_DN = 64 * 32, I_W1 = 32 * 4, I_W2 = 2 * 2;
    constexpr int PER_L = I_IN + I_OUT + I_UP + I_DN + 2 * I_W1 + 2 * I_W2;
    for (int it = gw; it < DEPTH * PER_L; it += NGW) {
        const int l = it / PER_L; int r = it % PER_L;
        if (r < I_IN) { transpose_item<true>(C.in[2] + (size_t)l * DM * DIN, DM, DIN, PN, C.WIN + (size_t)l * PN * DM, C.in[1] + l * DM, scr, r, lane); continue; } r -= I_IN;
        if (r < I_OUT) { transpose_item<false>(C.in[19] + (size_t)l * DM * DM, DM, DM, DM, C.WOUT + (size_t)l * DM * DM, nullptr, scr, r, lane); continue; } r -= I_OUT;
        if (r < I_UP) { transpose_item<false>(C.in[21] + (size_t)l * DM * DFF, DM, DFF, DFF, C.WUP + (size_t)l * DFF * DM, C.in[20] + l * DM, scr, r, lane); continue; } r -= I_UP;
        if (r < I_DN) { transpose_item<false>(C.in[22] + (size_t)l * DFF * DM, DFF, DM, DM, C.WDN + (size_t)l * DM * DFF, nullptr, scr, r, lane); continue; } r -= I_DN;
        if (r < 2 * I_W1) { const int kv = r / I_W1; transpose_item<false>(C.in[kv ? 10 : 7] + (size_t)l * 2048 * 128, 2048, 128, 128, C.W1T + (size_t)(l * 2 + kv) * 128 * 2048, nullptr, scr, r % I_W1, lane); continue; } r -= 2 * I_W1;
        { const int kv = r / I_W2; transpose_item<false>(C.in[kv ? 11 : 8] + (size_t)l * 128 * 64, 128, 64, 64, C.W2T + (size_t)(l * 2 + kv) * 64 * 128, nullptr, scr, r % I_W2, lane); }
    }
    for (int it = gw; it < DEPTH * 2 * 128; it += NGW) {
        const int l = it / 256, kv = (it / 128) & 1, j = it & 127;
        const float* pos = C.in[kv ? 9 : 6] + (size_t)l * 2048; const float* w1 = C.in[kv ? 10 : 7] + (size_t)l * 2048 * 128;
        float s = 0.f;
        for (int f = lane; f < 2048; f += 64) s += pos[f] * w1[(size_t)f * 128 + j];
        s = wave_sum(s);
        if (lane == 0) C.B1[it] = s;
    }
    for (int e = C.bid * 512 + tid; e < SEQ * 32; e += C.G * 512) {
        const int pos = e >> 5, i = e & 31; const float ang = (float)pos * ROPE_INV[i];
        float cs, sn; sincos_acc(ang, cs, sn); C.ROPE[2 * e] = cs; C.ROPE[2 * e + 1] = sn;
    }
    for (int m = gw; m < MTOK; m += NGW) rms_row_to_h16(C.in[0] + (size_t)m * DM, C.XN + (size_t)m * DM, lane);
}

__device__ __forceinline__ void phase_tok(const Ctx& C, int l) {
    TIDS
    const int gw = C.bid * 8 + wave, NGW = C.G * 8;
    const float* cw = C.in[13] + (size_t)l * 4 * 1024; const float* cb = C.in[14] + (size_t)l * 1024; const float* dtb = C.in[15] + l * 8;
    for (int m = gw; m < MTOK; m += NGW) {
        const int t = m & (SEQ - 1);
        h16* prow = C.PROJ + (size_t)m * PN;
#pragma unroll
        for (int it = 0; it < 5; ++it) { const int pi = lane + 64 * it, hd = pi >> 5, i = pi & 31;
            const int base = (hd < 4) ? (C_NQ + hd * 64) : (hd < 6) ? (C_KCMP + (hd - 4) * 64) : (hd < 8) ? (C_KSLC + (hd - 6) * 64) : (C_KWIN + (hd - 8) * 64);
            const float cs = C.ROPE[2 * (t * 32 + i)], sn = C.ROPE[2 * (t * 32 + i) + 1];
            const float x1 = (float)prow[base + i], x2 = (float)prow[base + 32 + i]; const float sc = (hd < 4) ? 0.18033688011112042f : 1.f;
            prow[base + i] = (h16)((x1 * cs - x2 * sn) * sc); prow[base + 32 + i] = (h16)((x2 * cs + x1 * sn) * sc); }
        { const int ch = lane * 16; float a[16];
#pragma unroll
            for (int e = 0; e < 16; ++e) a[e] = cb[ch + e];
#pragma unroll
            for (int i = 0; i < 4; ++i) { const int tt = t - 3 + i; if (tt < 0) continue;
                const h16* src = C.PROJ + (size_t)(m - 3 + i) * PN + C_SX + ch; const h16x8 x0 = *(const h16x8*)src, x1 = *(const h16x8*)(src + 8);
#pragma unroll
                for (int e = 0; e < 8; ++e) { a[e] += cw[i * 1024 + ch + e] * (float)x0[e]; a[8 + e] += cw[i * 1024 + ch + 8 + e] * (float)x1[e]; } }
            u32x4 o0, o1; o0.x = pkh(siluf_(a[0]), siluf_(a[1])); o0.y = pkh(siluf_(a[2]), siluf_(a[3])); o0.z = pkh(siluf_(a[4]), siluf_(a[5])); o0.w = pkh(siluf_(a[6]), siluf_(a[7]));
            o1.x = pkh(siluf_(a[8]), siluf_(a[9])); o1.y = pkh(siluf_(a[10]), siluf_(a[11])); o1.z = pkh(siluf_(a[12]), siluf_(a[13])); o1.w = pkh(siluf_(a[14]), siluf_(a[15]));
            h16* dst = C.XBCC + (size_t)m * 1024 + ch; *(u32x4*)dst = o0; *(u32x4*)(dst + 8) = o1; }
        if (lane < 8) C.DTV[(size_t)m * 8 + lane] = softplusf_(C.PSM[(size_t)m * PSM_W + 28 + lane] + dtb[lane]);
    }
}

__device__ __forceinline__ float gelu_tanh(float x) { const float u = 0.7978845608028654f * (x + 0.044715f * x * x * x); const float e = __expf(2.f * u); const float th = 1.f - 2.f / (e + 1.f); return 0.5f * x * (1.f + th); }
__device__ __forceinline__ void nsa_compress_unit(const Ctx& C, int l, int u) {
    const int kv = u >> 8, b = (u >> 6) & 3, g = (u >> 5) & 1, mt = u & 31;
    TIDS
    const int w = wave, cc = lane & 15, quad = lane >> 4;
    h16* Hs = (h16*)g_lds;
    const int n = mt * 16 + cc;
    const h16* W1T = C.W1T + (size_t)(l * 2 + kv) * 128 * 2048; const h16* W2T = C.W2T + (size_t)(l * 2 + kv) * 64 * 128; const float* B1 = C.B1 + (l * 2 + kv) * 128;
    const int col = (kv ? C_VCMP : C_KCMP) + g * 64 + quad * 8;
    f32x4 acc = {0.f, 0.f, 0.f, 0.f};
    const h16* brow = W1T + (size_t)(w * 16 + cc) * 2048 + quad * 8;
#pragma unroll 4
    for (int kk = 0; kk < 64; ++kk) {
        int tok = 16 * n + (kk >> 1); tok = tok < SEQ ? tok : SEQ - 1;
        const h16x8 a = *(const h16x8*)(C.PROJ + (size_t)(b * SEQ + tok) * PN + col + (kk & 1) * 32);
        const h16x8 bb = *(const h16x8*)(brow + kk * 32);
        acc = mfma16(a, bb, acc);
    }
    { const float bias = B1[w * 16 + cc];
#pragma unroll
        for (int j = 0; j < 4; ++j) Hs[(quad * 4 + j) * 136 + w * 16 + cc] = (h16)gelu_tanh(acc[j] + bias); }
    __syncthreads();
    if (w < 4) {
        f32x4 o = {0.f, 0.f, 0.f, 0.f};
#pragma unroll
        for (int kk = 0; kk < 4; ++kk) { const h16x8 a = *(const h16x8*)(Hs + cc * 136 + kk * 32 + quad * 8); const h16x8 bb = *(const h16x8*)(W2T + (size_t)(w * 16 + cc) * 128 + kk * 32 + quad * 8); o = mfma16(a, bb, o); }
        h16* dst = (kv ? C.VC : C.KC) + (size_t)((b * 2 + g) * 512 + mt * 16) * 64;
#pragma unroll
        for (int j = 0; j < 4; ++j) dst[(quad * 4 + j) * 64 + w * 16 + cc] = (h16)o[j];
    }
    __syncthreads();
}

__device__ __forceinline__ void ssd_states_unit(const Ctx& C, int l, int u) {
    const int b = u >> 9, c = (u >> 3) & 63, h = u & 7, g = h >> 2;
    TIDS
    const int w = wave, cc = lane & 15, quad = lane >> 4;
    const size_t row0 = (size_t)b * SEQ + c * 128;
    float* acs = (float*)g_lds; float* dtl = acs + 128; float* wl = acs + 256;
    h16* XT = (h16*)(g_lds + 2048);
    h16* BT = (h16*)(g_lds + 2048 + 17408);
    const float A = -__expf(C.in[16][l * 8 + h]);
    if (tid < 128) dtl[tid] = C.DTV[(row0 + tid) * 8 + h];
    __syncthreads();
    if (tid < 128) { float s = 0.f; for (int i = 0; i <= tid; ++i) s += dtl[i] * A; acs[tid] = s; }
    __syncthreads();
    if (tid < 128) { const float tot = acs[127]; wl[tid] = __expf(tot - acs[tid]) * dtl[tid]; C.ACS[(row0 + tid) * 8 + h] = acs[tid]; if (tid == 127) C.CD[(b * 64 + c) * 8 + h] = __expf(tot); }
    __syncthreads();
#pragma unroll
    for (int i = 0; i < 2; ++i) { const int ch = tid + 512 * i, tok = ch >> 3, c8 = ch & 7; const h16x8 v = *(const h16x8*)(C.XBCC + (row0 + tok) * 1024 + h * 64 + c8 * 8);
#pragma unroll
        for (int e = 0; e < 8; ++e) XT[(c8 * 8 + e) * 136 + tok] = v[e]; }
#pragma unroll
    for (int i = 0; i < 4; ++i) { const int ch = tid + 512 * i, tok = ch >> 4, c16 = ch & 15; const h16x8 v = *(const h16x8*)(C.XBCC + (row0 + tok) * 1024 + 512 + g * 128 + c16 * 8); const float ww = wl[tok];
#pragma unroll
        for (int e = 0; e < 8; ++e) BT[(c16 * 8 + e) * 136 + tok] = (h16)((float)v[e] * ww); }
    __syncthreads();
    const int mi = w & 3;
    float* dst = C.SSDST + (size_t)((b * 64 + c) * 8 + h) * 8192;
#pragma unroll
    for (int q = 0; q < 4; ++q) { const int ni = (w >> 2) * 4 + q; f32x4 acc = {0.f, 0.f, 0.f, 0.f};
#pragma unroll
        for (int kk = 0; kk < 4; ++kk) { const h16x8 a = *(const h16x8*)(XT + (mi * 16 + cc) * 136 + kk * 32 + quad * 8); const h16x8 bb = *(const h16x8*)(BT + (ni * 16 + cc) * 136 + kk * 32 + quad * 8); acc = mfma16(a, bb, acc); }
#pragma unroll
        for (int j = 0; j < 4; ++j) dst[(mi * 16 + quad * 4 + j) * 128 + ni * 16 + cc] = acc[j]; }
    __syncthreads();
}

__device__ __forceinline__ void ssd_y_unit(const Ctx& C, int l, int u) {
    const int b = u >> 9, c = (u >> 3) & 63, h = u & 7, g = h >> 2;
    TIDS
    const int w = wave, cc = lane & 15, quad = lane >> 4;
    const size_t row0 = (size_t)b * SEQ + c * 128;
    float* acs = (float*)g_lds; float* dtl = acs + 128;
    h16* Cm = (h16*)(g_lds + 2048);
    h16* Bm = (h16*)(g_lds + 2048 + 34816);
    h16* XT = (h16*)(g_lds + 2048 + 2 * 34816);
    h16* HE = (h16*)(g_lds + 2048 + 2 * 34816 + 17408);
    if (tid < 128) { acs[tid] = C.ACS[(row0 + tid) * 8 + h]; dtl[tid] = C.DTV[(row0 + tid) * 8 + h]; }
#pragma unroll
    for (int i = 0; i < 4; ++i) { const int ch = tid + 512 * i, tok = ch >> 4, c16 = ch & 15; const h16* src = C.XBCC + (row0 + tok) * 1024 + 512 + g * 128 + c16 * 8;
        *(h16x8*)(Bm + tok * 136 + c16 * 8) = *(const h16x8*)src; *(h16x8*)(Cm + tok * 136 + c16 * 8) = *(const h16x8*)(src + 256); }
#pragma unroll
    for (int i = 0; i < 2; ++i) { const int ch = tid + 512 * i, tok = ch >> 3, c8 = ch & 7; const h16x8 v = *(const h16x8*)(C.XBCC + (row0 + tok) * 1024 + h * 64 + c8 * 8);
#pragma unroll
        for (int e = 0; e < 8; ++e) XT[(c8 * 8 + e) * 136 + tok] = v[e]; }
    { const float* src = C.SSDST + (size_t)((b * 64 + c) * 8 + h) * 8192;
#pragma unroll
        for (int i = 0; i < 4; ++i) { const int e4 = tid + 512 * i, p = e4 >> 5, n4 = e4 & 31; const f32x4 v = *(const f32x4*)(src + e4 * 4);
            h16x4 o = {(h16)v.x, (h16)v.y, (h16)v.z, (h16)v.w}; *(h16x4*)(HE + p * 136 + n4 * 4) = o; } }
    __syncthreads();
    f32x4 cbt[8];
#pragma unroll
    for (int ni = 0; ni < 8; ++ni) { f32x4 acc = {0.f, 0.f, 0.f, 0.f};
#pragma unroll
        for (int kk = 0; kk < 4; ++kk) { const h16x8 a = *(const h16x8*)(Cm + (w * 16 + cc) * 136 + kk * 32 + quad * 8); const h16x8 bb = *(const h16x8*)(Bm + (ni * 16 + cc) * 136 + kk * 32 + quad * 8); acc = mfma16(a, bb, acc); }
        cbt[ni] = acc; }
    __syncthreads();
#pragma unroll
    for (int ni = 0; ni < 8; ++ni) { const int s = ni * 16 + cc; const float as_ = acs[s], ds_ = dtl[s];
#pragma unroll
        for (int j = 0; j < 4; ++j) { const int lr = w * 16 + quad * 4 + j; const float v = (s <= lr) ? cbt[ni][j] * __expf(acs[lr] - as_) * ds_ : 0.f; Bm[lr * 136 + s] = (h16)v; } }
    __syncthreads();
    const float Dh = C.in[17][l * 8 + h];
    float ssq[4] = {0.f, 0.f, 0.f, 0.f};
#pragma unroll
    for (int ni = 0; ni < 4; ++ni) { f32x4 acc = {0.f, 0.f, 0.f, 0.f};
#pragma unroll
        for (int kk = 0; kk < 4; ++kk) { const h16x8 a = *(const h16x8*)(Cm + (w * 16 + cc) * 136 + kk * 32 + quad * 8); const h16x8 bb = *(const h16x8*)(HE + (ni * 16 + cc) * 136 + kk * 32 + quad * 8); acc = mfma16(a, bb, acc); }
#pragma unroll
        for (int j = 0; j < 4; ++j) acc[j] *= __expf(acs[w * 16 + quad * 4 + j]);
#pragma unroll
        for (int kk = 0; kk < 4; ++kk) { const h16x8 a = *(const h16x8*)(Bm + (w * 16 + cc) * 136 + kk * 32 + quad * 8); const h16x8 bb = *(const h16x8*)(XT + (ni * 16 + cc) * 136 + kk * 32 + quad * 8); acc = mfma16(a, bb, acc); }
        const int p = ni * 16 + cc;
#pragma unroll
        for (int j = 0; j < 4; ++j) { const int lr = w * 16 + quad * 4 + j; const float x = (float)XT[p * 136 + lr];
            const float z = (float)C.PROJ[(row0 + lr) * PN + C_SZ + h * 64 + p]; const h16 yh = (h16)((acc[j] + Dh * x) * siluf_(z));
            C.XN[(row0 + lr) * 1024 + 512 + h * 64 + p] = yh; const float yr = (float)yh; ssq[j] += yr * yr; } }
#pragma unroll
    for (int j = 0; j < 4; ++j) { float s = ssq[j]; s += __shfl_xor(s, 1); s += __shfl_xor(s, 2); s += __shfl_xor(s, 4); s += __shfl_xor(s, 8);
        if (cc == 0) C.SSQ[(row0 + w * 16 + quad * 4 + j) * 8 + h] = s; }
    __syncthreads();
}

template <int PASS>
__device__ __forceinline__ void gla_block_unit(const Ctx& C, int l, int bu) {
    TIDS
    const int w = wave; const int wu = bu * 8 + w;
    const int bh = wu >> 7, seg = wu & 127, b = bh >> 2, h = bh & 3;
    const size_t row0 = (size_t)b * SEQ + seg * 64;
    float* as_ = (float*)(g_lds + w * 10240); float* qs = as_ + 512; float* ks = as_ + 1024;
    h16* vs = (h16*)(as_ + 1536); h16* rs_ = vs + 1024;
    const int tl = lane & 15, kq = lane >> 4;
    const float* w2 = C.in[3] + (size_t)l * 16 * 128 + h * 32 + kq * 8; const float* gb = C.in[4] + l * 128 + h * 32 + kq * 8;
    float S[32];
    float* gst = C.GLAST + (size_t)(bh * 128 + seg) * 2048;
    if (PASS == 1) {
#pragma unroll
        for (int kk = 0; kk < 32; ++kk) S[kk] = gst[kk * 64 + lane];
    } else {
#pragma unroll
        for (int kk = 0; kk < 32; ++kk) S[kk] = 0.f;
    }
    float gtot = 1.f;
    const float gnw = C.in[5][l * 256 + h * 64 + lane];
#pragma unroll 1
    for (int qt = 0; qt < 4; ++qt) {
        const size_t rowh = row0 + qt * 16;
        const size_t rowt = rowh + tl;
        f32x4 gl[4];
#pragma unroll
        for (int i = 0; i < 4; ++i) gl[i] = *(const f32x4*)(C.PSM + rowt * PSM_W + 4 * i);
        const h16x8 q0 = *(const h16x8*)(C.PROJ + rowt * PN + C_GQ + h * 32 + kq * 8);
        const h16x8 k0 = *(const h16x8*)(C.PROJ + rowt * PN + C_GK + h * 32 + kq * 8);
        h16x8 vx[2], rx[2];
#pragma unroll
        for (int i = 0; i < 2; ++i) { const int ch = lane + 64 * i, t = ch >> 3, c8 = ch & 7; vx[i] = *(const h16x8*)(C.PROJ + (rowh + t) * PN + C_GV + h * 64 + c8 * 8);
            if (PASS == 1) rx[i] = *(const h16x8*)(C.PROJ + (rowh + t) * PN + C_GR + h * 64 + c8 * 8); }
        float z[8];
#pragma unroll
        for (int k = 0; k < 8; ++k) z[k] = gb[k];
#pragma unroll
        for (int r = 0; r < 16; ++r) { const float gv = gl[r >> 2][r & 3];
#pragma unroll
            for (int k = 0; k < 8; ++k) z[k] += gv * w2[r * 128 + k]; }
        asm volatile("" ::: "memory");
#pragma unroll
        for (int k4 = 0; k4 < 2; ++k4) { f32x4 av, qv, kv;
#pragma unroll
            for (int e = 0; e < 4; ++e) { const int k = 4 * k4 + e; av[e] = ex2(-0.0625f * __builtin_amdgcn_logf(1.f + ex2(-1.4426950408889634f * z[k])));
                qv[e] = (float)q0[k] * 0.17677669529663687f; kv[e] = (float)k0[k]; }
            *(f32x4*)(as_ + tl * 32 + kq * 8 + 4 * k4) = av; *(f32x4*)(qs + tl * 32 + kq * 8 + 4 * k4) = qv; *(f32x4*)(ks + tl * 32 + kq * 8 + 4 * k4) = kv; }
#pragma unroll
        for (int i = 0; i < 2; ++i) { const int ch = lane + 64 * i; *(h16x8*)(vs + ch * 8) = vx[i]; if (PASS == 1) *(h16x8*)(rs_ + ch * 8) = rx[i]; }
        asm volatile("s_waitcnt lgkmcnt(0)" ::: "memory");
        if (PASS == 0) { if (lane < 32) { float p = 1.f;
#pragma unroll
                for (int t = 0; t < 16; ++t) p *= as_[t * 32 + lane];
                gtot *= p; } }
#pragma unroll 2
        for (int tok = 0; tok < 16; ++tok) { const float v = (float)vs[tok * 64 + lane]; float acc = 0.f;
#pragma unroll
            for (int k4 = 0; k4 < 8; ++k4) { const f32x4 a4 = *(const f32x4*)(as_ + tok * 32 + 4 * k4), kk4 = *(const f32x4*)(ks + tok * 32 + 4 * k4);
#pragma unroll
                for (int e = 0; e < 4; ++e) S[4 * k4 + e] = a4[e] * S[4 * k4 + e] + kk4[e] * v;
                if (PASS == 1) { const f32x4 q4 = *(const f32x4*)(qs + tok * 32 + 4 * k4);
#pragma unroll
                    for (int e = 0; e < 4; ++e) acc += q4[e] * S[4 * k4 + e]; } }
            if (PASS == 1) { const float ssq = wave_sum(acc * acc); const float rs = 1.0f / sqrtf(ssq * (1.f / 64.f) + EPS);
                C.XN[(rowh + tok) * 1024 + h * 64 + lane] = (h16)(acc * rs * gnw * siluf_((float)rs_[tok * 64 + lane])); } }
    }
    if (PASS == 0) {
#pragma unroll
        for (int kk = 0; kk < 32; ++kk) gst[kk * 64 + lane] = S[kk];
        if (lane < 32) C.GLAG[(size_t)(bh * 128 + seg) * 32 + lane] = gtot;
    }
}

__device__ __forceinline__ void phase_scans(const Ctx& C) {
    TIDS
    for (int e = C.bid * 512 + tid; e < BATCH * 8 * 8192; e += C.G * 512) {
        const int bh = e >> 13, b = bh >> 3, h = bh & 7, pn = e & 8191;
        float* p = C.SSDST + (size_t)(b * 64 * 8 + h) * 8192 + pn; const float* cd = C.CD + b * 64 * 8 + h;
        float st = 0.f;
        for (int c0 = 0; c0 < 64; c0 += 8) { float v[8], d[8];
#pragma unroll
            for (int i = 0; i < 8; ++i) { v[i] = p[(size_t)(c0 + i) * 8 * 8192]; d[i] = cd[(c0 + i) * 8]; }
#pragma unroll
            for (int i = 0; i < 8; ++i) { p[(size_t)(c0 + i) * 8 * 8192] = st; st = d[i] * st + v[i]; } }
    }
    for (int e = C.bid * 512 + tid; e < 16 * 2048; e += C.G * 512) {
        const int bh = e >> 11, kv = e & 2047, k = kv >> 6;
        float* p = C.GLAST + (size_t)bh * 128 * 2048 + kv; const float* gg = C.GLAG + (size_t)bh * 128 * 32 + k;
        float st = 0.f;
        for (int s0 = 0; s0 < 128; s0 += 8) { float v[8], d[8];
#pragma unroll
            for (int i = 0; i < 8; ++i) { v[i] = p[(size_t)(s0 + i) * 2048]; d[i] = gg[(s0 + i) * 32]; }
#pragma unroll
            for (int i = 0; i < 8; ++i) { p[(size_t)(s0 + i) * 2048] = st; st = d[i] * st + v[i]; } }
    }
}

__device__ __forceinline__ h16x4 tr_read(const h16* p) { typedef short s16x4 __attribute__((ext_vector_type(4))); return __builtin_bit_cast(h16x4, __builtin_amdgcn_ds_read_tr16_b64_v4i16((LAS s16x4*)p)); }
struct FlashState { float m, l; f32x4 O[4]; };
constexpr int KV_LD = 72, KV_TILE = 64 * KV_LD;
__device__ __forceinline__ void qk_tile(f32x4 (&s)[4], const h16* Ks, const h16x8 (&qf)[2], int cc, int quad) {
#pragma unroll
    for (int mt = 0; mt < 4; ++mt) { f32x4 a = {0.f, 0.f, 0.f, 0.f};
#pragma unroll
        for (int ks = 0; ks < 2; ++ks) { const h16x8 kf = *(const h16x8*)(Ks + (mt * 16 + cc) * KV_LD + ks * 32 + quad * 8); a = mfma16(kf, qf[ks], a); }
        s[mt] = a; }
}
__device__ __forceinline__ void pv_tile(f32x4 (&O)[4], const h16* Vs, const f32x4 (&p)[4], int cc, int quad) {
    h16x8 pf[2];
#pragma unroll
    for (int k2 = 0; k2 < 2; ++k2) pf[k2] = (h16x8){(h16)p[2 * k2][0], (h16)p[2 * k2][1], (h16)p[2 * k2][2], (h16)p[2 * k2][3], (h16)p[2 * k2 + 1][0], (h16)p[2 * k2 + 1][1], (h16)p[2 * k2 + 1][2], (h16)p[2 * k2 + 1][3]};
#pragma unroll
    for (int md = 0; md < 4; ++md)
#pragma unroll
        for (int k2 = 0; k2 < 2; ++k2) { const h16* vp = Vs + (32 * k2 + 4 * quad + (cc >> 2)) * KV_LD + md * 16 + 4 * (cc & 3);
            const h16x4 lo = tr_read(vp), hi = tr_read(vp + 16 * KV_LD);
            const h16x8 vf = {lo[0], lo[1], lo[2], lo[3], hi[0], hi[1], hi[2], hi[3]}; O[md] = mfma16(vf, pf[k2], O[md]); }
}
template <int MODE>
__device__ __forceinline__ void flash_tile(FlashState& st, const h16* Ks, const h16* Vs, const h16x8 (&qf)[2], int kv0, int tq, bool selbit, int cc, int quad) {
    f32x4 s[4]; qk_tile(s, Ks, qf, cc, quad);
    float tmax = -INFINITY;
#pragma unroll
    for (int mt = 0; mt < 4; ++mt)
#pragma unroll
        for (int j = 0; j < 4; ++j) { const int kp = kv0 + mt * 16 + quad * 4 + j;
            const bool ok = (MODE == 0) ? (selbit && kp <= tq) : (kp <= tq && kp > tq - 512);
            const float v = ok ? s[mt][j] : -INFINITY; s[mt][j] = v; tmax = fmaxf(tmax, v); }
    tmax = fmaxf(tmax, __shfl_xor(tmax, 16)); tmax = fmaxf(tmax, __shfl_xor(tmax, 32));
    const float mnew = fmaxf(st.m, tmax); const float muse = (mnew == -INFINITY) ? 0.f : mnew;
    const float alpha = ex2(st.m - muse);
    float psum = 0.f;
#pragma unroll
    for (int mt = 0; mt < 4; ++mt)
#pragma unroll
        for (int j = 0; j < 4; ++j) { const float p = ex2(s[mt][j] - muse); s[mt][j] = p; psum += p; }
    st.l = st.l * alpha + psum; st.m = mnew;
#pragma unroll
    for (int md = 0; md < 4; ++md) st.O[md] *= alpha;
    pv_tile(st.O, Vs, s, cc, quad);
}
template <bool NEEDV, class SrcFn, class CompFn>
__device__ __forceinline__ void kv_pipeline(int n, int tid, h16* Kb, h16* Vb, SrcFn src, CompFn comp) {
    if (n <= 0) return;
    const int key = tid >> 3, c8 = tid & 7; const int loff = key * KV_LD + c8 * 8;
    h16x8 kr, vr = {};
    { const h16 *kp, *vp; size_t stride; src(0, kp, vp, stride); kr = *(const h16x8*)(kp + (size_t)key * stride + c8 * 8); if (NEEDV) vr = *(const h16x8*)(vp + (size_t)key * stride + c8 * 8); }
    *(h16x8*)(Kb + loff) = kr; if (NEEDV) *(h16x8*)(Vb + loff) = vr;
    __syncthreads();
    for (int i = 0; i < n; ++i) {
        const int cur = i & 1; const bool more = (i + 1 < n);
        if (more) { const h16 *kp, *vp; size_t stride; src(i + 1, kp, vp, stride); kr = *(const h16x8*)(kp + (size_t)key * stride + c8 * 8); if (NEEDV) vr = *(const h16x8*)(vp + (size_t)key * stride + c8 * 8); }
        comp(i, Kb + cur * KV_TILE, Vb + cur * KV_TILE);
        if (more) { *(h16x8*)(Kb + (cur ^ 1) * KV_TILE + loff) = kr; if (NEEDV) *(h16x8*)(Vb + (cur ^ 1) * KV_TILE + loff) = vr; }
        __syncthreads();
    }
}
__device__ __forceinline__ void nsa_attn_unit(const Ctx& C, int l, int b, int g, int qb) {
    TIDS
    const int w = wave, cc = lane & 15, quad = lane >> 4;
    const int r = cc >> 3, ti = cc & 7, tloc = 8 * w + ti, tq = 64 * qb + tloc, h = 2 * g + r;
    const size_t rowq = (size_t)b * SEQ + tq;
    h16* Kb = (h16*)g_lds; h16* Vb = (h16*)(g_lds + 2 * KV_TILE * 2);
    float* imp = (float*)(g_lds + 36864);
    unsigned* sel = (unsigned*)(g_lds + 36864 + 32768);
    unsigned* uni = sel + 256;
    unsigned char* lst = (unsigned char*)(uni + 8);
    h16x8 qf[2];
#pragma unroll
    for (int ks = 0; ks < 2; ++ks) qf[ks] = *(const h16x8*)(C.PROJ + rowq * PN + C_NQ + h * 64 + ks * 32 + quad * 8);
    const h16* kcb = C.KC + (size_t)(b * 2 + g) * 512 * 64; const h16* vcb = C.VC + (size_t)(b * 2 + g) * 512 * 64;
    const int ncmp = 4 * qb + 3, ntile_c = (ncmp + 63) >> 6;
    auto src_cmp = [&](int i, const h16*& kp, const h16*& vp, size_t& stride) { kp = kcb + (size_t)i * 64 * 64; vp = vcb + (size_t)i * 64 * 64; stride = 64; };
    float m1 = -INFINITY, l1 = 0.f;
    kv_pipeline<false>(ntile_c, tid, Kb, Vb, src_cmp, [&](int tc, const h16* Ks, const h16*) {
        f32x4 s[4]; qk_tile(s, Ks, qf, cc, quad); float tmax = -INFINITY;
#pragma unroll
        for (int mt = 0; mt < 4; ++mt)
#pragma unroll
            for (int j = 0; j < 4; ++j) { const int n = tc * 64 + mt * 16 + quad * 4 + j; const float v = (16 * n + 31 <= tq) ? s[mt][j] : -INFINITY; s[mt][j] = v; tmax = fmaxf(tmax, v); }
        tmax = fmaxf(tmax, __shfl_xor(tmax, 16)); tmax = fmaxf(tmax, __shfl_xor(tmax, 32));
        const float mnew = fmaxf(m1, tmax), muse = (mnew == -INFINITY) ? 0.f : mnew;
        float ps = 0.f;
#pragma unroll
        for (int mt = 0; mt < 4; ++mt)
#pragma unroll
            for (int j = 0; j < 4; ++j) ps += ex2(s[mt][j] - muse);
        l1 = l1 * ex2(m1 - muse) + ps; m1 = mnew; });
    l1 += __shfl_xor(l1, 16); l1 += __shfl_xor(l1, 32);
    const float inv1 = (l1 > 0.f) ? 1.f / l1 : 0.f; const float m1u = (m1 == -INFINITY) ? 0.f : m1;
    f32x4 Oc[4];
#pragma unroll
    for (int md = 0; md < 4; ++md) Oc[md] = (f32x4){0.f, 0.f, 0.f, 0.f};
    float carry_q3 = 0.f;
    kv_pipeline<true>(ntile_c, tid, Kb, Vb, src_cmp, [&](int tc, const h16* Ks, const h16* Vs) {
        f32x4 s[4]; qk_tile(s, Ks, qf, cc, quad);
#pragma unroll
        for (int mt = 0; mt < 4; ++mt) { f32x4 a = s[mt];
#pragma unroll
            for (int j = 0; j < 4; ++j) { const int n = tc * 64 + mt * 16 + quad * 4 + j; a[j] = (16 * n + 31 <= tq) ? ex2(a[j] - m1u) * inv1 : 0.f; }
            s[mt] = a;
            const float s4 = (a[0] + a[1]) + (a[2] + a[3]); const float p3 = a[3];
            const float fromprev = __shfl(p3, (lane + 48) & 63);
            const float fromq3 = __shfl(p3, cc + 48);
            float val = s4 + ((quad == 0) ? carry_q3 : fromprev);
            carry_q3 = fromq3;
            val += __shfl_xor(val, 8);
            if (r == 0) imp[tloc * 128 + tc * 16 + mt * 4 + quad] = val; }
        pv_tile(Oc, Vs, s, cc, quad); });
    if (qb < 16) {
        if (tid < 64) { const unsigned mlo = (2u << qb) - 1u; sel[tid * 4 + 0] = mlo; sel[tid * 4 + 1] = 0u; sel[tid * 4 + 2] = 0u; sel[tid * 4 + 3] = 0u; }
    } else {
        const int jhi = qb - 2;
        const unsigned long long lt = __lanemask_lt();
        for (int t8 = 0; t8 < 8; ++t8) { const int row = 8 * w + t8; const float* ir = imp + row * 128;
            const int j1 = lane, j2 = lane + 64; const bool ok1 = (j1 >= 1 && j1 <= jhi), ok2 = (j2 <= jhi);
            const unsigned u1 = ok1 ? __float_as_uint(ir[j1]) + 1u : 0u, u2 = ok2 ? __float_as_uint(ir[j2]) + 1u : 0u;
            unsigned prefix = 0u;
            for (int bit = 30; bit >= 0; --bit) { const unsigned test = prefix | (1u << bit);
                const int cnt = __popcll(__ballot(u1 >= test)) + __popcll(__ballot(u2 >= test)); if (cnt >= 13) prefix = test; }
            const bool gt1 = u1 > prefix, gt2 = u2 > prefix, eq1 = u1 == prefix, eq2 = u2 == prefix;
            const unsigned long long bg1 = __ballot(gt1), bg2 = __ballot(gt2), be1 = __ballot(eq1), be2 = __ballot(eq2);
            const int need = 13 - __popcll(bg1) - __popcll(bg2);
            const bool s1 = gt1 || (eq1 && __popcll(be1 & lt) < need), s2 = gt2 || (eq2 && (__popcll(be1) + __popcll(be2 & lt)) < need);
            unsigned long long blo = __ballot(s1) | 1ull, bhi = __ballot(s2);
            { const int f0 = qb - 1, f1 = qb; if (f0 < 64) blo |= 1ull << f0; else bhi |= 1ull << (f0 - 64); if (f1 < 64) blo |= 1ull << f1; else bhi |= 1ull << (f1 - 64); }
            if (lane == 0) { sel[row * 4 + 0] = (unsigned)blo; sel[row * 4 + 1] = (unsigned)(blo >> 32); sel[row * 4 + 2] = (unsigned)bhi; sel[row * 4 + 3] = (unsigned)(bhi >> 32); } }
    }
    __syncthreads();
    if (w == 0) {
        unsigned o0 = sel[lane * 4 + 0], o1 = sel[lane * 4 + 1], o2 = sel[lane * 4 + 2], o3 = sel[lane * 4 + 3];
#pragma unroll
        for (int sft = 1; sft < 64; sft <<= 1) { o0 |= __shfl_xor(o0, sft); o1 |= __shfl_xor(o1, sft); o2 |= __shfl_xor(o2, sft); o3 |= __shfl_xor(o3, sft); }
        const unsigned long long mlo = ((unsigned long long)o1 << 32) | o0, mhi = ((unsigned long long)o3 << 32) | o2;
        const unsigned long long lt = __lanemask_lt(); const int nlo = __popcll(mlo);
        if ((mlo >> lane) & 1ull) lst[__popcll(mlo & lt)] = (unsigned char)lane;
        if ((mhi >> lane) & 1ull) lst[nlo + __popcll(mhi & lt)] = (unsigned char)(64 + lane);
        if (lane == 0) uni[4] = (unsigned)(nlo + __popcll(mhi));
    }
    __syncthreads();
    const unsigned long long selLo = ((unsigned long long)sel[tloc * 4 + 1] << 32) | sel[tloc * 4 + 0], selHi = ((unsigned long long)sel[tloc * 4 + 3] << 32) | sel[tloc * 4 + 2];
    const int nlist = (int)uni[4];
    FlashState fs; fs.m = -INFINITY; fs.l = 0.f;
#pragma unroll
    for (int md = 0; md < 4; ++md) fs.O[md] = (f32x4){0.f, 0.f, 0.f, 0.f};
    const h16* kslc = C.PROJ + (size_t)b * SEQ * PN + C_KSLC + g * 64; const h16* vslc = C.PROJ + (size_t)b * SEQ * PN + C_VSLC + g * 64;
    kv_pipeline<true>(nlist, tid, Kb, Vb,
        [&](int i, const h16*& kp, const h16*& vp, size_t& stride) { const int j = lst[i]; kp = kslc + (size_t)j * 64 * PN; vp = vslc + (size_t)j * 64 * PN; stride = PN; },
        [&](int i, const h16* Ks, const h16* Vs) { const int j = lst[i];
            const unsigned long long sw = (j < 64) ? selLo : selHi; const bool sb = ((sw >> (j & 63)) & 1ull) != 0ull;
            if (__any(sb)) flash_tile<0>(fs, Ks, Vs, qf, j * 64, tq, sb, cc, quad); });
    float ls = fs.l; ls += __shfl_xor(ls, 16); ls += __shfl_xor(ls, 32); const float invs = (ls > 0.f) ? 1.f / ls : 0.f;
    f32x4 Os[4];
#pragma unroll
    for (int md = 0; md < 4; ++md) Os[md] = fs.O[md] * invs;
    fs.m = -INFINITY; fs.l = 0.f;
#pragma unroll
    for (int md = 0; md < 4; ++md) fs.O[md] = (f32x4){0.f, 0.f, 0.f, 0.f};
    const h16* kwin = C.PROJ + (size_t)b * SEQ * PN + C_KWIN + g * 64; const h16* vwin = C.PROJ + (size_t)b * SEQ * PN + C_VWIN + g * 64;
    const int jw0 = (qb >= 8 ? qb - 8 : 0);
    kv_pipeline<true>(qb - jw0 + 1, tid, Kb, Vb,
        [&](int i, const h16*& kp, const h16*& vp, size_t& stride) { const int j = jw0 + i; kp = kwin + (size_t)j * 64 * PN; vp = vwin + (size_t)j * 64 * PN; stride = PN; },
        [&](int i, const h16* Ks, const h16* Vs) { flash_tile<1>(fs, Ks, Vs, qf, (jw0 + i) * 64, tq, true, cc, quad); });
    float lw = fs.l; lw += __shfl_xor(lw, 16); lw += __shfl_xor(lw, 32); const float invw = (lw > 0.f) ? 1.f / lw : 0.f;
    const float* gp = C.PSM + rowq * PSM_W + 16 + h * 3;
    const float g0 = sigmoidf_(gp[0]), g1 = sigmoidf_(gp[1]), g2 = sigmoidf_(gp[2]) * invw;
    float ssq = 0.f; f32x4 o[4];
#pragma unroll
    for (int md = 0; md < 4; ++md) { o[md] = g0 * Oc[md] + g1 * Os[md] + g2 * fs.O[md]; ssq += (o[md][0] * o[md][0] + o[md][1] * o[md][1]) + (o[md][2] * o[md][2] + o[md][3] * o[md][3]); }
    ssq += __shfl_xor(ssq, 16); ssq += __shfl_xor(ssq, 32);
    const float rs = 1.0f / sqrtf(ssq * (1.f / 64.f) + EPS);
    const float* nw = C.in[12] + l * 256 + h * 64;
#pragma unroll
    for (int md = 0; md < 4; ++md) { const int d = md * 16 + quad * 4; u32x2 wv; wv.x = pkh(o[md][0] * rs * nw[d], o[md][1] * rs * nw[d + 1]); wv.y = pkh(o[md][2] * rs * nw[d + 2], o[md][3] * rs * nw[d + 3]);
        *(u32x2*)(C.XN + rowq * 1024 + 256 + h * 64 + d) = wv; }
}

__device__ __forceinline__ void phase_ssdnorm(const Ctx& C, int l) {
    TIDS
    const int gw = C.bid * 8 + wave, NGW = C.G * 8; const float* nw = C.in[18] + l * 512 + lane * 8;
    for (int m = gw; m < MTOK; m += NGW) { const int g = lane >> 5; const f32x4 q = *(const f32x4*)(C.SSQ + (size_t)m * 8 + g * 4);
        const float rs = 1.0f / sqrtf(((q.x + q.y) + (q.z + q.w)) * (1.f / 256.f) + EPS);
        h16* p = C.XN + (size_t)m * 1024 + 512 + lane * 8; const h16x8 v = *(const h16x8*)p;
        u32x4 o; o.x = pkh((float)v[0] * rs * nw[0], (float)v[1] * rs * nw[1]); o.y = pkh((float)v[2] * rs * nw[2], (float)v[3] * rs * nw[3]);
        o.z = pkh((float)v[4] * rs * nw[4], (float)v[5] * rs * nw[5]); o.w = pkh((float)v[6] * rs * nw[6], (float)v[7] * rs * nw[7]); *(u32x4*)p = o; }
}
__device__ __forceinline__ void phase_norm(const Ctx& C, const float* src, h16* dst) {
    TIDS
    const int gw = C.bid * 8 + wave, NGW = C.G * 8;
    for (int m = gw; m < MTOK; m += NGW) rms_row_to_h16(src + (size_t)m * DM, dst + (size_t)m * DM, lane);
}
__device__ __forceinline__ void phase_final(const Ctx& C) {
    TIDS
    const int gw = C.bid * 8 + wave, NGW = C.G * 8; const f32x4* fw = (const f32x4*)C.in[23] + lane;
    for (int m = gw; m < MTOK; m += NGW) { f32x4* xr = (f32x4*)(C.out + (size_t)m * DM) + lane; f32x4 v[4]; float s = 0.f;
#pragma unroll
        for (int j = 0; j < 4; ++j) { v[j] = xr[64 * j]; s += (v[j].x * v[j].x + v[j].y * v[j].y) + (v[j].z * v[j].z + v[j].w * v[j].w); }
        const float rs = 1.0f / sqrtf(wave_sum(s) * (1.f / DM) + EPS);
#pragma unroll
        for (int j = 0; j < 4; ++j) xr[64 * j] = v[j] * rs * fw[64 * j]; }
}

constexpr int N_PHASES = 1 + 11 * DEPTH;
#ifndef PHM
#define PHM 0xffffffffu
#endif
#define EN(k) ((PHM >> (k)) & 1u)
#ifndef PROBE_PH
#define PROBE_PH -1
#define PROBE_REPS 1
#endif
#define REPN(ph) ((ph) == PROBE_PH ? PROBE_REPS : 1)
template <int ph> __device__ __forceinline__ void run_phase(const Params* kp, int rep) {
    Ctx C; make_ctx(C, kp);
    LAS unsigned char* ldsl = (LAS unsigned char*)g_lds;
    if constexpr (ph == 0) { if (EN(0)) phase_prep(C); return; }
    constexpr int l = (ph - 1) / 11, s = (ph - 1) % 11;
    if (s == 0) { if (EN(1)) { pg8::Gemm g{(const pg8::bf16_t*)C.XN, (const pg8::bf16_t*)(C.WIN + (size_t)l * PN * DM), MTOK, PN, DM}; pg8::StaticOrder S; S.init(MTOK, PN, C.G, C.bid);
        pg8::EpiProj E{C.PROJ, C.PSM}; pg8::gemm_phase<pg8::EpiProj>(ldsl, g, S, E); } }
    else if (s == 1) { if (EN(2)) phase_tok(C, l); }
    else if (s == 2) { for (int u = C.bid; u < 512 + 2048 + 256; u += C.G) { if (u < 512) { if (EN(3)) nsa_compress_unit(C, l, u); } else if (u < 2560) { if (EN(4)) ssd_states_unit(C, l, u - 512); } else { if (EN(5)) gla_block_unit<0>(C, l, u - 2560); } } }
    else if (s == 3) { if (EN(6) && rep == 0) phase_scans(C);
        if (EN(7)) for (int v = C.bid; v < 1024; v += C.G) { const int bg = (v & 255) >> 5, sidx = v & 31, k = v >> 8;
            const int qb = (k == 0) ? sidx : (k == 1) ? 63 - sidx : (k == 2) ? 64 + sidx : 127 - sidx; nsa_attn_unit(C, l, bg >> 1, bg & 1, qb); } }
    else if (s == 4) { for (int u = C.bid; u < 2048 + 256; u += C.G) { if (u < 2048) { if (EN(8)) ssd_y_unit(C, l, u); } else { if (EN(9)) gla_block_unit<1>(C, l, u - 2048); } } }
    else if (s == 5) { if (EN(10)) phase_ssdnorm(C, l); }
    else if (s == 6) { if (EN(11)) { pg8::Gemm g{(const pg8::bf16_t*)C.XN, (const pg8::bf16_t*)(C.WOUT + (size_t)l * DM * DM), MTOK, DM, DM}; pg8::StaticOrder S; S.init(MTOK, DM, C.G, C.bid);
        pg8::EpiRes E{l == 0 ? C.in[0] : C.out, C.out}; pg8::gemm_phase<pg8::EpiRes>(ldsl, g, S, E); } }
    else if (s == 7) { if (EN(12)) phase_norm(C, C.out, C.XN); }
    else if (s == 8) { if (EN(13)) { pg8::Gemm g{(const pg8::bf16_t*)C.XN, (const pg8::bf16_t*)(C.WUP + (size_t)l * DFF * DM), MTOK, DFF, DM}; pg8::StaticOrder S; S.init(MTOK, DFF, C.G, C.bid);
        pg8::EpiHid E{C.HID}; pg8::gemm_phase<pg8::EpiHid>(ldsl, g, S, E); } }
    else if (s == 9) { if (EN(14)) { pg8::Gemm g{(const pg8::bf16_t*)C.HID, (const pg8::bf16_t*)(C.WDN + (size_t)l * DM * DFF), MTOK, DM, DFF}; pg8::StaticOrder S; S.init(MTOK, DM, C.G, C.bid);
        pg8::EpiRes E{C.out, C.out}; pg8::gemm_phase<pg8::EpiRes>(ldsl, g, S, E); } }
    else { if (EN(15)) { if (l + 1 < DEPTH) phase_norm(C, C.out, C.XN); else phase_final(C); } }
}
constexpr int LDS_MISC = 131072;
template <int PH> __device__ __forceinline__ void phase_seq(const Params* kp, int lo, int hi, cg::grid_group& grid, const XcdBarrier& bar) {
    if constexpr (PH < N_PHASES) {
        if (lo <= PH && PH < hi) {
            for (int rep = 0; rep < REPN(PH); ++rep) run_phase<PH>(kp, rep);
            if (PH + 1 < hi) { if (PH == 0) grid.sync(); else xcd_barrier(bar); }
        }
        phase_seq<PH + 1>(kp, lo, hi, grid, bar);
    }
}
__global__ void __launch_bounds__(512, 2) fwd_kernel(Params P) {
    const Params* kp = (const Params*)__builtin_amdgcn_kernarg_segment_ptr();
    cg::grid_group grid = cg::this_grid();
    volatile LAS unsigned* st = (volatile LAS unsigned*)((LAS unsigned char*)g_lds + LDS_MISC);
    if (threadIdx.x < 2) st[threadIdx.x] = 0u;
    __syncthreads();
    const XcdBarrier bar = xcd_barrier_post((unsigned*)P.ws, st);
    phase_seq<0>(kp, P.ph_lo, P.ph_hi, grid, bar);
}

extern "C" void kernel_launch(void* const* d_in, const int* in_sizes, int n_in, void* d_out, int out_size, void* d_ws, size_t ws_size, hipStream_t stream) {
    static int grid = 0;
    if (grid == 0) {
        if (n_in != 24 || in_sizes[0] != MTOK * DM || out_size != MTOK * DM || ws_size < WS_END) { fprintf(stderr, "kernel_launch: unexpected shapes (n_in %d, ws %zu)\n", n_in, ws_size); grid = -1; return; }
        int dev = 0, cus = 0, per_cu = 0;
        hipGetDevice(&dev); hipDeviceGetAttribute(&cus, hipDeviceAttributeMultiprocessorCount, dev);
        hipFuncSetAttribute((const void*)fwd_kernel, hipFuncAttributeMaxDynamicSharedMemorySize, LDS_BYTES);
        hipOccupancyMaxActiveBlocksPerMultiprocessor(&per_cu, (const void*)fwd_kernel, 512, LDS_BYTES);
        (void)hipGetLastError();
        if (per_cu < 1) { fprintf(stderr, "kernel_launch: occupancy query says %d blocks/CU\n", per_cu); grid = -1; return; }
        grid = cus;
    }
    if (grid < 0) return;
    (void)hipMemsetAsync(d_ws, 0, 16384, stream);
    Params p{};
    for (int i = 0; i < 24; ++i) p.in[i] = (const float*)d_in[i];
    p.out = (float*)d_out; p.ws = (unsigned char*)d_ws;
#if MK_MULTI_LAUNCH
    for (int ph = 0; ph < N_PHASES; ++ph) { p.ph_lo = ph; p.ph_hi = ph + 1; hipLaunchKernelGGL(fwd_kernel, dim3(grid), dim3(512), LDS_BYTES, stream, p); }
#else
    p.ph_lo = 0; p.ph_hi = N_PHASES;
    void* args[] = {&p};
    hipError_t e = hipLaunchCooperativeKernel((const void*)fwd_kernel, dim3(grid), dim3(512), args, LDS_BYTES, stream);
    if (e != hipSuccess) fprintf(stderr, "cooperative launch failed: %s (grid %d)\n", hipGetErrorString(e), grid);
#endif
}
```

```cpp
#include <hip/hip_runtime.h>
#include <hip/hip_cooperative_groups.h>
#include <cstdio>
#include <cstdint>
namespace cg = cooperative_groups;

#ifndef MK_MULTI_LAUNCH
#define MK_MULTI_LAUNCH 0
#endif

#define LAS __attribute__((address_space(3)))
typedef _Float16 h16;
typedef _Float16 h16x8 __attribute__((ext_vector_type(8)));
typedef _Float16 h16x4 __attribute__((ext_vector_type(4)));
typedef _Float16 h16x2 __attribute__((ext_vector_type(2)));
typedef float f32x4 __attribute__((ext_vector_type(4)));
typedef float f32x2 __attribute__((ext_vector_type(2)));
typedef unsigned u32x4 __attribute__((ext_vector_type(4)));
typedef unsigned u32x2 __attribute__((ext_vector_type(2)));

constexpr int BATCH = 4, SEQ = 8192, DM = 1024, MTOK = BATCH * SEQ, DEPTH = 2;
constexpr int DIN = 3364, PN = 3584, DFF = 4096;
constexpr float EPS = 1e-6f;
constexpr int C_GQ = 0, C_GK = 128, C_GV = 256, C_GR = 512, C_NQ = 768, C_NKV = 1024, C_SZ = 1792, C_SX = 2304, C_SM = 3328;
constexpr int C_KCMP = C_NKV, C_VCMP = C_NKV + 128, C_KSLC = C_NKV + 256, C_VSLC = C_NKV + 384, C_KWIN = C_NKV + 512, C_VWIN = C_NKV + 640;
constexpr int PSM_W = 64;

constexpr size_t MiB = 1u << 20;
constexpr size_t WS_WIN = 2 * MiB;
constexpr size_t WS_WOUT = 16 * MiB;
constexpr size_t WS_WUP = 20 * MiB;
constexpr size_t WS_WDN = 36 * MiB;
constexpr size_t WS_W1T = 52 * MiB;
constexpr size_t WS_W2T = 54 * MiB;
constexpr size_t WS_B1 = 54 * MiB + 256 * 1024;
constexpr size_t WS_ROPE = 55 * MiB;
constexpr size_t WS_XN = 60 * MiB;
constexpr size_t WS_PROJ = 124 * MiB;
constexpr size_t WS_HID = 124 * MiB;
constexpr size_t WS_XBCC = 348 * MiB;
constexpr size_t WS_SSDST = 412 * MiB;
constexpr size_t WS_GLAST = 476 * MiB;
constexpr size_t WS_PSM = 492 * MiB;
constexpr size_t WS_KC = 500 * MiB;
constexpr size_t WS_VC = 500 * MiB + 512 * 1024;
constexpr size_t WS_SSQ = 501 * MiB;
constexpr size_t WS_DTV = 502 * MiB;
constexpr size_t WS_ACS = 503 * MiB;
constexpr size_t WS_CD = 504 * MiB;
constexpr size_t WS_GLAG = 504 * MiB + 64 * 1024;
constexpr size_t WS_END = 505 * MiB;

constexpr int LDS_BYTES = 147456;
extern __shared__ __attribute__((aligned(16))) unsigned char g_lds[];

struct Params { const float* in[24]; float* out; unsigned char* ws; int ph_lo, ph_hi; };

__constant__ float ROPE_INV[32] = {
 1.000000000e+00f, 7.498942614e-01f, 5.623413324e-01f, 4.216965139e-01f, 3.162277639e-01f, 2.371373773e-01f, 1.778279394e-01f, 1.333521307e-01f,
 1.000000015e-01f, 7.498941571e-02f, 5.623413250e-02f, 4.216965288e-02f, 3.162277490e-02f, 2.371373773e-02f, 1.778279431e-02f, 1.333521493e-02f,
 9.999999776e-03f, 7.498941850e-03f, 5.623413250e-03f, 4.216964822e-03f, 3.162277630e-03f, 2.371373586e-03f, 1.778279431e-03f, 1.333521446e-03f,
 1.000000047e-03f, 7.498942432e-04f, 5.623413017e-04f, 4.216965172e-04f, 3.162277571e-04f, 2.371373703e-04f, 1.778279402e-04f, 1.333521504e-04f };

__device__ __forceinline__ f32x4 mfma16(h16x8 a, h16x8 b, f32x4 c) { return __builtin_amdgcn_mfma_f32_16x16x32_f16(a, b, c, 0, 0, 0); }
__device__ __forceinline__ float wave_sum(float v) {
#pragma unroll
    for (int o = 1; o < 64; o <<= 1) v += __shfl_xor(v, o);
    return v;
}
__device__ __forceinline__ float ex2(float x) { return __builtin_amdgcn_exp2f(x); }
__device__ __forceinline__ float sigmoidf_(float x) { return 1.f / (1.f + __expf(-x)); }
__device__ __forceinline__ float siluf_(float x) { return x / (1.f + __expf(-x)); }
__device__ __forceinline__ float softplusf_(float x) { return fmaxf(x, 0.f) + log1pf(__expf(-fabsf(x))); }
__device__ __forceinline__ unsigned pkh(float lo, float hi) { h16x2 v = {(h16)lo, (h16)hi}; return __builtin_bit_cast(unsigned, v); }

__device__ __forceinline__ int opaque_tid() { int t = threadIdx.x; asm volatile("" : "+v"(t)); return t; }
namespace pg8 {
typedef unsigned short bf16_t;
constexpr int BM = 256, BK = 64, HALF = 128, HTB = HALF * BK * 2, STAGE_BYTES = 8 * HTB, NXCD = 8, WGM = 8;
__host__ __device__ __forceinline__ int lds_byte(int r, int c) { const int st = (r >> 4) * 2 + (c >> 5), rr = r & 15, cc = c & 31, ob = rr * 64 + cc * 2; return st * 1024 + (ob ^ (((ob >> 9) & 1) << 5)); }
__host__ __device__ __forceinline__ void stage_rc(int b, int& R, int& C) { const int st = b / 1024, sb = b % 1024, swz = sb ^ (((sb >> 9) & 1) << 5); R = (st >> 1) * 16 + swz / 64; C = (st & 1) * 32 + (swz % 64) / 2; }
__host__ __device__ __forceinline__ int perm32(int rho) { const int n = rho >> 4, i = rho & 15; return 8 * (i >> 2) + 4 * n + (i & 3); }
struct Unit { int pm, pn; };
struct Gemm { const bf16_t* A; const bf16_t* Bt; int M, N, K; };
struct StaticOrder {
    int nM, nN, nwg, G, c;
    __device__ void init(int M, int N, int G_, int c_) { nM = M / BM; nN = N / BM; nwg = nM * nN; G = G_; c = c_; }
    __device__ bool next(int i, Unit& u) const {
        const long L = (long)i * G + c; if (L >= nwg) return false;
        int wgid = (int)L; { const int q = nwg / NXCD, r = nwg % NXCD, xcd = wgid % NXCD, off = wgid / NXCD; wgid = (xcd < r ? xcd * (q + 1) : r * (q + 1) + (xcd - r) * q) + off; }
        const int nig = WGM * nN, gid = wgid / nig, fm = gid * WGM, gsz = (nM - fm) < WGM ? (nM - fm) : WGM;
        u.pm = fm + ((wgid % nig) % gsz); u.pn = (wgid % nig) / gsz; return true;
    }
};
struct EpiProj {
    static constexpr bool PERM = true;
    h16* O; float* PSM;
    __device__ __forceinline__ void operator()(const f32x4 (&acc)[2][2][4][2], const Unit& u, int wr, int wc, int fr, int fq) const {
        const int row0 = u.pm * BM + wr * 64 + fr, col0 = u.pn * BM + wc * 32 + 8 * fq;
#pragma unroll
        for (int ai = 0; ai < 2; ++ai)
#pragma unroll
            for (int m = 0; m < 4; ++m) { const int row = row0 + ai * HALF + m * 16;
#pragma unroll
                for (int bj = 0; bj < 2; ++bj) { const f32x4 v0 = acc[ai][bj][m][0], v1 = acc[ai][bj][m][1]; const int c = col0 + bj * HALF;
                    u32x4 w; w.x = pkh(v0[0], v0[1]); w.y = pkh(v0[2], v0[3]); w.z = pkh(v1[0], v1[1]); w.w = pkh(v1[2], v1[3]);
                    *(u32x4*)(O + (size_t)row * PN + c) = w;
                    if (c >= C_SM && c < C_SM + PSM_W) { float* p = PSM + (size_t)row * PSM_W + (c - C_SM); *(f32x4*)p = v0; *(f32x4*)(p + 4) = v1; } } }
    }
};
struct EpiHid {
    static constexpr bool PERM = true;
    h16* O;
    __device__ __forceinline__ void operator()(const f32x4 (&acc)[2][2][4][2], const Unit& u, int wr, int wc, int fr, int fq) const {
        const int row0 = u.pm * BM + wr * 64 + fr, col0 = u.pn * BM + wc * 32 + 8 * fq;
#pragma unroll
        for (int ai = 0; ai < 2; ++ai)
#pragma unroll
            for (int m = 0; m < 4; ++m) { const int row = row0 + ai * HALF + m * 16;
#pragma unroll
                for (int bj = 0; bj < 2; ++bj) { f32x4 v0 = acc[ai][bj][m][0], v1 = acc[ai][bj][m][1];
#pragma unroll
                    for (int e = 0; e < 4; ++e) { float a = fmaxf(v0[e], 0.f), b = fmaxf(v1[e], 0.f); v0[e] = a * a; v1[e] = b * b; }
                    u32x4 w; w.x = pkh(v0[0], v0[1]); w.y = pkh(v0[2], v0[3]); w.z = pkh(v1[0], v1[1]); w.w = pkh(v1[2], v1[3]);
                    *(u32x4*)(O + (size_t)row * DFF + col0 + bj * HALF) = w; } }
    }
};
struct EpiRes {
    static constexpr bool PERM = false;
    const float* base; float* out;
    __device__ __forceinline__ void operator()(const f32x4 (&acc)[2][2][4][2], const Unit& u, int wr, int wc, int fr, int fq) const {
        const int col0 = u.pn * BM + wc * 32 + 4 * fq;
#pragma unroll
        for (int ai = 0; ai < 2; ++ai)
#pragma unroll
            for (int m = 0; m < 4; ++m) { const size_t off = (size_t)(u.pm * BM + ai * HALF + wr * 64 + m * 16 + fr) * DM + col0;
#pragma unroll
                for (int bj = 0; bj < 2; ++bj)
#pragma unroll
                    for (int n = 0; n < 2; ++n) { const f32x4 bs = *(const f32x4*)(base + off + bj * HALF + n * 16); *(f32x4*)(out + off + bj * HALF + n * 16) = bs + acc[ai][bj][m][n]; } }
    }
};

template <class Epi>
__device__ __forceinline__ void gemm_phase(LAS unsigned char* lds, const Gemm g, const StaticOrder& S, const Epi& E) {
    const int tid = opaque_tid(), wid = __builtin_amdgcn_readfirstlane(tid >> 6), lane = tid & 63, wr = wid >> 2, wc = wid & 3, fr = lane & 15, fq = lane >> 4;
    const int K = g.K, nt = K / BK;
    unsigned voffA[2], voffB[2];
#pragma unroll
    for (int i = 0; i < 2; ++i) { int R, C; stage_rc(tid * 16 + i * 8192, R, C); const int Rb = Epi::PERM ? ((R & ~31) + perm32(R & 31)) : R;
        voffA[i] = (unsigned)(R * K + C) * 2u; voffB[i] = (unsigned)(Rb * K + C) * 2u; }
    const size_t kstep = (size_t)(BK * 2);
    const size_t hstep = (size_t)HALF * K * 2;
    const size_t tstep = 2 * hstep;
    const unsigned ldsw = (unsigned)wid * 1024u;
    const int aoff = lds_byte(wr * 64 + fr, fq * 8), boff = lds_byte(wc * 32 + fr, fq * 8);
#define PG8_SA(b, h) (((b) * 2 + (h)) * HTB)
#define PG8_SB(b, h) ((4 + (b) * 2 + (h)) * HTB)
#define PG8_STAGE(bufoff, gbase, voff) do { _Pragma("unroll") for (int _i = 0; _i < 2; ++_i) \
        __builtin_amdgcn_global_load_lds((const unsigned*)((const char*)(gbase) + (voff)[_i]), (LAS unsigned*)(lds + (bufoff) + ldsw + _i * 8192), 16, 0, 0); } while (0)
#define PG8_LDA(dst, b, h) do { _Pragma("unroll") for (int m = 0; m < 4; ++m) _Pragma("unroll") for (int k = 0; k < 2; ++k) dst[m][k] = *(const LAS h16x8*)(lds + PG8_SA(b, h) + aoff + m * 2048 + k * 1024); } while (0)
#define PG8_LDB(dst, b, h) do { _Pragma("unroll") for (int n = 0; n < 2; ++n) _Pragma("unroll") for (int k = 0; k < 2; ++k) dst[n][k] = *(const LAS h16x8*)(lds + PG8_SB(b, h) + boff + n * 2048 + k * 1024); } while (0)
#define PG8_MMA(ai, bj, At, Bt) do { __builtin_amdgcn_s_setprio(1); _Pragma("unroll") for (int m = 0; m < 4; ++m) _Pragma("unroll") for (int n = 0; n < 2; ++n) _Pragma("unroll") for (int k = 0; k < 2; ++k) \
        acc[ai][bj][m][n] = __builtin_amdgcn_mfma_f32_16x16x32_f16(Bt[n][k], At[m][k], acc[ai][bj][m][n], 0, 0, 0); __builtin_amdgcn_s_setprio(0); } while (0)
#define PG8_WAIT_V(n) asm volatile("s_waitcnt vmcnt(" #n ")" ::: "memory")
#define PG8_WAIT_L(n) asm volatile("s_waitcnt lgkmcnt(" #n ")" ::: "memory")
#define PG8_BAR __builtin_amdgcn_s_barrier()
#define PG8_SCHED __builtin_amdgcn_sched_barrier(0)
    Unit cur, nxt; int ui = 0;
    if (!S.next(0, cur)) return;
    f32x4 acc[2][2][4][2];
#pragma unroll
    for (int a = 0; a < 2; ++a)
#pragma unroll
        for (int b = 0; b < 2; ++b)
#pragma unroll
            for (int m = 0; m < 4; ++m)
#pragma unroll
                for (int n = 0; n < 2; ++n) acc[a][b][m][n] = (f32x4){0.f, 0.f, 0.f, 0.f};
    h16x8 At[4][2], B0[2][2], B1[2][2];
    const char* cA = (const char*)g.A + (size_t)cur.pm * tstep; const char* cB = (const char*)g.Bt + (size_t)cur.pn * tstep;
    PG8_STAGE(PG8_SB(0, 0), cB, voffB); PG8_STAGE(PG8_SB(0, 1), cB + hstep, voffB); PG8_STAGE(PG8_SA(0, 0), cA, voffA); PG8_STAGE(PG8_SA(0, 1), cA + hstep, voffA);
    if (wr == 1) PG8_BAR;
    PG8_WAIT_V(2); PG8_BAR;
    PG8_STAGE(PG8_SB(1, 0), cB + kstep, voffB); PG8_STAGE(PG8_SA(1, 0), cA + kstep, voffA); PG8_STAGE(PG8_SB(1, 1), cB + hstep + kstep, voffB);
    PG8_WAIT_V(6); PG8_BAR;
    for (;;) {
        const bool has_next = S.next(ui + 1, nxt);
        const char* nA = has_next ? (const char*)g.A + (size_t)nxt.pm * tstep : cA; const char* nB = has_next ? (const char*)g.Bt + (size_t)nxt.pn * tstep : cB;
        for (int t = 0; t < nt; t += 2) {
            const bool last = (t == nt - 2);
            const char* a1 = cA + (size_t)(t + 1) * kstep;
            const char* a2 = last ? nA : cA + (size_t)(t + 2) * kstep; const char* b2 = last ? nB : cB + (size_t)(t + 2) * kstep;
            const char* a3 = a2 + kstep; const char* b3 = b2 + kstep;
            PG8_LDB(B0, 0, 0); PG8_LDB(B1, 0, 1); PG8_SCHED; PG8_LDA(At, 0, 0); PG8_STAGE(PG8_SA(1, 1), a1 + hstep, voffA);
            PG8_WAIT_V(8); PG8_WAIT_L(0); PG8_BAR; PG8_MMA(0, 0, At, B0); PG8_MMA(0, 1, At, B1); PG8_BAR; PG8_SCHED;
            PG8_LDA(At, 0, 1); PG8_STAGE(PG8_SB(0, 0), b2, voffB); PG8_STAGE(PG8_SB(0, 1), b2 + hstep, voffB); PG8_STAGE(PG8_SA(0, 0), a2, voffA);
            PG8_WAIT_V(8); PG8_WAIT_L(0); PG8_BAR; PG8_MMA(1, 0, At, B0); PG8_MMA(1, 1, At, B1); PG8_BAR; PG8_SCHED;
            PG8_LDB(B0, 1, 0); PG8_LDB(B1, 1, 1); PG8_SCHED; PG8_LDA(At, 1, 0); PG8_STAGE(PG8_SA(0, 1), a2 + hstep, voffA);
            PG8_WAIT_V(8); PG8_WAIT_L(0); PG8_BAR; PG8_MMA(0, 0, At, B0); PG8_MMA(0, 1, At, B1); PG8_BAR; PG8_SCHED;
            PG8_LDA(At, 1, 1); PG8_STAGE(PG8_SB(1, 0), b3, voffB); PG8_STAGE(PG8_SB(1, 1), b3 + hstep, voffB); PG8_STAGE(PG8_SA(1, 0), a3, voffA);
            PG8_WAIT_V(8); PG8_WAIT_L(0); PG8_BAR; PG8_MMA(1, 0, At, B0); PG8_MMA(1, 1, At, B1); PG8_BAR; PG8_SCHED;
        }
        if (wr == 0) PG8_BAR;
        E(acc, cur, wr, wc, fr, fq);
        if (!has_next) break;
#pragma unroll
        for (int a = 0; a < 2; ++a)
#pragma unroll
            for (int b = 0; b < 2; ++b)
#pragma unroll
                for (int m = 0; m < 4; ++m)
#pragma unroll
                    for (int n = 0; n < 2; ++n) acc[a][b][m][n] = (f32x4){0.f, 0.f, 0.f, 0.f};
        cur = nxt; cA = nA; cB = nB; ++ui;
        if (wr == 1) PG8_BAR;
    }
    PG8_WAIT_V(0);
    PG8_BAR;
#undef PG8_SA
#undef PG8_SB
#undef PG8_STAGE
#undef PG8_LDA
#undef PG8_LDB
#undef PG8_MMA
#undef PG8_WAIT_V
#undef PG8_WAIT_L
#undef PG8_BAR
#undef PG8_SCHED
}
}


#define XB_TMO      128
#define XB_XCNT(j)  (256  + 64 * (j))
#define XB_XSUB(j)  (1280 + 64 * (j))
#define XB_XGEN(j)  (2304 + 64 * (j))
#define XB_TOP      3328
#define XB_TOPGEN   3392
#define XCD_BAR_WORDS 3456
#define XB_SPIN_CAP (1u << 18)
__device__ __forceinline__ unsigned xb_ld(unsigned* p)              { return __hip_atomic_load(p, __ATOMIC_RELAXED, __HIP_MEMORY_SCOPE_AGENT); }
__device__ __forceinline__ unsigned xb_add(unsigned* p, unsigned v) { return __hip_atomic_fetch_add(p, v, __ATOMIC_RELAXED, __HIP_MEMORY_SCOPE_AGENT); }
__device__ __forceinline__ unsigned xb_xcc_id() { return (unsigned)__builtin_amdgcn_s_getreg((3 << 11) | 20) & 0xFu; }
#define XB_SPIN(cond, bar) do { unsigned _sp = 0; while (cond) { __builtin_amdgcn_s_sleep(1); \
    if ((++_sp & 255u) == 0u) { if (xb_ld(&(bar)[XB_TMO])) break; if (_sp > XB_SPIN_CAP) { atomicAdd(&(bar)[XB_TMO], 1u); break; } } } } while (0)
struct XcdBarrier { unsigned* bar; unsigned x; volatile LAS unsigned* st; };
__device__ __forceinline__ XcdBarrier xcd_barrier_post(unsigned* bar, volatile LAS unsigned* st) {
    XcdBarrier b; b.bar = bar; b.x = xb_xcc_id(); b.st = st;
    if (threadIdx.x == 0) (void)xb_add(&bar[XB_XCNT(b.x)], 1u);
    return b;
}
__device__ __forceinline__ void xcd_barrier_complete(unsigned* bar, unsigned x, unsigned& nloc, unsigned& nx) {
    const unsigned G = gridDim.x * gridDim.y * gridDim.z;
    unsigned sum, cnt, mine, sp = 0u;
    for (;;) {
        sum = 0u; cnt = 0u; mine = 0u;
#pragma unroll
        for (unsigned j = 0; j < 16; ++j) { const unsigned c = xb_ld(&bar[XB_XCNT(j)]); sum += c; cnt += (c > 0u) ? 1u : 0u; mine = (j == x) ? c : mine; }
        if (sum == G) break;
        __builtin_amdgcn_s_sleep(1);
        if ((++sp & 255u) == 0u) { if (xb_ld(&bar[XB_TMO])) break; if (sp > XB_SPIN_CAP) { atomicAdd(&bar[XB_TMO], 1u); break; } }
    }
    nloc = mine > 0u ? mine : 1u; nx = cnt > 0u ? cnt : 1u;
}
__device__ __forceinline__ void xcd_barrier(const XcdBarrier& b) {
    asm volatile("s_waitcnt vmcnt(0)" ::: "memory");
    __syncthreads();
    if (threadIdx.x == 0) {
        unsigned* bar = b.bar;
        __builtin_amdgcn_s_waitcnt(0);
        unsigned nloc = b.st[0], nx = b.st[1];
        if (nloc == 0u) { xcd_barrier_complete(bar, b.x, nloc, nx); b.st[0] = nloc; b.st[1] = nx; }
        const unsigned old = xb_add(&bar[XB_XSUB(b.x)], 1u);
        const unsigned gen = old / nloc;
        if (old + 1u == (gen + 1u) * nloc) {
            __builtin_amdgcn_fence(__ATOMIC_RELEASE, "agent");
            asm volatile("s_waitcnt vmcnt(0)" ::: "memory");
            const unsigned og = xb_add(&bar[XB_TOP], 1u);
            const unsigned tg = og / nx;
            if (og + 1u == (tg + 1u) * nx) xb_add(&bar[XB_TOPGEN], 1u);
            else XB_SPIN(xb_ld(&bar[XB_TOPGEN]) == tg, bar);
            __builtin_amdgcn_fence(__ATOMIC_ACQUIRE, "agent");
            xb_add(&bar[XB_XGEN(b.x)], 1u);
            asm volatile("s_waitcnt vmcnt(0)" ::: "memory");
        } else {
            XB_SPIN(xb_ld(&bar[XB_XGEN(b.x)]) == gen, bar);
            __builtin_amdgcn_fence(__ATOMIC_ACQUIRE, "agent");
            asm volatile("s_waitcnt vmcnt(0)" ::: "memory");
        }
    }
    __syncthreads();
}

#define TIDS const int tid = opaque_tid(); const int lane = tid & 63; const int wave = __builtin_amdgcn_readfirstlane(tid >> 6); (void)lane; (void)wave;
struct Ctx {
    const float* in[24]; float* out; unsigned char* ws;
    int G, bid;
    h16 *WIN, *WOUT, *WUP, *WDN, *W1T, *W2T, *XN, *PROJ, *HID, *XBCC, *KC, *VC;
    float *B1, *ROPE, *SSDST, *GLAST, *PSM, *SSQ, *DTV, *ACS, *CD, *GLAG;
};
__device__ __forceinline__ void make_ctx(Ctx& C, const Params* kp0) {
    const Params* kp = kp0; asm volatile("" : "+s"(kp));
#pragma unroll
    for (int i = 0; i < 24; ++i) C.in[i] = kp->in[i];
    C.out = kp->out; unsigned char* ws = kp->ws; C.ws = ws; C.G = gridDim.x; C.bid = blockIdx.x;
    C.WIN = (h16*)(ws + WS_WIN); C.WOUT = (h16*)(ws + WS_WOUT); C.WUP = (h16*)(ws + WS_WUP); C.WDN = (h16*)(ws + WS_WDN); C.W1T = (h16*)(ws + WS_W1T); C.W2T = (h16*)(ws + WS_W2T);
    C.XN = (h16*)(ws + WS_XN); C.PROJ = (h16*)(ws + WS_PROJ); C.HID = (h16*)(ws + WS_HID); C.XBCC = (h16*)(ws + WS_XBCC); C.KC = (h16*)(ws + WS_KC); C.VC = (h16*)(ws + WS_VC);
    C.B1 = (float*)(ws + WS_B1); C.ROPE = (float*)(ws + WS_ROPE); C.SSDST = (float*)(ws + WS_SSDST); C.GLAST = (float*)(ws + WS_GLAST); C.PSM = (float*)(ws + WS_PSM);
    C.SSQ = (float*)(ws + WS_SSQ); C.DTV = (float*)(ws + WS_DTV); C.ACS = (float*)(ws + WS_ACS); C.CD = (float*)(ws + WS_CD); C.GLAG = (float*)(ws + WS_GLAG);
}

__device__ __forceinline__ int win_src_col(int n) {
    if (n < 512) return n;
    if (n < 768) return n - 512 + 528;
    if (n < 1024) return n - 768 + 784;
    if (n < 1792) return n - 1024 + 1040;
    if (n < 2304) return n - 1792 + 1820;
    if (n < 3328) return n - 2304 + 2332;
    const int r = n - 3328;
    if (r < 16) return 512 + r;
    if (r < 28) return 1808 + (r - 16);
    if (r < 36) return 3356 + (r - 28);
    return -1;
}
template <bool MAPW>
__device__ __forceinline__ void transpose_item(const float* W, int K, int Nsrc, int Ndst, h16* WT, const float* kscale, float* scr, int item, int lane) {
    const int nblk = Ndst / 32, kb = item / nblk, nb = item % nblk, k0 = 64 * kb, n0 = 32 * nb;
    const int nd = n0 + (lane & 31); const int sc = MAPW ? win_src_col(nd) : nd;
#pragma unroll 8
    for (int i = 0; i < 32; ++i) { const int kk = 2 * i + (lane >> 5); float v = 0.f;
        if (sc >= 0) { v = W[(size_t)(k0 + kk) * Nsrc + sc]; if (kscale) v *= kscale[k0 + kk]; }
        scr[kk * 33 + (lane & 31)] = v; }
    asm volatile("s_waitcnt lgkmcnt(0)" ::: "memory");
    const int c = lane & 7;
#pragma unroll
    for (int j = 0; j < 4; ++j) { const int n = (lane >> 3) + 8 * j; const float* s = scr + (8 * c) * 33 + n;
        u32x4 o; o.x = pkh(s[0 * 33], s[1 * 33]); o.y = pkh(s[2 * 33], s[3 * 33]); o.z = pkh(s[4 * 33], s[5 * 33]); o.w = pkh(s[6 * 33], s[7 * 33]);
        *(u32x4*)(WT + (size_t)(n0 + n) * K + k0 + 8 * c) = o; }
    asm volatile("s_waitcnt lgkmcnt(0)" ::: "memory");
}
__device__ __forceinline__ void rms_row_to_h16(const float* xrow, h16* orow, int lane) {
    const f32x4* xr = (const f32x4*)xrow + lane; f32x4 v[4]; float s = 0.f;
#pragma unroll
    for (int j = 0; j < 4; ++j) { v[j] = xr[64 * j]; s += (v[j].x * v[j].x + v[j].y * v[j].y) + (v[j].z * v[j].z + v[j].w * v[j].w); }
    const float rs = 1.0f / sqrtf(wave_sum(s) * (1.f / DM) + EPS);
    u32x2* o8 = (u32x2*)orow + lane;
#pragma unroll
    for (int j = 0; j < 4; ++j) { u32x2 w; w.x = pkh(v[j].x * rs, v[j].y * rs); w.y = pkh(v[j].z * rs, v[j].w * rs); o8[64 * j] = w; }
}
__device__ __forceinline__ void sincos_acc(float angf, float& c, float& s) {
    const double x = (double)angf; const double n = __builtin_rint(x * 0.63661977236758134308);
    const double r = __builtin_fma(-n, 1.5707963267948966192, x) - n * 6.123233995736766036e-17;
    const double r2 = r * r;
    double sp = -7.6471637318198164759e-13; sp = sp * r2 + 1.6059043836821614599e-10; sp = sp * r2 - 2.5052108385441718775e-08; sp = sp * r2 + 2.7557319223985890653e-06;
    sp = sp * r2 - 1.9841269841269841270e-04; sp = sp * r2 + 8.3333333333333333333e-03; sp = sp * r2 - 1.6666666666666666667e-01; const double sn = r + r * r2 * sp;
    double cp = 4.7794773323873852974e-14; cp = cp * r2 - 1.1470745597729724714e-11; cp = cp * r2 + 2.0876756987868098979e-09; cp = cp * r2 - 2.7557319223985890653e-07;
    cp = cp * r2 + 2.4801587301587301587e-05; cp = cp * r2 - 1.3888888888888888889e-03; cp = cp * r2 + 4.1666666666666666667e-02; cp = cp * r2 - 0.5; const double cs = 1.0 + r2 * cp;
    const int q = ((int)n) & 3;
    const double so = (q == 0) ? sn : (q == 1) ? cs : (q == 2) ? -sn : -cs;
    const double co = (q == 0) ? cs : (q == 1) ? -sn : (q == 2) ? -cs : sn;
    c = (float)co; s = (float)so;
}
__device__ __forceinline__ void phase_prep(const Ctx& C) {
    TIDS
    float* scr = (float*)(g_lds) + wave * (64 * 33);
    const int gw = C.bid * 8 + wave, NGW = C.G * 8;
    constexpr int I_IN = 16 * (PN / 32), I_OUT = 16 * 32, I_UP = 16 * 128, I_DN = 64 * 32, I_W1 = 32 * 4, I_W2 = 2 * 2;
    constexpr int PER_L = I_IN + I_OUT + I_UP + I_DN + 2 * I_W1 + 2 * I_W2;
    for (int it = gw; it < DEPTH * PER_L; it += NGW) {
        const int l = it / PER_L; int r = it % PER_L;
        if (r < I_IN) { transpose_item<true>(C.in[2] + (size_t)l * DM * DIN, DM, DIN, PN, C.WIN + (size_t)l * PN * DM, C.in[1] + l * DM, scr, r, lane); continue; } r -= I_IN;
        if (r < I_OUT) { transpose_item<false>(C.in[19] + (size_t)l * DM * DM, DM, DM, DM, C.WOUT + (size_t)l * DM * DM, nullptr, scr, r, lane); continue; } r -= I_OUT;
        if (r < I_UP) { transpose_item<false>(C.in[21] + (size_t)l * DM * DFF, DM, DFF, DFF, C.WUP + (size_t)l * DFF * DM, C.in[20] + l * DM, scr, r, lane); continue; } r -= I_UP;
        if (r < I_DN) { transpose_item<false>(C.in[22] + (size_t)l * DFF * DM, DFF, DM, DM, C.WDN + (size_t)l * DM * DFF, nullptr, scr, r, lane); continue; } r -= I_DN;
        if (r < 2 * I_W1) { const int kv = r / I_W1; transpose_item<false>(C.in[kv ? 10 : 7] + (size_t)l * 2048 * 128, 2048, 128, 128, C.W1T + (size_t)(l * 2 + kv) * 128 * 2048, nullptr, scr, r % I_W1, lane); continue; } r -= 2 * I_W1;
        { const int kv = r / I_W2; transpose_item<false>(C.in[kv ? 11 : 8] + (size_t)l * 128 * 64, 128, 64, 64, C.W2T + (size_t)(l * 2 + kv) * 64 * 128, nullptr, scr, r % I_W2, lane); }
    }
    for (int it = gw; it < DEPTH * 2 * 128; it += NGW) {
        const int l = it / 256, kv = (it / 128) & 1, j = it & 127;
        const float* pos = C.in[kv ? 9 : 6] + (size_t)l * 2048; const float* w1 = C.in[kv ? 10 : 7] + (size_t)l * 2048 * 128;
        float s = 0.f;
        for (int f = lane; f < 2048; f += 64) s += pos[f] * w1[(size_t)f * 128 + j];
        s = wave_sum(s);
        if (lane == 0) C.B1[it] = s;
    }
    for (int e = C.bid * 512 + tid; e < SEQ * 32; e += C.G * 512) {
        const int pos = e >> 5, i = e & 31; const float ang = (float)pos * ROPE_INV[i];
        float cs, sn; sincos_acc(ang, cs, sn); C.ROPE[2 * e] = cs; C.ROPE[2 * e + 1] = sn;
    }
    for (int m = gw; m < MTOK; m += NGW) rms_row_to_h16(C.in[0] + (size_t)m * DM, C.XN + (size_t)m * DM, lane);
}

__device__ __forceinline__ void phase_tok(const Ctx& C, int l) {
    TIDS
    const int gw = C.bid * 8 + wave, NGW = C.G * 8;
    const float* cw = C.in[13] + (size_t)l * 4 * 1024; const float* cb = C.in[14] + (size_t)l * 1024; const float* dtb = C.in[15] + l * 8;
    for (int m = gw; m < MTOK; m += NGW) {
        const int t = m & (SEQ - 1);
        h16* prow = C.PROJ + (size_t)m * PN;
#pragma unroll
        for (int it = 0; it < 5; ++it) { const int pi = lane + 64 * it, hd = pi >> 5, i = pi & 31;
            const int base = (hd < 4) ? (C_NQ + hd * 64) : (hd < 6) ? (C_KCMP + (hd - 4) * 64) : (hd < 8) ? (C_KSLC + (hd - 6) * 64) : (C_KWIN + (hd - 8) * 64);
            const float cs = C.ROPE[2 * (t * 32 + i)], sn = C.ROPE[2 * (t * 32 + i) + 1];
            const float x1 = (float)prow[base + i], x2 = (float)prow[base + 32 + i]; const float sc = (hd < 4) ? 0.18033688011112042f : 1.f;
            prow[base + i] = (h16)((x1 * cs - x2 * sn) * sc); prow[base + 32 + i] = (h16)((x2 * cs + x1 * sn) * sc); }
        { const int ch = lane * 16; float a[16];
#pragma unroll
            for (int e = 0; e < 16; ++e) a[e] = cb[ch + e];
#pragma unroll
            for (int i = 0; i < 4; ++i) { const int tt = t - 3 + i; if (tt < 0) continue;
                const h16* src = C.PROJ + (size_t)(m - 3 + i) * PN + C_SX + ch; const h16x8 x0 = *(const h16x8*)src, x1 = *(const h16x8*)(src + 8);
#pragma unroll
                for (int e = 0; e < 8; ++e) { a[e] += cw[i * 1024 + ch + e] * (float)x0[e]; a[8 + e] += cw[i * 1024 + ch + 8 + e] * (float)x1[e]; } }
            u32x4 o0, o1; o0.x = pkh(siluf_(a[0]), siluf_(a[1])); o0.y = pkh(siluf_(a[2]), siluf_(a[3])); o0.z = pkh(siluf_(a[4]), siluf_(a[5])); o0.w = pkh(siluf_(a[6]), siluf_(a[7]));
            o1.x = pkh(siluf_(a[8]), siluf_(a[9])); o1.y = pkh(siluf_(a[10]), siluf_(a[11])); o1.z = pkh(siluf_(a[12]), siluf_(a[13])); o1.w = pkh(siluf_(a[14]), siluf_(a[15]));
            h16* dst = C.XBCC + (size_t)m * 1024 + ch; *(u32x4*)dst = o0; *(u32x4*)(dst + 8) = o1; }
        if (lane < 8) C.DTV[(size_t)m * 8 + lane] = softplusf_(C.PSM[(size_t)m * PSM_W + 28 + lane] + dtb[lane]);
    }
}

__device__ __forceinline__ float gelu_tanh(float x) { const float u = 0.7978845608028654f * (x + 0.044715f * x * x * x); const float e = __expf(2.f * u); const float th = 1.f - 2.f / (e + 1.f); return 0.5f * x * (1.f + th); }
__device__ __forceinline__ void nsa_compress_unit(const Ctx& C, int l, int u) {
    const int kv = u >> 8, b = (u >> 6) & 3, g = (u >> 5) & 1, mt = u & 31;
    TIDS
    const int w = wave, cc = lane & 15, quad = lane >> 4;
    h16* Hs = (h16*)g_lds;
    const int n = mt * 16 + cc;
    const h16* W1T = C.W1T + (size_t)(l * 2 + kv) * 128 * 2048; const h16* W2T = C.W2T + (size_t)(l * 2 + kv) * 64 * 128; const float* B1 = C.B1 + (l * 2 + kv) * 128;
    const int col = (kv ? C_VCMP : C_KCMP) + g * 64 + quad * 8;
    f32x4 acc = {0.f, 0.f, 0.f, 0.f};
    const h16* brow = W1T + (size_t)(w * 16 + cc) * 2048 + quad * 8;
#pragma unroll 4
    for (int kk = 0; kk < 64; ++kk) {
        int tok = 16 * n + (kk >> 1); tok = tok < SEQ ? tok : SEQ - 1;
        const h16x8 a = *(const h16x8*)(C.PROJ + (size_t)(b * SEQ + tok) * PN + col + (kk & 1) * 32);
        const h16x8 bb = *(const h16x8*)(brow + kk * 32);
        acc = mfma16(a, bb, acc);
    }
    { const float bias = B1[w * 16 + cc];
#pragma unroll
        for (int j = 0; j < 4; ++j) Hs[(quad * 4 + j) * 136 + w * 16 + cc] = (h16)gelu_tanh(acc[j] + bias); }
    __syncthreads();
    if (w < 4) {
        f32x4 o = {0.f, 0.f, 0.f, 0.f};
#pragma unroll
        for (int kk = 0; kk < 4; ++kk) { const h16x8 a = *(const h16x8*)(Hs + cc * 136 + kk * 32 + quad * 8); const h16x8 bb = *(const h16x8*)(W2T + (size_t)(w * 16 + cc) * 128 + kk * 32 + quad * 8); o = mfma16(a, bb, o); }
        h16* dst = (kv ? C.VC : C.KC) + (size_t)((b * 2 + g) * 512 + mt * 16) * 64;
#pragma unroll
        for (int j = 0; j < 4; ++j) dst[(quad * 4 + j) * 64 + w * 16 + cc] = (h16)o[j];
    }
    __syncthreads();
}

__device__ __forceinline__ h16x4 tr_read(const h16* p) { typedef short s16x4 __attribute__((ext_vector_type(4))); return __builtin_bit_cast(h16x4, __builtin_amdgcn_ds_read_tr16_b64_v4i16((LAS s16x4*)p)); }
__device__ __forceinline__ h16x8 cat44(h16x4 lo, h16x4 hi) { return (h16x8){lo[0], lo[1], lo[2], lo[3], hi[0], hi[1], hi[2], hi[3]}; }
struct SsdPre { float dt; h16x8 x[2]; h16x8 bq[4]; };
__device__ __forceinline__ void ssd_states_load(const Ctx& C, int u, int tid, SsdPre& P) {
    const int b = u >> 9, c = (u >> 3) & 63, h = u & 7, g = h >> 2; const size_t row0 = (size_t)b * SEQ + c * 128;
    P.dt = (tid < 128) ? C.DTV[(row0 + tid) * 8 + h] : 0.f;
#pragma unroll
    for (int i = 0; i < 2; ++i) { const int ch = tid + 512 * i, tok = ch >> 3, c8 = ch & 7; P.x[i] = *(const h16x8*)(C.XBCC + (row0 + tok) * 1024 + h * 64 + c8 * 8); }
#pragma unroll
    for (int i = 0; i < 4; ++i) { const int ch = tid + 512 * i, tok = ch >> 4, c16 = ch & 15; P.bq[i] = *(const h16x8*)(C.XBCC + (row0 + tok) * 1024 + 512 + g * 128 + c16 * 8); }
}
__device__ __forceinline__ void ssd_states_phase(const Ctx& C, int l, int ufirst, int ustep) {
    TIDS
    const int w = wave, cc = lane & 15, quad = lane >> 4;
    float* acs = (float*)g_lds; float* dtl = acs + 128; float* wl = acs + 256;
    h16* Xs = (h16*)(g_lds + 2048);
    h16* Bs = (h16*)(g_lds + 2048 + 18432);
    int u = ufirst; SsdPre pre; if (u < 2048) ssd_states_load(C, u, tid, pre);
    while (u < 2048) {
        const int b = u >> 9, c = (u >> 3) & 63, h = u & 7; const size_t row0 = (size_t)b * SEQ + c * 128;
        const SsdPre cur = pre;
        const float A = -__expf(C.in[16][l * 8 + h]);
        if (tid < 128) dtl[tid] = cur.dt;
        __syncthreads();
        if (w == 0) {
            const float d0 = dtl[2 * lane], d1 = dtl[2 * lane + 1]; const float a0 = d0 * A, a1 = d1 * A, sm = a0 + a1; float incl = sm;
#pragma unroll
            for (int o = 1; o < 64; o <<= 1) { const float t = __shfl_up(incl, o); if (lane >= o) incl += t; }
            const float excl = incl - sm, tot = __shfl(incl, 63); const float c0 = excl + a0, c1 = incl;
            acs[2 * lane] = c0; acs[2 * lane + 1] = c1; wl[2 * lane] = __expf(tot - c0) * d0; wl[2 * lane + 1] = __expf(tot - c1) * d1;
            if (lane == 63) C.CD[(b * 64 + c) * 8 + h] = __expf(tot);
        }
        __syncthreads();
#pragma unroll
        for (int i = 0; i < 2; ++i) { const int ch = tid + 512 * i, tok = ch >> 3, c8 = ch & 7; *(h16x8*)(Xs + tok * 72 + c8 * 8) = cur.x[i]; }
#pragma unroll
        for (int i = 0; i < 4; ++i) { const int ch = tid + 512 * i, tok = ch >> 4, c16 = ch & 15; const float ww = wl[tok]; h16x8 o;
#pragma unroll
            for (int e = 0; e < 8; ++e) o[e] = (h16)((float)cur.bq[i][e] * ww);
            *(h16x8*)(Bs + tok * 136 + c16 * 8) = o; }
        if (tid < 128) C.ACS[(row0 + tid) * 8 + h] = acs[tid];
        const int un = u + ustep; if (un < 2048) ssd_states_load(C, un, tid, pre);
        __syncthreads();
        const int mi = w & 3;
        h16x8 xa[4];
#pragma unroll
        for (int kk = 0; kk < 4; ++kk) { const h16* xp = Xs + (kk * 32 + 8 * quad + (cc >> 2)) * 72 + mi * 16 + 4 * (cc & 3); xa[kk] = cat44(tr_read(xp), tr_read(xp + 4 * 72)); }
        float* dst = C.SSDST + (size_t)((b * 64 + c) * 8 + h) * 8192;
#pragma unroll
        for (int q = 0; q < 4; ++q) { const int ni = (w >> 2) * 4 + q; f32x4 acc = {0.f, 0.f, 0.f, 0.f};
#pragma unroll
            for (int kk = 0; kk < 4; ++kk) { const h16* bp = Bs + (kk * 32 + 8 * quad + (cc >> 2)) * 136 + ni * 16 + 4 * (cc & 3); acc = mfma16(xa[kk], cat44(tr_read(bp), tr_read(bp + 4 * 136)), acc); }
#pragma unroll
            for (int j = 0; j < 4; ++j) dst[(mi * 16 + quad * 4 + j) * 128 + ni * 16 + cc] = acc[j]; }
        u = un;
    }
    __syncthreads();
}

struct SsdYPre { float acs, dt; h16x8 cq[4], bq[4], x[2], z[2]; f32x4 he[4]; };
__device__ __forceinline__ void ssd_y_load(const Ctx& C, int u, int tid, SsdYPre& P) {
    const int b = u >> 9, c = (u >> 3) & 63, h = u & 7, g = h >> 2; const size_t row0 = (size_t)b * SEQ + c * 128;
    P.acs = (tid < 128) ? C.ACS[(row0 + tid) * 8 + h] : 0.f; P.dt = (tid < 128) ? C.DTV[(row0 + tid) * 8 + h] : 0.f;
#pragma unroll
    for (int i = 0; i < 4; ++i) { const int ch = tid + 512 * i, tok = ch >> 4, c16 = ch & 15; const h16* src = C.XBCC + (row0 + tok) * 1024 + 512 + g * 128 + c16 * 8; P.bq[i] = *(const h16x8*)src; P.cq[i] = *(const h16x8*)(src + 256); }
#pragma unroll
    for (int i = 0; i < 2; ++i) { const int ch = tid + 512 * i, tok = ch >> 3, c8 = ch & 7; P.x[i] = *(const h16x8*)(C.XBCC + (row0 + tok) * 1024 + h * 64 + c8 * 8); P.z[i] = *(const h16x8*)(C.PROJ + (row0 + tok) * PN + C_SZ + h * 64 + c8 * 8); }
    const float* src = C.SSDST + (size_t)((b * 64 + c) * 8 + h) * 8192;
#pragma unroll
    for (int i = 0; i < 4; ++i) P.he[i] = *(const f32x4*)(src + (tid + 512 * i) * 4);
}
__device__ __forceinline__ void ssd_y_phase(const Ctx& C, int l, int ufirst, int ustep) {
    TIDS
    const int w = wave, cc = lane & 15, quad = lane >> 4;
    float* acs = (float*)g_lds; float* dtl = acs + 128;
    h16* Cm = (h16*)(g_lds + 1024);
    h16* Bm = (h16*)(g_lds + 1024 + 34816);
    h16* Xs = (h16*)(g_lds + 1024 + 2 * 34816);
    h16* HE = (h16*)(g_lds + 1024 + 2 * 34816 + 18432);
    h16* Zs = (h16*)(g_lds + 1024 + 2 * 34816 + 18432 + 17408);
    int u = ufirst; SsdYPre pre; if (u < 2048) ssd_y_load(C, u, tid, pre);
    while (u < 2048) {
        const int b = u >> 9, c = (u >> 3) & 63, h = u & 7; const size_t row0 = (size_t)b * SEQ + c * 128;
        __syncthreads();
        if (tid < 128) { acs[tid] = pre.acs; dtl[tid] = pre.dt; }
#pragma unroll
        for (int i = 0; i < 4; ++i) { const int ch = tid + 512 * i, tok = ch >> 4, c16 = ch & 15; *(h16x8*)(Bm + tok * 136 + c16 * 8) = pre.bq[i]; *(h16x8*)(Cm + tok * 136 + c16 * 8) = pre.cq[i]; }
#pragma unroll
        for (int i = 0; i < 2; ++i) { const int ch = tid + 512 * i, tok = ch >> 3, c8 = ch & 7; *(h16x8*)(Xs + tok * 72 + c8 * 8) = pre.x[i]; *(h16x8*)(Zs + tok * 72 + c8 * 8) = pre.z[i]; }
#pragma unroll
        for (int i = 0; i < 4; ++i) { const int e4 = tid + 512 * i, p = e4 >> 5, n4 = e4 & 31; const f32x4 v = pre.he[i]; h16x4 o = {(h16)v.x, (h16)v.y, (h16)v.z, (h16)v.w}; *(h16x4*)(HE + p * 136 + n4 * 4) = o; }
        const int un = u + ustep; if (un < 2048) ssd_y_load(C, un, tid, pre);
        __syncthreads();
        f32x4 cbt[8];
        { h16x8 ca[4];
#pragma unroll
            for (int kk = 0; kk < 4; ++kk) ca[kk] = *(const h16x8*)(Cm + (w * 16 + cc) * 136 + kk * 32 + quad * 8);
#pragma unroll
            for (int ni = 0; ni < 8; ++ni) { f32x4 acc = {0.f, 0.f, 0.f, 0.f};
#pragma unroll
                for (int kk = 0; kk < 4; ++kk) { const h16x8 bb = *(const h16x8*)(Bm + (ni * 16 + cc) * 136 + kk * 32 + quad * 8); acc = mfma16(ca[kk], bb, acc); }
                cbt[ni] = acc; }
            __syncthreads();
#pragma unroll
            for (int ni = 0; ni < 8; ++ni) { const int sidx = ni * 16 + cc; const float as_ = acs[sidx], ds_ = dtl[sidx];
#pragma unroll
                for (int j = 0; j < 4; ++j) { const int lr = w * 16 + quad * 4 + j; const float v = (sidx <= lr) ? cbt[ni][j] * __expf(acs[lr] - as_) * ds_ : 0.f; Bm[lr * 136 + sidx] = (h16)v; } }
            __syncthreads();
            const float Dh = C.in[17][l * 8 + h];
            float ssq[4] = {0.f, 0.f, 0.f, 0.f};
            h16x8 ma[4];
#pragma unroll
            for (int kk = 0; kk < 4; ++kk) ma[kk] = *(const h16x8*)(Bm + (w * 16 + cc) * 136 + kk * 32 + quad * 8);
            float ea[4];
#pragma unroll
            for (int j = 0; j < 4; ++j) ea[j] = __expf(acs[w * 16 + quad * 4 + j]);
#pragma unroll
            for (int ni = 0; ni < 4; ++ni) { f32x4 acc = {0.f, 0.f, 0.f, 0.f};
#pragma unroll
                for (int kk = 0; kk < 4; ++kk) { const h16x8 bb = *(const h16x8*)(HE + (ni * 16 + cc) * 136 + kk * 32 + quad * 8); acc = mfma16(ca[kk], bb, acc); }
#pragma unroll
                for (int j = 0; j < 4; ++j) acc[j] *= ea[j];
#pragma unroll
                for (int kk = 0; kk < 4; ++kk) { const h16* xp = Xs + (kk * 32 + 8 * quad + (cc >> 2)) * 72 + ni * 16 + 4 * (cc & 3); acc = mfma16(ma[kk], cat44(tr_read(xp), tr_read(xp + 4 * 72)), acc); }
                const int p = ni * 16 + cc;
#pragma unroll
                for (int j = 0; j < 4; ++j) { const int lr = w * 16 + quad * 4 + j; const float x = (float)Xs[lr * 72 + p]; const float z = (float)Zs[lr * 72 + p];
                    const h16 yh = (h16)((acc[j] + Dh * x) * siluf_(z)); Zs[lr * 72 + p] = yh; const float yr = (float)yh; ssq[j] += yr * yr; } }
#pragma unroll
            for (int j = 0; j < 4; ++j) { float sv = ssq[j]; sv += __shfl_xor(sv, 1); sv += __shfl_xor(sv, 2); sv += __shfl_xor(sv, 4); sv += __shfl_xor(sv, 8);
                if (cc == 0) C.SSQ[(row0 + w * 16 + quad * 4 + j) * 8 + h] = sv; }
        }
        __syncthreads();
#pragma unroll
        for (int i = 0; i < 2; ++i) { const int ch = tid + 512 * i, tok = ch >> 3, c8 = ch & 7; *(h16x8*)(C.XN + (row0 + tok) * 1024 + 512 + h * 64 + c8 * 8) = *(const h16x8*)(Zs + tok * 72 + c8 * 8); }
        u = un;
    }
    __syncthreads();
}

template <int PASS>
__device__ __forceinline__ void gla_block_unit(const Ctx& C, int l, int bu) {
    TIDS
    const int w = wave; const int wu = bu * 8 + w;
    const int bh = wu >> 7, seg = wu & 127, b = bh >> 2, h = bh & 3;
    const size_t row0 = (size_t)b * SEQ + seg * 64;
    float* as_ = (float*)(g_lds + w * 10240); float* qs = as_ + 512; float* ks = as_ + 1024;
    h16* vs = (h16*)(as_ + 1536); h16* rs_ = vs + 1024;
    const int tl = lane & 15, kq = lane >> 4;
    const float* w2 = C.in[3] + (size_t)l * 16 * 128 + h * 32 + kq * 8; const float* gb = C.in[4] + l * 128 + h * 32 + kq * 8;
    float S[32];
    float* gst = C.GLAST + (size_t)(bh * 128 + seg) * 2048;
    if (PASS == 1) {
#pragma unroll
        for (int kk = 0; kk < 32; ++kk) S[kk] = gst[kk * 64 + lane];
    } else {
#pragma unroll
        for (int kk = 0; kk < 32; ++kk) S[kk] = 0.f;
    }
    float gtot = 1.f;
    const float gnw = C.in[5][l * 256 + h * 64 + lane];
#pragma unroll 1
    for (int qt = 0; qt < 4; ++qt) {
        const size_t rowh = row0 + qt * 16;
        const size_t rowt = rowh + tl;
        f32x4 gl[4];
#pragma unroll
        for (int i = 0; i < 4; ++i) gl[i] = *(const f32x4*)(C.PSM + rowt * PSM_W + 4 * i);
        const h16x8 q0 = *(const h16x8*)(C.PROJ + rowt * PN + C_GQ + h * 32 + kq * 8);
        const h16x8 k0 = *(const h16x8*)(C.PROJ + rowt * PN + C_GK + h * 32 + kq * 8);
        h16x8 vx[2], rx[2];
#pragma unroll
        for (int i = 0; i < 2; ++i) { const int ch = lane + 64 * i, t = ch >> 3, c8 = ch & 7; vx[i] = *(const h16x8*)(C.PROJ + (rowh + t) * PN + C_GV + h * 64 + c8 * 8);
            if (PASS == 1) rx[i] = *(const h16x8*)(C.PROJ + (rowh + t) * PN + C_GR + h * 64 + c8 * 8); }
        float z[8];
#pragma unroll
        for (int k = 0; k < 8; ++k) z[k] = gb[k];
#pragma unroll
        for (int r = 0; r < 16; ++r) { const float gv = gl[r >> 2][r & 3];
#pragma unroll
            for (int k = 0; k < 8; ++k) z[k] += gv * w2[r * 128 + k]; }
        asm volatile("" ::: "memory");
#pragma unroll
        for (int k4 = 0; k4 < 2; ++k4) { f32x4 av, qv, kv;
#pragma unroll
            for (int e = 0; e < 4; ++e) { const int k = 4 * k4 + e; av[e] = ex2(-0.0625f * __builtin_amdgcn_logf(1.f + ex2(-1.4426950408889634f * z[k])));
                qv[e] = (float)q0[k] * 0.17677669529663687f; kv[e] = (float)k0[k]; }
            *(f32x4*)(as_ + tl * 32 + kq * 8 + 4 * k4) = av; *(f32x4*)(qs + tl * 32 + kq * 8 + 4 * k4) = qv; *(f32x4*)(ks + tl * 32 + kq * 8 + 4 * k4) = kv; }
#pragma unroll
        for (int i = 0; i < 2; ++i) { const int ch = lane + 64 * i; *(h16x8*)(vs + ch * 8) = vx[i]; if (PASS == 1) *(h16x8*)(rs_ + ch * 8) = rx[i]; }
        asm volatile("s_waitcnt lgkmcnt(0)" ::: "memory");
        if (PASS == 0) { if (lane < 32) { float p = 1.f;
#pragma unroll
                for (int t = 0; t < 16; ++t) p *= as_[t * 32 + lane];
                gtot *= p; } }
#pragma unroll 2
        for (int tok = 0; tok < 16; ++tok) { const float v = (float)vs[tok * 64 + lane]; float acc = 0.f;
#pragma unroll
            for (int k4 = 0; k4 < 8; ++k4) { const f32x4 a4 = *(const f32x4*)(as_ + tok * 32 + 4 * k4), kk4 = *(const f32x4*)(ks + tok * 32 + 4 * k4);
#pragma unroll
                for (int e = 0; e < 4; ++e) S[4 * k4 + e] = a4[e] * S[4 * k4 + e] + kk4[e] * v;
                if (PASS == 1) { const f32x4 q4 = *(const f32x4*)(qs + tok * 32 + 4 * k4);
#pragma unroll
                    for (int e = 0; e < 4; ++e) acc += q4[e] * S[4 * k4 + e]; } }
            if (PASS == 1) { const float ssq = wave_sum(acc * acc); const float rs = 1.0f / sqrtf(ssq * (1.f / 64.f) + EPS);
                C.XN[(rowh + tok) * 1024 + h * 64 + lane] = (h16)(acc * rs * gnw * siluf_((float)rs_[tok * 64 + lane])); } }
    }
    if (PASS == 0) {
#pragma unroll
        for (int kk = 0; kk < 32; ++kk) gst[kk * 64 + lane] = S[kk];
        if (lane < 32) C.GLAG[(size_t)(bh * 128 + seg) * 32 + lane] = gtot;
    }
}

__device__ __forceinline__ void phase_scans(const Ctx& C) {
    TIDS
    for (int e = C.bid * 512 + tid; e < BATCH * 8 * 8192; e += C.G * 512) {
        const int bh = e >> 13, b = bh >> 3, h = bh & 7, pn = e & 8191;
        float* p = C.SSDST + (size_t)(b * 64 * 8 + h) * 8192 + pn; const float* cd = C.CD + b * 64 * 8 + h;
        float st = 0.f;
        for (int c0 = 0; c0 < 64; c0 += 8) { float v[8], d[8];
#pragma unroll
            for (int i = 0; i < 8; ++i) { v[i] = p[(size_t)(c0 + i) * 8 * 8192]; d[i] = cd[(c0 + i) * 8]; }
#pragma unroll
            for (int i = 0; i < 8; ++i) { p[(size_t)(c0 + i) * 8 * 8192] = st; st = d[i] * st + v[i]; } }
    }
    for (int e = C.bid * 512 + tid; e < 16 * 2048; e += C.G * 512) {
        const int bh = e >> 11, kv = e & 2047, k = kv >> 6;
        float* p = C.GLAST + (size_t)bh * 128 * 2048 + kv; const float* gg = C.GLAG + (size_t)bh * 128 * 32 + k;
        float st = 0.f;
        for (int s0 = 0; s0 < 128; s0 += 8) { float v[8], d[8];
#pragma unroll
            for (int i = 0; i < 8; ++i) { v[i] = p[(size_t)(s0 + i) * 2048]; d[i] = gg[(s0 + i) * 32]; }
#pragma unroll
            for (int i = 0; i < 8; ++i) { p[(size_t)(s0 + i) * 2048] = st; st = d[i] * st + v[i]; } }
    }
}

struct FlashState { float m, l; f32x4 O[4]; };
constexpr int KV_LD = 72, KV_TILE = 64 * KV_LD;
__device__ __forceinline__ void qk_tile(f32x4 (&s)[4], const h16* Ks, const h16x8 (&qf)[2], int cc, int quad) {
#pragma unroll
    for (int mt = 0; mt < 4; ++mt) { f32x4 a = {0.f, 0.f, 0.f, 0.f};
#pragma unroll
        for (int ks = 0; ks < 2; ++ks) { const h16x8 kf = *(const h16x8*)(Ks + (mt * 16 + cc) * KV_LD + ks * 32 + quad * 8); a = mfma16(kf, qf[ks], a); }
        s[mt] = a; }
}
__device__ __forceinline__ void pv_tile(f32x4 (&O)[4], const h16* Vs, const f32x4 (&p)[4], int cc, int quad) {
    h16x8 pf[2];
#pragma unroll
    for (int k2 = 0; k2 < 2; ++k2) pf[k2] = (h16x8){(h16)p[2 * k2][0], (h16)p[2 * k2][1], (h16)p[2 * k2][2], (h16)p[2 * k2][3], (h16)p[2 * k2 + 1][0], (h16)p[2 * k2 + 1][1], (h16)p[2 * k2 + 1][2], (h16)p[2 * k2 + 1][3]};
#pragma unroll
    for (int md = 0; md < 4; ++md)
#pragma unroll
        for (int k2 = 0; k2 < 2; ++k2) { const h16* vp = Vs + (32 * k2 + 4 * quad + (cc >> 2)) * KV_LD + md * 16 + 4 * (cc & 3);
            const h16x4 lo = tr_read(vp), hi = tr_read(vp + 16 * KV_LD);
            const h16x8 vf = {lo[0], lo[1], lo[2], lo[3], hi[0], hi[1], hi[2], hi[3]}; O[md] = mfma16(vf, pf[k2], O[md]); }
}
template <int MODE>
__device__ __forceinline__ void flash_tile(FlashState& st, const h16* Ks, const h16* Vs, const h16x8 (&qf)[2], int kv0, int tq, bool selbit, int cc, int quad) {
    f32x4 s[4]; qk_tile(s, Ks, qf, cc, quad);
    float tmax = -INFINITY;
#pragma unroll
    for (int mt = 0; mt < 4; ++mt)
#pragma unroll
        for (int j = 0; j < 4; ++j) { const int kp = kv0 + mt * 16 + quad * 4 + j;
            const bool ok = (MODE == 0) ? (selbit && kp <= tq) : (kp <= tq && kp > tq - 512);
            const float v = ok ? s[mt][j] : -INFINITY; s[mt][j] = v; tmax = fmaxf(tmax, v); }
    tmax = fmaxf(tmax, __shfl_xor(tmax, 16)); tmax = fmaxf(tmax, __shfl_xor(tmax, 32));
    const float mnew = fmaxf(st.m, tmax); const float muse = (mnew == -INFINITY) ? 0.f : mnew;
    const float alpha = ex2(st.m - muse);
    float psum = 0.f;
#pragma unroll
    for (int mt = 0; mt < 4; ++mt)
#pragma unroll
        for (int j = 0; j < 4; ++j) { const float p = ex2(s[mt][j] - muse); s[mt][j] = p; psum += p; }
    st.l = st.l * alpha + psum; st.m = mnew;
#pragma unroll
    for (int md = 0; md < 4; ++md) st.O[md] *= alpha;
    pv_tile(st.O, Vs, s, cc, quad);
}
template <bool NEEDV, class SrcFn, class CompFn>
__device__ __forceinline__ void kv_pipeline(int n, int tid, h16* Kb, h16* Vb, SrcFn src, CompFn comp) {
    if (n <= 0) return;
    const int key = tid >> 3, c8 = tid & 7; const int loff = key * KV_LD + c8 * 8;
    h16x8 kr, vr = {};
    { const h16 *kp, *vp; size_t stride; src(0, kp, vp, stride); kr = *(const h16x8*)(kp + (size_t)key * stride + c8 * 8); if (NEEDV) vr = *(const h16x8*)(vp + (size_t)key * stride + c8 * 8); }
    *(h16x8*)(Kb + loff) = kr; if (NEEDV) *(h16x8*)(Vb + loff) = vr;
    __syncthreads();
    for (int i = 0; i < n; ++i) {
        const int cur = i & 1; const bool more = (i + 1 < n);
        if (more) { const h16 *kp, *vp; size_t stride; src(i + 1, kp, vp, stride); kr = *(const h16x8*)(kp + (size_t)key * stride + c8 * 8); if (NEEDV) vr = *(const h16x8*)(vp + (size_t)key * stride + c8 * 8); }
        comp(i, Kb + cur * KV_TILE, Vb + cur * KV_TILE);
        if (more) { *(h16x8*)(Kb + (cur ^ 1) * KV_TILE + loff) = kr; if (NEEDV) *(h16x8*)(Vb + (cur ^ 1) * KV_TILE + loff) = vr; }
        __syncthreads();
    }
}
__device__ __forceinline__ void nsa_attn_unit(const Ctx& C, int l, int b, int g, int qb) {
    TIDS
    const int w = wave, cc = lane & 15, quad = lane >> 4;
    const int r = cc >> 3, ti = cc & 7, tloc = 8 * w + ti, tq = 64 * qb + tloc, h = 2 * g + r;
    const size_t rowq = (size_t)b * SEQ + tq;
    h16* Kb = (h16*)g_lds; h16* Vb = (h16*)(g_lds + 2 * KV_TILE * 2);
    float* imp = (float*)(g_lds + 36864);
    unsigned* sel = (unsigned*)(g_lds + 36864 + 32768);
    unsigned* uni = sel + 256;
    unsigned char* lst = (unsigned char*)(uni + 8);
    h16x8 qf[2];
#pragma unroll
    for (int ks = 0; ks < 2; ++ks) qf[ks] = *(const h16x8*)(C.PROJ + rowq * PN + C_NQ + h * 64 + ks * 32 + quad * 8);
    const h16* kcb = C.KC + (size_t)(b * 2 + g) * 512 * 64; const h16* vcb = C.VC + (size_t)(b * 2 + g) * 512 * 64;
    const int ncmp = 4 * qb + 3, ntile_c = (ncmp + 63) >> 6;
    auto src_cmp = [&](int i, const h16*& kp, const h16*& vp, size_t& stride) { kp = kcb + (size_t)i * 64 * 64; vp = vcb + (size_t)i * 64 * 64; stride = 64; };
    float m1 = -INFINITY, l1 = 0.f;
    kv_pipeline<false>(ntile_c, tid, Kb, Vb, src_cmp, [&](int tc, const h16* Ks, const h16*) {
        f32x4 s[4]; qk_tile(s, Ks, qf, cc, quad); float tmax = -INFINITY;
#pragma unroll
        for (int mt = 0; mt < 4; ++mt)
#pragma unroll
            for (int j = 0; j < 4; ++j) { const int n = tc * 64 + mt * 16 + quad * 4 + j; const float v = (16 * n + 31 <= tq) ? s[mt][j] : -INFINITY; s[mt][j] = v; tmax = fmaxf(tmax, v); }
        tmax = fmaxf(tmax, __shfl_xor(tmax, 16)); tmax = fmaxf(tmax, __shfl_xor(tmax, 32));
        const float mnew = fmaxf(m1, tmax), muse = (mnew == -INFINITY) ? 0.f : mnew;
        float ps = 0.f;
#pragma unroll
        for (int mt = 0; mt < 4; ++mt)
#pragma unroll
            for (int j = 0; j < 4; ++j) ps += ex2(s[mt][j] - muse);
        l1 = l1 * ex2(m1 - muse) + ps; m1 = mnew; });
    l1 += __shfl_xor(l1, 16); l1 += __shfl_xor(l1, 32);
    const float inv1 = (l1 > 0.f) ? 1.f / l1 : 0.f; const float m1u = (m1 == -INFINITY) ? 0.f : m1;
    f32x4 Oc[4];
#pragma unroll
    for (int md = 0; md < 4; ++md) Oc[md] = (f32x4){0.f, 0.f, 0.f, 0.f};
    float carry_q3 = 0.f;
    kv_pipeline<true>(ntile_c, tid, Kb, Vb, src_cmp, [&](int tc, const h16* Ks, const h16* Vs) {
        f32x4 s[4]; qk_tile(s, Ks, qf, cc, quad);
#pragma unroll
        for (int mt = 0; mt < 4; ++mt) { f32x4 a = s[mt];
#pragma unroll
            for (int j = 0; j < 4; ++j) { const int n = tc * 64 + mt * 16 + quad * 4 + j; a[j] = (16 * n + 31 <= tq) ? ex2(a[j] - m1u) * inv1 : 0.f; }
            s[mt] = a;
            const float s4 = (a[0] + a[1]) + (a[2] + a[3]); const float p3 = a[3];
            const float fromprev = __shfl(p3, (lane + 48) & 63);
            const float fromq3 = __shfl(p3, cc + 48);
            float val = s4 + ((quad == 0) ? carry_q3 : fromprev);
            carry_q3 = fromq3;
            val += __shfl_xor(val, 8);
            if (r == 0) imp[tloc * 128 + tc * 16 + mt * 4 + quad] = val; }
        pv_tile(Oc, Vs, s, cc, quad); });
    if (qb < 16) {
        if (tid < 64) { const unsigned mlo = (2u << qb) - 1u; sel[tid * 4 + 0] = mlo; sel[tid * 4 + 1] = 0u; sel[tid * 4 + 2] = 0u; sel[tid * 4 + 3] = 0u; }
    } else {
        const int jhi = qb - 2;
        const unsigned long long lt = __lanemask_lt();
        for (int t8 = 0; t8 < 8; ++t8) { const int row = 8 * w + t8; const float* ir = imp + row * 128;
            const int j1 = lane, j2 = lane + 64; const bool ok1 = (j1 >= 1 && j1 <= jhi), ok2 = (j2 <= jhi);
            const unsigned u1 = ok1 ? __float_as_uint(ir[j1]) + 1u : 0u, u2 = ok2 ? __float_as_uint(ir[j2]) + 1u : 0u;
            unsigned prefix = 0u;
            for (int bit = 30; bit >= 0; --bit) { const unsigned test = prefix | (1u << bit);
                const int cnt = __popcll(__ballot(u1 >= test)) + __popcll(__ballot(u2 >= test)); if (cnt >= 13) prefix = test; }
            const bool gt1 = u1 > prefix, gt2 = u2 > prefix, eq1 = u1 == prefix, eq2 = u2 == prefix;
            const unsigned long long bg1 = __ballot(gt1), bg2 = __ballot(gt2), be1 = __ballot(eq1), be2 = __ballot(eq2);
            const int need = 13 - __popcll(bg1) - __popcll(bg2);
            const bool s1 = gt1 || (eq1 && __popcll(be1 & lt) < need), s2 = gt2 || (eq2 && (__popcll(be1) + __popcll(be2 & lt)) < need);
            unsigned long long blo = __ballot(s1) | 1ull, bhi = __ballot(s2);
            { const int f0 = qb - 1, f1 = qb; if (f0 < 64) blo |= 1ull << f0; else bhi |= 1ull << (f0 - 64); if (f1 < 64) blo |= 1ull << f1; else bhi |= 1ull << (f1 - 64); }
            if (lane == 0) { sel[row * 4 + 0] = (unsigned)blo; sel[row * 4 + 1] = (unsigned)(blo >> 32); sel[row * 4 + 2] = (unsigned)bhi; sel[row * 4 + 3] = (unsigned)(bhi >> 32); } }
    }
    __syncthreads();
    if (w == 0) {
        unsigned o0 = sel[lane * 4 + 0], o1 = sel[lane * 4 + 1], o2 = sel[lane * 4 + 2], o3 = sel[lane * 4 + 3];
#pragma unroll
        for (int sft = 1; sft < 64; sft <<= 1) { o0 |= __shfl_xor(o0, sft); o1 |= __shfl_xor(o1, sft); o2 |= __shfl_xor(o2, sft); o3 |= __shfl_xor(o3, sft); }
        const unsigned long long mlo = ((unsigned long long)o1 << 32) | o0, mhi = ((unsigned long long)o3 << 32) | o2;
        const unsigned long long lt = __lanemask_lt(); const int nlo = __popcll(mlo);
        if ((mlo >> lane) & 1ull) lst[__popcll(mlo & lt)] = (unsigned char)lane;
        if ((mhi >> lane) & 1ull) lst[nlo + __popcll(mhi & lt)] = (unsigned char)(64 + lane);
        if (lane == 0) uni[4] = (unsigned)(nlo + __popcll(mhi));
    }
    __syncthreads();
    const unsigned long long selLo = ((unsigned long long)sel[tloc * 4 + 1] << 32) | sel[tloc * 4 + 0], selHi = ((unsigned long long)sel[tloc * 4 + 3] << 32) | sel[tloc * 4 + 2];
    const int nlist = (int)uni[4];
    FlashState fs; fs.m = -INFINITY; fs.l = 0.f;
#pragma unroll
    for (int md = 0; md < 4; ++md) fs.O[md] = (f32x4){0.f, 0.f, 0.f, 0.f};
    const h16* kslc = C.PROJ + (size_t)b * SEQ * PN + C_KSLC + g * 64; const h16* vslc = C.PROJ + (size_t)b * SEQ * PN + C_VSLC + g * 64;
    kv_pipeline<true>(nlist, tid, Kb, Vb,
        [&](int i, const h16*& kp, const h16*& vp, size_t& stride) { const int j = lst[i]; kp = kslc + (size_t)j * 64 * PN; vp = vslc + (size_t)j * 64 * PN; stride = PN; },
        [&](int i, const h16* Ks, const h16* Vs) { const int j = lst[i];
            const unsigned long long sw = (j < 64) ? selLo : selHi; const bool sb = ((sw >> (j & 63)) & 1ull) != 0ull;
            if (__any(sb)) flash_tile<0>(fs, Ks, Vs, qf, j * 64, tq, sb, cc, quad); });
    float ls = fs.l; ls += __shfl_xor(ls, 16); ls += __shfl_xor(ls, 32); const float invs = (ls > 0.f) ? 1.f / ls : 0.f;
    f32x4 Os[4];
#pragma unroll
    for (int md = 0; md < 4; ++md) Os[md] = fs.O[md] * invs;
    fs.m = -INFINITY; fs.l = 0.f;
#pragma unroll
    for (int md = 0; md < 4; ++md) fs.O[md] = (f32x4){0.f, 0.f, 0.f, 0.f};
    const h16* kwin = C.PROJ + (size_t)b * SEQ * PN + C_KWIN + g * 64; const h16* vwin = C.PROJ + (size_t)b * SEQ * PN + C_VWIN + g * 64;
    const int jw0 = (qb >= 8 ? qb - 8 : 0);
    kv_pipeline<true>(qb - jw0 + 1, tid, Kb, Vb,
        [&](int i, const h16*& kp, const h16*& vp, size_t& stride) { const int j = jw0 + i; kp = kwin + (size_t)j * 64 * PN; vp = vwin + (size_t)j * 64 * PN; stride = PN; },
        [&](int i, const h16* Ks, const h16* Vs) { flash_tile<1>(fs, Ks, Vs, qf, (jw0 + i) * 64, tq, true, cc, quad); });
    float lw = fs.l; lw += __shfl_xor(lw, 16); lw += __shfl_xor(lw, 32); const float invw = (lw > 0.f) ? 1.f / lw : 0.f;
    const float* gp = C.PSM + rowq * PSM_W + 16 + h * 3;
    const float g0 = sigmoidf_(gp[0]), g1 = sigmoidf_(gp[1]), g2 = sigmoidf_(gp[2]) * invw;
    float ssq = 0.f; f32x4 o[4];
#pragma unroll
    for (int md = 0; md < 4; ++md) { o[md] = g0 * Oc[md] + g1 * Os[md] + g2 * fs.O[md]; ssq += (o[md][0] * o[md][0] + o[md][1] * o[md][1]) + (o[md][2] * o[md][2] + o[md][3] * o[md][3]); }
    ssq += __shfl_xor(ssq, 16); ssq += __shfl_xor(ssq, 32);
    const float rs = 1.0f / sqrtf(ssq * (1.f / 64.f) + EPS);
    const float* nw = C.in[12] + l * 256 + h * 64;
#pragma unroll
    for (int md = 0; md < 4; ++md) { const int d = md * 16 + quad * 4; u32x2 wv; wv.x = pkh(o[md][0] * rs * nw[d], o[md][1] * rs * nw[d + 1]); wv.y = pkh(o[md][2] * rs * nw[d + 2], o[md][3] * rs * nw[d + 3]);
        *(u32x2*)(C.XN + rowq * 1024 + 256 + h * 64 + d) = wv; }
}

__device__ __forceinline__ void phase_ssdnorm(const Ctx& C, int l) {
    TIDS
    const int gw = C.bid * 8 + wave, NGW = C.G * 8; const float* nw = C.in[18] + l * 512 + lane * 8;
    for (int m = gw; m < MTOK; m += NGW) { const int g = lane >> 5; const f32x4 q = *(const f32x4*)(C.SSQ + (size_t)m * 8 + g * 4);
        const float rs = 1.0f / sqrtf(((q.x + q.y) + (q.z + q.w)) * (1.f / 256.f) + EPS);
        h16* p = C.XN + (size_t)m * 1024 + 512 + lane * 8; const h16x8 v = *(const h16x8*)p;
        u32x4 o; o.x = pkh((float)v[0] * rs * nw[0], (float)v[1] * rs * nw[1]); o.y = pkh((float)v[2] * rs * nw[2], (float)v[3] * rs * nw[3]);
        o.z = pkh((float)v[4] * rs * nw[4], (float)v[5] * rs * nw[5]); o.w = pkh((float)v[6] * rs * nw[6], (float)v[7] * rs * nw[7]); *(u32x4*)p = o; }
}
__device__ __forceinline__ void phase_norm(const Ctx& C, const float* src, h16* dst) {
    TIDS
    const int gw = C.bid * 8 + wave, NGW = C.G * 8;
    for (int m = gw; m < MTOK; m += NGW) rms_row_to_h16(src + (size_t)m * DM, dst + (size_t)m * DM, lane);
}
__device__ __forceinline__ void phase_final(const Ctx& C) {
    TIDS
    const int gw = C.bid * 8 + wave, NGW = C.G * 8; const f32x4* fw = (const f32x4*)C.in[23] + lane;
    for (int m = gw; m < MTOK; m += NGW) { f32x4* xr = (f32x4*)(C.out + (size_t)m * DM) + lane; f32x4 v[4]; float s = 0.f;
#pragma unroll
        for (int j = 0; j < 4; ++j) { v[j] = xr[64 * j]; s += (v[j].x * v[j].x + v[j].y * v[j].y) + (v[j].z * v[j].z + v[j].w * v[j].w); }
        const float rs = 1.0f / sqrtf(wave_sum(s) * (1.f / DM) + EPS);
#pragma unroll
        for (int j = 0; j < 4; ++j) xr[64 * j] = v[j] * rs * fw[64 * j]; }
}

constexpr int N_PHASES = 1 + 11 * DEPTH;
#ifndef PHM
#define PHM 0xffffffffu
#endif
#define EN(k) ((PHM >> (k)) & 1u)
#ifndef PROBE_PH
#define PROBE_PH -1
#define PROBE_REPS 1
#endif
#define REPN(ph) ((ph) == PROBE_PH ? PROBE_REPS : 1)
template <int ph> __device__ __forceinline__ void run_phase(const Params* kp, int rep) {
    Ctx C; make_ctx(C, kp);
    LAS unsigned char* ldsl = (LAS unsigned char*)g_lds;
    if constexpr (ph == 0) { if (EN(0)) phase_prep(C); return; }
    constexpr int l = (ph - 1) / 11, s = (ph - 1) % 11;
    if (s == 0) { if (EN(1)) { pg8::Gemm g{(const pg8::bf16_t*)C.XN, (const pg8::bf16_t*)(C.WIN + (size_t)l * PN * DM), MTOK, PN, DM}; pg8::StaticOrder S; S.init(MTOK, PN, C.G, C.bid);
        pg8::EpiProj E{C.PROJ, C.PSM}; pg8::gemm_phase<pg8::EpiProj>(ldsl, g, S, E); } }
    else if (s == 1) { if (EN(2)) phase_tok(C, l); }
    else if (s == 2) { if (EN(3)) for (int u = C.bid; u < 512; u += C.G) nsa_compress_unit(C, l, u);
        if (EN(4)) ssd_states_phase(C, l, C.bid, C.G);
        if (EN(5)) for (int u = C.bid; u < 256; u += C.G) gla_block_unit<0>(C, l, u); }
    else if (s == 3) { if (EN(6) && rep == 0) phase_scans(C);
        if (EN(7)) for (int v = C.bid; v < 1024; v += C.G) { const int bg = (v & 255) >> 5, sidx = v & 31, k = v >> 8;
            const int qb = (k == 0) ? sidx : (k == 1) ? 63 - sidx : (k == 2) ? 64 + sidx : 127 - sidx; nsa_attn_unit(C, l, bg >> 1, bg & 1, qb); } }
    else if (s == 4) { if (EN(8)) ssd_y_phase(C, l, C.bid, C.G);
        if (EN(9)) for (int u = C.bid; u < 256; u += C.G) gla_block_unit<1>(C, l, u); }
    else if (s == 5) { if (EN(10)) phase_ssdnorm(C, l); }
    else if (s == 6) { if (EN(11)) { pg8::Gemm g{(const pg8::bf16_t*)C.XN, (const pg8::bf16_t*)(C.WOUT + (size_t)l * DM * DM), MTOK, DM, DM}; pg8::StaticOrder S; S.init(MTOK, DM, C.G, C.bid);
        pg8::EpiRes E{l == 0 ? C.in[0] : C.out, C.out}; pg8::gemm_phase<pg8::EpiRes>(ldsl, g, S, E); } }
    else if (s == 7) { if (EN(12)) phase_norm(C, C.out, C.XN); }
    else if (s == 8) { if (EN(13)) { pg8::Gemm g{(const pg8::bf16_t*)C.XN, (const pg8::bf16_t*)(C.WUP + (size_t)l * DFF * DM), MTOK, DFF, DM}; pg8::StaticOrder S; S.init(MTOK, DFF, C.G, C.bid);
        pg8::EpiHid E{C.HID}; pg8::gemm_phase<pg8::EpiHid>(ldsl, g, S, E); } }
    else if (s == 9) { if (EN(14)) { pg8::Gemm g{(const pg8::bf16_t*)C.HID, (const pg8::bf16_t*)(C.WDN + (size_t)l * DM * DFF), MTOK, DM, DFF}; pg8::StaticOrder S; S.init(MTOK, DM, C.G, C.bid);
        pg8::EpiRes E{C.out, C.out}; pg8::gemm_phase<pg8::EpiRes>(ldsl, g, S, E); } }
    else { if (EN(15)) { if (l + 1 < DEPTH) phase_norm(C, C.out, C.XN); else phase_final(C); } }
}
constexpr int LDS_MISC = 131072;
template <int PH> __device__ __forceinline__ void phase_seq(const Params* kp, int lo, int hi, cg::grid_group& grid, const XcdBarrier& bar) {
    if constexpr (PH < N_PHASES) {
        if (lo <= PH && PH < hi) {
            for (int rep = 0; rep < REPN(PH); ++rep) run_phase<PH>(kp, rep);
            if (PH + 1 < hi) { if (PH == 0) grid.sync(); else xcd_barrier(bar); }
        }
        phase_seq<PH + 1>(kp, lo, hi, grid, bar);
    }
}
__global__ void __launch_bounds__(512, 2) fwd_kernel(Params P) {
    const Params* kp = (const Params*)__builtin_amdgcn_kernarg_segment_ptr();
    cg::grid_group grid = cg::this_grid();
    volatile LAS unsigned* st = (volatile LAS unsigned*)((LAS unsigned char*)g_lds + LDS_MISC);
    if (threadIdx.x < 2) st[threadIdx.x] = 0u;
    __syncthreads();
    const XcdBarrier bar = xcd_barrier_post((unsigned*)P.ws, st);
    phase_seq<0>(kp, P.ph_lo, P.ph_hi, grid, bar);
}

extern "C" void kernel_launch(void* const* d_in, const int* in_sizes, int n_in, void* d_out, int out_size, void* d_ws, size_t ws_size, hipStream_t stream) {
    static int grid = 0;
    if (grid == 0) {
        if (n_in != 24 || in_sizes[0] != MTOK * DM || out_size != MTOK * DM || ws_size < WS_END) { fprintf(stderr, "kernel_launch: unexpected shapes (n_in %d, ws %zu)\n", n_in, ws_size); grid = -1; return; }
        int dev = 0, cus = 0, per_cu = 0;
        hipGetDevice(&dev); hipDeviceGetAttribute(&cus, hipDeviceAttributeMultiprocessorCount, dev);
        hipFuncSetAttribute((const void*)fwd_kernel, hipFuncAttributeMaxDynamicSharedMemorySize, LDS_BYTES);
        hipOccupancyMaxActiveBlocksPerMultiprocessor(&per_cu, (const void*)fwd_kernel, 512, LDS_BYTES);
        (void)hipGetLastError();
        if (per_cu < 1) { fprintf(stderr, "kernel_launch: occupancy query says %d blocks/CU\n", per_cu); grid = -1; return; }
        grid = cus;
    }
    if (grid < 0) return;
    (void)hipMemsetAsync(d_ws, 0, 16384, stream);
    Params p{};
    for (int i = 0; i < 24; ++i) p.in[i] = (const float*)d_in[i];
    p.out = (float*)d_out; p.ws = (unsigned char*)d_ws;
#if MK_MULTI_LAUNCH
    for (int ph = 0; ph < N_PHASES; ++ph) { p.ph_lo = ph; p.ph_hi = ph + 1; hipLaunchKernelGGL(fwd_kernel, dim3(grid), dim3(512), LDS_BYTES, stream, p); }
#else
    p.ph_lo = 0; p.ph_hi = N_PHASES;
    void* args[] = {&p};
    hipError_t e = hipLaunchCooperativeKernel((const void*)fwd_kernel, dim3(grid), dim3(512), args, LDS_BYTES, stream);
    if (e != hipSuccess) fprintf(stderr, "cooperative launch failed: %s (grid %d)\n", hipGetErrorString(e), grid);
#endif
}
```

```cpp
#include <hip/hip_runtime.h>
#include <hip/hip_cooperative_groups.h>
#include <cstdio>
#include <cstdint>
namespace cg = cooperative_groups;

#ifndef MK_MULTI_LAUNCH
#define MK_MULTI_LAUNCH 0
#endif

#define LAS __attribute__((address_space(3)))
typedef _Float16 h16;
typedef _Float16 h16x8 __attribute__((ext_vector_type(8)));
typedef _Float16 h16x4 __attribute__((ext_vector_type(4)));
typedef _Float16 h16x2 __attribute__((ext_vector_type(2)));
typedef float f32x4 __attribute__((ext_vector_type(4)));
typedef float f32x2 __attribute__((ext_vector_type(2)));
typedef unsigned u32x4 __attribute__((ext_vector_type(4)));
typedef unsigned u32x2 __attribute__((ext_vector_type(2)));

constexpr int BATCH = 4, SEQ = 8192, DM = 1024, MTOK = BATCH * SEQ, DEPTH = 2;
constexpr int DIN = 3364, PN = 3584, DFF = 4096;
constexpr float EPS = 1e-6f;
constexpr int C_GQ = 0, C_GK = 128, C_GV = 256, C_GR = 512, C_NQ = 768, C_NKV = 1024, C_SZ = 1792, C_SX = 2304, C_SM = 3328;
constexpr int C_KCMP = C_NKV, C_VCMP = C_NKV + 128, C_KSLC = C_NKV + 256, C_VSLC = C_NKV + 384, C_KWIN = C_NKV + 512, C_VWIN = C_NKV + 640;
constexpr int PSM_W = 64;

constexpr size_t MiB = 1u << 20;
constexpr size_t WS_WIN = 2 * MiB;
constexpr size_t WS_WOUT = 16 * MiB;
constexpr size_t WS_WUP = 20 * MiB;
constexpr size_t WS_WDN = 36 * MiB;
constexpr size_t WS_W1T = 52 * MiB;
constexpr size_t WS_W2T = 54 * MiB;
constexpr size_t WS_B1 = 54 * MiB + 256 * 1024;
constexpr size_t WS_ROPE = 55 * MiB;
constexpr size_t WS_XN = 60 * MiB;
constexpr size_t WS_PROJ = 124 * MiB;
constexpr size_t WS_HID = 124 * MiB;
constexpr size_t WS_XBCC = 348 * MiB;
constexpr size_t WS_SSDST = 412 * MiB;
constexpr size_t WS_GLAST = 476 * MiB;
constexpr size_t WS_PSM = 492 * MiB;
constexpr size_t WS_KC = 500 * MiB;
constexpr size_t WS_VC = 500 * MiB + 512 * 1024;
constexpr size_t WS_SSQ = 501 * MiB;
constexpr size_t WS_DTV = 502 * MiB;
constexpr size_t WS_ACS = 503 * MiB;
constexpr size_t WS_CD = 504 * MiB;
constexpr size_t WS_GLAG = 504 * MiB + 64 * 1024;
constexpr size_t WS_END = 505 * MiB;

constexpr int LDS_BYTES = 147456;
extern __shared__ __attribute__((aligned(16))) unsigned char g_lds[];

struct Params { const float* in[24]; float* out; unsigned char* ws; int ph_lo, ph_hi; };

__constant__ float ROPE_INV[32] = {
 1.000000000e+00f, 7.498942614e-01f, 5.623413324e-01f, 4.216965139e-01f, 3.162277639e-01f, 2.371373773e-01f, 1.778279394e-01f, 1.333521307e-01f,
 1.000000015e-01f, 7.498941571e-02f, 5.623413250e-02f, 4.216965288e-02f, 3.162277490e-02f, 2.371373773e-02f, 1.778279431e-02f, 1.333521493e-02f,
 9.999999776e-03f, 7.498941850e-03f, 5.623413250e-03f, 4.216964822e-03f, 3.162277630e-03f, 2.371373586e-03f, 1.778279431e-03f, 1.333521446e-03f,
 1.000000047e-03f, 7.498942432e-04f, 5.623413017e-04f, 4.216965172e-04f, 3.162277571e-04f, 2.371373703e-04f, 1.778279402e-04f, 1.333521504e-04f };

__device__ __forceinline__ f32x4 mfma16(h16x8 a, h16x8 b, f32x4 c) { return __builtin_amdgcn_mfma_f32_16x16x32_f16(a, b, c, 0, 0, 0); }
__device__ __forceinline__ float wave_sum(float v) {
#pragma unroll
    for (int o = 1; o < 64; o <<= 1) v += __shfl_xor(v, o);
    return v;
}
__device__ __forceinline__ float ex2(float x) { return __builtin_amdgcn_exp2f(x); }
__device__ __forceinline__ float sigmoidf_(float x) { return 1.f / (1.f + __expf(-x)); }
__device__ __forceinline__ float siluf_(float x) { return x / (1.f + __expf(-x)); }
__device__ __forceinline__ float softplusf_(float x) { return fmaxf(x, 0.f) + log1pf(__expf(-fabsf(x))); }
__device__ __forceinline__ unsigned pkh(float lo, float hi) { h16x2 v = {(h16)lo, (h16)hi}; return __builtin_bit_cast(unsigned, v); }

__device__ __forceinline__ int opaque_tid() { int t = threadIdx.x; asm volatile("" : "+v"(t)); return t; }
namespace pg8 {
typedef unsigned short bf16_t;
constexpr int BM = 256, BK = 64, HALF = 128, HTB = HALF * BK * 2, STAGE_BYTES = 8 * HTB, NXCD = 8, WGM = 8;
__host__ __device__ __forceinline__ int lds_byte(int r, int c) { const int st = (r >> 4) * 2 + (c >> 5), rr = r & 15, cc = c & 31, ob = rr * 64 + cc * 2; return st * 1024 + (ob ^ (((ob >> 9) & 1) << 5)); }
__host__ __device__ __forceinline__ void stage_rc(int b, int& R, int& C) { const int st = b / 1024, sb = b % 1024, swz = sb ^ (((sb >> 9) & 1) << 5); R = (st >> 1) * 16 + swz / 64; C = (st & 1) * 32 + (swz % 64) / 2; }
__host__ __device__ __forceinline__ int perm32(int rho) { const int n = rho >> 4, i = rho & 15; return 8 * (i >> 2) + 4 * n + (i & 3); }
struct Unit { int pm, pn; };
struct Gemm { const bf16_t* A; const bf16_t* Bt; int M, N, K; };
struct StaticOrder {
    int nM, nN, nwg, G, c;
    __device__ void init(int M, int N, int G_, int c_) { nM = M / BM; nN = N / BM; nwg = nM * nN; G = G_; c = c_; }
    __device__ bool next(int i, Unit& u) const {
        const long L = (long)i * G + c; if (L >= nwg) return false;
        int wgid = (int)L; { const int q = nwg / NXCD, r = nwg % NXCD, xcd = wgid % NXCD, off = wgid / NXCD; wgid = (xcd < r ? xcd * (q + 1) : r * (q + 1) + (xcd - r) * q) + off; }
        const int nig = WGM * nN, gid = wgid / nig, fm = gid * WGM, gsz = (nM - fm) < WGM ? (nM - fm) : WGM;
        u.pm = fm + ((wgid % nig) % gsz); u.pn = (wgid % nig) / gsz; return true;
    }
};
struct EpiProj {
    static constexpr bool PERM = true;
    h16* O; float* PSM;
    __device__ __forceinline__ void operator()(const f32x4 (&acc)[2][2][4][2], const Unit& u, int wr, int wc, int fr, int fq) const {
        const int row0 = u.pm * BM + wr * 64 + fr, col0 = u.pn * BM + wc * 32 + 8 * fq;
#pragma unroll
        for (int ai = 0; ai < 2; ++ai)
#pragma unroll
            for (int m = 0; m < 4; ++m) { const int row = row0 + ai * HALF + m * 16;
#pragma unroll
                for (int bj = 0; bj < 2; ++bj) { const f32x4 v0 = acc[ai][bj][m][0], v1 = acc[ai][bj][m][1]; const int c = col0 + bj * HALF;
                    u32x4 w; w.x = pkh(v0[0], v0[1]); w.y = pkh(v0[2], v0[3]); w.z = pkh(v1[0], v1[1]); w.w = pkh(v1[2], v1[3]);
                    *(u32x4*)(O + (size_t)row * PN + c) = w;
                    if (c >= C_SM && c < C_SM + PSM_W) { float* p = PSM + (size_t)row * PSM_W + (c - C_SM); *(f32x4*)p = v0; *(f32x4*)(p + 4) = v1; } } }
    }
};
struct EpiHid {
    static constexpr bool PERM = true;
    h16* O;
    __device__ __forceinline__ void operator()(const f32x4 (&acc)[2][2][4][2], const Unit& u, int wr, int wc, int fr, int fq) const {
        const int row0 = u.pm * BM + wr * 64 + fr, col0 = u.pn * BM + wc * 32 + 8 * fq;
#pragma unroll
        for (int ai = 0; ai < 2; ++ai)
#pragma unroll
            for (int m = 0; m < 4; ++m) { const int row = row0 + ai * HALF + m * 16;
#pragma unroll
                for (int bj = 0; bj < 2; ++bj) { f32x4 v0 = acc[ai][bj][m][0], v1 = acc[ai][bj][m][1];
#pragma unroll
                    for (int e = 0; e < 4; ++e) { float a = fmaxf(v0[e], 0.f), b = fmaxf(v1[e], 0.f); v0[e] = a * a; v1[e] = b * b; }
                    u32x4 w; w.x = pkh(v0[0], v0[1]); w.y = pkh(v0[2], v0[3]); w.z = pkh(v1[0], v1[1]); w.w = pkh(v1[2], v1[3]);
                    *(u32x4*)(O + (size_t)row * DFF + col0 + bj * HALF) = w; } }
    }
};
struct EpiRes {
    static constexpr bool PERM = false;
    const float* base; float* out;
    __device__ __forceinline__ void operator()(const f32x4 (&acc)[2][2][4][2], const Unit& u, int wr, int wc, int fr, int fq) const {
        const int col0 = u.pn * BM + wc * 32 + 4 * fq;
#pragma unroll
        for (int ai = 0; ai < 2; ++ai)
#pragma unroll
            for (int m = 0; m < 4; ++m) { const size_t off = (size_t)(u.pm * BM + ai * HALF + wr * 64 + m * 16 + fr) * DM + col0;
#pragma unroll
                for (int bj = 0; bj < 2; ++bj)
#pragma unroll
                    for (int n = 0; n < 2; ++n) { const f32x4 bs = *(const f32x4*)(base + off + bj * HALF + n * 16); *(f32x4*)(out + off + bj * HALF + n * 16) = bs + acc[ai][bj][m][n]; } }
    }
};

template <class Epi>
__device__ __forceinline__ void gemm_phase(LAS unsigned char* lds, const Gemm g, const StaticOrder& S, const Epi& E) {
    const int tid = opaque_tid(), wid = __builtin_amdgcn_readfirstlane(tid >> 6), lane = tid & 63, wr = wid >> 2, wc = wid & 3, fr = lane & 15, fq = lane >> 4;
    const int K = g.K, nt = K / BK;
    unsigned voffA[2], voffB[2];
#pragma unroll
    for (int i = 0; i < 2; ++i) { int R, C; stage_rc(tid * 16 + i * 8192, R, C); const int Rb = Epi::PERM ? ((R & ~31) + perm32(R & 31)) : R;
        voffA[i] = (unsigned)(R * K + C) * 2u; voffB[i] = (unsigned)(Rb * K + C) * 2u; }
    const size_t kstep = (size_t)(BK * 2);
    const size_t hstep = (size_t)HALF * K * 2;
    const size_t tstep = 2 * hstep;
    const unsigned ldsw = (unsigned)wid * 1024u;
    const int aoff = lds_byte(wr * 64 + fr, fq * 8), boff = lds_byte(wc * 32 + fr, fq * 8);
#define PG8_SA(b, h) (((b) * 2 + (h)) * HTB)
#define PG8_SB(b, h) ((4 + (b) * 2 + (h)) * HTB)
#define PG8_STAGE(bufoff, gbase, voff) do { _Pragma("unroll") for (int _i = 0; _i < 2; ++_i) \
        __builtin_amdgcn_global_load_lds((const unsigned*)((const char*)(gbase) + (voff)[_i]), (LAS unsigned*)(lds + (bufoff) + ldsw + _i * 8192), 16, 0, 0); } while (0)
#define PG8_LDA(dst, b, h) do { _Pragma("unroll") for (int m = 0; m < 4; ++m) _Pragma("unroll") for (int k = 0; k < 2; ++k) dst[m][k] = *(const LAS h16x8*)(lds + PG8_SA(b, h) + aoff + m * 2048 + k * 1024); } while (0)
#define PG8_LDB(dst, b, h) do { _Pragma("unroll") for (int n = 0; n < 2; ++n) _Pragma("unroll") for (int k = 0; k < 2; ++k) dst[n][k] = *(const LAS h16x8*)(lds + PG8_SB(b, h) + boff + n * 2048 + k * 1024); } while (0)
#define PG8_MMA(ai, bj, At, Bt) do { __builtin_amdgcn_s_setprio(1); _Pragma("unroll") for (int m = 0; m < 4; ++m) _Pragma("unroll") for (int n = 0; n < 2; ++n) _Pragma("unroll") for (int k = 0; k < 2; ++k) \
        acc[ai][bj][m][n] = __builtin_amdgcn_mfma_f32_16x16x32_f16(Bt[n][k], At[m][k], acc[ai][bj][m][n], 0, 0, 0); __builtin_amdgcn_s_setprio(0); } while (0)
#define PG8_WAIT_V(n) asm volatile("s_waitcnt vmcnt(" #n ")" ::: "memory")
#define PG8_WAIT_L(n) asm volatile("s_waitcnt lgkmcnt(" #n ")" ::: "memory")
#define PG8_BAR __builtin_amdgcn_s_barrier()
#define PG8_SCHED __builtin_amdgcn_sched_barrier(0)
    Unit cur, nxt; int ui = 0;
    if (!S.next(0, cur)) return;
    f32x4 acc[2][2][4][2];
#pragma unroll
    for (int a = 0; a < 2; ++a)
#pragma unroll
        for (int b = 0; b < 2; ++b)
#pragma unroll
            for (int m = 0; m < 4; ++m)
#pragma unroll
                for (int n = 0; n < 2; ++n) acc[a][b][m][n] = (f32x4){0.f, 0.f, 0.f, 0.f};
    h16x8 At[4][2], B0[2][2], B1[2][2];
    const char* cA = (const char*)g.A + (size_t)cur.pm * tstep; const char* cB = (const char*)g.Bt + (size_t)cur.pn * tstep;
    PG8_STAGE(PG8_SB(0, 0), cB, voffB); PG8_STAGE(PG8_SB(0, 1), cB + hstep, voffB); PG8_STAGE(PG8_SA(0, 0), cA, voffA); PG8_STAGE(PG8_SA(0, 1), cA + hstep, voffA);
    if (wr == 1) PG8_BAR;
    PG8_WAIT_V(2); PG8_BAR;
    PG8_STAGE(PG8_SB(1, 0), cB + kstep, voffB); PG8_STAGE(PG8_SA(1, 0), cA + kstep, voffA); PG8_STAGE(PG8_SB(1, 1), cB + hstep + kstep, voffB);
    PG8_WAIT_V(6); PG8_BAR;
    for (;;) {
        const bool has_next = S.next(ui + 1, nxt);
        const char* nA = has_next ? (const char*)g.A + (size_t)nxt.pm * tstep : cA; const char* nB = has_next ? (const char*)g.Bt + (size_t)nxt.pn * tstep : cB;
        for (int t = 0; t < nt; t += 2) {
            const bool last = (t == nt - 2);
            const char* a1 = cA + (size_t)(t + 1) * kstep;
            const char* a2 = last ? nA : cA + (size_t)(t + 2) * kstep; const char* b2 = last ? nB : cB + (size_t)(t + 2) * kstep;
            const char* a3 = a2 + kstep; const char* b3 = b2 + kstep;
            PG8_LDB(B0, 0, 0); PG8_LDB(B1, 0, 1); PG8_SCHED; PG8_LDA(At, 0, 0); PG8_STAGE(PG8_SA(1, 1), a1 + hstep, voffA);
            PG8_WAIT_V(8); PG8_WAIT_L(0); PG8_BAR; PG8_MMA(0, 0, At, B0); PG8_MMA(0, 1, At, B1); PG8_BAR; PG8_SCHED;
            PG8_LDA(At, 0, 1); PG8_STAGE(PG8_SB(0, 0), b2, voffB); PG8_STAGE(PG8_SB(0, 1), b2 + hstep, voffB); PG8_STAGE(PG8_SA(0, 0), a2, voffA);
            PG8_WAIT_V(8); PG8_WAIT_L(0); PG8_BAR; PG8_MMA(1, 0, At, B0); PG8_MMA(1, 1, At, B1); PG8_BAR; PG8_SCHED;
            PG8_LDB(B0, 1, 0); PG8_LDB(B1, 1, 1); PG8_SCHED; PG8_LDA(At, 1, 0); PG8_STAGE(PG8_SA(0, 1), a2 + hstep, voffA);
            PG8_WAIT_V(8); PG8_WAIT_L(0); PG8_BAR; PG8_MMA(0, 0, At, B0); PG8_MMA(0, 1, At, B1); PG8_BAR; PG8_SCHED;
            PG8_LDA(At, 1, 1); PG8_STAGE(PG8_SB(1, 0), b3, voffB); PG8_STAGE(PG8_SB(1, 1), b3 + hstep, voffB); PG8_STAGE(PG8_SA(1, 0), a3, voffA);
            PG8_WAIT_V(8); PG8_WAIT_L(0); PG8_BAR; PG8_MMA(1, 0, At, B0); PG8_MMA(1, 1, At, B1); PG8_BAR; PG8_SCHED;
        }
        if (wr == 0) PG8_BAR;
        E(acc, cur, wr, wc, fr, fq);
        if (!has_next) break;
#pragma unroll
        for (int a = 0; a < 2; ++a)
#pragma unroll
            for (int b = 0; b < 2; ++b)
#pragma unroll
                for (int m = 0; m < 4; ++m)
#pragma unroll
                    for (int n = 0; n < 2; ++n) acc[a][b][m][n] = (f32x4){0.f, 0.f, 0.f, 0.f};
        cur = nxt; cA = nA; cB = nB; ++ui;
        if (wr == 1) PG8_BAR;
    }
    PG8_WAIT_V(0);
    PG8_BAR;
#undef PG8_SA
#undef PG8_SB
#undef PG8_STAGE
#undef PG8_LDA
#undef PG8_LDB
#undef PG8_MMA
#undef PG8_WAIT_V
#undef PG8_WAIT_L
#undef PG8_BAR
#undef PG8_SCHED
}
}


#define XB_TMO      128
#define XB_XCNT(j)  (256  + 64 * (j))
#define XB_XSUB(j)  (1280 + 64 * (j))
#define XB_XGEN(j)  (2304 + 64 * (j))
#define XB_TOP      3328
#define XB_TOPGEN   3392
#define XCD_BAR_WORDS 3456
#define XB_SPIN_CAP (1u << 18)
__device__ __forceinline__ unsigned xb_ld(unsigned* p)              { return __hip_atomic_load(p, __ATOMIC_RELAXED, __HIP_MEMORY_SCOPE_AGENT); }
__device__ __forceinline__ unsigned xb_add(unsigned* p, unsigned v) { return __hip_atomic_fetch_add(p, v, __ATOMIC_RELAXED, __HIP_MEMORY_SCOPE_AGENT); }
__device__ __forceinline__ unsigned xb_xcc_id() { return (unsigned)__builtin_amdgcn_s_getreg((3 << 11) | 20) & 0xFu; }
#define XB_SPIN(cond, bar) do { unsigned _sp = 0; while (cond) { __builtin_amdgcn_s_sleep(1); \
    if ((++_sp & 255u) == 0u) { if (xb_ld(&(bar)[XB_TMO])) break; if (_sp > XB_SPIN_CAP) { atomicAdd(&(bar)[XB_TMO], 1u); break; } } } } while (0)
struct XcdBarrier { unsigned* bar; unsigned x; volatile LAS unsigned* st; };
__device__ __forceinline__ XcdBarrier xcd_barrier_post(unsigned* bar, volatile LAS unsigned* st) {
    XcdBarrier b; b.bar = bar; b.x = xb_xcc_id(); b.st = st;
    if (threadIdx.x == 0) (void)xb_add(&bar[XB_XCNT(b.x)], 1u);
    return b;
}
__device__ __forceinline__ void xcd_barrier_complete(unsigned* bar, unsigned x, unsigned& nloc, unsigned& nx) {
    const unsigned G = gridDim.x * gridDim.y * gridDim.z;
    unsigned sum, cnt, mine, sp = 0u;
    for (;;) {
        sum = 0u; cnt = 0u; mine = 0u;
#pragma unroll
        for (unsigned j = 0; j < 16; ++j) { const unsigned c = xb_ld(&bar[XB_XCNT(j)]); sum += c; cnt += (c > 0u) ? 1u : 0u; mine = (j == x) ? c : mine; }
        if (sum == G) break;
        __builtin_amdgcn_s_sleep(1);
        if ((++sp & 255u) == 0u) { if (xb_ld(&bar[XB_TMO])) break; if (sp > XB_SPIN_CAP) { atomicAdd(&bar[XB_TMO], 1u); break; } }
    }
    nloc = mine > 0u ? mine : 1u; nx = cnt > 0u ? cnt : 1u;
}
__device__ __forceinline__ void xcd_barrier(const XcdBarrier& b) {
    asm volatile("s_waitcnt vmcnt(0)" ::: "memory");
    __syncthreads();
    if (threadIdx.x == 0) {
        unsigned* bar = b.bar;
        __builtin_amdgcn_s_waitcnt(0);
        unsigned nloc = b.st[0], nx = b.st[1];
        if (nloc == 0u) { xcd_barrier_complete(bar, b.x, nloc, nx); b.st[0] = nloc; b.st[1] = nx; }
        const unsigned old = xb_add(&bar[XB_XSUB(b.x)], 1u);
        const unsigned gen = old / nloc;
        if (old + 1u == (gen + 1u) * nloc) {
            __builtin_amdgcn_fence(__ATOMIC_RELEASE, "agent");
            asm volatile("s_waitcnt vmcnt(0)" ::: "memory");
            const unsigned og = xb_add(&bar[XB_TOP], 1u);
            const unsigned tg = og / nx;
            if (og + 1u == (tg + 1u) * nx) xb_add(&bar[XB_TOPGEN], 1u);
            else XB_SPIN(xb_ld(&bar[XB_TOPGEN]) == tg, bar);
            __builtin_amdgcn_fence(__ATOMIC_ACQUIRE, "agent");
            xb_add(&bar[XB_XGEN(b.x)], 1u);
            asm volatile("s_waitcnt vmcnt(0)" ::: "memory");
        } else {
            XB_SPIN(xb_ld(&bar[XB_XGEN(b.x)]) == gen, bar);
            __builtin_amdgcn_fence(__ATOMIC_ACQUIRE, "agent");
            asm volatile("s_waitcnt vmcnt(0)" ::: "memory");
        }
    }
    __syncthreads();
}

#define TIDS const int tid = opaque_tid(); const int lane = tid & 63; const int wave = __builtin_amdgcn_readfirstlane(tid >> 6); (void)lane; (void)wave;
struct Ctx {
    const float* in[24]; float* out; unsigned char* ws;
    int G, bid;
    h16 *WIN, *WOUT, *WUP, *WDN, *W1T, *W2T, *XN, *PROJ, *HID, *XBCC, *KC, *VC;
    float *B1, *ROPE, *SSDST, *GLAST, *PSM, *SSQ, *DTV, *ACS, *CD, *GLAG;
};
__device__ __forceinline__ void make_ctx(Ctx& C, const Params* kp) {
#pragma unroll
    for (int i = 0; i < 24; ++i) C.in[i] = kp->in[i];
    C.out = kp->out; unsigned char* ws = kp->ws; C.ws = ws; C.G = gridDim.x; C.bid = blockIdx.x;
    C.WIN = (h16*)(ws + WS_WIN); C.WOUT = (h16*)(ws + WS_WOUT); C.WUP = (h16*)(ws + WS_WUP); C.WDN = (h16*)(ws + WS_WDN); C.W1T = (h16*)(ws + WS_W1T); C.W2T = (h16*)(ws + WS_W2T);
    C.XN = (h16*)(ws + WS_XN); C.PROJ = (h16*)(ws + WS_PROJ); C.HID = (h16*)(ws + WS_HID); C.XBCC = (h16*)(ws + WS_XBCC); C.KC = (h16*)(ws + WS_KC); C.VC = (h16*)(ws + WS_VC);
    C.B1 = (float*)(ws + WS_B1); C.ROPE = (float*)(ws + WS_ROPE); C.SSDST = (float*)(ws + WS_SSDST); C.GLAST = (float*)(ws + WS_GLAST); C.PSM = (float*)(ws + WS_PSM);
    C.SSQ = (float*)(ws + WS_SSQ); C.DTV = (float*)(ws + WS_DTV); C.ACS = (float*)(ws + WS_ACS); C.CD = (float*)(ws + WS_CD); C.GLAG = (float*)(ws + WS_GLAG);
}

__device__ __forceinline__ int win_src_col(int n) {
    if (n < 512) return n;
    if (n < 768) return n - 512 + 528;
    if (n < 1024) return n - 768 + 784;
    if (n < 1792) return n - 1024 + 1040;
    if (n < 2304) return n - 1792 + 1820;
    if (n < 3328) return n - 2304 + 2332;
    const int r = n - 3328;
    if (r < 16) return 512 + r;
    if (r < 28) return 1808 + (r - 16);
    if (r < 36) return 3356 + (r - 28);
    return -1;
}
template <bool MAPW>
__device__ __forceinline__ void transpose_item(const float* W, int K, int Nsrc, int Ndst, h16* WT, const float* kscale, float* scr, int item, int lane) {
    const int nblk = Ndst / 32, kb = item / nblk, nb = item % nblk, k0 = 64 * kb, n0 = 32 * nb;
    const int nd = n0 + (lane & 31); const int sc = MAPW ? win_src_col(nd) : nd;
#pragma unroll 8
    for (int i = 0; i < 32; ++i) { const int kk = 2 * i + (lane >> 5); float v = 0.f;
        if (sc >= 0) { v = W[(size_t)(k0 + kk) * Nsrc + sc]; if (kscale) v *= kscale[k0 + kk]; }
        scr[kk * 33 + (lane & 31)] = v; }
    asm volatile("s_waitcnt lgkmcnt(0)" ::: "memory");
    const int c = lane & 7;
#pragma unroll
    for (int j = 0; j < 4; ++j) { const int n = (lane >> 3) + 8 * j; const float* s = scr + (8 * c) * 33 + n;
        u32x4 o; o.x = pkh(s[0 * 33], s[1 * 33]); o.y = pkh(s[2 * 33], s[3 * 33]); o.z = pkh(s[4 * 33], s[5 * 33]); o.w = pkh(s[6 * 33], s[7 * 33]);
        *(u32x4*)(WT + (size_t)(n0 + n) * K + k0 + 8 * c) = o; }
    asm volatile("s_waitcnt lgkmcnt(0)" ::: "memory");
}
__device__ __forceinline__ void rms_row_to_h16(const float* xrow, h16* orow, int lane) {
    const f32x4* xr = (const f32x4*)xrow + lane; f32x4 v[4]; float s = 0.f;
#pragma unroll
    for (int j = 0; j < 4; ++j) { v[j] = xr[64 * j]; s += (v[j].x * v[j].x + v[j].y * v[j].y) + (v[j].z * v[j].z + v[j].w * v[j].w); }
    const float rs = 1.0f / sqrtf(wave_sum(s) * (1.f / DM) + EPS);
    u32x2* o8 = (u32x2*)orow + lane;
#pragma unroll
    for (int j = 0; j < 4; ++j) { u32x2 w; w.x = pkh(v[j].x * rs, v[j].y * rs); w.y = pkh(v[j].z * rs, v[j].w * rs); o8[64 * j] = w; }
}
__device__ __forceinline__ void sincos_acc(float angf, float& c, float& s) {
    const double x = (double)angf; const double n = __builtin_rint(x * 0.63661977236758134308);
    const double r = __builtin_fma(-n, 1.5707963267948966192, x) - n * 6.123233995736766036e-17;
    const double r2 = r * r;
    double sp = -7.6471637318198164759e-13; sp = sp * r2 + 1.6059043836821614599e-10; sp = sp * r2 - 2.5052108385441718775e-08; sp = sp * r2 + 2.7557319223985890653e-06;
    sp = sp * r2 - 1.9841269841269841270e-04; sp = sp * r2 + 8.3333333333333333333e-03; sp = sp * r2 - 1.6666666666666666667e-01; const double sn = r + r * r2 * sp;
    double cp = 4.7794773323873852974e-14; cp = cp * r2 - 1.1470745597729724714e-11; cp = cp * r2 + 2.0876756987868098979e-09; cp = cp * r2 - 2.7557319223985890653e-07;
    cp = cp * r2 + 2.4801587301587301587e-05; cp = cp * r2 - 1.3888888888888888889e-03; cp = cp * r2 + 4.1666666666666666667e-02; cp = cp * r2 - 0.5; const double cs = 1.0 + r2 * cp;
    const int q = ((int)n) & 3;
    const double so = (q == 0) ? sn : (q == 1) ? cs : (q == 2) ? -sn : -cs;
    const double co = (q == 0) ? cs : (q == 1) ? -sn : (q == 2) ? -cs : sn;
    c = (float)co; s = (float)so;
}
__device__ __forceinline__ void phase_prep(const Ctx& C) {
    TIDS
    float* scr = (float*)(g_lds) + wave * (64 * 33);
    const int gw = C.bid * 8 + wave, NGW = C.G * 8;
    constexpr int I_IN = 16 * (PN / 32), I_OUT = 16 * 32, I_UP = 16 * 128, I_DN = 64 * 32, I_W1 = 32 * 4, I_W2 = 2 * 2;
    constexpr int PER_L = I_IN + I_OUT + I_UP + I_DN + 2 * I_W1 + 2 * I_W2;
    for (int it = gw; it < DEPTH * PER_L; it += NGW) {
        const int l = it / PER_L; int r = it % PER_L;
        if (r < I_IN) { transpose_item<true>(C.in[2] + (size_t)l * DM * DIN, DM, DIN, PN, C.WIN + (size_t)l * PN * DM, C.in[1] + l * DM, scr, r, lane); continue; } r -= I_IN;
        if (r < I_OUT) { transpose_item<false>(C.in[19] + (size_t)l * DM * DM, DM, DM, DM, C.WOUT + (size_t)l * DM * DM, nullptr, scr, r, lane); continue; } r -= I_OUT;
        if (r < I_UP) { transpose_item<false>(C.in[21] + (size_t)l * DM * DFF, DM, DFF, DFF, C.WUP + (size_t)l * DFF * DM, C.in[20] + l * DM, scr, r, lane); continue; } r -= I_UP;
        if (r < I_DN) { transpose_item<false>(C.in[22] + (size_t)l * DFF * DM, DFF, DM, DM, C.WDN + (size_t)l * DM * DFF, nullptr, scr, r, lane); continue; } r -= I_DN;
        if (r < 2 * I_W1) { const int kv = r / I_W1; transpose_item<false>(C.in[kv ? 10 : 7] + (size_t)l * 2048 * 128, 2048, 128, 128, C.W1T + (size_t)(l * 2 + kv) * 128 * 2048, nullptr, scr, r % I_W1, lane); continue; } r -= 2 * I_W1;
        { const int kv = r / I_W2; transpose_item<false>(C.in[kv ? 11 : 8] + (size_t)l * 128 * 64, 128, 64, 64, C.W2T + (size_t)(l * 2 + kv) * 64 * 128, nullptr, scr, r % I_W2, lane); }
    }
    for (int it = gw; it < DEPTH * 2 * 128; it += NGW) {
        const int l = it / 256, kv = (it / 128) & 1, j = it & 127;
        const float* pos = C.in[kv ? 9 : 6] + (size_t)l * 2048; const float* w1 = C.in[kv ? 10 : 7] + (size_t)l * 2048 * 128;
        float s = 0.f;
        for (int f = lane; f < 2048; f += 64) s += pos[f] * w1[(size_t)f * 128 + j];
        s = wave_sum(s);
        if (lane == 0) C.B1[it] = s;
    }
    for (int e = C.bid * 512 + tid; e < SEQ * 32; e += C.G * 512) {
        const int pos = e >> 5, i = e & 31; const float ang = (float)pos * ROPE_INV[i];
        float cs, sn; sincos_acc(ang, cs, sn); C.ROPE[2 * e] = cs; C.ROPE[2 * e + 1] = sn;
    }
    for (int m = gw; m < MTOK; m += NGW) rms_row_to_h16(C.in[0] + (size_t)m * DM, C.XN + (size_t)m * DM, lane);
}

__device__ __forceinline__ void phase_tok(const Ctx& C, int l) {
    TIDS
    const int gw = C.bid * 8 + wave, NGW = C.G * 8;
    const float* cw = C.in[13] + (size_t)l * 4 * 1024; const float* cb = C.in[14] + (size_t)l * 1024; const float* dtb = C.in[15] + l * 8;
    for (int m = gw; m < MTOK; m += NGW) {
        const int t = m & (SEQ - 1);
        h16* prow = C.PROJ + (size_t)m * PN;
#pragma unroll
        for (int it = 0; it < 5; ++it) { const int pi = lane + 64 * it, hd = pi >> 5, i = pi & 31;
            const int base = (hd < 4) ? (C_NQ + hd * 64) : (hd < 6) ? (C_KCMP + (hd - 4) * 64) : (hd < 8) ? (C_KSLC + (hd - 6) * 64) : (C_KWIN + (hd - 8) * 64);
            const float cs = C.ROPE[2 * (t * 32 + i)], sn = C.ROPE[2 * (t * 32 + i) + 1];
            const float x1 = (float)prow[base + i], x2 = (float)prow[base + 32 + i]; const float sc = (hd < 4) ? 0.18033688011112042f : 1.f;
            prow[base + i] = (h16)((x1 * cs - x2 * sn) * sc); prow[base + 32 + i] = (h16)((x2 * cs + x1 * sn) * sc); }
        { const int ch = lane * 16; float a[16];
#pragma unroll
            for (int e = 0; e < 16; ++e) a[e] = cb[ch + e];
#pragma unroll
            for (int i = 0; i < 4; ++i) { const int tt = t - 3 + i; if (tt < 0) continue;
                const h16* src = C.PROJ + (size_t)(m - 3 + i) * PN + C_SX + ch; const h16x8 x0 = *(const h16x8*)src, x1 = *(const h16x8*)(src + 8);
#pragma unroll
                for (int e = 0; e < 8; ++e) { a[e] += cw[i * 1024 + ch + e] * (float)x0[e]; a[8 + e] += cw[i * 1024 + ch + 8 + e] * (float)x1[e]; } }
            u32x4 o0, o1; o0.x = pkh(siluf_(a[0]), siluf_(a[1])); o0.y = pkh(siluf_(a[2]), siluf_(a[3])); o0.z = pkh(siluf_(a[4]), siluf_(a[5])); o0.w = pkh(siluf_(a[6]), siluf_(a[7]));
            o1.x = pkh(siluf_(a[8]), siluf_(a[9])); o1.y = pkh(siluf_(a[10]), siluf_(a[11])); o1.z = pkh(siluf_(a[12]), siluf_(a[13])); o1.w = pkh(siluf_(a[14]), siluf_(a[15]));
            h16* dst = C.XBCC + (size_t)m * 1024 + ch; *(u32x4*)dst = o0; *(u32x4*)(dst + 8) = o1; }
        if (lane < 8) C.DTV[(size_t)m * 8 + lane] = softplusf_(C.PSM[(size_t)m * PSM_W + 28 + lane] + dtb[lane]);
    }
}

__device__ __forceinline__ float gelu_tanh(float x) { const float u = 0.7978845608028654f * (x + 0.044715f * x * x * x); const float e = __expf(2.f * u); const float th = 1.f - 2.f / (e + 1.f); return 0.5f * x * (1.f + th); }
__device__ __forceinline__ void nsa_compress_unit(const Ctx& C, int l, int u) {
    const int kv = u >> 8, b = (u >> 6) & 3, g = (u >> 5) & 1, mt = u & 31;
    TIDS
    const int w = wave, cc = lane & 15, quad = lane >> 4;
    h16* Hs = (h16*)g_lds;
    const int n = mt * 16 + cc;
    const h16* W1T = C.W1T + (size_t)(l * 2 + kv) * 128 * 2048; const h16* W2T = C.W2T + (size_t)(l * 2 + kv) * 64 * 128; const float* B1 = C.B1 + (l * 2 + kv) * 128;
    const int col = (kv ? C_VCMP : C_KCMP) + g * 64 + quad * 8;
    f32x4 acc = {0.f, 0.f, 0.f, 0.f};
    const h16* brow = W1T + (size_t)(w * 16 + cc) * 2048 + quad * 8;
#pragma unroll 4
    for (int kk = 0; kk < 64; ++kk) {
        int tok = 16 * n + (kk >> 1); tok = tok < SEQ ? tok : SEQ - 1;
        const h16x8 a = *(const h16x8*)(C.PROJ + (size_t)(b * SEQ + tok) * PN + col + (kk & 1) * 32);
        const h16x8 bb = *(const h16x8*)(brow + kk * 32);
        acc = mfma16(a, bb, acc);
    }
    { const float bias = B1[w * 16 + cc];
#pragma unroll
        for (int j = 0; j < 4; ++j) Hs[(quad * 4 + j) * 136 + w * 16 + cc] = (h16)gelu_tanh(acc[j] + bias); }
    __syncthreads();
    if (w < 4) {
        f32x4 o = {0.f, 0.f, 0.f, 0.f};
#pragma unroll
        for (int kk = 0; kk < 4; ++kk) { const h16x8 a = *(const h16x8*)(Hs + cc * 136 + kk * 32 + quad * 8); const h16x8 bb = *(const h16x8*)(W2T + (size_t)(w * 16 + cc) * 128 + kk * 32 + quad * 8); o = mfma16(a, bb, o); }
        h16* dst = (kv ? C.VC : C.KC) + (size_t)((b * 2 + g) * 512 + mt * 16) * 64;
#pragma unroll
        for (int j = 0; j < 4; ++j) dst[(quad * 4 + j) * 64 + w * 16 + cc] = (h16)o[j];
    }
    __syncthreads();
}

__device__ __forceinline__ h16x4 tr_read(const h16* p) { typedef short s16x4 __attribute__((ext_vector_type(4))); return __builtin_bit_cast(h16x4, __builtin_amdgcn_ds_read_tr16_b64_v4i16((LAS s16x4*)p)); }
__device__ __forceinline__ h16x8 cat44(h16x4 lo, h16x4 hi) { return (h16x8){lo[0], lo[1], lo[2], lo[3], hi[0], hi[1], hi[2], hi[3]}; }
struct SsdPre { float dt; h16x8 x[2]; h16x8 bq[4]; };
__device__ __forceinline__ void ssd_states_load(const Ctx& C, int u, int tid, SsdPre& P) {
    const int b = u >> 9, c = (u >> 3) & 63, h = u & 7, g = h >> 2; const size_t row0 = (size_t)b * SEQ + c * 128;
    P.dt = (tid < 128) ? C.DTV[(row0 + tid) * 8 + h] : 0.f;
#pragma unroll
    for (int i = 0; i < 2; ++i) { const int ch = tid + 512 * i, tok = ch >> 3, c8 = ch & 7; P.x[i] = *(const h16x8*)(C.XBCC + (row0 + tok) * 1024 + h * 64 + c8 * 8); }
#pragma unroll
    for (int i = 0; i < 4; ++i) { const int ch = tid + 512 * i, tok = ch >> 4, c16 = ch & 15; P.bq[i] = *(const h16x8*)(C.XBCC + (row0 + tok) * 1024 + 512 + g * 128 + c16 * 8); }
}
__device__ __forceinline__ void ssd_states_phase(const Ctx& C, int l, int ufirst, int ustep) {
    TIDS
    const int w = wave, cc = lane & 15, quad = lane >> 4;
    float* acs = (float*)g_lds; float* dtl = acs + 128; float* wl = acs + 256;
    h16* Xs = (h16*)(g_lds + 2048);
    h16* Bs = (h16*)(g_lds + 2048 + 18432);
    int u = ufirst; SsdPre pre; if (u < 2048) ssd_states_load(C, u, tid, pre);
    while (u < 2048) {
        const int b = u >> 9, c = (u >> 3) & 63, h = u & 7; const size_t row0 = (size_t)b * SEQ + c * 128;
        const SsdPre cur = pre;
        const float A = -__expf(C.in[16][l * 8 + h]);
        if (tid < 128) dtl[tid] = cur.dt;
        __syncthreads();
        if (w == 0) {
            const float d0 = dtl[2 * lane], d1 = dtl[2 * lane + 1]; const float a0 = d0 * A, a1 = d1 * A, sm = a0 + a1; float incl = sm;
#pragma unroll
            for (int o = 1; o < 64; o <<= 1) { const float t = __shfl_up(incl, o); if (lane >= o) incl += t; }
            const float excl = incl - sm, tot = __shfl(incl, 63); const float c0 = excl + a0, c1 = incl;
            acs[2 * lane] = c0; acs[2 * lane + 1] = c1; wl[2 * lane] = __expf(tot - c0) * d0; wl[2 * lane + 1] = __expf(tot - c1) * d1;
            if (lane == 63) C.CD[(b * 64 + c) * 8 + h] = __expf(tot);
        }
        __syncthreads();
#pragma unroll
        for (int i = 0; i < 2; ++i) { const int ch = tid + 512 * i, tok = ch >> 3, c8 = ch & 7; *(h16x8*)(Xs + tok * 72 + c8 * 8) = cur.x[i]; }
#pragma unroll
        for (int i = 0; i < 4; ++i) { const int ch = tid + 512 * i, tok = ch >> 4, c16 = ch & 15; const float ww = wl[tok]; h16x8 o;
#pragma unroll
            for (int e = 0; e < 8; ++e) o[e] = (h16)((float)cur.bq[i][e] * ww);
            *(h16x8*)(Bs + tok * 136 + c16 * 8) = o; }
        if (tid < 128) C.ACS[(row0 + tid) * 8 + h] = acs[tid];
        const int un = u + ustep; if (un < 2048) ssd_states_load(C, un, tid, pre);
        __syncthreads();
        const int mi = w & 3;
        h16x8 xa[4];
#pragma unroll
        for (int kk = 0; kk < 4; ++kk) { const h16* xp = Xs + (kk * 32 + 8 * quad + (cc >> 2)) * 72 + mi * 16 + 4 * (cc & 3); xa[kk] = cat44(tr_read(xp), tr_read(xp + 4 * 72)); }
        float* dst = C.SSDST + (size_t)((b * 64 + c) * 8 + h) * 8192;
#pragma unroll
        for (int q = 0; q < 4; ++q) { const int ni = (w >> 2) * 4 + q; f32x4 acc = {0.f, 0.f, 0.f, 0.f};
#pragma unroll
            for (int kk = 0; kk < 4; ++kk) { const h16* bp = Bs + (kk * 32 + 8 * quad + (cc >> 2)) * 136 + ni * 16 + 4 * (cc & 3); acc = mfma16(xa[kk], cat44(tr_read(bp), tr_read(bp + 4 * 136)), acc); }
#pragma unroll
            for (int j = 0; j < 4; ++j) dst[(mi * 16 + quad * 4 + j) * 128 + ni * 16 + cc] = acc[j]; }
        u = un;
    }
    __syncthreads();
}

struct SsdYPre { float acs, dt; h16x8 cq[4], bq[4], x[2], z[2]; f32x4 he[4]; };
__device__ __forceinline__ void ssd_y_load(const Ctx& C, int u, int tid, SsdYPre& P) {
    const int b = u >> 9, c = (u >> 3) & 63, h = u & 7, g = h >> 2; const size_t row0 = (size_t)b * SEQ + c * 128;
    P.acs = (tid < 128) ? C.ACS[(row0 + tid) * 8 + h] : 0.f; P.dt = (tid < 128) ? C.DTV[(row0 + tid) * 8 + h] : 0.f;
#pragma unroll
    for (int i = 0; i < 4; ++i) { const int ch = tid + 512 * i, tok = ch >> 4, c16 = ch & 15; const h16* src = C.XBCC + (row0 + tok) * 1024 + 512 + g * 128 + c16 * 8; P.bq[i] = *(const h16x8*)src; P.cq[i] = *(const h16x8*)(src + 256); }
#pragma unroll
    for (int i = 0; i < 2; ++i) { const int ch = tid + 512 * i, tok = ch >> 3, c8 = ch & 7; P.x[i] = *(const h16x8*)(C.XBCC + (row0 + tok) * 1024 + h * 64 + c8 * 8); P.z[i] = *(const h16x8*)(C.PROJ + (row0 + tok) * PN + C_SZ + h * 64 + c8 * 8); }
    const float* src = C.SSDST + (size_t)((b * 64 + c) * 8 + h) * 8192;
#pragma unroll
    for (int i = 0; i < 4; ++i) P.he[i] = *(const f32x4*)(src + (tid + 512 * i) * 4);
}
__device__ __forceinline__ void ssd_y_phase(const Ctx& C, int l, int ufirst, int ustep) {
    TIDS
    const int w = wave, cc = lane & 15, quad = lane >> 4;
    float* acs = (float*)g_lds; float* dtl = acs + 128;
    h16* Cm = (h16*)(g_lds + 1024);
    h16* Bm = (h16*)(g_lds + 1024 + 34816);
    h16* Xs = (h16*)(g_lds + 1024 + 2 * 34816);
    h16* HE = (h16*)(g_lds + 1024 + 2 * 34816 + 18432);
    h16* Zs = (h16*)(g_lds + 1024 + 2 * 34816 + 18432 + 17408);
    int u = ufirst; SsdYPre pre; if (u < 2048) ssd_y_load(C, u, tid, pre);
    while (u < 2048) {
        const int b = u >> 9, c = (u >> 3) & 63, h = u & 7; const size_t row0 = (size_t)b * SEQ + c * 128;
        __syncthreads();
        if (tid < 128) { acs[tid] = pre.acs; dtl[tid] = pre.dt; }
#pragma unroll
        for (int i = 0; i < 4; ++i) { const int ch = tid + 512 * i, tok = ch >> 4, c16 = ch & 15; *(h16x8*)(Bm + tok * 136 + c16 * 8) = pre.bq[i]; *(h16x8*)(Cm + tok * 136 + c16 * 8) = pre.cq[i]; }
#pragma unroll
        for (int i = 0; i < 2; ++i) { const int ch = tid + 512 * i, tok = ch >> 3, c8 = ch & 7; *(h16x8*)(Xs + tok * 72 + c8 * 8) = pre.x[i]; *(h16x8*)(Zs + tok * 72 + c8 * 8) = pre.z[i]; }
#pragma unroll
        for (int i = 0; i < 4; ++i) { const int e4 = tid + 512 * i, p = e4 >> 5, n4 = e4 & 31; const f32x4 v = pre.he[i]; h16x4 o = {(h16)v.x, (h16)v.y, (h16)v.z, (h16)v.w}; *(h16x4*)(HE + p * 136 + n4 * 4) = o; }
        const int un = u + ustep; if (un < 2048) ssd_y_load(C, un, tid, pre);
        __syncthreads();
        f32x4 cbt[8];
        { h16x8 ca[4];
#pragma unroll
            for (int kk = 0; kk < 4; ++kk) ca[kk] = *(const h16x8*)(Cm + (w * 16 + cc) * 136 + kk * 32 + quad * 8);
#pragma unroll
            for (int ni = 0; ni < 8; ++ni) { f32x4 acc = {0.f, 0.f, 0.f, 0.f};
#pragma unroll
                for (int kk = 0; kk < 4; ++kk) { const h16x8 bb = *(const h16x8*)(Bm + (ni * 16 + cc) * 136 + kk * 32 + quad * 8); acc = mfma16(ca[kk], bb, acc); }
                cbt[ni] = acc; }
            __syncthreads();
#pragma unroll
            for (int ni = 0; ni < 8; ++ni) { const int sidx = ni * 16 + cc; const float as_ = acs[sidx], ds_ = dtl[sidx];
#pragma unroll
                for (int j = 0; j < 4; ++j) { const int lr = w * 16 + quad * 4 + j; const float v = (sidx <= lr) ? cbt[ni][j] * __expf(acs[lr] - as_) * ds_ : 0.f; Bm[lr * 136 + sidx] = (h16)v; } }
            __syncthreads();
            const float Dh = C.in[17][l * 8 + h];
            float ssq[4] = {0.f, 0.f, 0.f, 0.f};
            h16x8 ma[4];
#pragma unroll
            for (int kk = 0; kk < 4; ++kk) ma[kk] = *(const h16x8*)(Bm + (w * 16 + cc) * 136 + kk * 32 + quad * 8);
            float ea[4];
#pragma unroll
            for (int j = 0; j < 4; ++j) ea[j] = __expf(acs[w * 16 + quad * 4 + j]);
#pragma unroll
            for (int ni = 0; ni < 4; ++ni) { f32x4 acc = {0.f, 0.f, 0.f, 0.f};
#pragma unroll
                for (int kk = 0; kk < 4; ++kk) { const h16x8 bb = *(const h16x8*)(HE + (ni * 16 + cc) * 136 + kk * 32 + quad * 8); acc = mfma16(ca[kk], bb, acc); }
#pragma unroll
                for (int j = 0; j < 4; ++j) acc[j] *= ea[j];
#pragma unroll
                for (int kk = 0; kk < 4; ++kk) { const h16* xp = Xs + (kk * 32 + 8 * quad + (cc >> 2)) * 72 + ni * 16 + 4 * (cc & 3); acc = mfma16(ma[kk], cat44(tr_read(xp), tr_read(xp + 4 * 72)), acc); }
                const int p = ni * 16 + cc;
#pragma unroll
                for (int j = 0; j < 4; ++j) { const int lr = w * 16 + quad * 4 + j; const float x = (float)Xs[lr * 72 + p]; const float z = (float)Zs[lr * 72 + p];
                    const h16 yh = (h16)((acc[j] + Dh * x) * siluf_(z)); Zs[lr * 72 + p] = yh; const float yr = (float)yh; ssq[j] += yr * yr; } }
#pragma unroll
            for (int j = 0; j < 4; ++j) { float sv = ssq[j]; sv += __shfl_xor(sv, 1); sv += __shfl_xor(sv, 2); sv += __shfl_xor(sv, 4); sv += __shfl_xor(sv, 8);
                if (cc == 0) C.SSQ[(row0 + w * 16 + quad * 4 + j) * 8 + h] = sv; }
        }
        __syncthreads();
#pragma unroll
        for (int i = 0; i < 2; ++i) { const int ch = tid + 512 * i, tok = ch >> 3, c8 = ch & 7; *(h16x8*)(C.XN + (row0 + tok) * 1024 + 512 + h * 64 + c8 * 8) = *(const h16x8*)(Zs + tok * 72 + c8 * 8); }
        u = un;
    }
    __syncthreads();
}

template <int PASS>
__device__ __forceinline__ void gla_block_unit(const Ctx& C, int l, int bu) {
    TIDS
    const int w = wave; const int wu = bu * 8 + w;
    const int bh = wu >> 7, seg = wu & 127, b = bh >> 2, h = bh & 3;
    const size_t row0 = (size_t)b * SEQ + seg * 64;
    float* as_ = (float*)(g_lds + w * 10240); float* qs = as_ + 512; float* ks = as_ + 1024;
    h16* vs = (h16*)(as_ + 1536); h16* rs_ = vs + 1024;
    const int tl = lane & 15, kq = lane >> 4;
    const float* w2 = C.in[3] + (size_t)l * 16 * 128 + h * 32 + kq * 8; const float* gb = C.in[4] + l * 128 + h * 32 + kq * 8;
    float S[32];
    float* gst = C.GLAST + (size_t)(bh * 128 + seg) * 2048;
    if (PASS == 1) {
#pragma unroll
        for (int kk = 0; kk < 32; ++kk) S[kk] = gst[kk * 64 + lane];
    } else {
#pragma unroll
        for (int kk = 0; kk < 32; ++kk) S[kk] = 0.f;
    }
    float gtot = 1.f;
    const float gnw = C.in[5][l * 256 + h * 64 + lane];
#pragma unroll 1
    for (int qt = 0; qt < 4; ++qt) {
        const size_t rowh = row0 + qt * 16;
        const size_t rowt = rowh + tl;
        f32x4 gl[4];
#pragma unroll
        for (int i = 0; i < 4; ++i) gl[i] = *(const f32x4*)(C.PSM + rowt * PSM_W + 4 * i);
        const h16x8 q0 = *(const h16x8*)(C.PROJ + rowt * PN + C_GQ + h * 32 + kq * 8);
        const h16x8 k0 = *(const h16x8*)(C.PROJ + rowt * PN + C_GK + h * 32 + kq * 8);
        h16x8 vx[2], rx[2];
#pragma unroll
        for (int i = 0; i < 2; ++i) { const int ch = lane + 64 * i, t = ch >> 3, c8 = ch & 7; vx[i] = *(const h16x8*)(C.PROJ + (rowh + t) * PN + C_GV + h * 64 + c8 * 8);
            if (PASS == 1) rx[i] = *(const h16x8*)(C.PROJ + (rowh + t) * PN + C_GR + h * 64 + c8 * 8); }
        float z[8];
#pragma unroll
        for (int k = 0; k < 8; ++k) z[k] = gb[k];
#pragma unroll
        for (int r = 0; r < 16; ++r) { const float gv = gl[r >> 2][r & 3];
#pragma unroll
            for (int k = 0; k < 8; ++k) z[k] += gv * w2[r * 128 + k]; }
        asm volatile("" ::: "memory");
#pragma unroll
        for (int k4 = 0; k4 < 2; ++k4) { f32x4 av, qv, kv;
#pragma unroll
            for (int e = 0; e < 4; ++e) { const int k = 4 * k4 + e; av[e] = ex2(-0.0625f * __builtin_amdgcn_logf(1.f + ex2(-1.4426950408889634f * z[k])));
                qv[e] = (float)q0[k] * 0.17677669529663687f; kv[e] = (float)k0[k]; }
            *(f32x4*)(as_ + tl * 32 + kq * 8 + 4 * k4) = av; *(f32x4*)(qs + tl * 32 + kq * 8 + 4 * k4) = qv; *(f32x4*)(ks + tl * 32 + kq * 8 + 4 * k4) = kv; }
#pragma unroll
        for (int i = 0; i < 2; ++i) { const int ch = lane + 64 * i; *(h16x8*)(vs + ch * 8) = vx[i]; if (PASS == 1) *(h16x8*)(rs_ + ch * 8) = rx[i]; }
        asm volatile("s_waitcnt lgkmcnt(0)" ::: "memory");
        if (PASS == 0) { if (lane < 32) { float p = 1.f;
#pragma unroll
                for (int t = 0; t < 16; ++t) p *= as_[t * 32 + lane];
                gtot *= p; } }
#pragma unroll 2
        for (int tok = 0; tok < 16; ++tok) { const float v = (float)vs[tok * 64 + lane]; float acc = 0.f;
#pragma unroll
            for (int k4 = 0; k4 < 8; ++k4) { const f32x4 a4 = *(const f32x4*)(as_ + tok * 32 + 4 * k4), kk4 = *(const f32x4*)(ks + tok * 32 + 4 * k4);
#pragma unroll
                for (int e = 0; e < 4; ++e) S[4 * k4 + e] = a4[e] * S[4 * k4 + e] + kk4[e] * v;
                if (PASS == 1) { const f32x4 q4 = *(const f32x4*)(qs + tok * 32 + 4 * k4);
#pragma unroll
                    for (int e = 0; e < 4; ++e) acc += q4[e] * S[4 * k4 + e]; } }
            if (PASS == 1) { const float ssq = wave_sum(acc * acc); const float rs = 1.0f / sqrtf(ssq * (1.f / 64.f) + EPS);
                C.XN[(rowh + tok) * 1024 + h * 64 + lane] = (h16)(acc * rs * gnw * siluf_((float)rs_[tok * 64 + lane])); } }
    }
    if (PASS == 0) {
#pragma unroll
        for (int kk = 0; kk < 32; ++kk) gst[kk * 64 + lane] = S[kk];
        if (lane < 32) C.GLAG[(size_t)(bh * 128 + seg) * 32 + lane] = gtot;
    }
}

__device__ __forceinline__ void phase_scans(const Ctx& C) {
    TIDS
    for (int e = C.bid * 512 + tid; e < BATCH * 8 * 8192; e += C.G * 512) {
        const int bh = e >> 13, b = bh >> 3, h = bh & 7, pn = e & 8191;
        float* p = C.SSDST + (size_t)(b * 64 * 8 + h) * 8192 + pn; const float* cd = C.CD + b * 64 * 8 + h;
        float st = 0.f;
        for (int c0 = 0; c0 < 64; c0 += 8) { float v[8], d[8];
#pragma unroll
            for (int i = 0; i < 8; ++i) { v[i] = p[(size_t)(c0 + i) * 8 * 8192]; d[i] = cd[(c0 + i) * 8]; }
#pragma unroll
            for (int i = 0; i < 8; ++i) { p[(size_t)(c0 + i) * 8 * 8192] = st; st = d[i] * st + v[i]; } }
    }
    for (int e = C.bid * 512 + tid; e < 16 * 2048; e += C.G * 512) {
        const int bh = e >> 11, kv = e & 2047, k = kv >> 6;
        float* p = C.GLAST + (size_t)bh * 128 * 2048 + kv; const float* gg = C.GLAG + (size_t)bh * 128 * 32 + k;
        float st = 0.f;
        for (int s0 = 0; s0 < 128; s0 += 8) { float v[8], d[8];
#pragma unroll
            for (int i = 0; i < 8; ++i) { v[i] = p[(size_t)(s0 + i) * 2048]; d[i] = gg[(s0 + i) * 32]; }
#pragma unroll
            for (int i = 0; i < 8; ++i) { p[(size_t)(s0 + i) * 2048] = st; st = d[i] * st + v[i]; } }
    }
}

struct FlashState { float m, l; f32x4 O[4]; };
constexpr int KV_LD = 72, KV_TILE = 64 * KV_LD;
__device__ __forceinline__ void qk_tile(f32x4 (&s)[4], const h16* Ks, const h16x8 (&qf)[2], int cc, int quad) {
#pragma unroll
    for (int mt = 0; mt < 4; ++mt) { f32x4 a = {0.f, 0.f, 0.f, 0.f};
#pragma unroll
        for (int ks = 0; ks < 2; ++ks) { const h16x8 kf = *(const h16x8*)(Ks + (mt * 16 + cc) * KV_LD + ks * 32 + quad * 8); a = mfma16(kf, qf[ks], a); }
        s[mt] = a; }
}
__device__ __forceinline__ void pv_tile(f32x4 (&O)[4], const h16* Vs, const f32x4 (&p)[4], int cc, int quad) {
    h16x8 pf[2];
#pragma unroll
    for (int k2 = 0; k2 < 2; ++k2) pf[k2] = (h16x8){(h16)p[2 * k2][0], (h16)p[2 * k2][1], (h16)p[2 * k2][2], (h16)p[2 * k2][3], (h16)p[2 * k2 + 1][0], (h16)p[2 * k2 + 1][1], (h16)p[2 * k2 + 1][2], (h16)p[2 * k2 + 1][3]};
#pragma unroll
    for (int md = 0; md < 4; ++md)
#pragma unroll
        for (int k2 = 0; k2 < 2; ++k2) { const h16* vp = Vs + (32 * k2 + 4 * quad + (cc >> 2)) * KV_LD + md * 16 + 4 * (cc & 3);
            const h16x4 lo = tr_read(vp), hi = tr_read(vp + 16 * KV_LD);
            const h16x8 vf = {lo[0], lo[1], lo[2], lo[3], hi[0], hi[1], hi[2], hi[3]}; O[md] = mfma16(vf, pf[k2], O[md]); }
}
template <int MODE>
__device__ __forceinline__ void flash_tile(FlashState& st, const h16* Ks, const h16* Vs, const h16x8 (&qf)[2], int kv0, int tq, bool selbit, int cc, int quad) {
    f32x4 s[4]; qk_tile(s, Ks, qf, cc, quad);
    float tmax = -INFINITY;
#pragma unroll
    for (int mt = 0; mt < 4; ++mt)
#pragma unroll
        for (int j = 0; j < 4; ++j) { const int kp = kv0 + mt * 16 + quad * 4 + j;
            const bool ok = (MODE == 0) ? (selbit && kp <= tq) : (kp <= tq && kp > tq - 512);
            const float v = ok ? s[mt][j] : -INFINITY; s[mt][j] = v; tmax = fmaxf(tmax, v); }
    tmax = fmaxf(tmax, __shfl_xor(tmax, 16)); tmax = fmaxf(tmax, __shfl_xor(tmax, 32));
    const float mnew = fmaxf(st.m, tmax); const float muse = (mnew == -INFINITY) ? 0.f : mnew;
    const float alpha = ex2(st.m - muse);
    float psum = 0.f;
#pragma unroll
    for (int mt = 0; mt < 4; ++mt)
#pragma unroll
        for (int j = 0; j < 4; ++j) { const float p = ex2(s[mt][j] - muse); s[mt][j] = p; psum += p; }
    st.l = st.l * alpha + psum; st.m = mnew;
#pragma unroll
    for (int md = 0; md < 4; ++md) st.O[md] *= alpha;
    pv_tile(st.O, Vs, s, cc, quad);
}
template <bool NEEDV, class SrcFn, class CompFn>
__device__ __forceinline__ void kv_pipeline(int n, int tid, h16* Kb, h16* Vb, SrcFn src, CompFn comp) {
    if (n <= 0) return;
    const int key = tid >> 3, c8 = tid & 7; const int loff = key * KV_LD + c8 * 8;
    h16x8 kr, vr = {};
    { const h16 *kp, *vp; size_t stride; src(0, kp, vp, stride); kr = *(const h16x8*)(kp + (size_t)key * stride + c8 * 8); if (NEEDV) vr = *(const h16x8*)(vp + (size_t)key * stride + c8 * 8); }
    *(h16x8*)(Kb + loff) = kr; if (NEEDV) *(h16x8*)(Vb + loff) = vr;
    __syncthreads();
    for (int i = 0; i < n; ++i) {
        const int cur = i & 1; const bool more = (i + 1 < n);
        if (more) { const h16 *kp, *vp; size_t stride; src(i + 1, kp, vp, stride); kr = *(const h16x8*)(kp + (size_t)key * stride + c8 * 8); if (NEEDV) vr = *(const h16x8*)(vp + (size_t)key * stride + c8 * 8); }
        comp(i, Kb + cur * KV_TILE, Vb + cur * KV_TILE);
        if (more) { *(h16x8*)(Kb + (cur ^ 1) * KV_TILE + loff) = kr; if (NEEDV) *(h16x8*)(Vb + (cur ^ 1) * KV_TILE + loff) = vr; }
        __syncthreads();
    }
}
__device__ __forceinline__ void nsa_attn_unit(const Ctx& C, int l, int b, int g, int qb) {
    TIDS
    const int w = wave, cc = lane & 15, quad = lane >> 4;
    const int r = cc >> 3, ti = cc & 7, tloc = 8 * w + ti, tq = 64 * qb + tloc, h = 2 * g + r;
    const size_t rowq = (size_t)b * SEQ + tq;
    h16* Kb = (h16*)g_lds; h16* Vb = (h16*)(g_lds + 2 * KV_TILE * 2);
    float* imp = (float*)(g_lds + 36864);
    unsigned* sel = (unsigned*)(g_lds + 36864 + 32768);
    unsigned* uni = sel + 256;
    unsigned char* lst = (unsigned char*)(uni + 8);
    h16x8 qf[2];
#pragma unroll
    for (int ks = 0; ks < 2; ++ks) qf[ks] = *(const h16x8*)(C.PROJ + rowq * PN + C_NQ + h * 64 + ks * 32 + quad * 8);
    const h16* kcb = C.KC + (size_t)(b * 2 + g) * 512 * 64; const h16* vcb = C.VC + (size_t)(b * 2 + g) * 512 * 64;
    const int ncmp = 4 * qb + 3, ntile_c = (ncmp + 63) >> 6;
    auto src_cmp = [&](int i, const h16*& kp, const h16*& vp, size_t& stride) { kp = kcb + (size_t)i * 64 * 64; vp = vcb + (size_t)i * 64 * 64; stride = 64; };
    float m1 = -INFINITY, l1 = 0.f;
    kv_pipeline<false>(ntile_c, tid, Kb, Vb, src_cmp, [&](int tc, const h16* Ks, const h16*) {
        f32x4 s[4]; qk_tile(s, Ks, qf, cc, quad); float tmax = -INFINITY;
#pragma unroll
        for (int mt = 0; mt < 4; ++mt)
#pragma unroll
            for (int j = 0; j < 4; ++j) { const int n = tc * 64 + mt * 16 + quad * 4 + j; const float v = (16 * n + 31 <= tq) ? s[mt][j] : -INFINITY; s[mt][j] = v; tmax = fmaxf(tmax, v); }
        tmax = fmaxf(tmax, __shfl_xor(tmax, 16)); tmax = fmaxf(tmax, __shfl_xor(tmax, 32));
        const float mnew = fmaxf(m1, tmax), muse = (mnew == -INFINITY) ? 0.f : mnew;
        float ps = 0.f;
#pragma unroll
        for (int mt = 0; mt < 4; ++mt)
#pragma unroll
            for (int j = 0; j < 4; ++j) ps += ex2(s[mt][j] - muse);
        l1 = l1 * ex2(m1 - muse) + ps; m1 = mnew; });
    l1 += __shfl_xor(l1, 16); l1 += __shfl_xor(l1, 32);
    const float inv1 = (l1 > 0.f) ? 1.f / l1 : 0.f; const float m1u = (m1 == -INFINITY) ? 0.f : m1;
    f32x4 Oc[4];
#pragma unroll
    for (int md = 0; md < 4; ++md) Oc[md] = (f32x4){0.f, 0.f, 0.f, 0.f};
    float carry_q3 = 0.f;
    kv_pipeline<true>(ntile_c, tid, Kb, Vb, src_cmp, [&](int tc, const h16* Ks, const h16* Vs) {
        f32x4 s[4]; qk_tile(s, Ks, qf, cc, quad);
#pragma unroll
        for (int mt = 0; mt < 4; ++mt) { f32x4 a = s[mt];
#pragma unroll
            for (int j = 0; j < 4; ++j) { const int n = tc * 64 + mt * 16 + quad * 4 + j; a[j] = (16 * n + 31 <= tq) ? ex2(a[j] - m1u) * inv1 : 0.f; }
            s[mt] = a;
            const float s4 = (a[0] + a[1]) + (a[2] + a[3]); const float p3 = a[3];
            const float fromprev = __shfl(p3, (lane + 48) & 63);
            const float fromq3 = __shfl(p3, cc + 48);
            float val = s4 + ((quad == 0) ? carry_q3 : fromprev);
            carry_q3 = fromq3;
            val += __shfl_xor(val, 8);
            if (r == 0) imp[tloc * 128 + tc * 16 + mt * 4 + quad] = val; }
        pv_tile(Oc, Vs, s, cc, quad); });
    if (qb < 16) {
        if (tid < 64) { const unsigned mlo = (2u << qb) - 1u; sel[tid * 4 + 0] = mlo; sel[tid * 4 + 1] = 0u; sel[tid * 4 + 2] = 0u; sel[tid * 4 + 3] = 0u; }
    } else {
        const int jhi = qb - 2;
        const unsigned long long lt = __lanemask_lt();
        for (int t8 = 0; t8 < 8; ++t8) { const int row = 8 * w + t8; const float* ir = imp + row * 128;
            const int j1 = lane, j2 = lane + 64; const bool ok1 = (j1 >= 1 && j1 <= jhi), ok2 = (j2 <= jhi);
            const unsigned u1 = ok1 ? __float_as_uint(ir[j1]) + 1u : 0u, u2 = ok2 ? __float_as_uint(ir[j2]) + 1u : 0u;
            unsigned prefix = 0u;
            for (int bit = 30; bit >= 0; --bit) { const unsigned test = prefix | (1u << bit);
                const int cnt = __popcll(__ballot(u1 >= test)) + __popcll(__ballot(u2 >= test)); if (cnt >= 13) prefix = test; }
            const bool gt1 = u1 > prefix, gt2 = u2 > prefix, eq1 = u1 == prefix, eq2 = u2 == prefix;
            const unsigned long long bg1 = __ballot(gt1), bg2 = __ballot(gt2), be1 = __ballot(eq1), be2 = __ballot(eq2);
            const int need = 13 - __popcll(bg1) - __popcll(bg2);
            const bool s1 = gt1 || (eq1 && __popcll(be1 & lt) < need), s2 = gt2 || (eq2 && (__popcll(be1) + __popcll(be2 & lt)) < need);
            unsigned long long blo = __ballot(s1) | 1ull, bhi = __ballot(s2);
            { const int f0 = qb - 1, f1 = qb; if (f0 < 64) blo |= 1ull << f0; else bhi |= 1ull << (f0 - 64); if (f1 < 64) blo |= 1ull << f1; else bhi |= 1ull << (f1 - 64); }
            if (lane == 0) { sel[row * 4 + 0] = (unsigned)blo; sel[row * 4 + 1] = (unsigned)(blo >> 32); sel[row * 4 + 2] = (unsigned)bhi; sel[row * 4 + 3] = (unsigned)(bhi >> 32); } }
    }
    __syncthreads();
    if (w == 0) {
        unsigned o0 = sel[lane * 4 + 0], o1 = sel[lane * 4 + 1], o2 = sel[lane * 4 + 2], o3 = sel[lane * 4 + 3];
#pragma unroll
        for (int sft = 1; sft < 64; sft <<= 1) { o0 |= __shfl_xor(o0, sft); o1 |= __shfl_xor(o1, sft); o2 |= __shfl_xor(o2, sft); o3 |= __shfl_xor(o3, sft); }
        const unsigned long long mlo = ((unsigned long long)o1 << 32) | o0, mhi = ((unsigned long long)o3 << 32) | o2;
        const unsigned long long lt = __lanemask_lt(); const int nlo = __popcll(mlo);
        if ((mlo >> lane) & 1ull) lst[__popcll(mlo & lt)] = (unsigned char)lane;
        if ((mhi >> lane) & 1ull) lst[nlo + __popcll(mhi & lt)] = (unsigned char)(64 + lane);
        if (lane == 0) uni[4] = (unsigned)(nlo + __popcll(mhi));
    }
    __syncthreads();
    const unsigned long long selLo = ((unsigned long long)sel[tloc * 4 + 1] << 32) | sel[tloc * 4 + 0], selHi = ((unsigned long long)sel[tloc * 4 + 3] << 32) | sel[tloc * 4 + 2];
    const int nlist = (int)uni[4];
    FlashState fs; fs.m = -INFINITY; fs.l = 0.f;
#pragma unroll
    for (int md = 0; md < 4; ++md) fs.O[md] = (f32x4){0.f, 0.f, 0.f, 0.f};
    const h16* kslc = C.PROJ + (size_t)b * SEQ * PN + C_KSLC + g * 64; const h16* vslc = C.PROJ + (size_t)b * SEQ * PN + C_VSLC + g * 64;
    kv_pipeline<true>(nlist, tid, Kb, Vb,
        [&](int i, const h16*& kp, const h16*& vp, size_t& stride) { const int j = lst[i]; kp = kslc + (size_t)j * 64 * PN; vp = vslc + (size_t)j * 64 * PN; stride = PN; },
        [&](int i, const h16* Ks, const h16* Vs) { const int j = lst[i];
            const unsigned long long sw = (j < 64) ? selLo : selHi; const bool sb = ((sw >> (j & 63)) & 1ull) != 0ull;
            if (__any(sb)) flash_tile<0>(fs, Ks, Vs, qf, j * 64, tq, sb, cc, quad); });
    float ls = fs.l; ls += __shfl_xor(ls, 16); ls += __shfl_xor(ls, 32); const float invs = (ls > 0.f) ? 1.f / ls : 0.f;
    f32x4 Os[4];
#pragma unroll
    for (int md = 0; md < 4; ++md) Os[md] = fs.O[md] * invs;
    fs.m = -INFINITY; fs.l = 0.f;
#pragma unroll
    for (int md = 0; md < 4; ++md) fs.O[md] = (f32x4){0.f, 0.f, 0.f, 0.f};
    const h16* kwin = C.PROJ + (size_t)b * SEQ * PN + C_KWIN + g * 64; const h16* vwin = C.PROJ + (size_t)b * SEQ * PN + C_VWIN + g * 64;
    const int jw0 = (qb >= 8 ? qb - 8 : 0);
    kv_pipeline<true>(qb - jw0 + 1, tid, Kb, Vb,
        [&](int i, const h16*& kp, const h16*& vp, size_t& stride) { const int j = jw0 + i; kp = kwin + (size_t)j * 64 * PN; vp = vwin + (size_t)j * 64 * PN; stride = PN; },
        [&](int i, const h16* Ks, const h16* Vs) { flash_tile<1>(fs, Ks, Vs, qf, (jw0 + i) * 64, tq, true, cc, quad); });
    float lw = fs.l; lw += __shfl_xor(lw, 16); lw += __shfl_xor(lw, 32); const float invw = (lw > 0.f) ? 1.f / lw : 0.f;
    const float* gp = C.PSM + rowq * PSM_W + 16 + h * 3;
    const float g0 = sigmoidf_(gp[0]), g1 = sigmoidf_(gp[1]), g2 = sigmoidf_(gp[2]) * invw;
    float ssq = 0.f; f32x4 o[4];
#pragma unroll
    for (int md = 0; md < 4; ++md) { o[md] = g0 * Oc[md] + g1 * Os[md] + g2 * fs.O[md]; ssq += (o[md][0] * o[md][0] + o[md][1] * o[md][1]) + (o[md][2] * o[md][2] + o[md][3] * o[md][3]); }
    ssq += __shfl_xor(ssq, 16); ssq += __shfl_xor(ssq, 32);
    const float rs = 1.0f / sqrtf(ssq * (1.f / 64.f) + EPS);
    const float* nw = C.in[12] + l * 256 + h * 64;
#pragma unroll
    for (int md = 0; md < 4; ++md) { const int d = md * 16 + quad * 4; u32x2 wv; wv.x = pkh(o[md][0] * rs * nw[d], o[md][1] * rs * nw[d + 1]); wv.y = pkh(o[md][2] * rs * nw[d + 2], o[md][3] * rs * nw[d + 3]);
        *(u32x2*)(C.XN + rowq * 1024 + 256 + h * 64 + d) = wv; }
}

__device__ __forceinline__ void phase_ssdnorm(const Ctx& C, int l) {
    TIDS
    const int gw = C.bid * 8 + wave, NGW = C.G * 8; const float* nw = C.in[18] + l * 512 + lane * 8;
    for (int m = gw; m < MTOK; m += NGW) { const int g = lane >> 5; const f32x4 q = *(const f32x4*)(C.SSQ + (size_t)m * 8 + g * 4);
        const float rs = 1.0f / sqrtf(((q.x + q.y) + (q.z + q.w)) * (1.f / 256.f) + EPS);
        h16* p = C.XN + (size_t)m * 1024 + 512 + lane * 8; const h16x8 v = *(const h16x8*)p;
        u32x4 o; o.x = pkh((float)v[0] * rs * nw[0], (float)v[1] * rs * nw[1]); o.y = pkh((float)v[2] * rs * nw[2], (float)v[3] * rs * nw[3]);
        o.z = pkh((float)v[4] * rs * nw[4], (float)v[5] * rs * nw[5]); o.w = pkh((float)v[6] * rs * nw[6], (float)v[7] * rs * nw[7]); *(u32x4*)p = o; }
}
__device__ __forceinline__ void phase_norm(const Ctx& C, const float* src, h16* dst) {
    TIDS
    const int gw = C.bid * 8 + wave, NGW = C.G * 8;
    for (int m = gw; m < MTOK; m += NGW) rms_row_to_h16(src + (size_t)m * DM, dst + (size_t)m * DM, lane);
}
__device__ __forceinline__ void phase_final(const Ctx& C) {
    TIDS
    const int gw = C.bid * 8 + wave, NGW = C.G * 8; const f32x4* fw = (const f32x4*)C.in[23] + lane;
    for (int m = gw; m < MTOK; m += NGW) { f32x4* xr = (f32x4*)(C.out + (size_t)m * DM) + lane; f32x4 v[4]; float s = 0.f;
#pragma unroll
        for (int j = 0; j < 4; ++j) { v[j] = xr[64 * j]; s += (v[j].x * v[j].x + v[j].y * v[j].y) + (v[j].z * v[j].z + v[j].w * v[j].w); }
        const float rs = 1.0f / sqrtf(wave_sum(s) * (1.f / DM) + EPS);
#pragma unroll
        for (int j = 0; j < 4; ++j) xr[64 * j] = v[j] * rs * fw[64 * j]; }
}

constexpr int N_PHASES = 1 + 11 * DEPTH;
#ifndef PHM
#define PHM 0xffffffffu
#endif
#define EN(k) ((PHM >> (k)) & 1u)
#ifndef PROBE_PH
#define PROBE_PH -1
#define PROBE_REPS 1
#endif
#define REPN(ph) ((ph) == PROBE_PH ? PROBE_REPS : 1)
#ifndef PROBE_BIT
#define PROBE_BIT -1
#endif
#define RB(k) for (int rb_ = 0; rb_ < ((k) == PROBE_BIT && l == 0 ? 2 : 1); ++rb_)
template <int ph> __device__ __forceinline__ void run_phase(const Params* kp, int rep) {
    Ctx C; make_ctx(C, kp);
    LAS unsigned char* ldsl = (LAS unsigned char*)g_lds;
    if constexpr (ph == 0) { if (EN(0)) phase_prep(C); return; }
    constexpr int l = (ph - 1) / 11, s = (ph - 1) % 11;
    if (s == 0) { if (EN(1)) { pg8::Gemm g{(const pg8::bf16_t*)C.XN, (const pg8::bf16_t*)(C.WIN + (size_t)l * PN * DM), MTOK, PN, DM}; pg8::StaticOrder S; S.init(MTOK, PN, C.G, C.bid);
        pg8::EpiProj E{C.PROJ, C.PSM}; pg8::gemm_phase<pg8::EpiProj>(ldsl, g, S, E); } }
    else if (s == 1) { if (EN(2)) phase_tok(C, l); }
    else if (s == 2) { RB(3) for (int u = C.bid; u < 512; u += C.G) nsa_compress_unit(C, l, u);
        RB(4) ssd_states_phase(C, l, C.bid, C.G);
        RB(5) for (int u = C.bid; u < 256; u += C.G) gla_block_unit<0>(C, l, u); }
    else if (s == 3) { if (EN(6) && rep == 0) phase_scans(C);
        if (EN(7)) for (int v = C.bid; v < 1024; v += C.G) { const int bg = (v & 255) >> 5, sidx = v & 31, k = v >> 8;
            const int qb = (k == 0) ? sidx : (k == 1) ? 63 - sidx : (k == 2) ? 64 + sidx : 127 - sidx; nsa_attn_unit(C, l, bg >> 1, bg & 1, qb); } }
    else if (s == 4) { RB(8) ssd_y_phase(C, l, C.bid, C.G);
        RB(9) for (int u = C.bid; u < 256; u += C.G) gla_block_unit<1>(C, l, u); }
    else if (s == 5) { if (EN(10)) phase_ssdnorm(C, l); }
    else if (s == 6) { if (EN(11)) { pg8::Gemm g{(const pg8::bf16_t*)C.XN, (const pg8::bf16_t*)(C.WOUT + (size_t)l * DM * DM), MTOK, DM, DM}; pg8::StaticOrder S; S.init(MTOK, DM, C.G, C.bid);
        pg8::EpiRes E{l == 0 ? C.in[0] : C.out, C.out}; pg8::gemm_phase<pg8::EpiRes>(ldsl, g, S, E); } }
    else if (s == 7) { if (EN(12)) phase_norm(C, C.out, C.XN); }
    else if (s == 8) { if (EN(13)) { pg8::Gemm g{(const pg8::bf16_t*)C.XN, (const pg8::bf16_t*)(C.WUP + (size_t)l * DFF * DM), MTOK, DFF, DM}; pg8::StaticOrder S; S.init(MTOK, DFF, C.G, C.bid);
        pg8::EpiHid E{C.HID}; pg8::gemm_phase<pg8::EpiHid>(ldsl, g, S, E); } }
    else if (s == 9) { if (EN(14)) { pg8::Gemm g{(const pg8::bf16_t*)C.HID, (const pg8::bf16_t*)(C.WDN + (size_t)l * DM * DFF), MTOK, DM, DFF}; pg8::StaticOrder S; S.init(MTOK, DM, C.G, C.bid);
        pg8::EpiRes E{C.out, C.out}; pg8::gemm_phase<pg8::EpiRes>(ldsl, g, S, E); } }
    else { if (EN(15)) { if (l + 1 < DEPTH) phase_norm(C, C.out, C.XN); else phase_final(C); } }
}
constexpr int LDS_MISC = 131072;
template <int PH> __device__ __forceinline__ void phase_seq(const Params* kp, int lo, int hi, cg::grid_group& grid, const XcdBarrier& bar) {
    if constexpr (PH < N_PHASES) {
        if (lo <= PH && PH < hi) {
            for (int rep = 0; rep < REPN(PH); ++rep) run_phase<PH>(kp, rep);
            if (PH + 1 < hi) { if (PH == 0) grid.sync(); else xcd_barrier(bar); }
        }
        phase_seq<PH + 1>(kp, lo, hi, grid, bar);
    }
}
__global__ void __launch_bounds__(512, 2) fwd_kernel(Params P) {
    const Params* kp = &P;
    cg::grid_group grid = cg::this_grid();
    volatile LAS unsigned* st = (volatile LAS unsigned*)((LAS unsigned char*)g_lds + LDS_MISC);
    if (threadIdx.x < 2) st[threadIdx.x] = 0u;
    __syncthreads();
    const XcdBarrier bar = xcd_barrier_post((unsigned*)P.ws, st);
    phase_seq<0>(kp, P.ph_lo, P.ph_hi, grid, bar);
}

extern "C" void kernel_launch(void* const* d_in, const int* in_sizes, int n_in, void* d_out, int out_size, void* d_ws, size_t ws_size, hipStream_t stream) {
    static int grid = 0;
    if (grid == 0) {
        if (n_in != 24 || in_sizes[0] != MTOK * DM || out_size != MTOK * DM || ws_size < WS_END) { fprintf(stderr, "kernel_launch: unexpected shapes (n_in %d, ws %zu)\n", n_in, ws_size); grid = -1; return; }
        int dev = 0, cus = 0, per_cu = 0;
        hipGetDevice(&dev); hipDeviceGetAttribute(&cus, hipDeviceAttributeMultiprocessorCount, dev);
        hipFuncSetAttribute((const void*)fwd_kernel, hipFuncAttributeMaxDynamicSharedMemorySize, LDS_BYTES);
        hipOccupancyMaxActiveBlocksPerMultiprocessor(&per_cu, (const void*)fwd_kernel, 512, LDS_BYTES);
        (void)hipGetLastError();
        if (per_cu < 1) { fprintf(stderr, "kernel_launch: occupancy query says %d blocks/CU\n", per_cu); grid = -1; return; }
        grid = cus;
    }
    if (grid < 0) return;
    (void)hipMemsetAsync(d_ws, 0, 16384, stream);
    Params p{};
    for (int i = 0; i < 24; ++i) p.in[i] = (const float*)d_in[i];
    p.out = (float*)d_out; p.ws = (unsigned char*)d_ws;
#if MK_MULTI_LAUNCH
    for (int ph = 0; ph < N_PHASES; ++ph) { p.ph_lo = ph; p.ph_hi = ph + 1; hipLaunchKernelGGL(fwd_kernel, dim3(grid), dim3(512), LDS_BYTES, stream, p); }
#else
    p.ph_lo = 0; p.ph_hi = N_PHASES;
    void* args[] = {&p};
    hipError_t e = hipLaunchCooperativeKernel((const void*)fwd_kernel, dim3(grid), dim3(512), args, LDS_BYTES, stream);
    if (e != hipSuccess) fprintf(stderr, "cooperative launch failed: %s (grid %d)\n", hipGetErrorString(e), grid);
#endif
}
```

```cpp
#include <hip/hip_runtime.h>
#include <hip/hip_cooperative_groups.h>
#include <cstdio>
#include <cstdint>
namespace cg = cooperative_groups;

#ifndef MK_MULTI_LAUNCH
#define MK_MULTI_LAUNCH 0
#endif
#ifndef MK_COOP
#define MK_COOP 0
#endif

#define LAS __attribute__((address_space(3)))
typedef _Float16 h16;
typedef _Float16 h16x8 __attribute__((ext_vector_type(8)));
typedef _Float16 h16x4 __attribute__((ext_vector_type(4)));
typedef _Float16 h16x2 __attribute__((ext_vector_type(2)));
typedef float f32x4 __attribute__((ext_vector_type(4)));
typedef float f32x2 __attribute__((ext_vector_type(2)));
typedef unsigned u32x4 __attribute__((ext_vector_type(4)));
typedef unsigned u32x2 __attribute__((ext_vector_type(2)));

constexpr int BATCH = 4, SEQ = 8192, DM = 1024, MTOK = BATCH * SEQ, DEPTH = 2;
constexpr int DIN = 3364, PN = 3584, DFF = 4096;
constexpr float EPS = 1e-6f;
constexpr int C_GQ = 0, C_GK = 128, C_GV = 256, C_GR = 512, C_NQ = 768, C_NKV = 1024, C_SZ = 1792, C_SX = 2304, C_SM = 3328;
constexpr int C_KCMP = C_NKV, C_VCMP = C_NKV + 128, C_KSLC = C_NKV + 256, C_VSLC = C_NKV + 384, C_KWIN = C_NKV + 512, C_VWIN = C_NKV + 640;
constexpr int PSM_W = 64;

constexpr size_t MiB = 1u << 20;
constexpr size_t WS_WIN = 2 * MiB;
constexpr size_t WS_WOUT = 16 * MiB;
constexpr size_t WS_WUP = 20 * MiB;
constexpr size_t WS_WDN = 36 * MiB;
constexpr size_t WS_W1T = 52 * MiB;
constexpr size_t WS_W2T = 54 * MiB;
constexpr size_t WS_B1 = 16384;
constexpr size_t WS_ROPE = 55 * MiB;
constexpr size_t WS_XN = 60 * MiB;
constexpr size_t WS_PROJ = 124 * MiB;
constexpr size_t WS_HID = 124 * MiB;
constexpr size_t WS_XBCC = 348 * MiB;
constexpr size_t WS_SSDST = 444 * MiB;
constexpr size_t WS_GLAST = 476 * MiB;
constexpr size_t WS_PSM = 492 * MiB;
constexpr size_t WS_KC = 500 * MiB;
constexpr size_t WS_VC = 500 * MiB + 512 * 1024;
constexpr size_t WS_SSQ = 501 * MiB;
constexpr size_t WS_DTV = 502 * MiB;
constexpr size_t WS_ACS = 503 * MiB;
constexpr size_t WS_CD = 504 * MiB;
constexpr size_t WS_GLAG = 504 * MiB + 64 * 1024;
constexpr size_t WS_RSS = 505 * MiB;
constexpr size_t WS_B1P = 54 * MiB + 256 * 1024;
constexpr size_t WS_H16 = 380 * MiB;
constexpr size_t WS_END = 509 * MiB;

constexpr int LDS_BYTES = 147456;
constexpr int LDS_MISC = 131072;
extern __shared__ __attribute__((aligned(16))) unsigned char g_lds[];

struct Params { const float* in[24]; float* out; unsigned char* ws; int ph_lo, ph_hi; };

__constant__ float ROPE_INV[32] = {
 1.000000000e+00f, 7.498942614e-01f, 5.623413324e-01f, 4.216965139e-01f, 3.162277639e-01f, 2.371373773e-01f, 1.778279394e-01f, 1.333521307e-01f,
 1.000000015e-01f, 7.498941571e-02f, 5.623413250e-02f, 4.216965288e-02f, 3.162277490e-02f, 2.371373773e-02f, 1.778279431e-02f, 1.333521493e-02f,
 9.999999776e-03f, 7.498941850e-03f, 5.623413250e-03f, 4.216964822e-03f, 3.162277630e-03f, 2.371373586e-03f, 1.778279431e-03f, 1.333521446e-03f,
 1.000000047e-03f, 7.498942432e-04f, 5.623413017e-04f, 4.216965172e-04f, 3.162277571e-04f, 2.371373703e-04f, 1.778279402e-04f, 1.333521504e-04f };

__device__ __forceinline__ f32x4 mfma16(h16x8 a, h16x8 b, f32x4 c) { return __builtin_amdgcn_mfma_f32_16x16x32_f16(a, b, c, 0, 0, 0); }
__device__ __forceinline__ float wave_sum(float v) {
#pragma unroll
    for (int o = 1; o < 64; o <<= 1) v += __shfl_xor(v, o);
    return v;
}
__device__ __forceinline__ float ex2(float x) { return __builtin_amdgcn_exp2f(x); }
__device__ __forceinline__ float max3f(float a, float b, float c) { return __builtin_fmaxf(__builtin_fmaxf(a, b), c); }
__device__ __forceinline__ float sigmoidf_(float x) { return 1.f / (1.f + __expf(-x)); }
__device__ __forceinline__ float siluf_(float x) { return x / (1.f + __expf(-x)); }
__device__ __forceinline__ float softplusf_(float x) { return fmaxf(x, 0.f) + log1pf(__expf(-fabsf(x))); }
typedef __bf16 bf16x2_t __attribute__((ext_vector_type(2)));
__device__ __forceinline__ unsigned pkb(float lo, float hi) { f32x2 v = {lo, hi}; bf16x2_t b = __builtin_convertvector(v, bf16x2_t); return __builtin_bit_cast(unsigned, b); }
__device__ __forceinline__ unsigned pkh(float lo, float hi) { h16x2 v = {(h16)lo, (h16)hi}; return __builtin_bit_cast(unsigned, v); }

__device__ __forceinline__ int opaque_lane() { int t = __builtin_amdgcn_mbcnt_hi(~0u, __builtin_amdgcn_mbcnt_lo(~0u, 0u)); asm volatile("" : "+v"(t)); return t; }
__device__ __forceinline__ float row_ssq16(const float* ssq, int row) {
    const f32x4* p = (const f32x4*)(ssq + (size_t)row * 16); const f32x4 a = p[0], b = p[1], c = p[2], d = p[3];
    return (((a.x + a.y) + (a.z + a.w)) + ((b.x + b.y) + (b.z + b.w))) + (((c.x + c.y) + (c.z + c.w)) + ((d.x + d.y) + (d.z + d.w))); }
namespace pg8 {
typedef unsigned short bf16_t;
typedef __bf16 bf16x8_t __attribute__((ext_vector_type(8)));
constexpr int BM = 256, BK = 64, HALF = 128, HTB = HALF * BK * 2, STAGE_BYTES = 8 * HTB, NXCD = 8, WGM = 8;
__host__ __device__ __forceinline__ int lds_byte(int r, int c) { const int st = (r >> 4) * 2 + (c >> 5), rr = r & 15, cc = c & 31, ob = rr * 64 + cc * 2; return st * 1024 + (ob ^ (((ob >> 9) & 1) << 5)); }
__host__ __device__ __forceinline__ void stage_rc(int b, int& R, int& C) { const int st = b / 1024, sb = b % 1024, swz = sb ^ (((sb >> 9) & 1) << 5); R = (st >> 1) * 16 + swz / 64; C = (st & 1) * 32 + (swz % 64) / 2; }
__host__ __device__ __forceinline__ int perm32(int rho) { const int n = rho >> 4, i = rho & 15; return 8 * (i >> 2) + 4 * n + (i & 3); }
struct Unit { int pm, pn; };
struct Gemm { const bf16_t* A; const bf16_t* Bt; int M, N, K; };
struct StaticOrder {
    int nM, nN, nwg, G, c;
    __device__ void init(int M, int N, int G_, int c_) { nM = M / BM; nN = N / BM; nwg = nM * nN; G = G_; c = c_; }
    __device__ bool next(int i, Unit& u) const {
        const long L = (long)i * G + c; if (L >= nwg) return false;
        int wgid = (int)L; { const int q = nwg / NXCD, r = nwg % NXCD, xcd = wgid % NXCD, off = wgid / NXCD; wgid = (xcd < r ? xcd * (q + 1) : r * (q + 1) + (xcd - r) * q) + off; }
        const int nig = WGM * nN, gid = wgid / nig, fm = gid * WGM, gsz = (nM - fm) < WGM ? (nM - fm) : WGM;
        u.pm = fm + ((wgid % nig) % gsz); u.pn = (wgid % nig) / gsz; return true;
    }
};
struct EpiProj {
    static constexpr bool PERM = true;
    h16* O; float* PSM; const float* ssq;
    __device__ __forceinline__ void operator()(const f32x4 (&acc)[2][2][4][2], const Unit& u, int wr, int wc, int fr, int fq) const {
        const int row0 = u.pm * BM + wr * 64 + fr, col0 = u.pn * BM + wc * 32 + 8 * fq;
#pragma unroll
        for (int ai = 0; ai < 2; ++ai)
#pragma unroll
            for (int m = 0; m < 4; ++m) { const int row = row0 + ai * HALF + m * 16; const float rs = ssq ? 1.0f / sqrtf(row_ssq16(ssq, row) * (1.f / DM) + EPS) : 1.f;
#pragma unroll
                for (int bj = 0; bj < 2; ++bj) { const f32x4 v0 = acc[ai][bj][m][0] * rs, v1 = acc[ai][bj][m][1] * rs; const int c = col0 + bj * HALF;
                    u32x4 w; w.x = pkh(v0[0], v0[1]); w.y = pkh(v0[2], v0[3]); w.z = pkh(v1[0], v1[1]); w.w = pkh(v1[2], v1[3]);
                    *(u32x4*)(O + (size_t)row * PN + c) = w;
                    if (c >= C_SM && c < C_SM + PSM_W) { float* p = PSM + (size_t)row * PSM_W + (c - C_SM); *(f32x4*)p = v0; *(f32x4*)(p + 4) = v1; } } }
    }
};
struct EpiHid {
    static constexpr bool PERM = true;
    h16* O; const float* ssq;
    __device__ __forceinline__ void operator()(const f32x4 (&acc)[2][2][4][2], const Unit& u, int wr, int wc, int fr, int fq) const {
        const int row0 = u.pm * BM + wr * 64 + fr, col0 = u.pn * BM + wc * 32 + 8 * fq;
#pragma unroll
        for (int ai = 0; ai < 2; ++ai)
#pragma unroll
            for (int m = 0; m < 4; ++m) { const int row = row0 + ai * HALF + m * 16; const float rs = 1.0f / sqrtf(row_ssq16(ssq, row) * (1.f / DM) + EPS);
#pragma unroll
                for (int bj = 0; bj < 2; ++bj) { f32x4 v0 = acc[ai][bj][m][0] * rs, v1 = acc[ai][bj][m][1] * rs;
#pragma unroll
                    for (int e = 0; e < 4; ++e) { float a = fmaxf(v0[e], 0.f), b = fmaxf(v1[e], 0.f); v0[e] = a * a; v1[e] = b * b; }
                    u32x4 w; w.x = pkb(v0[0], v0[1]); w.y = pkb(v0[2], v0[3]); w.z = pkb(v1[0], v1[1]); w.w = pkb(v1[2], v1[3]);
                    *(u32x4*)(O + (size_t)row * DFF + col0 + bj * HALF) = w; } }
    }
};
struct EpiRes {
    static constexpr bool PERM = false;
    const float* base32; h16* hs; float* ssq;
    __device__ __forceinline__ void operator()(const f32x4 (&acc)[2][2][4][2], const Unit& u, int wr, int wc, int fr, int fq) const {
        const int col0 = u.pn * BM + wc * 32 + 4 * fq;
#pragma unroll
        for (int ai = 0; ai < 2; ++ai)
#pragma unroll
            for (int m = 0; m < 4; ++m) { const int row = u.pm * BM + ai * HALF + wr * 64 + m * 16 + fr; const size_t off = (size_t)row * DM + col0; float sq = 0.f;
#pragma unroll
                for (int bj = 0; bj < 2; ++bj)
#pragma unroll
                    for (int n = 0; n < 2; ++n) { f32x4 bs;
                        if (base32) bs = *(const f32x4*)(base32 + off + bj * HALF + n * 16);
                        else { const h16x4 b4 = *(const h16x4*)(hs + off + bj * HALF + n * 16); bs = (f32x4){(float)b4[0], (float)b4[1], (float)b4[2], (float)b4[3]}; }
                        const f32x4 hv = bs + acc[ai][bj][m][n];
                        const h16x4 h4 = {(h16)hv[0], (h16)hv[1], (h16)hv[2], (h16)hv[3]}; *(h16x4*)(hs + off + bj * HALF + n * 16) = h4;
                        const float r0 = (float)h4[0], r1 = (float)h4[1], r2 = (float)h4[2], r3 = (float)h4[3];
                        sq += (r0 * r0 + r1 * r1) + (r2 * r2 + r3 * r3); }
                sq += __shfl_xor(sq, 16); sq += __shfl_xor(sq, 32);
                if (fq == 0) ssq[(size_t)row * 16 + u.pn * 4 + wc] = sq; }
    }
};

template <class Epi, bool BF = false>
__device__ __forceinline__ void gemm_phase(LAS unsigned char* lds, const Gemm g, const StaticOrder& S, const Epi& E, int wid) {
    const int lane = opaque_lane(), tid = wid * 64 + lane, wr = wid >> 2, wc = wid & 3, fr = lane & 15, fq = lane >> 4;
    const int K = g.K, nt = K / BK;
    unsigned voffA[2], voffB[2];
#pragma unroll
    for (int i = 0; i < 2; ++i) { int R, C; stage_rc(tid * 16 + i * 8192, R, C); const int Rb = Epi::PERM ? ((R & ~31) + perm32(R & 31)) : R;
        voffA[i] = (unsigned)(R * K + C) * 2u; voffB[i] = (unsigned)(Rb * K + C) * 2u; }
    const size_t kstep = (size_t)(BK * 2);
    const size_t hstep = (size_t)HALF * K * 2;
    const size_t tstep = 2 * hstep;
    const unsigned ldsw = (unsigned)wid * 1024u;
    const int aoff = lds_byte(wr * 64 + fr, fq * 8), boff = lds_byte(wc * 32 + fr, fq * 8);
#define PG8_SA(b, h) (((b) * 2 + (h)) * HTB)
#define PG8_SB(b, h) ((4 + (b) * 2 + (h)) * HTB)
#define PG8_STAGE(bufoff, gbase, voff) do { _Pragma("unroll") for (int _i = 0; _i < 2; ++_i) \
        __builtin_amdgcn_global_load_lds((const unsigned*)((const char*)(gbase) + (voff)[_i]), (LAS unsigned*)(lds + (bufoff) + ldsw + _i * 8192), 16, 0, 0); } while (0)
#define PG8_LDA(dst, b, h) do { _Pragma("unroll") for (int m = 0; m < 4; ++m) _Pragma("unroll") for (int k = 0; k < 2; ++k) dst[m][k] = *(const LAS h16x8*)(lds + PG8_SA(b, h) + aoff + m * 2048 + k * 1024); } while (0)
#define PG8_LDB(dst, b, h) do { _Pragma("unroll") for (int n = 0; n < 2; ++n) _Pragma("unroll") for (int k = 0; k < 2; ++k) dst[n][k] = *(const LAS h16x8*)(lds + PG8_SB(b, h) + boff + n * 2048 + k * 1024); } while (0)
#define PG8_MMA(ai, bj, At, Bt) do { __builtin_amdgcn_s_setprio(1); _Pragma("unroll") for (int m = 0; m < 4; ++m) _Pragma("unroll") for (int n = 0; n < 2; ++n) _Pragma("unroll") for (int k = 0; k < 2; ++k) \
        acc[ai][bj][m][n] = BF ? __builtin_amdgcn_mfma_f32_16x16x32_bf16(__builtin_bit_cast(bf16x8_t, Bt[n][k]), __builtin_bit_cast(bf16x8_t, At[m][k]), acc[ai][bj][m][n], 0, 0, 0) : __builtin_amdgcn_mfma_f32_16x16x32_f16(Bt[n][k], At[m][k], acc[ai][bj][m][n], 0, 0, 0); __builtin_amdgcn_s_setprio(0); } while (0)
#define PG8_WAIT_V(n) asm volatile("s_waitcnt vmcnt(" #n ")" ::: "memory")
#define PG8_WAIT_L(n) asm volatile("s_waitcnt lgkmcnt(" #n ")" ::: "memory")
#define PG8_BAR __builtin_amdgcn_s_barrier()
#define PG8_SCHED __builtin_amdgcn_sched_barrier(0)
    Unit cur, nxt; int ui = 0;
    if (!S.next(0, cur)) return;
    f32x4 acc[2][2][4][2];
#pragma unroll
    for (int a = 0; a < 2; ++a)
#pragma unroll
        for (int b = 0; b < 2; ++b)
#pragma unroll
            for (int m = 0; m < 4; ++m)
#pragma unroll
                for (int n = 0; n < 2; ++n) acc[a][b][m][n] = (f32x4){0.f, 0.f, 0.f, 0.f};
    h16x8 At[4][2], B0[2][2], B1[2][2];
    const char* cA = (const char*)g.A + (size_t)cur.pm * tstep; const char* cB = (const char*)g.Bt + (size_t)cur.pn * tstep;
    PG8_STAGE(PG8_SB(0, 0), cB, voffB); PG8_STAGE(PG8_SB(0, 1), cB + hstep, voffB); PG8_STAGE(PG8_SA(0, 0), cA, voffA); PG8_STAGE(PG8_SA(0, 1), cA + hstep, voffA);
    if (wr == 1) PG8_BAR;
    PG8_WAIT_V(2); PG8_BAR;
    PG8_STAGE(PG8_SB(1, 0), cB + kstep, voffB); PG8_STAGE(PG8_SA(1, 0), cA + kstep, voffA); PG8_STAGE(PG8_SB(1, 1), cB + hstep + kstep, voffB);
    PG8_WAIT_V(6); PG8_BAR;
    for (;;) {
        const bool has_next = S.next(ui + 1, nxt);
        const char* nA = has_next ? (const char*)g.A + (size_t)nxt.pm * tstep : cA; const char* nB = has_next ? (const char*)g.Bt + (size_t)nxt.pn * tstep : cB;
        for (int t = 0; t < nt; t += 2) {
            const bool last = (t == nt - 2);
            const char* a1 = cA + (size_t)(t + 1) * kstep;
            const char* a2 = last ? nA : cA + (size_t)(t + 2) * kstep; const char* b2 = last ? nB : cB + (size_t)(t + 2) * kstep;
            const char* a3 = a2 + kstep; const char* b3 = b2 + kstep;
            PG8_LDB(B0, 0, 0); PG8_LDB(B1, 0, 1); PG8_SCHED; PG8_LDA(At, 0, 0); PG8_STAGE(PG8_SA(1, 1), a1 + hstep, voffA);
            PG8_WAIT_V(8); PG8_WAIT_L(0); PG8_BAR; PG8_MMA(0, 0, At, B0); PG8_MMA(0, 1, At, B1); PG8_BAR; PG8_SCHED;
            PG8_LDA(At, 0, 1); PG8_STAGE(PG8_SB(0, 0), b2, voffB); PG8_STAGE(PG8_SB(0, 1), b2 + hstep, voffB); PG8_STAGE(PG8_SA(0, 0), a2, voffA);
            PG8_WAIT_V(8); PG8_WAIT_L(0); PG8_BAR; PG8_MMA(1, 0, At, B0); PG8_MMA(1, 1, At, B1); PG8_BAR; PG8_SCHED;
            PG8_LDB(B0, 1, 0); PG8_LDB(B1, 1, 1); PG8_SCHED; PG8_LDA(At, 1, 0); PG8_STAGE(PG8_SA(0, 1), a2 + hstep, voffA);
            PG8_WAIT_V(8); PG8_WAIT_L(0); PG8_BAR; PG8_MMA(0, 0, At, B0); PG8_MMA(0, 1, At, B1); PG8_BAR; PG8_SCHED;
            PG8_LDA(At, 1, 1); PG8_STAGE(PG8_SB(1, 0), b3, voffB); PG8_STAGE(PG8_SB(1, 1), b3 + hstep, voffB); PG8_STAGE(PG8_SA(1, 0), a3, voffA);
            PG8_WAIT_V(8); PG8_WAIT_L(0); PG8_BAR; PG8_MMA(1, 0, At, B0); PG8_MMA(1, 1, At, B1); PG8_BAR; PG8_SCHED;
        }
        if (wr == 0) PG8_BAR;
        E(acc, cur, wr, wc, fr, fq);
        if (!has_next) break;
#pragma unroll
        for (int a = 0; a < 2; ++a)
#pragma unroll
            for (int b = 0; b < 2; ++b)
#pragma unroll
                for (int m = 0; m < 4; ++m)
#pragma unroll
                    for (int n = 0; n < 2; ++n) acc[a][b][m][n] = (f32x4){0.f, 0.f, 0.f, 0.f};
        cur = nxt; cA = nA; cB = nB; ++ui;
        if (wr == 1) PG8_BAR;
    }
    PG8_WAIT_V(0);
    PG8_BAR;
#undef PG8_SA
#undef PG8_SB
#undef PG8_STAGE
#undef PG8_LDA
#undef PG8_LDB
#undef PG8_MMA
#undef PG8_WAIT_V
#undef PG8_WAIT_L
#undef PG8_BAR
#undef PG8_SCHED
}
}


#define XB_TMO      128
#define XB_XCNT(j)  (256  + 64 * (j))
#define XB_XSUB(j)  (1280 + 64 * (j))
#define XB_XGEN(j)  (2304 + 64 * (j))
#define XB_TOP      3328
#define XB_TOPGEN   3392
#define XCD_BAR_WORDS 3456
#define XB_SPIN_CAP (1u << 18)
__device__ __forceinline__ unsigned xb_ld(unsigned* p)              { return __hip_atomic_load(p, __ATOMIC_RELAXED, __HIP_MEMORY_SCOPE_AGENT); }
__device__ __forceinline__ unsigned xb_add(unsigned* p, unsigned v) { return __hip_atomic_fetch_add(p, v, __ATOMIC_RELAXED, __HIP_MEMORY_SCOPE_AGENT); }
__device__ __forceinline__ unsigned xb_xcc_id() { return (unsigned)__builtin_amdgcn_s_getreg((3 << 11) | 20) & 0xFu; }
#define XB_SPIN(cond, bar) do { unsigned _sp = 0; while (cond) { __builtin_amdgcn_s_sleep(1); \
    if ((++_sp & 255u) == 0u) { if (xb_ld(&(bar)[XB_TMO])) break; if (_sp > XB_SPIN_CAP) { atomicAdd(&(bar)[XB_TMO], 1u); break; } } } } while (0)
struct XcdBarrier { unsigned* bar; unsigned x; volatile LAS unsigned* st; int wv; };
__device__ __forceinline__ XcdBarrier xcd_barrier_post(unsigned* bar, volatile LAS unsigned* st, int wv) {
    XcdBarrier b; b.bar = bar; b.x = xb_xcc_id(); b.st = st; b.wv = wv;
    if (wv == 0 && opaque_lane() == 0) (void)xb_add(&bar[XB_XCNT(b.x)], 1u);
    return b;
}
__device__ __forceinline__ void xcd_barrier_complete(unsigned* bar, unsigned x, unsigned& nloc, unsigned& nx) {
    const unsigned G = gridDim.x * gridDim.y * gridDim.z;
    unsigned sum, cnt, mine, sp = 0u;
    for (;;) {
        sum = 0u; cnt = 0u; mine = 0u;
#pragma unroll
        for (unsigned j = 0; j < 16; ++j) { const unsigned c = xb_ld(&bar[XB_XCNT(j)]); sum += c; cnt += (c > 0u) ? 1u : 0u; mine = (j == x) ? c : mine; }
        if (sum == G) break;
        __builtin_amdgcn_s_sleep(1);
        if ((++sp & 255u) == 0u) { if (xb_ld(&bar[XB_TMO])) break; if (sp > XB_SPIN_CAP) { atomicAdd(&bar[XB_TMO], 1u); break; } }
    }
    nloc = mine > 0u ? mine : 1u; nx = cnt > 0u ? cnt : 1u;
}
__device__ __forceinline__ void xcd_barrier(const XcdBarrier& b) {
    asm volatile("s_waitcnt vmcnt(0)" ::: "memory");
    __syncthreads();
    if (b.wv == 0 && opaque_lane() == 0) {
        unsigned* bar = b.bar;
        __builtin_amdgcn_s_waitcnt(0);
        unsigned nloc = b.st[0], nx = b.st[1];
        if (nloc == 0u) { xcd_barrier_complete(bar, b.x, nloc, nx); b.st[0] = nloc; b.st[1] = nx; }
        const unsigned old = xb_add(&bar[XB_XSUB(b.x)], 1u);
        const unsigned gen = old / nloc;
        if (old + 1u == (gen + 1u) * nloc) {
            __builtin_amdgcn_fence(__ATOMIC_RELEASE, "agent");
            asm volatile("s_waitcnt vmcnt(0)" ::: "memory");
            const unsigned og = xb_add(&bar[XB_TOP], 1u);
            const unsigned tg = og / nx;
            if (og + 1u == (tg + 1u) * nx) xb_add(&bar[XB_TOPGEN], 1u);
            else XB_SPIN(xb_ld(&bar[XB_TOPGEN]) == tg, bar);
            __builtin_amdgcn_fence(__ATOMIC_ACQUIRE, "agent");
            xb_add(&bar[XB_XGEN(b.x)], 1u);
            asm volatile("s_waitcnt vmcnt(0)" ::: "memory");
        } else {
            XB_SPIN(xb_ld(&bar[XB_XGEN(b.x)]) == gen, bar);
            __builtin_amdgcn_fence(__ATOMIC_ACQUIRE, "agent");
            asm volatile("s_waitcnt vmcnt(0)" ::: "memory");
        }
    }
    __syncthreads();
}

#define TIDS const int lane = opaque_lane(); const int wave = C.wv; const int tid = wave * 64 + lane; (void)tid;
struct Ctx {
    const float* in[24]; float* out; unsigned char* ws;
    int G, bid, wv;
    h16 *WIN, *WOUT, *WUP, *WDN, *W1T, *W2T, *XN, *PROJ, *HID, *XBCC, *KC, *VC;
    h16* SSDST; float *B1P, *B1, *ROPE, *GLAST, *PSM, *SSQ, *DTV, *ACS, *CD, *GLAG, *RSS; h16* H16;
};
__device__ __forceinline__ void make_ctx(Ctx& C, const Params* kp, int wv) {
    C.wv = wv;
#pragma unroll
    for (int i = 0; i < 24; ++i) C.in[i] = kp->in[i];
    C.out = kp->out; unsigned char* ws = kp->ws; C.ws = ws; C.G = gridDim.x; C.bid = blockIdx.x;
    C.WIN = (h16*)(ws + WS_WIN); C.WOUT = (h16*)(ws + WS_WOUT); C.WUP = (h16*)(ws + WS_WUP); C.WDN = (h16*)(ws + WS_WDN); C.W1T = (h16*)(ws + WS_W1T); C.W2T = (h16*)(ws + WS_W2T);
    C.XN = (h16*)(ws + WS_XN); C.PROJ = (h16*)(ws + WS_PROJ); C.HID = (h16*)(ws + WS_HID); C.XBCC = (h16*)kp->out;      C.KC = (h16*)(ws + WS_KC); C.VC = (h16*)(ws + WS_VC);
    C.B1 = (float*)(ws + WS_B1); C.B1P = (float*)(ws + WS_B1P); C.ROPE = (float*)(ws + WS_ROPE); C.SSDST = (h16*)(ws + WS_SSDST); C.RSS = (float*)(ws + WS_RSS); C.H16 = (h16*)(ws + WS_H16); C.GLAST = (float*)(ws + WS_GLAST); C.PSM = (float*)(ws + WS_PSM);
    C.SSQ = (float*)(ws + WS_SSQ); C.DTV = (float*)(ws + WS_DTV); C.ACS = (float*)(ws + WS_ACS); C.CD = (float*)(ws + WS_CD); C.GLAG = (float*)(ws + WS_GLAG);
}

__device__ __forceinline__ int win_src_col(int n) {
    if (n < 512) return n;
    if (n < 768) return n - 512 + 528;
    if (n < 1024) return n - 768 + 784;
    if (n < 1792) return n - 1024 + 1040;
    if (n < 2304) return n - 1792 + 1820;
    if (n < 3328) return n - 2304 + 2332;
    const int r = n - 3328;
    if (r < 16) return 512 + r;
    if (r < 28) return 1808 + (r - 16);
    if (r < 36) return 3356 + (r - 28);
    return -1;
}
template <bool MAPW, bool OBF = false>
__device__ __forceinline__ void transpose_item(const float* W, int K, int Nsrc, int Ndst, h16* WT, const float* kscale, float* scr, int item, int lane) {
    const int nblk = Ndst / 32, kb = item / nblk, nb = item % nblk, k0 = 64 * kb, n0 = 32 * nb;
    const int nd = n0 + (lane & 31); const int sc = MAPW ? win_src_col(nd) : nd;
    float vv[32];
#pragma unroll
    for (int i = 0; i < 32; ++i) { const int kk = 2 * i + (lane >> 5); vv[i] = (sc >= 0) ? W[(size_t)(k0 + kk) * Nsrc + sc] : 0.f; }
#pragma unroll
    for (int i = 0; i < 32; ++i) { const int kk = 2 * i + (lane >> 5); scr[kk * 33 + (lane & 31)] = kscale ? vv[i] * kscale[k0 + kk] : vv[i]; }
    asm volatile("s_waitcnt lgkmcnt(0)" ::: "memory");
    const int c = lane & 7;
#pragma unroll
    for (int j = 0; j < 4; ++j) { const int n = (lane >> 3) + 8 * j; const float* s = scr + (8 * c) * 33 + n;
        u32x4 o; if (OBF) { o.x = pkb(s[0 * 33], s[1 * 33]); o.y = pkb(s[2 * 33], s[3 * 33]); o.z = pkb(s[4 * 33], s[5 * 33]); o.w = pkb(s[6 * 33], s[7 * 33]); } else { o.x = pkh(s[0 * 33], s[1 * 33]); o.y = pkh(s[2 * 33], s[3 * 33]); o.z = pkh(s[4 * 33], s[5 * 33]); o.w = pkh(s[6 * 33], s[7 * 33]); }
        *(u32x4*)(WT + (size_t)(n0 + n) * K + k0 + 8 * c) = o; }
    asm volatile("s_waitcnt lgkmcnt(0)" ::: "memory");
}
__device__ __forceinline__ void rms_row_to_h16(const float* xrow, h16* orow, int lane) {
    const f32x4* xr = (const f32x4*)xrow + lane; f32x4 v[4]; float s = 0.f;
#pragma unroll
    for (int j = 0; j < 4; ++j) { v[j] = xr[64 * j]; s += (v[j].x * v[j].x + v[j].y * v[j].y) + (v[j].z * v[j].z + v[j].w * v[j].w); }
    const float rs = 1.0f / sqrtf(wave_sum(s) * (1.f / DM) + EPS);
    u32x2* o8 = (u32x2*)orow + lane;
#pragma unroll
    for (int j = 0; j < 4; ++j) { u32x2 w; w.x = pkh(v[j].x * rs, v[j].y * rs); w.y = pkh(v[j].z * rs, v[j].w * rs); o8[64 * j] = w; }
}
__device__ __forceinline__ void sincos_acc(float angf, float& c, float& s) {
    const double x = (double)angf; const double n = __builtin_rint(x * 0.63661977236758134308);
    const double r = __builtin_fma(-n, 1.5707963267948966192, x) - n * 6.123233995736766036e-17;
    const double r2 = r * r;
    double sp = -7.6471637318198164759e-13; sp = sp * r2 + 1.6059043836821614599e-10; sp = sp * r2 - 2.5052108385441718775e-08; sp = sp * r2 + 2.7557319223985890653e-06;
    sp = sp * r2 - 1.9841269841269841270e-04; sp = sp * r2 + 8.3333333333333333333e-03; sp = sp * r2 - 1.6666666666666666667e-01; const double sn = r + r * r2 * sp;
    double cp = 4.7794773323873852974e-14; cp = cp * r2 - 1.1470745597729724714e-11; cp = cp * r2 + 2.0876756987868098979e-09; cp = cp * r2 - 2.7557319223985890653e-07;
    cp = cp * r2 + 2.4801587301587301587e-05; cp = cp * r2 - 1.3888888888888888889e-03; cp = cp * r2 + 4.1666666666666666667e-02; cp = cp * r2 - 0.5; const double cs = 1.0 + r2 * cp;
    const int q = ((int)n) & 3;
    const double so = (q == 0) ? sn : (q == 1) ? cs : (q == 2) ? -sn : -cs;
    const double co = (q == 0) ? cs : (q == 1) ? -sn : (q == 2) ? -cs : sn;
    c = (float)co; s = (float)so;
}
__device__ __forceinline__ void phase_prep(const Ctx& C) {
    TIDS
    float* scr = (float*)(g_lds) + wave * (64 * 33);
    const int gw = C.bid * 8 + wave, NGW = C.G * 8;
    constexpr int I_IN = 16 * (PN / 32), I_OUT = 16 * 32, I_UP = 16 * 128, I_DN = 64 * 32, I_W1 = 32 * 4, I_W2 = 2 * 2;
    constexpr int PER_L = I_IN + I_OUT + I_UP + I_DN + 2 * I_W1 + 2 * I_W2;
    for (int it = gw; it < DEPTH * PER_L; it += NGW) {
        const int l = it / PER_L; int r = it % PER_L;
        if (r < I_IN) { transpose_item<true>(C.in[2] + (size_t)l * DM * DIN, DM, DIN, PN, C.WIN + (size_t)l * PN * DM, C.in[1] + l * DM, scr, r, lane); continue; } r -= I_IN;
        if (r < I_OUT) { transpose_item<false, true>(C.in[19] + (size_t)l * DM * DM, DM, DM, DM, C.WOUT + (size_t)l * DM * DM, nullptr, scr, r, lane); continue; } r -= I_OUT;
        if (r < I_UP) { transpose_item<false>(C.in[21] + (size_t)l * DM * DFF, DM, DFF, DFF, C.WUP + (size_t)l * DFF * DM, C.in[20] + l * DM, scr, r, lane); continue; } r -= I_UP;
        if (r < I_DN) { transpose_item<false, true>(C.in[22] + (size_t)l * DFF * DM, DFF, DM, DM, C.WDN + (size_t)l * DM * DFF, nullptr, scr, r, lane); continue; } r -= I_DN;
        if (r < 2 * I_W1) { const int kv = r / I_W1; transpose_item<false>(C.in[kv ? 10 : 7] + (size_t)l * 2048 * 128, 2048, 128, 128, C.W1T + (size_t)(l * 2 + kv) * 128 * 2048, nullptr, scr, r % I_W1, lane); continue; } r -= 2 * I_W1;
        { const int kv = r / I_W2; transpose_item<false>(C.in[kv ? 11 : 8] + (size_t)l * 128 * 64, 128, 64, 64, C.W2T + (size_t)(l * 2 + kv) * 64 * 128, nullptr, scr, r % I_W2, lane); }
    }
    for (int it = gw; it < DEPTH * 2 * 32; it += NGW) {
        const int lk = it >> 5, fc = it & 31, l = lk >> 1, kv = lk & 1;
        const float* pos = C.in[kv ? 9 : 6] + (size_t)l * 2048 + fc * 64; const float* w1 = C.in[kv ? 10 : 7] + (size_t)l * 2048 * 128 + (size_t)fc * 64 * 128;
        float s0 = 0.f, s1 = 0.f;
#pragma unroll 16
        for (int f = 0; f < 64; ++f) { const float pv = pos[f]; s0 += pv * w1[f * 128 + lane]; s1 += pv * w1[f * 128 + 64 + lane]; }
        C.B1P[(size_t)it * 128 + lane] = s0; C.B1P[(size_t)it * 128 + 64 + lane] = s1;
    }
    for (int e = C.bid * 512 + tid; e < SEQ * 32; e += C.G * 512) {
        const int pos = e >> 5, i = e & 31; const float ang = (float)pos * ROPE_INV[i];
        float cs, sn; sincos_acc(ang, cs, sn); C.ROPE[2 * e] = cs; C.ROPE[2 * e + 1] = sn;
    }
    for (int m0 = gw * 4; m0 < MTOK; m0 += NGW * 4) {
        f32x4 v[4][4]; float ss[4];
#pragma unroll
        for (int r = 0; r < 4; ++r) { const f32x4* xr = (const f32x4*)(C.in[0] + (size_t)(m0 + r) * DM) + lane;
#pragma unroll
            for (int j = 0; j < 4; ++j) v[r][j] = xr[64 * j]; }
#pragma unroll
        for (int r = 0; r < 4; ++r) { float sq = 0.f;
#pragma unroll
            for (int j = 0; j < 4; ++j) sq += (v[r][j].x * v[r][j].x + v[r][j].y * v[r][j].y) + (v[r][j].z * v[r][j].z + v[r][j].w * v[r][j].w);
            ss[r] = sq; }
#pragma unroll
        for (int o = 1; o < 64; o <<= 1) {
#pragma unroll
            for (int r = 0; r < 4; ++r) ss[r] += __shfl_xor(ss[r], o); }
#pragma unroll
        for (int r = 0; r < 4; ++r) { const float rs = 1.0f / sqrtf(ss[r] * (1.f / DM) + EPS); u32x2* o8 = (u32x2*)(C.XN + (size_t)(m0 + r) * DM) + lane;
#pragma unroll
            for (int j = 0; j < 4; ++j) { u32x2 w; w.x = pkh(v[r][j].x * rs, v[r][j].y * rs); w.y = pkh(v[r][j].z * rs, v[r][j].w * rs); o8[64 * j] = w; } }
    }
}

__device__ __forceinline__ void phase_tok(const Ctx& C, int l) {
    TIDS
    const int gw = C.bid * 8 + wave, NGW = C.G * 8;
    if (l == 0 && C.bid == 0) { float sb = 0.f; const float* pp = C.B1P + (size_t)(tid >> 7) * 32 * 128 + (tid & 127);
        for (int fc = 0; fc < 32; ++fc) sb += pp[fc * 128];
        C.B1[tid] = sb; }
    const float* cw = C.in[13] + (size_t)l * 4 * 1024; const float* cb = C.in[14] + (size_t)l * 1024; const float* dtb = C.in[15] + l * 8;
    const int ch = lane * 16;
    float wgt[4][16], bias[16];
#pragma unroll
    for (int e = 0; e < 16; ++e) { bias[e] = cb[ch + e];
#pragma unroll
        for (int i = 0; i < 4; ++i) wgt[i][e] = cw[i * 1024 + ch + e]; }
    const float dbias = (lane < 8) ? dtb[lane] : 0.f;
    const int hd = lane >> 2, c8 = (lane & 3) * 8; const bool rl = lane < 16;
    const int rbase = (hd < 2) ? (C_KSLC + hd * 64) : (C_KWIN + (hd - 2) * 64);
    const float rsc = 1.f;
    for (int run = gw; run < MTOK / 16; run += NGW) {
        const int m0 = run * 16, t0 = m0 & (SEQ - 1);
        h16x8 hist[3][2];
#pragma unroll
        for (int i = 0; i < 3; ++i) { const int tt = t0 - 3 + i;
            if (tt >= 0) { const h16* src = C.PROJ + (size_t)(m0 - 3 + i) * PN + C_SX + ch; hist[i][0] = *(const h16x8*)src; hist[i][1] = *(const h16x8*)(src + 8); }
            else { hist[i][0] = (h16x8){}; hist[i][1] = (h16x8){}; } }
        h16x8 nc0, nc1, nx1 = {}, nx2 = {}; f32x4 ntb[4] = {}; float ndtr = 0.f;
        { const h16* prow = C.PROJ + (size_t)m0 * PN; nc0 = *(const h16x8*)(prow + C_SX + ch); nc1 = *(const h16x8*)(prow + C_SX + ch + 8);
            if (rl) { nx1 = *(const h16x8*)(prow + rbase + c8); nx2 = *(const h16x8*)(prow + rbase + 32 + c8);
#pragma unroll
                for (int i = 0; i < 4; ++i) ntb[i] = *(const f32x4*)(C.ROPE + 2 * (t0 * 32 + c8) + 4 * i); }
            if (lane < 8) ndtr = C.PSM[(size_t)m0 * PSM_W + 28 + lane]; }
#pragma unroll 1
        for (int k = 0; k < 16; ++k) { const int m = m0 + k;
            h16* prow = C.PROJ + (size_t)m * PN;
            const h16x8 c0 = nc0, c1 = nc1, x1 = nx1, x2 = nx2; f32x4 tb[4]; tb[0] = ntb[0]; tb[1] = ntb[1]; tb[2] = ntb[2]; tb[3] = ntb[3]; const float dtr = ndtr;
            if (k < 15) { const h16* pn = prow + PN; nc0 = *(const h16x8*)(pn + C_SX + ch); nc1 = *(const h16x8*)(pn + C_SX + ch + 8);
                if (rl) { nx1 = *(const h16x8*)(pn + rbase + c8); nx2 = *(const h16x8*)(pn + rbase + 32 + c8);
#pragma unroll
                    for (int i = 0; i < 4; ++i) ntb[i] = *(const f32x4*)(C.ROPE + 2 * ((t0 + k + 1) * 32 + c8) + 4 * i); }
                if (lane < 8) ndtr = C.PSM[(size_t)(m + 1) * PSM_W + 28 + lane]; }
            float a[16];
#pragma unroll
            for (int e = 0; e < 8; ++e) { a[e] = bias[e] + wgt[0][e] * (float)hist[0][0][e] + wgt[1][e] * (float)hist[1][0][e] + wgt[2][e] * (float)hist[2][0][e] + wgt[3][e] * (float)c0[e];
                a[8 + e] = bias[8 + e] + wgt[0][8 + e] * (float)hist[0][1][e] + wgt[1][8 + e] * (float)hist[1][1][e] + wgt[2][8 + e] * (float)hist[2][1][e] + wgt[3][8 + e] * (float)c1[e]; }
            hist[0][0] = hist[1][0]; hist[0][1] = hist[1][1]; hist[1][0] = hist[2][0]; hist[1][1] = hist[2][1]; hist[2][0] = c0; hist[2][1] = c1;
            u32x4 o0, o1; o0.x = pkh(siluf_(a[0]), siluf_(a[1])); o0.y = pkh(siluf_(a[2]), siluf_(a[3])); o0.z = pkh(siluf_(a[4]), siluf_(a[5])); o0.w = pkh(siluf_(a[6]), siluf_(a[7]));
            o1.x = pkh(siluf_(a[8]), siluf_(a[9])); o1.y = pkh(siluf_(a[10]), siluf_(a[11])); o1.z = pkh(siluf_(a[12]), siluf_(a[13])); o1.w = pkh(siluf_(a[14]), siluf_(a[15]));
            h16* dst = C.XBCC + (size_t)m * 1024 + ch; *(u32x4*)dst = o0; *(u32x4*)(dst + 8) = o1;
            if (rl) { h16x8 y1, y2;
#pragma unroll
                for (int e = 0; e < 8; ++e) { const float cs = tb[e >> 1][2 * (e & 1)], sn = tb[e >> 1][2 * (e & 1) + 1]; const float a1 = (float)x1[e], a2 = (float)x2[e];
                    y1[e] = (h16)((a1 * cs - a2 * sn) * rsc); y2[e] = (h16)((a2 * cs + a1 * sn) * rsc); }
                *(h16x8*)(prow + rbase + c8) = y1; *(h16x8*)(prow + rbase + 32 + c8) = y2; }
            if (lane < 8) C.DTV[(size_t)m * 8 + lane] = softplusf_(dtr + dbias);
        }
    }
}

__device__ __forceinline__ float gelu_tanh(float x) { const float u = 0.7978845608028654f * (x + 0.044715f * x * x * x); const float e = __expf(2.f * u); const float th = 1.f - 2.f / (e + 1.f); return 0.5f * x * (1.f + th); }
__device__ __forceinline__ void nsa_compress_unit(const Ctx& C, int l, int u) {
    const int kv = u >> 7, b = (u >> 5) & 3, g = (u >> 4) & 1, mt2 = u & 15;
    TIDS
    const int w = wave, cc = lane & 15, quad = lane >> 4;
    h16* As = (h16*)g_lds;
    h16* Hs = (h16*)(g_lds + 2 * 272 * 72 * 2);
    const h16* W1T = C.W1T + (size_t)(l * 2 + kv) * 128 * 2048; const h16* W2T = C.W2T + (size_t)(l * 2 + kv) * 64 * 128; const float* B1 = C.B1 + (l * 2 + kv) * 128;
    const int col = (kv ? C_VCMP : C_KCMP) + g * 64;
    {
        h16x8 s1[5], s2[5]; f32x4 tb[5][4];
#pragma unroll
        for (int i = 0; i < 5; ++i) { const int pc = tid + 512 * i; if (pc < 2 * 272 * 4) { const int half = pc / (272 * 4), rem = pc % (272 * 4), t = rem >> 2, c4 = rem & 3;
                int tok = 256 * mt2 + 4096 * half + t; tok = tok < SEQ ? tok : SEQ - 1; const h16* src = C.PROJ + (size_t)(b * SEQ + tok) * PN + col + c4 * 8;
                s1[i] = *(const h16x8*)src; s2[i] = *(const h16x8*)(src + 32);
                if (kv == 0) {
#pragma unroll
                    for (int q4 = 0; q4 < 4; ++q4) tb[i][q4] = *(const f32x4*)(C.ROPE + 2 * (tok * 32 + c4 * 8) + 4 * q4); } } }
#pragma unroll
        for (int i = 0; i < 5; ++i) { const int pc = tid + 512 * i; if (pc < 2 * 272 * 4) { const int half = pc / (272 * 4), rem = pc % (272 * 4), t = rem >> 2, c4 = rem & 3;
                h16x8 y1 = s1[i], y2 = s2[i];
                if (kv == 0) {
#pragma unroll
                    for (int e = 0; e < 8; ++e) { const float cs = tb[i][e >> 1][2 * (e & 1)], sn = tb[i][e >> 1][2 * (e & 1) + 1]; const float a1 = (float)s1[i][e], a2 = (float)s2[i][e];
                        y1[e] = (h16)(a1 * cs - a2 * sn); y2[e] = (h16)(a2 * cs + a1 * sn); } }
                *(h16x8*)(As + (half * 272 + t) * 72 + c4 * 8) = y1; *(h16x8*)(As + (half * 272 + t) * 72 + 32 + c4 * 8) = y2; } } }
    __syncthreads();
    f32x4 acc0 = {0.f, 0.f, 0.f, 0.f}, acc1 = {0.f, 0.f, 0.f, 0.f};
    const h16* brow = W1T + (size_t)(w * 16 + cc) * 2048 + quad * 8;
    const h16* a0p = As + (16 * cc) * 72 + quad * 8; const h16* a1p = a0p + 272 * 72;
#pragma unroll 16
    for (int kk = 0; kk < 64; ++kk) {
        const h16x8 bb = *(const h16x8*)(brow + kk * 32);
        const h16x8 a0 = *(const h16x8*)(a0p + (kk >> 1) * 72 + (kk & 1) * 32);
        const h16x8 a1 = *(const h16x8*)(a1p + (kk >> 1) * 72 + (kk & 1) * 32);
        acc0 = mfma16(a0, bb, acc0); acc1 = mfma16(a1, bb, acc1);
    }
    { const float bias = B1[w * 16 + cc];
#pragma unroll
        for (int j = 0; j < 4; ++j) { Hs[(quad * 4 + j) * 136 + w * 16 + cc] = (h16)gelu_tanh(acc0[j] + bias); Hs[(16 + quad * 4 + j) * 136 + w * 16 + cc] = (h16)gelu_tanh(acc1[j] + bias); } }
    __syncthreads();
    { const int half = w >> 2, wn = w & 3;
        f32x4 o = {0.f, 0.f, 0.f, 0.f};
#pragma unroll
        for (int kk = 0; kk < 4; ++kk) { const h16x8 a = *(const h16x8*)(Hs + (half * 16 + cc) * 136 + kk * 32 + quad * 8); const h16x8 bb = *(const h16x8*)(W2T + (size_t)(wn * 16 + cc) * 128 + kk * 32 + quad * 8); o = mfma16(a, bb, o); }
        h16* dst = (kv ? C.VC : C.KC) + (size_t)((b * 2 + g) * 512 + (mt2 + 16 * half) * 16) * 64;
#pragma unroll
        for (int j = 0; j < 4; ++j) dst[(quad * 4 + j) * 64 + wn * 16 + cc] = (h16)o[j];
    }
    __syncthreads();
}

__device__ __forceinline__ h16x4 tr_read(const h16* p) { typedef short s16x4 __attribute__((ext_vector_type(4))); return __builtin_bit_cast(h16x4, __builtin_amdgcn_ds_read_tr16_b64_v4i16((LAS s16x4*)p)); }
__device__ __forceinline__ h16x8 cat44(h16x4 lo, h16x4 hi) { return (h16x8){lo[0], lo[1], lo[2], lo[3], hi[0], hi[1], hi[2], hi[3]}; }
struct SsdPre { float dt; h16x8 x[2]; h16x8 bq[4]; };
__device__ __forceinline__ void ssd_states_load(const Ctx& C, int u, int tid, SsdPre& P) {
    const int b = u >> 9, c = (u >> 3) & 63, h = u & 7, g = h >> 2; const size_t row0 = (size_t)b * SEQ + c * 128;
    P.dt = (tid < 128) ? C.DTV[(row0 + tid) * 8 + h] : 0.f;
#pragma unroll
    for (int i = 0; i < 2; ++i) { const int ch = tid + 512 * i, tok = ch >> 3, c8 = ch & 7; P.x[i] = *(const h16x8*)(C.XBCC + (row0 + tok) * 1024 + h * 64 + c8 * 8); }
#pragma unroll
    for (int i = 0; i < 4; ++i) { const int ch = tid + 512 * i, tok = ch >> 4, c16 = ch & 15; P.bq[i] = *(const h16x8*)(C.XBCC + (row0 + tok) * 1024 + 512 + g * 128 + c16 * 8); }
}
__device__ __forceinline__ void ssd_states_phase(const Ctx& C, int l, int ufirst, int ustep) {
    TIDS
    const int w = wave, cc = lane & 15, quad = lane >> 4;
    float* acs = (float*)g_lds; float* dtl = acs + 128; float* wl = acs + 256;
    h16* Xs = (h16*)(g_lds + 2048);
    h16* Bs = (h16*)(g_lds + 2048 + 18432);
    h16* Os_ = (h16*)(g_lds + 2048 + 18432 + 34816);
    int u = ufirst; SsdPre pre; if (u < 2048) ssd_states_load(C, u, tid, pre);
    while (u < 2048) {
        const int b = u >> 9, c = (u >> 3) & 63, h = u & 7; const size_t row0 = (size_t)b * SEQ + c * 128;
        const SsdPre cur = pre;
        const float A = -__expf(C.in[16][l * 8 + h]);
        if (tid < 128) dtl[tid] = cur.dt;
        __syncthreads();
        if (w == 0) {
            const float d0 = dtl[2 * lane], d1 = dtl[2 * lane + 1]; const float a0 = d0 * A, a1 = d1 * A, sm = a0 + a1; float incl = sm;
#pragma unroll
            for (int o = 1; o < 64; o <<= 1) { const float t = __shfl_up(incl, o); if (lane >= o) incl += t; }
            const float excl = incl - sm, tot = __shfl(incl, 63); const float c0 = excl + a0, c1 = incl;
            acs[2 * lane] = c0; acs[2 * lane + 1] = c1; wl[2 * lane] = __expf(tot - c0) * d0; wl[2 * lane + 1] = __expf(tot - c1) * d1;
            if (lane == 63) C.CD[(b * 64 + c) * 8 + h] = __expf(tot);
        }
        __syncthreads();
#pragma unroll
        for (int i = 0; i < 2; ++i) { const int ch = tid + 512 * i, tok = ch >> 3, c8 = ch & 7; *(h16x8*)(Xs + tok * 72 + c8 * 8) = cur.x[i]; }
#pragma unroll
        for (int i = 0; i < 4; ++i) { const int ch = tid + 512 * i, tok = ch >> 4, c16 = ch & 15; const float ww = wl[tok]; h16x8 o;
#pragma unroll
            for (int e = 0; e < 8; ++e) o[e] = (h16)((float)cur.bq[i][e] * ww);
            *(h16x8*)(Bs + tok * 136 + c16 * 8) = o; }
        if (tid < 128) C.ACS[(row0 + tid) * 8 + h] = acs[tid];
        const int un = u + ustep; if (un < 2048) ssd_states_load(C, un, tid, pre);
        __syncthreads();
        const int mi = w & 3;
        h16x8 xa[4];
#pragma unroll
        for (int kk = 0; kk < 4; ++kk) { const h16* xp = Xs + (kk * 32 + 8 * quad + (cc >> 2)) * 72 + mi * 16 + 4 * (cc & 3); xa[kk] = cat44(tr_read(xp), tr_read(xp + 4 * 72)); }
        h16* dst = C.SSDST + (size_t)((b * 64 + c) * 8 + h) * 8192;
#pragma unroll
        for (int q = 0; q < 4; ++q) { const int ni = (w >> 2) * 4 + q; f32x4 acc = {0.f, 0.f, 0.f, 0.f};
#pragma unroll
            for (int kk = 0; kk < 4; ++kk) { const h16* bp = Bs + (kk * 32 + 8 * quad + (cc >> 2)) * 136 + ni * 16 + 4 * (cc & 3); acc = mfma16(xa[kk], cat44(tr_read(bp), tr_read(bp + 4 * 136)), acc); }
#pragma unroll
            for (int j = 0; j < 4; ++j) Os_[(mi * 16 + quad * 4 + j) * 136 + ni * 16 + cc] = (h16)acc[j]; }
        __syncthreads();
#pragma unroll
        for (int i = 0; i < 2; ++i) { const int ch = tid + 512 * i, p = ch >> 4, c16 = ch & 15; *(h16x8*)(dst + p * 128 + c16 * 8) = *(const h16x8*)(Os_ + p * 136 + c16 * 8); }
        u = un;
    }
    __syncthreads();
}

struct SsdYPre { float acs, dt; h16x8 x[2], z[2], he[2]; };
struct SsdBC { h16x8 cq[4], bq[4]; };
__device__ __forceinline__ void ssd_y_load(const Ctx& C, int bc, int h, int tid, SsdYPre& P) {
    const int b = bc >> 6, c = bc & 63; const size_t row0 = (size_t)b * SEQ + c * 128;
    P.acs = (tid < 128) ? C.ACS[(row0 + tid) * 8 + h] : 0.f; P.dt = (tid < 128) ? C.DTV[(row0 + tid) * 8 + h] : 0.f;
#pragma unroll
    for (int i = 0; i < 2; ++i) { const int ch = tid + 512 * i, tok = ch >> 3, c8 = ch & 7; P.x[i] = *(const h16x8*)(C.XBCC + (row0 + tok) * 1024 + h * 64 + c8 * 8); P.z[i] = *(const h16x8*)(C.PROJ + (row0 + tok) * PN + C_SZ + h * 64 + c8 * 8); }
    const h16* src = C.SSDST + (size_t)((b * 64 + c) * 8 + h) * 8192;
#pragma unroll
    for (int i = 0; i < 2; ++i) P.he[i] = *(const h16x8*)(src + (tid + 512 * i) * 8);
}
__device__ __forceinline__ void ssd_bc_load(const Ctx& C, int bc, int g, int tid, SsdBC& P) {
    const int b = bc >> 6, c = bc & 63; const size_t row0 = (size_t)b * SEQ + c * 128;
#pragma unroll
    for (int i = 0; i < 4; ++i) { const int ch = tid + 512 * i, tok = ch >> 4, c16 = ch & 15; const h16* src = C.XBCC + (row0 + tok) * 1024 + 512 + g * 128 + c16 * 8; P.bq[i] = *(const h16x8*)src; P.cq[i] = *(const h16x8*)(src + 256); }
}
__device__ __forceinline__ void ssd_y_phase(const Ctx& C, int l, int bcfirst, int bcstep) {
    TIDS
    const int w = wave, cc = lane & 15, quad = lane >> 4;
    float* acs = (float*)g_lds; float* dtl = acs + 128; float* rss = acs + 256;
    h16* Cm = (h16*)(g_lds + 2048);
    h16* Bm = (h16*)(g_lds + 2048 + 34816);
    h16* Xs = (h16*)(g_lds + 2048 + 2 * 34816);
    h16* HE = (h16*)(g_lds + 2048 + 2 * 34816 + 18432);
    h16* Zs = (h16*)(g_lds + 2048 + 2 * 34816 + 18432 + 17408);
    const float* nwp = C.in[18] + l * 512;
    for (int bc = bcfirst; bc < 256; bc += bcstep) {
        const int b = bc >> 6, c = bc & 63; const size_t row0 = (size_t)b * SEQ + c * 128;
        SsdYPre pre; ssd_y_load(C, bc, 0, tid, pre);
        h16x4 cbt[8];
#pragma unroll 1
        for (int h = 0; h < 8; ++h) { const int g = h >> 2;
            __syncthreads();
            if (tid < 128) { acs[tid] = pre.acs; dtl[tid] = pre.dt; if ((h & 3) == 0) rss[tid] = 0.f; }
            if ((h & 3) == 0) { SsdBC pbc; ssd_bc_load(C, bc, g, tid, pbc);
#pragma unroll
                for (int i = 0; i < 4; ++i) { const int ch = tid + 512 * i, tok = ch >> 4, c16 = ch & 15; *(h16x8*)(Bm + tok * 136 + c16 * 8) = pbc.bq[i]; *(h16x8*)(Cm + tok * 136 + c16 * 8) = pbc.cq[i]; } }
#pragma unroll
            for (int i = 0; i < 2; ++i) { const int ch = tid + 512 * i, tok = ch >> 3, c8 = ch & 7; *(h16x8*)(Xs + tok * 72 + c8 * 8) = pre.x[i]; *(h16x8*)(Zs + tok * 72 + c8 * 8) = pre.z[i]; }
#pragma unroll
            for (int i = 0; i < 2; ++i) { const int ch = tid + 512 * i, p = ch >> 4, c16 = ch & 15; *(h16x8*)(HE + p * 136 + c16 * 8) = pre.he[i]; }
            if (h < 7) ssd_y_load(C, bc, h + 1, tid, pre);
            __syncthreads();
            h16x8 ca[4];
#pragma unroll
            for (int kk = 0; kk < 4; ++kk) ca[kk] = *(const h16x8*)(Cm + (w * 16 + cc) * 136 + kk * 32 + quad * 8);
            if ((h & 3) == 0) {
#pragma unroll
                for (int ni = 0; ni < 8; ++ni) { f32x4 acc = {0.f, 0.f, 0.f, 0.f};
#pragma unroll
                    for (int kk = 0; kk < 4; ++kk) { const h16x8 bb = *(const h16x8*)(Bm + (ni * 16 + cc) * 136 + kk * 32 + quad * 8); acc = mfma16(ca[kk], bb, acc); }
                    cbt[ni] = (h16x4){(h16)acc[0], (h16)acc[1], (h16)acc[2], (h16)acc[3]}; }
                __syncthreads();
            }
#pragma unroll
            for (int ni = 0; ni < 8; ++ni) { const int sidx = ni * 16 + cc; const float as_ = acs[sidx], ds_ = dtl[sidx];
#pragma unroll
                for (int j = 0; j < 4; ++j) { const int lr = w * 16 + quad * 4 + j; const float v = (sidx <= lr) ? (float)cbt[ni][j] * __expf(acs[lr] - as_) * ds_ : 0.f; Bm[lr * 136 + sidx] = (h16)v; } }
            __syncthreads();
            const float Dh = C.in[17][l * 8 + h];
            float ssq[4] = {0.f, 0.f, 0.f, 0.f};
            h16x8 ma[4];
#pragma unroll
            for (int kk = 0; kk < 4; ++kk) ma[kk] = *(const h16x8*)(Bm + (w * 16 + cc) * 136 + kk * 32 + quad * 8);
            float ea[4];
#pragma unroll
            for (int j = 0; j < 4; ++j) ea[j] = __expf(acs[w * 16 + quad * 4 + j]);
#pragma unroll
            for (int ni = 0; ni < 4; ++ni) { f32x4 acc = {0.f, 0.f, 0.f, 0.f};
#pragma unroll
                for (int kk = 0; kk < 4; ++kk) { const h16x8 bb = *(const h16x8*)(HE + (ni * 16 + cc) * 136 + kk * 32 + quad * 8); acc = mfma16(ca[kk], bb, acc); }
#pragma unroll
                for (int j = 0; j < 4; ++j) acc[j] *= ea[j];
#pragma unroll
                for (int kk = 0; kk < 4; ++kk) { const h16* xp = Xs + (kk * 32 + 8 * quad + (cc >> 2)) * 72 + ni * 16 + 4 * (cc & 3); acc = mfma16(ma[kk], cat44(tr_read(xp), tr_read(xp + 4 * 72)), acc); }
                const int p = ni * 16 + cc;
#pragma unroll
                for (int j = 0; j < 4; ++j) { const int lr = w * 16 + quad * 4 + j; const float x = (float)Xs[lr * 72 + p]; const float z = (float)Zs[lr * 72 + p];
                    const h16 yh = (h16)((acc[j] + Dh * x) * siluf_(z)); Zs[lr * 72 + p] = yh; const float yr = (float)yh; ssq[j] += yr * yr; } }
#pragma unroll
            for (int j = 0; j < 4; ++j) { float sv = ssq[j]; sv += __shfl_xor(sv, 1); sv += __shfl_xor(sv, 2); sv += __shfl_xor(sv, 4); sv += __shfl_xor(sv, 8);
                if (cc == 0) rss[w * 16 + quad * 4 + j] += sv; }
            __syncthreads();
#pragma unroll
            for (int i = 0; i < 2; ++i) { const int ch = tid + 512 * i, tok = ch >> 3, c8 = ch & 7; *(h16x8*)(C.XN + (row0 + tok) * 1024 + 512 + h * 64 + c8 * 8) = *(const h16x8*)(Zs + tok * 72 + c8 * 8); }
            if ((h & 3) == 3) {
                asm volatile("s_waitcnt vmcnt(0)" ::: "memory");
                __syncthreads();
#pragma unroll
                for (int i = 0; i < 8; ++i) { const int ch = tid + 512 * i, tok = ch >> 5, c8 = ch & 31; const float rs = 1.0f / sqrtf(rss[tok] * (1.f / 256.f) + EPS);
                    h16* p = C.XN + (row0 + tok) * 1024 + 512 + g * 256 + c8 * 8; const h16x8 v = *(const h16x8*)p; const float* nw = nwp + g * 256 + c8 * 8;
                    u32x4 o; o.x = pkb((float)v[0] * rs * nw[0], (float)v[1] * rs * nw[1]); o.y = pkb((float)v[2] * rs * nw[2], (float)v[3] * rs * nw[3]);
                    o.z = pkb((float)v[4] * rs * nw[4], (float)v[5] * rs * nw[5]); o.w = pkb((float)v[6] * rs * nw[6], (float)v[7] * rs * nw[7]); *(u32x4*)p = o; }
            }
        }
    }
    __syncthreads();
}

struct GlaLoad { f32x4 gl[4]; h16x8 q0, k0, vx[2], rx[2]; };
template <int PASS>
__device__ __forceinline__ void gla_load(const Ctx& C, GlaLoad& L, size_t rowh, int h, int lane) {
    const int tl = lane & 15, kq = lane >> 4; const size_t rowt = rowh + tl;
#pragma unroll
    for (int i = 0; i < 4; ++i) L.gl[i] = *(const f32x4*)(C.PSM + rowt * PSM_W + 4 * i);
    L.q0 = *(const h16x8*)(C.PROJ + rowt * PN + C_GQ + h * 32 + kq * 8);
    L.k0 = *(const h16x8*)(C.PROJ + rowt * PN + C_GK + h * 32 + kq * 8);
#pragma unroll
    for (int i = 0; i < 2; ++i) { const int ch = lane + 64 * i, t = ch >> 3, c8 = ch & 7; L.vx[i] = *(const h16x8*)(C.PROJ + (rowh + t) * PN + C_GV + h * 64 + c8 * 8);
        if (PASS == 1) L.rx[i] = *(const h16x8*)(C.PROJ + (rowh + t) * PN + C_GR + h * 64 + c8 * 8); }
}
template <int PASS>
__device__ __forceinline__ void gla_block_unit(const Ctx& C, int l, int bu) {
    TIDS
    const int w = wave; const int wu = bu * 8 + w; const int cc = lane & 15, quad = lane >> 4;
    const int bh = wu >> 7, seg = wu & 127, b = bh >> 2, h = bh & 3;
    const size_t row0 = (size_t)b * SEQ + seg * 64;
    unsigned char* wl = g_lds + w * 11264;
    h16* QT = (h16*)wl; h16* KT = QT + 640; h16* KH = KT + 640;
    h16* VS = KH + 640; h16* RS = VS + 1152;
    float* EM = (float*)(RS + 1152); float* EE = EM + 32;
    float* W2S = EE + 32;
    const int tl = cc, kq = quad;
    const float* gb = C.in[4] + l * 128 + h * 32 + kq * 8;
    { const float* w2g = C.in[3] + (size_t)l * 16 * 128 + h * 32;
#pragma unroll
        for (int i = 0; i < 2; ++i) { const int e4 = lane + 64 * i, r = e4 >> 3, c4 = e4 & 7; *(f32x4*)(W2S + r * 32 + c4 * 4) = *(const f32x4*)(w2g + r * 128 + c4 * 4); } }
    const float* w2 = W2S + kq * 8;
    f32x4 S[2][4];
    float* gst = C.GLAST + (size_t)(bh * 128 + seg) * 2048;
#pragma unroll
    for (int md = 0; md < 2; ++md)
#pragma unroll
        for (int nt = 0; nt < 4; ++nt)
#pragma unroll
            for (int j = 0; j < 4; ++j) S[md][nt][j] = (PASS == 1) ? gst[(16 * md + 4 * quad + j) * 64 + 16 * nt + cc] : 0.f;
    float bsum[8];
#pragma unroll
    for (int k = 0; k < 8; ++k) bsum[k] = 0.f;
    float gnw[4][4];
    if (PASS == 1) {
#pragma unroll
        for (int mt = 0; mt < 4; ++mt)
#pragma unroll
            for (int j = 0; j < 4; ++j) gnw[mt][j] = C.in[5][l * 256 + h * 64 + 16 * mt + 4 * quad + j]; }
    GlaLoad pre, pre2; gla_load<PASS>(C, pre, row0, h, lane); gla_load<PASS>(C, pre2, row0 + 16, h, lane);
#pragma unroll 1
    for (int qt = 0; qt < 4; ++qt) {
        const size_t rowh = row0 + qt * 16;
        const GlaLoad cur = pre; pre = pre2;
        if (qt < 2) gla_load<PASS>(C, pre2, rowh + 32, h, lane);
        float bi[8];
#pragma unroll
        for (int k = 0; k < 8; ++k) bi[k] = gb[k];
#pragma unroll
        for (int r = 0; r < 16; ++r) { const float gv = cur.gl[r >> 2][r & 3]; const f32x4 wa = *(const f32x4*)(w2 + r * 32), wb = *(const f32x4*)(w2 + r * 32 + 4);
#pragma unroll
            for (int k = 0; k < 4; ++k) { bi[k] += gv * wa[k]; bi[4 + k] += gv * wb[k]; } }
#pragma unroll
        for (int k = 0; k < 8; ++k) bi[k] = -0.0625f * __builtin_amdgcn_logf(1.f + ex2(-1.4426950408889634f * bi[k]));
#pragma unroll
        for (int o = 1; o < 16; o <<= 1)
#pragma unroll
            for (int k = 0; k < 8; ++k) { const float t = __shfl_up(bi[k], o, 16); if (tl >= o) bi[k] += t; }
        float bmid[8], bend[8];
#pragma unroll
        for (int k = 0; k < 8; ++k) { bmid[k] = __shfl(bi[k], 7, 16); bend[k] = __shfl(bi[k], 15, 16); bsum[k] += bend[k]; }
        asm volatile("" ::: "memory");
        { h16x8 qo, ko, kh;
#pragma unroll
            for (int k = 0; k < 8; ++k) { const float kf = (float)cur.k0[k]; qo[k] = (h16)((float)cur.q0[k] * 0.17677669529663687f * ex2(bi[k] - bmid[k])); ko[k] = (h16)(kf * ex2(bmid[k] - bi[k])); kh[k] = (h16)(kf * ex2(bend[k] - bi[k])); }
            *(h16x8*)(QT + tl * 40 + kq * 8) = qo; *(h16x8*)(KT + tl * 40 + kq * 8) = ko; *(h16x8*)(KH + tl * 40 + kq * 8) = kh;
            if (tl == 0) {
#pragma unroll
                for (int k4 = 0; k4 < 2; ++k4) { f32x4 em, ee;
#pragma unroll
                    for (int e = 0; e < 4; ++e) { em[e] = ex2(bmid[4 * k4 + e]); ee[e] = ex2(bend[4 * k4 + e]); }
                    *(f32x4*)(EM + kq * 8 + 4 * k4) = em; *(f32x4*)(EE + kq * 8 + 4 * k4) = ee; } } }
#pragma unroll
        for (int i = 0; i < 2; ++i) { const int ch = lane + 64 * i, t = ch >> 3, c8 = ch & 7; *(h16x8*)(VS + t * 72 + c8 * 8) = cur.vx[i]; if (PASS == 1) *(h16x8*)(RS + t * 72 + c8 * 8) = cur.rx[i]; }
        asm volatile("s_waitcnt lgkmcnt(0)" ::: "memory");
        h16x8 vfr[4];
#pragma unroll
        for (int nt = 0; nt < 4; ++nt) { const h16x4 t4 = tr_read(VS + (4 * quad + (cc >> 2)) * 72 + 16 * nt + 4 * (cc & 3)); vfr[nt] = (h16x8){t4[0], t4[1], t4[2], t4[3], (h16)0.f, (h16)0.f, (h16)0.f, (h16)0.f}; }
        if (PASS == 1) {
            f32x4 at = {0.f, 0.f, 0.f, 0.f};
            at = mfma16(*(const h16x8*)(KT + cc * 40 + quad * 8), *(const h16x8*)(QT + cc * 40 + quad * 8), at);
            h16x8 pa;
#pragma unroll
            for (int e = 0; e < 4; ++e) { pa[e] = (h16)((4 * quad + e <= cc) ? at[e] : 0.f); pa[4 + e] = (h16)0.f; }
            const h16x4 ql = *(const h16x4*)(QT + cc * 40 + 4 * quad), qh = *(const h16x4*)(QT + cc * 40 + 16 + 4 * quad);
            const h16x8 qfr = cat44(ql, qh);
            const f32x4 em0 = *(const f32x4*)(EM + 4 * quad), em1 = *(const f32x4*)(EM + 16 + 4 * quad);
            f32x4 ot[4]; float ssq = 0.f;
#pragma unroll
            for (int mt = 0; mt < 4; ++mt) { f32x4 acc = {0.f, 0.f, 0.f, 0.f};
                acc = mfma16(vfr[mt], pa, acc);
                const h16x8 sfr = {(h16)(S[0][mt][0] * em0[0]), (h16)(S[0][mt][1] * em0[1]), (h16)(S[0][mt][2] * em0[2]), (h16)(S[0][mt][3] * em0[3]),
                                   (h16)(S[1][mt][0] * em1[0]), (h16)(S[1][mt][1] * em1[1]), (h16)(S[1][mt][2] * em1[2]), (h16)(S[1][mt][3] * em1[3])};
                acc = mfma16(sfr, qfr, acc);
                ot[mt] = acc; ssq += (acc[0] * acc[0] + acc[1] * acc[1]) + (acc[2] * acc[2] + acc[3] * acc[3]); }
            ssq += __shfl_xor(ssq, 16); ssq += __shfl_xor(ssq, 32);
            const float rs = 1.0f / sqrtf(ssq * (1.f / 64.f) + EPS);
#pragma unroll
            for (int mt = 0; mt < 4; ++mt) { const h16x4 r4 = *(const h16x4*)(RS + cc * 72 + 16 * mt + 4 * quad);
                u32x2 wv; wv.x = pkb(ot[mt][0] * rs * gnw[mt][0] * siluf_((float)r4[0]), ot[mt][1] * rs * gnw[mt][1] * siluf_((float)r4[1]));
                wv.y = pkb(ot[mt][2] * rs * gnw[mt][2] * siluf_((float)r4[2]), ot[mt][3] * rs * gnw[mt][3] * siluf_((float)r4[3]));
                *(u32x2*)(C.XN + (rowh + cc) * 1024 + h * 64 + 16 * mt + 4 * quad) = wv; }
        }
#pragma unroll
        for (int md = 0; md < 2; ++md) { const f32x4 ee = *(const f32x4*)(EE + 16 * md + 4 * quad);
            const h16x4 k4 = tr_read(KH + (4 * quad + (cc >> 2)) * 40 + 16 * md + 4 * (cc & 3));
            const h16x8 kfr = {k4[0], k4[1], k4[2], k4[3], (h16)0.f, (h16)0.f, (h16)0.f, (h16)0.f};
#pragma unroll
            for (int nt = 0; nt < 4; ++nt) { S[md][nt] = S[md][nt] * ee; S[md][nt] = mfma16(kfr, vfr[nt], S[md][nt]); } }
    }
    if (PASS == 0) {
#pragma unroll
        for (int md = 0; md < 2; ++md)
#pragma unroll
            for (int nt = 0; nt < 4; ++nt)
#pragma unroll
                for (int j = 0; j < 4; ++j) gst[(16 * md + 4 * quad + j) * 64 + 16 * nt + cc] = S[md][nt][j];
        if (tl == 0) {
#pragma unroll
            for (int k = 0; k < 8; ++k) C.GLAG[(size_t)(bh * 128 + seg) * 32 + kq * 8 + k] = ex2(bsum[k]); }
    }
}

__device__ __forceinline__ void phase_scans(const Ctx& C) {
    TIDS
    for (int e = C.bid * 512 + tid; e < BATCH * 8 * 4096; e += C.G * 512) {
        const int bh = e >> 12, b = bh >> 3, h = bh & 7, pn = e & 4095;
        h16x2* p = (h16x2*)(C.SSDST + (size_t)(b * 64 * 8 + h) * 8192) + pn; const float* cd = C.CD + b * 64 * 8 + h;
        float s0 = 0.f, s1 = 0.f;
        for (int c0 = 0; c0 < 64; c0 += 16) { h16x2 v[16]; float d[16];
#pragma unroll
            for (int i = 0; i < 16; ++i) { v[i] = p[(size_t)(c0 + i) * 8 * 4096]; d[i] = cd[(c0 + i) * 8]; }
#pragma unroll
            for (int i = 0; i < 16; ++i) { h16x2 o = {(h16)s0, (h16)s1}; p[(size_t)(c0 + i) * 8 * 4096] = o; s0 = d[i] * s0 + (float)v[i][0]; s1 = d[i] * s1 + (float)v[i][1]; } }
    }
    for (int e = C.bid * 512 + tid; e < 16 * 2048; e += C.G * 512) {
        const int bh = e >> 11, kv = e & 2047, k = kv >> 6;
        float* p = C.GLAST + (size_t)bh * 128 * 2048 + kv; const float* gg = C.GLAG + (size_t)bh * 128 * 32 + k;
        float st = 0.f;
        for (int s0 = 0; s0 < 128; s0 += 8) { float v[8], d[8];
#pragma unroll
            for (int i = 0; i < 8; ++i) { v[i] = p[(size_t)(s0 + i) * 2048]; d[i] = gg[(s0 + i) * 32]; }
#pragma unroll
            for (int i = 0; i < 8; ++i) { p[(size_t)(s0 + i) * 2048] = st; st = d[i] * st + v[i]; } }
    }
}

constexpr int KV_LD = 80, KV_TILE = 64 * KV_LD;
__device__ __forceinline__ void qk_tile(f32x4 (&s)[4], const h16* Ks, const h16x8 (&qf)[2], int cc, int quad) {
#pragma unroll
    for (int mt = 0; mt < 4; ++mt) { f32x4 a = {0.f, 0.f, 0.f, 0.f};
#pragma unroll
        for (int ks = 0; ks < 2; ++ks) { const h16x8 kf = *(const h16x8*)(Ks + (mt * 16 + cc) * KV_LD + ks * 32 + quad * 8); a = mfma16(kf, qf[ks], a); }
        s[mt] = a; }
}
__device__ __forceinline__ void pv_tile(f32x4 (&O)[4], const h16* Vs, const f32x4 (&p)[4], int cc, int quad) {
    h16x8 pf[2];
#pragma unroll
    for (int k2 = 0; k2 < 2; ++k2) pf[k2] = (h16x8){(h16)p[2 * k2][0], (h16)p[2 * k2][1], (h16)p[2 * k2][2], (h16)p[2 * k2][3], (h16)p[2 * k2 + 1][0], (h16)p[2 * k2 + 1][1], (h16)p[2 * k2 + 1][2], (h16)p[2 * k2 + 1][3]};
#pragma unroll
    for (int md = 0; md < 4; ++md)
#pragma unroll
        for (int k2 = 0; k2 < 2; ++k2) { const h16* vp = Vs + (32 * k2 + 4 * quad + (cc >> 2)) * KV_LD + md * 16 + 4 * (cc & 3);
            const h16x4 lo = tr_read(vp), hi = tr_read(vp + 16 * KV_LD);
            const h16x8 vf = {lo[0], lo[1], lo[2], lo[3], hi[0], hi[1], hi[2], hi[3]}; O[md] = mfma16(vf, pf[k2], O[md]); }
}
struct FlashState { float mref, l; f32x4 O[4]; bool started; };
template <int MODE, bool MASKED>
__device__ __forceinline__ void flash_tile2(FlashState (&st)[2], const h16* Ks, const h16* Vs, const h16x8 (&qf)[2][2], int kv0, const int (&tq)[2], const bool (&sb)[2], int cc, int quad) {
    if (MODE == 0) { if (!__any(sb[0] || sb[1])) return; }
    h16x8 kf[4][2];
#pragma unroll
    for (int mt = 0; mt < 4; ++mt)
#pragma unroll
        for (int ks = 0; ks < 2; ++ks) kf[mt][ks] = *(const h16x8*)(Ks + (mt * 16 + cc) * KV_LD + ks * 32 + quad * 8);
    f32x4 s[2][4]; float rmax[2];
#pragma unroll
    for (int gi = 0; gi < 2; ++gi) { const float nm = -st[gi].mref; const f32x4 negm = {nm, nm, nm, nm};
#pragma unroll
        for (int mt = 0; mt < 4; ++mt) { f32x4 a = mfma16(kf[mt][0], qf[gi][0], negm); s[gi][mt] = mfma16(kf[mt][1], qf[gi][1], a); } }
#pragma unroll
    for (int gi = 0; gi < 2; ++gi) { float tmax = -INFINITY;
        if (MASKED) {
#pragma unroll
            for (int mt = 0; mt < 4; ++mt)
#pragma unroll
                for (int j = 0; j < 4; ++j) { const int kp = kv0 + mt * 16 + quad * 4 + j; const bool ok = (MODE == 0) ? (kp <= tq[gi]) : (kp <= tq[gi] && kp > tq[gi] - 512);
                    const float v = ok ? s[gi][mt][j] : -INFINITY; s[gi][mt][j] = v; tmax = fmaxf(tmax, v); }
        } else {
            float ta = max3f(s[gi][0][0], s[gi][0][1], s[gi][0][2]), tb = max3f(s[gi][0][3], s[gi][1][0], s[gi][1][1]);
            ta = max3f(ta, s[gi][1][2], s[gi][1][3]); tb = max3f(tb, s[gi][2][0], s[gi][2][1]); ta = max3f(ta, s[gi][2][2], s[gi][2][3]); tb = max3f(tb, s[gi][3][0], s[gi][3][1]);
            tmax = max3f(ta, tb, fmaxf(s[gi][3][2], s[gi][3][3]));
        }
        tmax = fmaxf(tmax, __shfl_xor(tmax, 16)); tmax = fmaxf(tmax, __shfl_xor(tmax, 32));
        rmax[gi] = (MODE == 0 && !sb[gi]) ? -INFINITY : tmax; }
    bool upd[2];
#pragma unroll
    for (int gi = 0; gi < 2; ++gi) upd[gi] = (rmax[gi] > -INFINITY) && (!st[gi].started || rmax[gi] > 8.f);
    if (__any(upd[0] || upd[1])) {
#pragma unroll
        for (int gi = 0; gi < 2; ++gi) { const float dl = upd[gi] ? rmax[gi] : 0.f; const float f = (upd[gi] && st[gi].started) ? ex2(-dl) : 1.f;
            st[gi].mref += dl; st[gi].l *= f; st[gi].started = st[gi].started || upd[gi];
#pragma unroll
            for (int mt = 0; mt < 4; ++mt) { s[gi][mt] = s[gi][mt] - dl; st[gi].O[mt] *= f; } }
    }
    h16x8 pf[2][2];
#pragma unroll
    for (int gi = 0; gi < 2; ++gi) {
#pragma unroll
        for (int mt = 0; mt < 4; ++mt)
#pragma unroll
            for (int j = 0; j < 4; ++j) s[gi][mt][j] = ex2(s[gi][mt][j]);
        const f32x4 ps4 = (s[gi][0] + s[gi][1]) + (s[gi][2] + s[gi][3]);
        float psum = (ps4[0] + ps4[1]) + (ps4[2] + ps4[3]);
        u32x4 w0, w1; w0.x = pkh(s[gi][0][0], s[gi][0][1]); w0.y = pkh(s[gi][0][2], s[gi][0][3]); w0.z = pkh(s[gi][1][0], s[gi][1][1]); w0.w = pkh(s[gi][1][2], s[gi][1][3]);
        w1.x = pkh(s[gi][2][0], s[gi][2][1]); w1.y = pkh(s[gi][2][2], s[gi][2][3]); w1.z = pkh(s[gi][3][0], s[gi][3][1]); w1.w = pkh(s[gi][3][2], s[gi][3][3]);
        if (MODE == 0) { const unsigned mk = sb[gi] ? 0xffffffffu : 0u; w0 = w0 & mk; w1 = w1 & mk; psum = sb[gi] ? psum : 0.f; }
        st[gi].l += psum; pf[gi][0] = __builtin_bit_cast(h16x8, w0); pf[gi][1] = __builtin_bit_cast(h16x8, w1); }
#pragma unroll
    for (int md = 0; md < 4; ++md)
#pragma unroll
        for (int k2 = 0; k2 < 2; ++k2) { const h16* vp = Vs + (32 * k2 + 4 * quad + (cc >> 2)) * KV_LD + md * 16 + 4 * (cc & 3);
            const h16x8 vf = cat44(tr_read(vp), tr_read(vp + 16 * KV_LD));
            st[0].O[md] = mfma16(vf, pf[0][k2], st[0].O[md]); st[1].O[md] = mfma16(vf, pf[1][k2], st[1].O[md]); }
}
template <bool NEEDV, class SrcFn, class CompFn>
__device__ __forceinline__ void kv_pipeline(int n, int tid, h16* Kb, h16* Vb, SrcFn src, CompFn comp) {
    if (n <= 0) return;
    const int key = tid >> 3, c8 = tid & 7; const int loff = key * KV_LD + c8 * 8;
    h16x8 kr, vr = {};
    { const h16 *kp, *vp; size_t stride; src(0, kp, vp, stride); kr = *(const h16x8*)(kp + (size_t)key * stride + c8 * 8); if (NEEDV) vr = *(const h16x8*)(vp + (size_t)key * stride + c8 * 8); }
    *(h16x8*)(Kb + loff) = kr; if (NEEDV) *(h16x8*)(Vb + loff) = vr;
    __syncthreads();
    for (int i = 0; i < n; ++i) {
        const int cur = i & 1; const bool more = (i + 1 < n);
        if (more) { const h16 *kp, *vp; size_t stride; src(i + 1, kp, vp, stride); kr = *(const h16x8*)(kp + (size_t)key * stride + c8 * 8); if (NEEDV) vr = *(const h16x8*)(vp + (size_t)key * stride + c8 * 8); }
        comp(i, Kb + cur * KV_TILE, Vb + cur * KV_TILE);
        if (more) { *(h16x8*)(Kb + (cur ^ 1) * KV_TILE + loff) = kr; if (NEEDV) *(h16x8*)(Vb + (cur ^ 1) * KV_TILE + loff) = vr; }
        __syncthreads();
    }
}
__device__ __forceinline__ void nsa_attn_unit(const Ctx& C, int l, int b, int g, int qq) {
    TIDS
    const int w = wave, cc = lane & 15, quad = lane >> 4;
    const int r = cc >> 3, ti = cc & 7, h = 2 * g + r;
    const int qbw = 2 * qq + (w >> 2), qbh = 2 * qq + 1;
    int tloc[2], tq[2]; size_t rowq[2];
#pragma unroll
    for (int gi = 0; gi < 2; ++gi) { tloc[gi] = 16 * w + 8 * gi + ti; tq[gi] = 128 * qq + tloc[gi]; rowq[gi] = (size_t)b * SEQ + tq[gi]; }
    h16* Kb = (h16*)g_lds; h16* Vb = (h16*)(g_lds + 2 * KV_TILE * 2);
    float* imp = (float*)(g_lds + 40960);
    unsigned* sel = (unsigned*)(g_lds + 40960 + 65536);
    unsigned* uni = sel + 512;
    unsigned char* lst = (unsigned char*)(uni + 8);
    h16x8 qf[2][2];
#pragma unroll
    for (int gi = 0; gi < 2; ++gi) {
        const h16x8 x1 = *(const h16x8*)(C.PROJ + rowq[gi] * PN + C_NQ + h * 64 + quad * 8), x2 = *(const h16x8*)(C.PROJ + rowq[gi] * PN + C_NQ + h * 64 + 32 + quad * 8);
        f32x4 tb[4];
#pragma unroll
        for (int i = 0; i < 4; ++i) tb[i] = *(const f32x4*)(C.ROPE + 2 * (tq[gi] * 32 + quad * 8) + 4 * i);
#pragma unroll
        for (int e = 0; e < 8; ++e) { const float cs = tb[e >> 1][2 * (e & 1)], sn = tb[e >> 1][2 * (e & 1) + 1]; const float a1 = (float)x1[e], a2 = (float)x2[e];
            qf[gi][0][e] = (h16)((a1 * cs - a2 * sn) * 0.18033688011112042f); qf[gi][1][e] = (h16)((a2 * cs + a1 * sn) * 0.18033688011112042f); } }
    const h16* kcb = C.KC + (size_t)(b * 2 + g) * 512 * 64; const h16* vcb = C.VC + (size_t)(b * 2 + g) * 512 * 64;
    const int ncmp = 4 * qbh + 3, ntile_c = (ncmp + 63) >> 6;
    auto src_cmp = [&](int i, const h16*& kp, const h16*& vp, size_t& stride) { kp = kcb + (size_t)i * 64 * 64; vp = vcb + (size_t)i * 64 * 64; stride = 64; };
    float m1[2] = {-INFINITY, -INFINITY}, l1[2] = {0.f, 0.f};
    kv_pipeline<false>(ntile_c, tid, Kb, Vb, src_cmp, [&](int tc, const h16* Ks, const h16*) {
        h16x8 kf[4][2];
#pragma unroll
        for (int mt = 0; mt < 4; ++mt)
#pragma unroll
            for (int ks = 0; ks < 2; ++ks) kf[mt][ks] = *(const h16x8*)(Ks + (mt * 16 + cc) * KV_LD + ks * 32 + quad * 8);
#pragma unroll
        for (int gi = 0; gi < 2; ++gi) { f32x4 s[4]; float tmax = -INFINITY;
#pragma unroll
            for (int mt = 0; mt < 4; ++mt) { f32x4 a = {0.f, 0.f, 0.f, 0.f}; a = mfma16(kf[mt][0], qf[gi][0], a); a = mfma16(kf[mt][1], qf[gi][1], a);
#pragma unroll
                for (int j = 0; j < 4; ++j) { const int n = tc * 64 + mt * 16 + quad * 4 + j; const float v = (16 * n + 31 <= tq[gi]) ? a[j] : -INFINITY; a[j] = v; tmax = fmaxf(tmax, v); }
                s[mt] = a; }
            tmax = fmaxf(tmax, __shfl_xor(tmax, 16)); tmax = fmaxf(tmax, __shfl_xor(tmax, 32));
            const float mnew = fmaxf(m1[gi], tmax), muse = (mnew == -INFINITY) ? 0.f : mnew;
            float ps = 0.f;
#pragma unroll
            for (int mt = 0; mt < 4; ++mt)
#pragma unroll
                for (int j = 0; j < 4; ++j) ps += ex2(s[mt][j] - muse);
            l1[gi] = l1[gi] * ex2(m1[gi] - muse) + ps; m1[gi] = mnew; } });
    float inv1[2], m1u[2];
#pragma unroll
    for (int gi = 0; gi < 2; ++gi) { float t = l1[gi]; t += __shfl_xor(t, 16); t += __shfl_xor(t, 32); inv1[gi] = (t > 0.f) ? 1.f / t : 0.f; m1u[gi] = (m1[gi] == -INFINITY) ? 0.f : m1[gi]; }
    f32x4 Oc[2][4];
#pragma unroll
    for (int gi = 0; gi < 2; ++gi)
#pragma unroll
        for (int md = 0; md < 4; ++md) Oc[gi][md] = (f32x4){0.f, 0.f, 0.f, 0.f};
    float carry_q3[2] = {0.f, 0.f};
    kv_pipeline<true>(ntile_c, tid, Kb, Vb, src_cmp, [&](int tc, const h16* Ks, const h16* Vs) {
        h16x8 kf[4][2]; h16x8 pf[2][2];
#pragma unroll
        for (int mt = 0; mt < 4; ++mt)
#pragma unroll
            for (int ks = 0; ks < 2; ++ks) kf[mt][ks] = *(const h16x8*)(Ks + (mt * 16 + cc) * KV_LD + ks * 32 + quad * 8);
#pragma unroll
        for (int gi = 0; gi < 2; ++gi) { f32x4 s[4];
#pragma unroll
            for (int mt = 0; mt < 4; ++mt) { f32x4 a = {0.f, 0.f, 0.f, 0.f}; a = mfma16(kf[mt][0], qf[gi][0], a); a = mfma16(kf[mt][1], qf[gi][1], a);
#pragma unroll
                for (int j = 0; j < 4; ++j) { const int n = tc * 64 + mt * 16 + quad * 4 + j; a[j] = (16 * n + 31 <= tq[gi]) ? ex2(a[j] - m1u[gi]) * inv1[gi] : 0.f; }
                s[mt] = a;
                const float s4 = (a[0] + a[1]) + (a[2] + a[3]); const float p3 = a[3];
                const float fromprev = __shfl(p3, (lane + 48) & 63);
                const float fromq3 = __shfl(p3, cc + 48);
                float val = s4 + ((quad == 0) ? carry_q3[gi] : fromprev);
                carry_q3[gi] = fromq3;
                val += __shfl_xor(val, 8);
                if (r == 0) imp[tloc[gi] * 128 + tc * 16 + mt * 4 + quad] = val; }
#pragma unroll
            for (int k2 = 0; k2 < 2; ++k2) pf[gi][k2] = (h16x8){(h16)s[2 * k2][0], (h16)s[2 * k2][1], (h16)s[2 * k2][2], (h16)s[2 * k2][3], (h16)s[2 * k2 + 1][0], (h16)s[2 * k2 + 1][1], (h16)s[2 * k2 + 1][2], (h16)s[2 * k2 + 1][3]}; }
#pragma unroll
        for (int md = 0; md < 4; ++md)
#pragma unroll
            for (int k2 = 0; k2 < 2; ++k2) { const h16* vp = Vs + (32 * k2 + 4 * quad + (cc >> 2)) * KV_LD + md * 16 + 4 * (cc & 3);
                const h16x8 vf = cat44(tr_read(vp), tr_read(vp + 16 * KV_LD));
                Oc[0][md] = mfma16(vf, pf[0][k2], Oc[0][md]); Oc[1][md] = mfma16(vf, pf[1][k2], Oc[1][md]); } });
    if (qbw < 16) {
        if (lane < 16) { const unsigned mlo = (2u << qbw) - 1u; const int row = 16 * w + lane; sel[row * 4 + 0] = mlo; sel[row * 4 + 1] = 0u; sel[row * 4 + 2] = 0u; sel[row * 4 + 3] = 0u; }
    } else {
        const int jhi = qbw - 2;
        const unsigned long long lt = __lanemask_lt();
        for (int t16 = 0; t16 < 16; ++t16) { const int row = 16 * w + t16; const float* ir = imp + row * 128;
            const int j1 = lane, j2 = lane + 64; const bool ok1 = (j1 >= 1 && j1 <= jhi), ok2 = (j2 <= jhi);
            const unsigned u1 = ok1 ? __float_as_uint(ir[j1]) + 1u : 0u, u2 = ok2 ? __float_as_uint(ir[j2]) + 1u : 0u;
            unsigned prefix = 0u;
            for (int bit = 30; bit >= 0; --bit) { const unsigned test = prefix | (1u << bit);
                const int cnt = __popcll(__ballot(u1 >= test)) + __popcll(__ballot(u2 >= test)); if (cnt >= 13) prefix = test; }
            const bool gt1 = u1 > prefix, gt2 = u2 > prefix, eq1 = u1 == prefix, eq2 = u2 == prefix;
            const unsigned long long bg1 = __ballot(gt1), bg2 = __ballot(gt2), be1 = __ballot(eq1), be2 = __ballot(eq2);
            const int need = 13 - __popcll(bg1) - __popcll(bg2);
            const bool s1 = gt1 || (eq1 && __popcll(be1 & lt) < need), s2 = gt2 || (eq2 && (__popcll(be1) + __popcll(be2 & lt)) < need);
            unsigned long long blo = __ballot(s1) | 1ull, bhi = __ballot(s2);
            { const int f0 = qbw - 1, f1 = qbw; if (f0 < 64) blo |= 1ull << f0; else bhi |= 1ull << (f0 - 64); if (f1 < 64) blo |= 1ull << f1; else bhi |= 1ull << (f1 - 64); }
            if (lane == 0) { sel[row * 4 + 0] = (unsigned)blo; sel[row * 4 + 1] = (unsigned)(blo >> 32); sel[row * 4 + 2] = (unsigned)bhi; sel[row * 4 + 3] = (unsigned)(bhi >> 32); } }
    }
    __syncthreads();
    if (w == 0) {
        unsigned o0 = sel[lane * 4 + 0] | sel[(lane + 64) * 4 + 0], o1 = sel[lane * 4 + 1] | sel[(lane + 64) * 4 + 1], o2 = sel[lane * 4 + 2] | sel[(lane + 64) * 4 + 2], o3 = sel[lane * 4 + 3] | sel[(lane + 64) * 4 + 3];
#pragma unroll
        for (int sft = 1; sft < 64; sft <<= 1) { o0 |= __shfl_xor(o0, sft); o1 |= __shfl_xor(o1, sft); o2 |= __shfl_xor(o2, sft); o3 |= __shfl_xor(o3, sft); }
        const unsigned long long mlo = ((unsigned long long)o1 << 32) | o0, mhi = ((unsigned long long)o3 << 32) | o2;
        const unsigned long long lt = __lanemask_lt(); const int nlo = __popcll(mlo);
        if ((mlo >> lane) & 1ull) lst[__popcll(mlo & lt)] = (unsigned char)lane;
        if ((mhi >> lane) & 1ull) lst[nlo + __popcll(mhi & lt)] = (unsigned char)(64 + lane);
        if (lane == 0) uni[4] = (unsigned)(nlo + __popcll(mhi));
    }
    __syncthreads();
    { f32x4* park = (f32x4*)imp;
#pragma unroll
        for (int gi = 0; gi < 2; ++gi)
#pragma unroll
            for (int md = 0; md < 4; ++md) park[(gi * 4 + md) * 512 + tid] = Oc[gi][md]; }
    unsigned long long selLo[2], selHi[2];
#pragma unroll
    for (int gi = 0; gi < 2; ++gi) { selLo[gi] = ((unsigned long long)sel[tloc[gi] * 4 + 1] << 32) | sel[tloc[gi] * 4 + 0]; selHi[gi] = ((unsigned long long)sel[tloc[gi] * 4 + 3] << 32) | sel[tloc[gi] * 4 + 2]; }
    const int nlist = (int)uni[4];
    FlashState fs[2];
#pragma unroll
    for (int gi = 0; gi < 2; ++gi) { fs[gi].mref = 0.f; fs[gi].l = 0.f; fs[gi].started = false;
#pragma unroll
        for (int md = 0; md < 4; ++md) fs[gi].O[md] = (f32x4){0.f, 0.f, 0.f, 0.f}; }
    const h16* kslc = C.PROJ + (size_t)b * SEQ * PN + C_KSLC + g * 64; const h16* vslc = C.PROJ + (size_t)b * SEQ * PN + C_VSLC + g * 64;
    kv_pipeline<true>(nlist, tid, Kb, Vb,
        [&](int i, const h16*& kp, const h16*& vp, size_t& stride) { const int j = lst[i]; kp = kslc + (size_t)j * 64 * PN; vp = vslc + (size_t)j * 64 * PN; stride = PN; },
        [&](int i, const h16* Ks, const h16* Vs) { const int j = lst[i]; bool sb[2];
#pragma unroll
            for (int gi = 0; gi < 2; ++gi) { const unsigned long long sw = (j < 64) ? selLo[gi] : selHi[gi]; sb[gi] = ((sw >> (j & 63)) & 1ull) != 0ull; }
            if (j >= 2 * qq) flash_tile2<0, true>(fs, Ks, Vs, qf, j * 64, tq, sb, cc, quad); else flash_tile2<0, false>(fs, Ks, Vs, qf, j * 64, tq, sb, cc, quad); });
    f32x4 Os[2][4];
#pragma unroll
    for (int gi = 0; gi < 2; ++gi) { float ls = fs[gi].l; ls += __shfl_xor(ls, 16); ls += __shfl_xor(ls, 32); const float invs = (ls > 0.f) ? 1.f / ls : 0.f;
#pragma unroll
        for (int md = 0; md < 4; ++md) Os[gi][md] = fs[gi].O[md] * invs; }
#pragma unroll
    for (int gi = 0; gi < 2; ++gi) { fs[gi].mref = 0.f; fs[gi].l = 0.f; fs[gi].started = false;
#pragma unroll
        for (int md = 0; md < 4; ++md) fs[gi].O[md] = (f32x4){0.f, 0.f, 0.f, 0.f}; }
    const h16* kwin = C.PROJ + (size_t)b * SEQ * PN + C_KWIN + g * 64; const h16* vwin = C.PROJ + (size_t)b * SEQ * PN + C_VWIN + g * 64;
    const int jw0 = (2 * qq >= 8 ? 2 * qq - 8 : 0);
    kv_pipeline<true>(qbh - jw0 + 1, tid, Kb, Vb,
        [&](int i, const h16*& kp, const h16*& vp, size_t& stride) { const int j = jw0 + i; kp = kwin + (size_t)j * 64 * PN; vp = vwin + (size_t)j * 64 * PN; stride = PN; },
        [&](int i, const h16* Ks, const h16* Vs) { const int j = jw0 + i; const bool sbt[2] = {true, true};
            if (j >= 2 * qq || j <= 2 * qq - 7) flash_tile2<1, true>(fs, Ks, Vs, qf, j * 64, tq, sbt, cc, quad); else flash_tile2<1, false>(fs, Ks, Vs, qf, j * 64, tq, sbt, cc, quad); });
#pragma unroll
    for (int gi = 0; gi < 2; ++gi) {
        float lw = fs[gi].l; lw += __shfl_xor(lw, 16); lw += __shfl_xor(lw, 32); const float invw = (lw > 0.f) ? 1.f / lw : 0.f;
        const float* gp = C.PSM + rowq[gi] * PSM_W + 16 + h * 3;
        const float g0 = sigmoidf_(gp[0]), g1 = sigmoidf_(gp[1]), g2 = sigmoidf_(gp[2]) * invw;
        float ssq = 0.f; f32x4 o[4];
#pragma unroll
        for (int md = 0; md < 4; ++md) { o[md] = g0 * ((const f32x4*)imp)[(gi * 4 + md) * 512 + tid] + g1 * Os[gi][md] + g2 * fs[gi].O[md]; ssq += (o[md][0] * o[md][0] + o[md][1] * o[md][1]) + (o[md][2] * o[md][2] + o[md][3] * o[md][3]); }
        ssq += __shfl_xor(ssq, 16); ssq += __shfl_xor(ssq, 32);
        const float rs = 1.0f / sqrtf(ssq * (1.f / 64.f) + EPS);
        const float* nw = C.in[12] + l * 256 + h * 64;
#pragma unroll
        for (int md = 0; md < 4; ++md) { const int d = md * 16 + quad * 4; u32x2 wv; wv.x = pkb(o[md][0] * rs * nw[d], o[md][1] * rs * nw[d + 1]); wv.y = pkb(o[md][2] * rs * nw[d + 2], o[md][3] * rs * nw[d + 3]);
            *(u32x2*)(C.XN + rowq[gi] * 1024 + 256 + h * 64 + d) = wv; }
    }
}

__device__ __forceinline__ void phase_ssdnorm(const Ctx& C, int l) {
    TIDS
    const int gw = C.bid * 8 + wave, NGW = C.G * 8; const float* nw = C.in[18] + l * 512 + lane * 8;
    for (int m = gw; m < MTOK; m += NGW) { const int g = lane >> 5; const f32x4 q = *(const f32x4*)(C.SSQ + (size_t)m * 8 + g * 4);
        const float rs = 1.0f / sqrtf(((q.x + q.y) + (q.z + q.w)) * (1.f / 256.f) + EPS);
        h16* p = C.XN + (size_t)m * 1024 + 512 + lane * 8; const h16x8 v = *(const h16x8*)p;
        u32x4 o; o.x = pkh((float)v[0] * rs * nw[0], (float)v[1] * rs * nw[1]); o.y = pkh((float)v[2] * rs * nw[2], (float)v[3] * rs * nw[3]);
        o.z = pkh((float)v[4] * rs * nw[4], (float)v[5] * rs * nw[5]); o.w = pkh((float)v[6] * rs * nw[6], (float)v[7] * rs * nw[7]); *(u32x4*)p = o; }
}
__device__ __forceinline__ void phase_norm(const Ctx& C, const float* src, h16* dst) {
    TIDS
    const int gw = C.bid * 8 + wave, NGW = C.G * 8;
    for (int m = gw; m < MTOK; m += NGW) rms_row_to_h16(src + (size_t)m * DM, dst + (size_t)m * DM, lane);
}
__device__ __forceinline__ void phase_final(const Ctx& C) {
    TIDS
    const int gw = C.bid * 8 + wave, NGW = C.G * 8; const float* ssq = C.RSS + (size_t)MTOK * 16;
    f32x4 fw[4];
#pragma unroll
    for (int j = 0; j < 4; ++j) fw[j] = *((const f32x4*)C.in[23] + lane + 64 * j);
    for (int m0 = gw * 4; m0 < MTOK; m0 += NGW * 4) { h16x4 v[4][4]; float rs[4];
#pragma unroll
        for (int r = 0; r < 4; ++r) { rs[r] = row_ssq16(ssq, m0 + r); const h16x4* hr = (const h16x4*)(C.H16 + (size_t)(m0 + r) * DM) + lane;
#pragma unroll
            for (int j = 0; j < 4; ++j) v[r][j] = hr[64 * j]; }
#pragma unroll
        for (int r = 0; r < 4; ++r) { const float sc = 1.0f / sqrtf(rs[r] * (1.f / DM) + EPS); f32x4* xr = (f32x4*)(C.out + (size_t)(m0 + r) * DM) + lane;
#pragma unroll
            for (int j = 0; j < 4; ++j) xr[64 * j] = (f32x4){(float)v[r][j][0], (float)v[r][j][1], (float)v[r][j][2], (float)v[r][j][3]} * sc * fw[j]; } }
}

constexpr int N_PHASES_DECL = 0;
#ifndef PHM
#define PHM 0xffffffffu
#endif
#define EN(k) ((PHM >> (k)) & 1u)
#ifndef PROBE_PH
#define PROBE_PH -1
#define PROBE_REPS 1
#endif
#define REPN(ph) ((ph) == PROBE_PH ? PROBE_REPS : 1)
#ifndef TS_PROBE
#define TS_PROBE 0
#define TS_A 0
#define TS_B 1
#define TS_DIV 4.0f
#endif
#ifndef PROBE_BIT
#define PROBE_BIT -1
#endif
#define RB(k) for (int rb_ = 0; rb_ < ((k) == PROBE_BIT && l == 0 ? 2 : 1); ++rb_)
template <int ph> __device__ __forceinline__ void run_phase(const Params* kp, int rep, int wv) {
    Ctx C; make_ctx(C, kp, wv);
    LAS unsigned char* ldsl = (LAS unsigned char*)g_lds;
    if constexpr (ph == 0) { if (EN(0)) phase_prep(C); return; }
    if constexpr (ph == 1 + 8 * DEPTH) { if (EN(15)) phase_final(C); return; }
    constexpr int l = (ph - 1) / 8, s = (ph - 1) % 8;
    if (s == 0) { if (EN(1)) { pg8::Gemm g{(const pg8::bf16_t*)(l == 0 ? C.XN : C.H16), (const pg8::bf16_t*)(C.WIN + (size_t)l * PN * DM), MTOK, PN, DM}; pg8::StaticOrder S; S.init(MTOK, PN, C.G, C.bid);
        pg8::EpiProj E{C.PROJ, C.PSM, l == 0 ? (const float*)nullptr : C.RSS + (size_t)MTOK * 16}; pg8::gemm_phase<pg8::EpiProj>(ldsl, g, S, E, C.wv); } }
    else if (s == 1) { if (EN(2)) phase_tok(C, l); }
    else if (s == 2) { RB(3) for (int u = C.bid; u < 256; u += C.G) nsa_compress_unit(C, l, u);
#if TS_PROBE
        if (l == 0 && blockIdx.x == 0) { __syncthreads(); if (C.wv == 0 && opaque_lane() == 0) ((volatile LAS unsigned long long*)((LAS unsigned char*)g_lds + LDS_MISC + 64))[27] = __builtin_amdgcn_s_memrealtime(); }
#endif
        RB(4) ssd_states_phase(C, l, C.bid, C.G);
#if TS_PROBE
        if (l == 0 && blockIdx.x == 0) { __syncthreads(); if (C.wv == 0 && opaque_lane() == 0) ((volatile LAS unsigned long long*)((LAS unsigned char*)g_lds + LDS_MISC + 64))[28] = __builtin_amdgcn_s_memrealtime(); }
#endif
        RB(5) for (int u = C.bid; u < 256; u += C.G) gla_block_unit<0>(C, l, u); }
    else if (s == 3) { if (EN(6) && rep == 0) phase_scans(C);
#if TS_PROBE
        if (l == 0 && blockIdx.x == 0) { __syncthreads(); if (C.wv == 0 && opaque_lane() == 0) ((volatile LAS unsigned long long*)((LAS unsigned char*)g_lds + LDS_MISC + 64))[30] = __builtin_amdgcn_s_memrealtime(); }
#endif
        if (EN(7)) for (int v = C.bid; v < 512; v += C.G) { const int bg = (v & 255) >> 5, sidx = v & 31, k = v >> 8;
            const int qq = (k == 0) ? sidx : 63 - sidx; nsa_attn_unit(C, l, bg >> 1, bg & 1, qq); } }
    else if (s == 4) { RB(8) ssd_y_phase(C, l, C.bid, C.G);
#if TS_PROBE
        if (l == 0 && blockIdx.x == 0) { __syncthreads(); if (C.wv == 0 && opaque_lane() == 0) ((volatile LAS unsigned long long*)((LAS unsigned char*)g_lds + LDS_MISC + 64))[29] = __builtin_amdgcn_s_memrealtime(); }
#endif
        RB(9) for (int u = C.bid; u < 256; u += C.G) gla_block_unit<1>(C, l, u); }
    else if (s == 5) { if (EN(11)) { pg8::Gemm g{(const pg8::bf16_t*)C.XN, (const pg8::bf16_t*)(C.WOUT + (size_t)l * DM * DM), MTOK, DM, DM}; pg8::StaticOrder S; S.init(MTOK, DM, C.G, C.bid);
        pg8::EpiRes E{l == 0 ? C.in[0] : (const float*)nullptr, C.H16, C.RSS}; pg8::gemm_phase<pg8::EpiRes, true>(ldsl, g, S, E, C.wv); } }
    else if (s == 6) { if (EN(13)) { pg8::Gemm g{(const pg8::bf16_t*)C.H16, (const pg8::bf16_t*)(C.WUP + (size_t)l * DFF * DM), MTOK, DFF, DM}; pg8::StaticOrder S; S.init(MTOK, DFF, C.G, C.bid);
        pg8::EpiHid E{C.HID, C.RSS}; pg8::gemm_phase<pg8::EpiHid>(ldsl, g, S, E, C.wv); } }
    else if (s == 7) { if (EN(14)) { pg8::Gemm g{(const pg8::bf16_t*)C.HID, (const pg8::bf16_t*)(C.WDN + (size_t)l * DM * DFF), MTOK, DM, DFF}; pg8::StaticOrder S; S.init(MTOK, DM, C.G, C.bid);
        pg8::EpiRes E{(const float*)nullptr, C.H16, C.RSS + (size_t)MTOK * 16}; pg8::gemm_phase<pg8::EpiRes, true>(ldsl, g, S, E, C.wv); } }
}
constexpr int PH_PER_L = 8;
constexpr int N_PHASES = 1 + PH_PER_L * DEPTH + 1;
template <int PH> __device__ __forceinline__ void phase_seq(const Params* kp, int lo, int hi, cg::grid_group& grid, const XcdBarrier& bar, int wv) {
    if constexpr (PH < N_PHASES) {
        if (lo <= PH && PH < hi) {
            for (int rep = 0; rep < REPN(PH); ++rep) run_phase<PH>(kp, rep, wv);
            if (PH + 1 < hi) { if (MK_COOP && PH == 0) grid.sync(); else xcd_barrier(bar); }
#if TS_PROBE
            if (blockIdx.x == 0 && wv == 0 && opaque_lane() == 0) ((volatile LAS unsigned long long*)((LAS unsigned char*)g_lds + LDS_MISC + 64))[PH + 1] = __builtin_amdgcn_s_memrealtime();
#endif
        }
        phase_seq<PH + 1>(kp, lo, hi, grid, bar, wv);
    }
}
__global__ void __launch_bounds__(512, 2) fwd_kernel(Params P) {
    const Params* kp = &P;
    cg::grid_group grid = cg::this_grid();
    volatile LAS unsigned* st = (volatile LAS unsigned*)((LAS unsigned char*)g_lds + LDS_MISC);
    const int wv = __builtin_amdgcn_readfirstlane((int)threadIdx.x >> 6);
    if (threadIdx.x < 2) st[threadIdx.x] = 0u;
    __syncthreads();
    const XcdBarrier bar = xcd_barrier_post((unsigned*)P.ws, st, wv);
#if TS_PROBE
    if (blockIdx.x == 0 && wv == 0 && opaque_lane() == 0) ((volatile LAS unsigned long long*)((LAS unsigned char*)g_lds + LDS_MISC + 64))[0] = __builtin_amdgcn_s_memrealtime();
#endif
    phase_seq<0>(kp, P.ph_lo, P.ph_hi, grid, bar, wv);
#if TS_PROBE
    if (blockIdx.x == 0 && wv == 0 && opaque_lane() == 0) { volatile LAS unsigned long long* ts = (volatile LAS unsigned long long*)((LAS unsigned char*)g_lds + LDS_MISC + 64);
        const float us = (float)(ts[TS_B] - ts[TS_A]) * 0.01f; P.out[0] = us * (1.0f / TS_DIV); }
#endif
}

extern "C" void kernel_launch(void* const* d_in, const int* in_sizes, int n_in, void* d_out, int out_size, void* d_ws, size_t ws_size, hipStream_t stream) {
    static int grid = 0;
    if (grid == 0) {
        if (n_in != 24 || in_sizes[0] != MTOK * DM || out_size != MTOK * DM || ws_size < WS_END) { fprintf(stderr, "kernel_launch: unexpected shapes (n_in %d, ws %zu)\n", n_in, ws_size); grid = -1; return; }
        int dev = 0, cus = 0, per_cu = 0;
        hipGetDevice(&dev); hipDeviceGetAttribute(&cus, hipDeviceAttributeMultiprocessorCount, dev);
        hipFuncSetAttribute((const void*)fwd_kernel, hipFuncAttributeMaxDynamicSharedMemorySize, LDS_BYTES);
        hipOccupancyMaxActiveBlocksPerMultiprocessor(&per_cu, (const void*)fwd_kernel, 512, LDS_BYTES);
        (void)hipGetLastError();
        if (per_cu < 1) { fprintf(stderr, "kernel_launch: occupancy query says %d blocks/CU\n", per_cu); grid = -1; return; }
        grid = cus;
    }
    if (grid < 0) return;
    (void)hipMemsetAsync(d_ws, 0, 32768, stream);
    Params p{};
    for (int i = 0; i < 24; ++i) p.in[i] = (const float*)d_in[i];
    p.out = (float*)d_out; p.ws = (unsigned char*)d_ws;
#if MK_MULTI_LAUNCH
    for (int ph = 0; ph < N_PHASES; ++ph) { p.ph_lo = ph; p.ph_hi = ph + 1; hipLaunchKernelGGL(fwd_kernel, dim3(grid), dim3(512), LDS_BYTES, stream, p); }
#else
    p.ph_lo = 0; p.ph_hi = N_PHASES;
#if MK_COOP
    void* args[] = {&p};
    hipError_t e = hipLaunchCooperativeKernel((const void*)fwd_kernel, dim3(grid), dim3(512), args, LDS_BYTES, stream);
    if (e != hipSuccess) fprintf(stderr, "cooperative launch failed: %s (grid %d)\n", hipGetErrorString(e), grid);
#else
    hipLaunchKernelGGL(fwd_kernel, dim3(grid), dim3(512), LDS_BYTES, stream, p);
#endif
#endif
}
```

```cpp
#include <hip/hip_runtime.h>
#include <hip/hip_cooperative_groups.h>
#include <cstdio>
#include <cstdint>
namespace cg = cooperative_groups;

#ifndef MK_MULTI_LAUNCH
#define MK_MULTI_LAUNCH 0
#endif
#ifndef MK_COOP
#define MK_COOP 0
#endif

#define LAS __attribute__((address_space(3)))
typedef _Float16 h16;
typedef _Float16 h16x8 __attribute__((ext_vector_type(8)));
typedef _Float16 h16x4 __attribute__((ext_vector_type(4)));
typedef _Float16 h16x2 __attribute__((ext_vector_type(2)));
typedef float f32x4 __attribute__((ext_vector_type(4)));
typedef float f32x2 __attribute__((ext_vector_type(2)));
typedef unsigned u32x4 __attribute__((ext_vector_type(4)));
typedef unsigned u32x2 __attribute__((ext_vector_type(2)));

constexpr int BATCH = 4, SEQ = 8192, DM = 1024, MTOK = BATCH * SEQ, DEPTH = 2;
constexpr int DIN = 3364, PN = 3584, DFF = 4096;
constexpr float EPS = 1e-6f;
constexpr int C_GQ = 0, C_GK = 128, C_GV = 256, C_GR = 512, C_NQ = 768, C_NKV = 1024, C_SZ = 1792, C_SX = 2304, C_SM = 3328;
constexpr int C_KCMP = C_NKV, C_VCMP = C_NKV + 128, C_KSLC = C_NKV + 256, C_VSLC = C_NKV + 384, C_KWIN = C_NKV + 512, C_VWIN = C_NKV + 640;
constexpr int PSM_W = 64;

constexpr size_t MiB = 1u << 20;
constexpr size_t WS_WIN = 2 * MiB;
constexpr size_t WS_WOUT = 16 * MiB;
constexpr size_t WS_WUP = 20 * MiB;
constexpr size_t WS_WDN = 36 * MiB;
constexpr size_t WS_W1T = 52 * MiB;
constexpr size_t WS_W2T = 54 * MiB;
constexpr size_t WS_B1 = 16384;
constexpr size_t WS_ROPE = 55 * MiB;
constexpr size_t WS_XN = 60 * MiB;
constexpr size_t WS_PROJ = 124 * MiB;
constexpr size_t WS_HID = 124 * MiB;
constexpr size_t WS_XBCC = 348 * MiB;
constexpr size_t WS_SSDST = 444 * MiB;
constexpr size_t WS_GLAST = 476 * MiB;
constexpr size_t WS_PSM = 492 * MiB;
constexpr size_t WS_KC = 500 * MiB;
constexpr size_t WS_VC = 500 * MiB + 512 * 1024;
constexpr size_t WS_SSQ = 501 * MiB;
constexpr size_t WS_DTV = 502 * MiB;
constexpr size_t WS_ACS = 503 * MiB;
constexpr size_t WS_CD = 504 * MiB;
constexpr size_t WS_GLAG = 504 * MiB + 64 * 1024;
constexpr size_t WS_RSS = 505 * MiB;
constexpr size_t WS_B1P = 54 * MiB + 256 * 1024;
constexpr size_t WS_H16 = 380 * MiB;
constexpr size_t WS_END = 507 * MiB;

constexpr int LDS_BYTES = 147456;
constexpr int LDS_MISC = 131072;
extern __shared__ __attribute__((aligned(16))) unsigned char g_lds[];

struct Params { const float* in[24]; float* out; unsigned char* ws; int ph_lo, ph_hi; };

__constant__ float ROPE_INV[32] = {
 1.000000000e+00f, 7.498942614e-01f, 5.623413324e-01f, 4.216965139e-01f, 3.162277639e-01f, 2.371373773e-01f, 1.778279394e-01f, 1.333521307e-01f,
 1.000000015e-01f, 7.498941571e-02f, 5.623413250e-02f, 4.216965288e-02f, 3.162277490e-02f, 2.371373773e-02f, 1.778279431e-02f, 1.333521493e-02f,
 9.999999776e-03f, 7.498941850e-03f, 5.623413250e-03f, 4.216964822e-03f, 3.162277630e-03f, 2.371373586e-03f, 1.778279431e-03f, 1.333521446e-03f,
 1.000000047e-03f, 7.498942432e-04f, 5.623413017e-04f, 4.216965172e-04f, 3.162277571e-04f, 2.371373703e-04f, 1.778279402e-04f, 1.333521504e-04f };

__device__ __forceinline__ f32x4 mfma16(h16x8 a, h16x8 b, f32x4 c) { return __builtin_amdgcn_mfma_f32_16x16x32_f16(a, b, c, 0, 0, 0); }
__device__ __forceinline__ float wave_sum(float v) {
#pragma unroll
    for (int o = 1; o < 64; o <<= 1) v += __shfl_xor(v, o);
    return v;
}
__device__ __forceinline__ float ex2(float x) { return __builtin_amdgcn_exp2f(x); }
__device__ __forceinline__ float max3f(float a, float b, float c) { return __builtin_fmaxf(__builtin_fmaxf(a, b), c); }
__device__ __forceinline__ float sigmoidf_(float x) { return 1.f / (1.f + __expf(-x)); }
__device__ __forceinline__ float siluf_(float x) { return x / (1.f + __expf(-x)); }
__device__ __forceinline__ float softplusf_(float x) { return fmaxf(x, 0.f) + log1pf(__expf(-fabsf(x))); }
typedef __bf16 bf16x2_t __attribute__((ext_vector_type(2)));
__device__ __forceinline__ unsigned pkb(float lo, float hi) { f32x2 v = {lo, hi}; bf16x2_t b = __builtin_convertvector(v, bf16x2_t); return __builtin_bit_cast(unsigned, b); }
__device__ __forceinline__ unsigned pkh(float lo, float hi) { h16x2 v = {(h16)lo, (h16)hi}; return __builtin_bit_cast(unsigned, v); }

__device__ __forceinline__ int opaque_lane() { int t = __builtin_amdgcn_mbcnt_hi(~0u, __builtin_amdgcn_mbcnt_lo(~0u, 0u)); asm volatile("" : "+v"(t)); return t; }
constexpr float RSS_SCALE = 1048576.f, RSS_INV = 1.f / 1048576.f;
namespace pg8 {
typedef unsigned short bf16_t;
typedef __bf16 bf16x8_t __attribute__((ext_vector_type(8)));
constexpr int BM = 256, BK = 64, HALF = 128, HTB = HALF * BK * 2, STAGE_BYTES = 8 * HTB, NXCD = 8, WGM = 8;
__host__ __device__ __forceinline__ int lds_byte(int r, int c) { const int st = (r >> 4) * 2 + (c >> 5), rr = r & 15, cc = c & 31, ob = rr * 64 + cc * 2; return st * 1024 + (ob ^ (((ob >> 9) & 1) << 5)); }
__host__ __device__ __forceinline__ void stage_rc(int b, int& R, int& C) { const int st = b / 1024, sb = b % 1024, swz = sb ^ (((sb >> 9) & 1) << 5); R = (st >> 1) * 16 + swz / 64; C = (st & 1) * 32 + (swz % 64) / 2; }
__host__ __device__ __forceinline__ int perm32(int rho) { const int n = rho >> 4, i = rho & 15; return 8 * (i >> 2) + 4 * n + (i & 3); }
struct Unit { int pm, pn; };
struct Gemm { const bf16_t* A; const bf16_t* Bt; int M, N, K; };
struct StaticOrder {
    int nM, nN, nwg, G, c;
    __device__ void init(int M, int N, int G_, int c_) { nM = M / BM; nN = N / BM; nwg = nM * nN; G = G_; c = c_; }
    __device__ bool next(int i, Unit& u) const {
        const long L = (long)i * G + c; if (L >= nwg) return false;
        int wgid = (int)L; { const int q = nwg / NXCD, r = nwg % NXCD, xcd = wgid % NXCD, off = wgid / NXCD; wgid = (xcd < r ? xcd * (q + 1) : r * (q + 1) + (xcd - r) * q) + off; }
        const int nig = WGM * nN, gid = wgid / nig, fm = gid * WGM, gsz = (nM - fm) < WGM ? (nM - fm) : WGM;
        u.pm = fm + ((wgid % nig) % gsz); u.pn = (wgid % nig) / gsz; return true;
    }
};
struct EpiProj {
    static constexpr bool PERM = true;
    h16* O; float* PSM; const unsigned long long* ssq;
    __device__ __forceinline__ void operator()(const f32x4 (&acc)[2][2][4][2], const Unit& u, int wr, int wc, int fr, int fq) const {
        const int row0 = u.pm * BM + wr * 64 + fr, col0 = u.pn * BM + wc * 32 + 8 * fq;
#pragma unroll
        for (int ai = 0; ai < 2; ++ai)
#pragma unroll
            for (int m = 0; m < 4; ++m) { const int row = row0 + ai * HALF + m * 16; const float rs = ssq ? 1.0f / sqrtf((float)ssq[row] * (RSS_INV / DM) + EPS) : 1.f;
#pragma unroll
                for (int bj = 0; bj < 2; ++bj) { const f32x4 v0 = acc[ai][bj][m][0] * rs, v1 = acc[ai][bj][m][1] * rs; const int c = col0 + bj * HALF;
                    u32x4 w; w.x = pkh(v0[0], v0[1]); w.y = pkh(v0[2], v0[3]); w.z = pkh(v1[0], v1[1]); w.w = pkh(v1[2], v1[3]);
                    *(u32x4*)(O + (size_t)row * PN + c) = w;
                    if (c >= C_SM && c < C_SM + PSM_W) { float* p = PSM + (size_t)row * PSM_W + (c - C_SM); *(f32x4*)p = v0; *(f32x4*)(p + 4) = v1; } } }
    }
};
struct EpiHid {
    static constexpr bool PERM = true;
    h16* O; const unsigned long long* ssq;
    __device__ __forceinline__ void operator()(const f32x4 (&acc)[2][2][4][2], const Unit& u, int wr, int wc, int fr, int fq) const {
        const int row0 = u.pm * BM + wr * 64 + fr, col0 = u.pn * BM + wc * 32 + 8 * fq;
#pragma unroll
        for (int ai = 0; ai < 2; ++ai)
#pragma unroll
            for (int m = 0; m < 4; ++m) { const int row = row0 + ai * HALF + m * 16; const float rs = 1.0f / sqrtf((float)ssq[row] * (RSS_INV / DM) + EPS);
#pragma unroll
                for (int bj = 0; bj < 2; ++bj) { f32x4 v0 = acc[ai][bj][m][0] * rs, v1 = acc[ai][bj][m][1] * rs;
#pragma unroll
                    for (int e = 0; e < 4; ++e) { float a = fmaxf(v0[e], 0.f), b = fmaxf(v1[e], 0.f); v0[e] = a * a; v1[e] = b * b; }
                    u32x4 w; w.x = pkb(v0[0], v0[1]); w.y = pkb(v0[2], v0[3]); w.z = pkb(v1[0], v1[1]); w.w = pkb(v1[2], v1[3]);
                    *(u32x4*)(O + (size_t)row * DFF + col0 + bj * HALF) = w; } }
    }
};
struct EpiRes {
    static constexpr bool PERM = false;
    const float* base32; h16* hs; unsigned long long* ssq;
    __device__ __forceinline__ void operator()(const f32x4 (&acc)[2][2][4][2], const Unit& u, int wr, int wc, int fr, int fq) const {
        const int col0 = u.pn * BM + wc * 32 + 4 * fq;
#pragma unroll
        for (int ai = 0; ai < 2; ++ai)
#pragma unroll
            for (int m = 0; m < 4; ++m) { const int row = u.pm * BM + ai * HALF + wr * 64 + m * 16 + fr; const size_t off = (size_t)row * DM + col0; float sq = 0.f;
#pragma unroll
                for (int bj = 0; bj < 2; ++bj)
#pragma unroll
                    for (int n = 0; n < 2; ++n) { f32x4 bs;
                        if (base32) bs = *(const f32x4*)(base32 + off + bj * HALF + n * 16);
                        else { const h16x4 b4 = *(const h16x4*)(hs + off + bj * HALF + n * 16); bs = (f32x4){(float)b4[0], (float)b4[1], (float)b4[2], (float)b4[3]}; }
                        const f32x4 hv = bs + acc[ai][bj][m][n];
                        const h16x4 h4 = {(h16)hv[0], (h16)hv[1], (h16)hv[2], (h16)hv[3]}; *(h16x4*)(hs + off + bj * HALF + n * 16) = h4;
                        const float r0 = (float)h4[0], r1 = (float)h4[1], r2 = (float)h4[2], r3 = (float)h4[3];
                        sq += (r0 * r0 + r1 * r1) + (r2 * r2 + r3 * r3); }
                sq += __shfl_xor(sq, 16); sq += __shfl_xor(sq, 32);
                if (fq == 0) atomicAdd(ssq + row, (unsigned long long)(sq * RSS_SCALE + 0.5f)); }
    }
};

template <class Epi, bool BF = false>
__device__ __forceinline__ void gemm_phase(LAS unsigned char* lds, const Gemm g, const StaticOrder& S, const Epi& E, int wid) {
    const int lane = opaque_lane(), tid = wid * 64 + lane, wr = wid >> 2, wc = wid & 3, fr = lane & 15, fq = lane >> 4;
    const int K = g.K, nt = K / BK;
    unsigned voffA[2], voffB[2];
#pragma unroll
    for (int i = 0; i < 2; ++i) { int R, C; stage_rc(tid * 16 + i * 8192, R, C); const int Rb = Epi::PERM ? ((R & ~31) + perm32(R & 31)) : R;
        voffA[i] = (unsigned)(R * K + C) * 2u; voffB[i] = (unsigned)(Rb * K + C) * 2u; }
    const size_t kstep = (size_t)(BK * 2);
    const size_t hstep = (size_t)HALF * K * 2;
    const size_t tstep = 2 * hstep;
    const unsigned ldsw = (unsigned)wid * 1024u;
    const int aoff = lds_byte(wr * 64 + fr, fq * 8), boff = lds_byte(wc * 32 + fr, fq * 8);
#define PG8_SA(b, h) (((b) * 2 + (h)) * HTB)
#define PG8_SB(b, h) ((4 + (b) * 2 + (h)) * HTB)
#define PG8_STAGE(bufoff, gbase, voff) do { _Pragma("unroll") for (int _i = 0; _i < 2; ++_i) \
        __builtin_amdgcn_global_load_lds((const unsigned*)((const char*)(gbase) + (voff)[_i]), (LAS unsigned*)(lds + (bufoff) + ldsw + _i * 8192), 16, 0, 0); } while (0)
#define PG8_LDA(dst, b, h) do { _Pragma("unroll") for (int m = 0; m < 4; ++m) _Pragma("unroll") for (int k = 0; k < 2; ++k) dst[m][k] = *(const LAS h16x8*)(lds + PG8_SA(b, h) + aoff + m * 2048 + k * 1024); } while (0)
#define PG8_LDB(dst, b, h) do { _Pragma("unroll") for (int n = 0; n < 2; ++n) _Pragma("unroll") for (int k = 0; k < 2; ++k) dst[n][k] = *(const LAS h16x8*)(lds + PG8_SB(b, h) + boff + n * 2048 + k * 1024); } while (0)
#define PG8_MMA(ai, bj, At, Bt) do { __builtin_amdgcn_s_setprio(1); _Pragma("unroll") for (int m = 0; m < 4; ++m) _Pragma("unroll") for (int n = 0; n < 2; ++n) _Pragma("unroll") for (int k = 0; k < 2; ++k) \
        acc[ai][bj][m][n] = BF ? __builtin_amdgcn_mfma_f32_16x16x32_bf16(__builtin_bit_cast(bf16x8_t, Bt[n][k]), __builtin_bit_cast(bf16x8_t, At[m][k]), acc[ai][bj][m][n], 0, 0, 0) : __builtin_amdgcn_mfma_f32_16x16x32_f16(Bt[n][k], At[m][k], acc[ai][bj][m][n], 0, 0, 0); __builtin_amdgcn_s_setprio(0); } while (0)
#define PG8_WAIT_V(n) asm volatile("s_waitcnt vmcnt(" #n ")" ::: "memory")
#define PG8_WAIT_L(n) asm volatile("s_waitcnt lgkmcnt(" #n ")" ::: "memory")
#define PG8_BAR __builtin_amdgcn_s_barrier()
#define PG8_SCHED __builtin_amdgcn_sched_barrier(0)
    Unit cur, nxt; int ui = 0;
    if (!S.next(0, cur)) return;
    f32x4 acc[2][2][4][2];
#pragma unroll
    for (int a = 0; a < 2; ++a)
#pragma unroll
        for (int b = 0; b < 2; ++b)
#pragma unroll
            for (int m = 0; m < 4; ++m)
#pragma unroll
                for (int n = 0; n < 2; ++n) acc[a][b][m][n] = (f32x4){0.f, 0.f, 0.f, 0.f};
    h16x8 At[4][2], B0[2][2], B1[2][2];
    const char* cA = (const char*)g.A + (size_t)cur.pm * tstep; const char* cB = (const char*)g.Bt + (size_t)cur.pn * tstep;
    PG8_STAGE(PG8_SB(0, 0), cB, voffB); PG8_STAGE(PG8_SB(0, 1), cB + hstep, voffB); PG8_STAGE(PG8_SA(0, 0), cA, voffA); PG8_STAGE(PG8_SA(0, 1), cA + hstep, voffA);
    if (wr == 1) PG8_BAR;
    PG8_WAIT_V(2); PG8_BAR;
    PG8_STAGE(PG8_SB(1, 0), cB + kstep, voffB); PG8_STAGE(PG8_SA(1, 0), cA + kstep, voffA); PG8_STAGE(PG8_SB(1, 1), cB + hstep + kstep, voffB);
    PG8_WAIT_V(6); PG8_BAR;
    for (;;) {
        const bool has_next = S.next(ui + 1, nxt);
        const char* nA = has_next ? (const char*)g.A + (size_t)nxt.pm * tstep : cA; const char* nB = has_next ? (const char*)g.Bt + (size_t)nxt.pn * tstep : cB;
        for (int t = 0; t < nt; t += 2) {
            const bool last = (t == nt - 2);
            const char* a1 = cA + (size_t)(t + 1) * kstep;
            const char* a2 = last ? nA : cA + (size_t)(t + 2) * kstep; const char* b2 = last ? nB : cB + (size_t)(t + 2) * kstep;
            const char* a3 = a2 + kstep; const char* b3 = b2 + kstep;
            PG8_LDB(B0, 0, 0); PG8_LDB(B1, 0, 1); PG8_SCHED; PG8_LDA(At, 0, 0); PG8_STAGE(PG8_SA(1, 1), a1 + hstep, voffA);
            PG8_WAIT_V(8); PG8_WAIT_L(0); PG8_BAR; PG8_MMA(0, 0, At, B0); PG8_MMA(0, 1, At, B1); PG8_BAR; PG8_SCHED;
            PG8_LDA(At, 0, 1); PG8_STAGE(PG8_SB(0, 0), b2, voffB); PG8_STAGE(PG8_SB(0, 1), b2 + hstep, voffB); PG8_STAGE(PG8_SA(0, 0), a2, voffA);
            PG8_WAIT_V(8); PG8_WAIT_L(0); PG8_BAR; PG8_MMA(1, 0, At, B0); PG8_MMA(1, 1, At, B1); PG8_BAR; PG8_SCHED;
            PG8_LDB(B0, 1, 0); PG8_LDB(B1, 1, 1); PG8_SCHED; PG8_LDA(At, 1, 0); PG8_STAGE(PG8_SA(0, 1), a2 + hstep, voffA);
            PG8_WAIT_V(8); PG8_WAIT_L(0); PG8_BAR; PG8_MMA(0, 0, At, B0); PG8_MMA(0, 1, At, B1); PG8_BAR; PG8_SCHED;
            PG8_LDA(At, 1, 1); PG8_STAGE(PG8_SB(1, 0), b3, voffB); PG8_STAGE(PG8_SB(1, 1), b3 + hstep, voffB); PG8_STAGE(PG8_SA(1, 0), a3, voffA);
            PG8_WAIT_V(8); PG8_WAIT_L(0); PG8_BAR; PG8_MMA(1, 0, At, B0); PG8_MMA(1, 1, At, B1); PG8_BAR; PG8_SCHED;
        }
        if (wr == 0) PG8_BAR;
        E(acc, cur, wr, wc, fr, fq);
        if (!has_next) break;
#pragma unroll
        for (int a = 0; a < 2; ++a)
#pragma unroll
            for (int b = 0; b < 2; ++b)
#pragma unroll
                for (int m = 0; m < 4; ++m)
#pragma unroll
                    for (int n = 0; n < 2; ++n) acc[a][b][m][n] = (f32x4){0.f, 0.f, 0.f, 0.f};
        cur = nxt; cA = nA; cB = nB; ++ui;
        if (wr == 1) PG8_BAR;
    }
    PG8_WAIT_V(0);
    PG8_BAR;
#undef PG8_SA
#undef PG8_SB
#undef PG8_STAGE
#undef PG8_LDA
#undef PG8_LDB
#undef PG8_MMA
#undef PG8_WAIT_V
#undef PG8_WAIT_L
#undef PG8_BAR
#undef PG8_SCHED
}
}


#define XB_TMO      128
#define XB_XCNT(j)  (256  + 64 * (j))
#define XB_XSUB(j)  (1280 + 64 * (j))
#define XB_XGEN(j)  (2304 + 64 * (j))
#define XB_TOP      3328
#define XB_TOPGEN   3392
#define XCD_BAR_WORDS 3456
#define XB_SPIN_CAP (1u << 18)
__device__ __forceinline__ unsigned xb_ld(unsigned* p)              { return __hip_atomic_load(p, __ATOMIC_RELAXED, __HIP_MEMORY_SCOPE_AGENT); }
__device__ __forceinline__ unsigned xb_add(unsigned* p, unsigned v) { return __hip_atomic_fetch_add(p, v, __ATOMIC_RELAXED, __HIP_MEMORY_SCOPE_AGENT); }
__device__ __forceinline__ unsigned xb_xcc_id() { return (unsigned)__builtin_amdgcn_s_getreg((3 << 11) | 20) & 0xFu; }
#define XB_SPIN(cond, bar) do { unsigned _sp = 0; while (cond) { __builtin_amdgcn_s_sleep(1); \
    if ((++_sp & 255u) == 0u) { if (xb_ld(&(bar)[XB_TMO])) break; if (_sp > XB_SPIN_CAP) { atomicAdd(&(bar)[XB_TMO], 1u); break; } } } } while (0)
struct XcdBarrier { unsigned* bar; unsigned x; volatile LAS unsigned* st; int wv; };
__device__ __forceinline__ XcdBarrier xcd_barrier_post(unsigned* bar, volatile LAS unsigned* st, int wv) {
    XcdBarrier b; b.bar = bar; b.x = xb_xcc_id(); b.st = st; b.wv = wv;
    if (wv == 0 && opaque_lane() == 0) (void)xb_add(&bar[XB_XCNT(b.x)], 1u);
    return b;
}
__device__ __forceinline__ void xcd_barrier_complete(unsigned* bar, unsigned x, unsigned& nloc, unsigned& nx) {
    const unsigned G = gridDim.x * gridDim.y * gridDim.z;
    unsigned sum, cnt, mine, sp = 0u;
    for (;;) {
        sum = 0u; cnt = 0u; mine = 0u;
#pragma unroll
        for (unsigned j = 0; j < 16; ++j) { const unsigned c = xb_ld(&bar[XB_XCNT(j)]); sum += c; cnt += (c > 0u) ? 1u : 0u; mine = (j == x) ? c : mine; }
        if (sum == G) break;
        __builtin_amdgcn_s_sleep(1);
        if ((++sp & 255u) == 0u) { if (xb_ld(&bar[XB_TMO])) break; if (sp > XB_SPIN_CAP) { atomicAdd(&bar[XB_TMO], 1u); break; } }
    }
    nloc = mine > 0u ? mine : 1u; nx = cnt > 0u ? cnt : 1u;
}
__device__ __forceinline__ void xcd_barrier(const XcdBarrier& b) {
    asm volatile("s_waitcnt vmcnt(0)" ::: "memory");
    __syncthreads();
    if (b.wv == 0 && opaque_lane() == 0) {
        unsigned* bar = b.bar;
        __builtin_amdgcn_s_waitcnt(0);
        unsigned nloc = b.st[0], nx = b.st[1];
        if (nloc == 0u) { xcd_barrier_complete(bar, b.x, nloc, nx); b.st[0] = nloc; b.st[1] = nx; }
        const unsigned old = xb_add(&bar[XB_XSUB(b.x)], 1u);
        const unsigned gen = old / nloc;
        if (old + 1u == (gen + 1u) * nloc) {
            __builtin_amdgcn_fence(__ATOMIC_RELEASE, "agent");
            asm volatile("s_waitcnt vmcnt(0)" ::: "memory");
            const unsigned og = xb_add(&bar[XB_TOP], 1u);
            const unsigned tg = og / nx;
            if (og + 1u == (tg + 1u) * nx) xb_add(&bar[XB_TOPGEN], 1u);
            else XB_SPIN(xb_ld(&bar[XB_TOPGEN]) == tg, bar);
            __builtin_amdgcn_fence(__ATOMIC_ACQUIRE, "agent");
            xb_add(&bar[XB_XGEN(b.x)], 1u);
            asm volatile("s_waitcnt vmcnt(0)" ::: "memory");
        } else {
            XB_SPIN(xb_ld(&bar[XB_XGEN(b.x)]) == gen, bar);
            __builtin_amdgcn_fence(__ATOMIC_ACQUIRE, "agent");
            asm volatile("s_waitcnt vmcnt(0)" ::: "memory");
        }
    }
    __syncthreads();
}

#define TIDS const int lane = opaque_lane(); const int wave = C.wv; const int tid = wave * 64 + lane; (void)tid;
struct Ctx {
    const float* in[24]; float* out; unsigned char* ws;
    int G, bid, wv;
    h16 *WIN, *WOUT, *WUP, *WDN, *W1T, *W2T, *XN, *PROJ, *HID, *XBCC, *KC, *VC;
    h16* SSDST; unsigned long long* RSS; float *B1P, *B1, *ROPE, *GLAST, *PSM, *SSQ, *DTV, *ACS, *CD, *GLAG; h16* H16;
};
__device__ __forceinline__ void make_ctx(Ctx& C, const Params* kp, int wv) {
    C.wv = wv;
#pragma unroll
    for (int i = 0; i < 24; ++i) C.in[i] = kp->in[i];
    C.out = kp->out; unsigned char* ws = kp->ws; C.ws = ws; C.G = gridDim.x; C.bid = blockIdx.x;
    C.WIN = (h16*)(ws + WS_WIN); C.WOUT = (h16*)(ws + WS_WOUT); C.WUP = (h16*)(ws + WS_WUP); C.WDN = (h16*)(ws + WS_WDN); C.W1T = (h16*)(ws + WS_W1T); C.W2T = (h16*)(ws + WS_W2T);
    C.XN = (h16*)(ws + WS_XN); C.PROJ = (h16*)(ws + WS_PROJ); C.HID = (h16*)(ws + WS_HID); C.XBCC = (h16*)kp->out;      C.KC = (h16*)(ws + WS_KC); C.VC = (h16*)(ws + WS_VC);
    C.B1 = (float*)(ws + WS_B1); C.B1P = (float*)(ws + WS_B1P); C.ROPE = (float*)(ws + WS_ROPE); C.SSDST = (h16*)(ws + WS_SSDST); C.RSS = (unsigned long long*)(ws + WS_RSS); C.H16 = (h16*)(ws + WS_H16); C.GLAST = (float*)(ws + WS_GLAST); C.PSM = (float*)(ws + WS_PSM);
    C.SSQ = (float*)(ws + WS_SSQ); C.DTV = (float*)(ws + WS_DTV); C.ACS = (float*)(ws + WS_ACS); C.CD = (float*)(ws + WS_CD); C.GLAG = (float*)(ws + WS_GLAG);
}

__device__ __forceinline__ int win_src_col(int n) {
    if (n < 512) return n;
    if (n < 768) return n - 512 + 528;
    if (n < 1024) return n - 768 + 784;
    if (n < 1792) return n - 1024 + 1040;
    if (n < 2304) return n - 1792 + 1820;
    if (n < 3328) return n - 2304 + 2332;
    const int r = n - 3328;
    if (r < 16) return 512 + r;
    if (r < 28) return 1808 + (r - 16);
    if (r < 36) return 3356 + (r - 28);
    return -1;
}
template <bool MAPW, bool OBF = false>
__device__ __forceinline__ void transpose_item(const float* W, int K, int Nsrc, int Ndst, h16* WT, const float* kscale, float* scr, int item, int lane) {
    const int nblk = Ndst / 32, kb = item / nblk, nb = item % nblk, k0 = 64 * kb, n0 = 32 * nb;
    const int nd = n0 + (lane & 31); const int sc = MAPW ? win_src_col(nd) : nd;
    float vv[32];
#pragma unroll
    for (int i = 0; i < 32; ++i) { const int kk = 2 * i + (lane >> 5); vv[i] = (sc >= 0) ? W[(size_t)(k0 + kk) * Nsrc + sc] : 0.f; }
#pragma unroll
    for (int i = 0; i < 32; ++i) { const int kk = 2 * i + (lane >> 5); scr[kk * 33 + (lane & 31)] = kscale ? vv[i] * kscale[k0 + kk] : vv[i]; }
    asm volatile("s_waitcnt lgkmcnt(0)" ::: "memory");
    const int c = lane & 7;
#pragma unroll
    for (int j = 0; j < 4; ++j) { const int n = (lane >> 3) + 8 * j; const float* s = scr + (8 * c) * 33 + n;
        u32x4 o; if (OBF) { o.x = pkb(s[0 * 33], s[1 * 33]); o.y = pkb(s[2 * 33], s[3 * 33]); o.z = pkb(s[4 * 33], s[5 * 33]); o.w = pkb(s[6 * 33], s[7 * 33]); } else { o.x = pkh(s[0 * 33], s[1 * 33]); o.y = pkh(s[2 * 33], s[3 * 33]); o.z = pkh(s[4 * 33], s[5 * 33]); o.w = pkh(s[6 * 33], s[7 * 33]); }
        *(u32x4*)(WT + (size_t)(n0 + n) * K + k0 + 8 * c) = o; }
    asm volatile("s_waitcnt lgkmcnt(0)" ::: "memory");
}
__device__ __forceinline__ void rms_row_to_h16(const float* xrow, h16* orow, int lane) {
    const f32x4* xr = (const f32x4*)xrow + lane; f32x4 v[4]; float s = 0.f;
#pragma unroll
    for (int j = 0; j < 4; ++j) { v[j] = xr[64 * j]; s += (v[j].x * v[j].x + v[j].y * v[j].y) + (v[j].z * v[j].z + v[j].w * v[j].w); }
    const float rs = 1.0f / sqrtf(wave_sum(s) * (1.f / DM) + EPS);
    u32x2* o8 = (u32x2*)orow + lane;
#pragma unroll
    for (int j = 0; j < 4; ++j) { u32x2 w; w.x = pkh(v[j].x * rs, v[j].y * rs); w.y = pkh(v[j].z * rs, v[j].w * rs); o8[64 * j] = w; }
}
__device__ __forceinline__ void sincos_acc(float angf, float& c, float& s) {
    const double x = (double)angf; const double n = __builtin_rint(x * 0.63661977236758134308);
    const double r = __builtin_fma(-n, 1.5707963267948966192, x) - n * 6.123233995736766036e-17;
    const double r2 = r * r;
    double sp = -7.6471637318198164759e-13; sp = sp * r2 + 1.6059043836821614599e-10; sp = sp * r2 - 2.5052108385441718775e-08; sp = sp * r2 + 2.7557319223985890653e-06;
    sp = sp * r2 - 1.9841269841269841270e-04; sp = sp * r2 + 8.3333333333333333333e-03; sp = sp * r2 - 1.6666666666666666667e-01; const double sn = r + r * r2 * sp;
    double cp = 4.7794773323873852974e-14; cp = cp * r2 - 1.1470745597729724714e-11; cp = cp * r2 + 2.0876756987868098979e-09; cp = cp * r2 - 2.7557319223985890653e-07;
    cp = cp * r2 + 2.4801587301587301587e-05; cp = cp * r2 - 1.3888888888888888889e-03; cp = cp * r2 + 4.1666666666666666667e-02; cp = cp * r2 - 0.5; const double cs = 1.0 + r2 * cp;
    const int q = ((int)n) & 3;
    const double so = (q == 0) ? sn : (q == 1) ? cs : (q == 2) ? -sn : -cs;
    const double co = (q == 0) ? cs : (q == 1) ? -sn : (q == 2) ? -cs : sn;
    c = (float)co; s = (float)so;
}
__device__ __forceinline__ void phase_prep(const Ctx& C) {
    TIDS
    float* scr = (float*)(g_lds) + wave * (64 * 33);
    const int gw = C.bid * 8 + wave, NGW = C.G * 8;
    constexpr int I_IN = 16 * (PN / 32), I_OUT = 16 * 32, I_UP = 16 * 128, I_DN = 64 * 32, I_W1 = 32 * 4, I_W2 = 2 * 2;
    constexpr int PER_L = I_IN + I_OUT + I_UP + I_DN + 2 * I_W1 + 2 * I_W2;
    for (int it = gw; it < DEPTH * PER_L; it += NGW) {
        const int l = it / PER_L; int r = it % PER_L;
        if (r < I_IN) { transpose_item<true>(C.in[2] + (size_t)l * DM * DIN, DM, DIN, PN, C.WIN + (size_t)l * PN * DM, C.in[1] + l * DM, scr, r, lane); continue; } r -= I_IN;
        if (r < I_OUT) { transpose_item<false, true>(C.in[19] + (size_t)l * DM * DM, DM, DM, DM, C.WOUT + (size_t)l * DM * DM, nullptr, scr, r, lane); continue; } r -= I_OUT;
        if (r < I_UP) { transpose_item<false>(C.in[21] + (size_t)l * DM * DFF, DM, DFF, DFF, C.WUP + (size_t)l * DFF * DM, C.in[20] + l * DM, scr, r, lane); continue; } r -= I_UP;
        if (r < I_DN) { transpose_item<false, true>(C.in[22] + (size_t)l * DFF * DM, DFF, DM, DM, C.WDN + (size_t)l * DM * DFF, nullptr, scr, r, lane); continue; } r -= I_DN;
        if (r < 2 * I_W1) { const int kv = r / I_W1; transpose_item<false>(C.in[kv ? 10 : 7] + (size_t)l * 2048 * 128, 2048, 128, 128, C.W1T + (size_t)(l * 2 + kv) * 128 * 2048, nullptr, scr, r % I_W1, lane); continue; } r -= 2 * I_W1;
        { const int kv = r / I_W2; transpose_item<false>(C.in[kv ? 11 : 8] + (size_t)l * 128 * 64, 128, 64, 64, C.W2T + (size_t)(l * 2 + kv) * 64 * 128, nullptr, scr, r % I_W2, lane); }
    }
    for (int it = gw; it < DEPTH * 2 * 32; it += NGW) {
        const int lk = it >> 5, fc = it & 31, l = lk >> 1, kv = lk & 1;
        const float* pos = C.in[kv ? 9 : 6] + (size_t)l * 2048 + fc * 64; const float* w1 = C.in[kv ? 10 : 7] + (size_t)l * 2048 * 128 + (size_t)fc * 64 * 128;
        float s0 = 0.f, s1 = 0.f;
#pragma unroll 16
        for (int f = 0; f < 64; ++f) { const float pv = pos[f]; s0 += pv * w1[f * 128 + lane]; s1 += pv * w1[f * 128 + 64 + lane]; }
        C.B1P[(size_t)it * 128 + lane] = s0; C.B1P[(size_t)it * 128 + 64 + lane] = s1;
    }
    for (int e = C.bid * 512 + tid; e < SEQ * 32; e += C.G * 512) {
        const int pos = e >> 5, i = e & 31; const float ang = (float)pos * ROPE_INV[i];
        float cs, sn; sincos_acc(ang, cs, sn); C.ROPE[2 * e] = cs; C.ROPE[2 * e + 1] = sn;
    }
    for (int e = C.bid * 512 + tid; e < 2 * DEPTH * MTOK; e += C.G * 512) C.RSS[e] = 0ull;
    for (int m0 = gw * 4; m0 < MTOK; m0 += NGW * 4) {
        f32x4 v[4][4]; float ss[4];
#pragma unroll
        for (int r = 0; r < 4; ++r) { const f32x4* xr = (const f32x4*)(C.in[0] + (size_t)(m0 + r) * DM) + lane;
#pragma unroll
            for (int j = 0; j < 4; ++j) v[r][j] = xr[64 * j]; }
#pragma unroll
        for (int r = 0; r < 4; ++r) { float sq = 0.f;
#pragma unroll
            for (int j = 0; j < 4; ++j) sq += (v[r][j].x * v[r][j].x + v[r][j].y * v[r][j].y) + (v[r][j].z * v[r][j].z + v[r][j].w * v[r][j].w);
            ss[r] = sq; }
#pragma unroll
        for (int o = 1; o < 64; o <<= 1) {
#pragma unroll
            for (int r = 0; r < 4; ++r) ss[r] += __shfl_xor(ss[r], o); }
#pragma unroll
        for (int r = 0; r < 4; ++r) { const float rs = 1.0f / sqrtf(ss[r] * (1.f / DM) + EPS); u32x2* o8 = (u32x2*)(C.XN + (size_t)(m0 + r) * DM) + lane;
#pragma unroll
            for (int j = 0; j < 4; ++j) { u32x2 w; w.x = pkh(v[r][j].x * rs, v[r][j].y * rs); w.y = pkh(v[r][j].z * rs, v[r][j].w * rs); o8[64 * j] = w; } }
    }
}

__device__ __forceinline__ void phase_tok(const Ctx& C, int l) {
    TIDS
    const int gw = C.bid * 8 + wave, NGW = C.G * 8;
    if (l == 0 && C.bid == 0) { float sb = 0.f; const float* pp = C.B1P + (size_t)(tid >> 7) * 32 * 128 + (tid & 127);
        for (int fc = 0; fc < 32; ++fc) sb += pp[fc * 128];
        C.B1[tid] = sb; }
    const float* cw = C.in[13] + (size_t)l * 4 * 1024; const float* cb = C.in[14] + (size_t)l * 1024; const float* dtb = C.in[15] + l * 8;
    const int ch = lane * 16;
    float wgt[4][16], bias[16];
#pragma unroll
    for (int e = 0; e < 16; ++e) { bias[e] = cb[ch + e];
#pragma unroll
        for (int i = 0; i < 4; ++i) wgt[i][e] = cw[i * 1024 + ch + e]; }
    const float dbias = (lane < 8) ? dtb[lane] : 0.f;
    const int hd = lane >> 2, c8 = (lane & 3) * 8; const bool rl = lane < 16;
    const int rbase = (hd < 2) ? (C_KSLC + hd * 64) : (C_KWIN + (hd - 2) * 64);
    const float rsc = 1.f;
    for (int run = gw; run < MTOK / 16; run += NGW) {
        const int m0 = run * 16, t0 = m0 & (SEQ - 1);
        h16x8 hist[3][2];
#pragma unroll
        for (int i = 0; i < 3; ++i) { const int tt = t0 - 3 + i;
            if (tt >= 0) { const h16* src = C.PROJ + (size_t)(m0 - 3 + i) * PN + C_SX + ch; hist[i][0] = *(const h16x8*)src; hist[i][1] = *(const h16x8*)(src + 8); }
            else { hist[i][0] = (h16x8){}; hist[i][1] = (h16x8){}; } }
        h16x8 nc0, nc1, nx1 = {}, nx2 = {}; f32x4 ntb[4] = {}; float ndtr = 0.f;
        { const h16* prow = C.PROJ + (size_t)m0 * PN; nc0 = *(const h16x8*)(prow + C_SX + ch); nc1 = *(const h16x8*)(prow + C_SX + ch + 8);
            if (rl) { nx1 = *(const h16x8*)(prow + rbase + c8); nx2 = *(const h16x8*)(prow + rbase + 32 + c8);
#pragma unroll
                for (int i = 0; i < 4; ++i) ntb[i] = *(const f32x4*)(C.ROPE + 2 * (t0 * 32 + c8) + 4 * i); }
            if (lane < 8) ndtr = C.PSM[(size_t)m0 * PSM_W + 28 + lane]; }
#pragma unroll 1
        for (int k = 0; k < 16; ++k) { const int m = m0 + k;
            h16* prow = C.PROJ + (size_t)m * PN;
            const h16x8 c0 = nc0, c1 = nc1, x1 = nx1, x2 = nx2; f32x4 tb[4]; tb[0] = ntb[0]; tb[1] = ntb[1]; tb[2] = ntb[2]; tb[3] = ntb[3]; const float dtr = ndtr;
            if (k < 15) { const h16* pn = prow + PN; nc0 = *(const h16x8*)(pn + C_SX + ch); nc1 = *(const h16x8*)(pn + C_SX + ch + 8);
                if (rl) { nx1 = *(const h16x8*)(pn + rbase + c8); nx2 = *(const h16x8*)(pn + rbase + 32 + c8);
#pragma unroll
                    for (int i = 0; i < 4; ++i) ntb[i] = *(const f32x4*)(C.ROPE + 2 * ((t0 + k + 1) * 32 + c8) + 4 * i); }
                if (lane < 8) ndtr = C.PSM[(size_t)(m + 1) * PSM_W + 28 + lane]; }
            float a[16];
#pragma unroll
            for (int e = 0; e < 8; ++e) { a[e] = bias[e] + wgt[0][e] * (float)hist[0][0][e] + wgt[1][e] * (float)hist[1][0][e] + wgt[2][e] * (float)hist[2][0][e] + wgt[3][e] * (float)c0[e];
                a[8 + e] = bias[8 + e] + wgt[0][8 + e] * (float)hist[0][1][e] + wgt[1][8 + e] * (float)hist[1][1][e] + wgt[2][8 + e] * (float)hist[2][1][e] + wgt[3][8 + e] * (float)c1[e]; }
            hist[0][0] = hist[1][0]; hist[0][1] = hist[1][1]; hist[1][0] = hist[2][0]; hist[1][1] = hist[2][1]; hist[2][0] = c0; hist[2][1] = c1;
            u32x4 o0, o1; o0.x = pkh(siluf_(a[0]), siluf_(a[1])); o0.y = pkh(siluf_(a[2]), siluf_(a[3])); o0.z = pkh(siluf_(a[4]), siluf_(a[5])); o0.w = pkh(siluf_(a[6]), siluf_(a[7]));
            o1.x = pkh(siluf_(a[8]), siluf_(a[9])); o1.y = pkh(siluf_(a[10]), siluf_(a[11])); o1.z = pkh(siluf_(a[12]), siluf_(a[13])); o1.w = pkh(siluf_(a[14]), siluf_(a[15]));
            h16* dst = C.XBCC + (size_t)m * 1024 + ch; *(u32x4*)dst = o0; *(u32x4*)(dst + 8) = o1;
            if (rl) { h16x8 y1, y2;
#pragma unroll
                for (int e = 0; e < 8; ++e) { const float cs = tb[e >> 1][2 * (e & 1)], sn = tb[e >> 1][2 * (e & 1) + 1]; const float a1 = (float)x1[e], a2 = (float)x2[e];
                    y1[e] = (h16)((a1 * cs - a2 * sn) * rsc); y2[e] = (h16)((a2 * cs + a1 * sn) * rsc); }
                *(h16x8*)(prow + rbase + c8) = y1; *(h16x8*)(prow + rbase + 32 + c8) = y2; }
            if (lane < 8) C.DTV[(size_t)m * 8 + lane] = softplusf_(dtr + dbias);
        }
    }
}

__device__ __forceinline__ float gelu_tanh(float x) { const float u = 0.7978845608028654f * (x + 0.044715f * x * x * x); const float e = __expf(2.f * u); const float th = 1.f - 2.f / (e + 1.f); return 0.5f * x * (1.f + th); }
__device__ __forceinline__ void nsa_compress_unit(const Ctx& C, int l, int u) {
    const int kv = u >> 7, b = (u >> 5) & 3, g = (u >> 4) & 1, mt2 = u & 15;
    TIDS
    const int w = wave, cc = lane & 15, quad = lane >> 4;
    h16* As = (h16*)g_lds;
    h16* Hs = (h16*)(g_lds + 2 * 272 * 72 * 2);
    const h16* W1T = C.W1T + (size_t)(l * 2 + kv) * 128 * 2048; const h16* W2T = C.W2T + (size_t)(l * 2 + kv) * 64 * 128; const float* B1 = C.B1 + (l * 2 + kv) * 128;
    const int col = (kv ? C_VCMP : C_KCMP) + g * 64;
    {
        h16x8 s1[5], s2[5]; f32x4 tb[5][4];
#pragma unroll
        for (int i = 0; i < 5; ++i) { const int pc = tid + 512 * i; if (pc < 2 * 272 * 4) { const int half = pc / (272 * 4), rem = pc % (272 * 4), t = rem >> 2, c4 = rem & 3;
                int tok = 256 * mt2 + 4096 * half + t; tok = tok < SEQ ? tok : SEQ - 1; const h16* src = C.PROJ + (size_t)(b * SEQ + tok) * PN + col + c4 * 8;
                s1[i] = *(const h16x8*)src; s2[i] = *(const h16x8*)(src + 32);
                if (kv == 0) {
#pragma unroll
                    for (int q4 = 0; q4 < 4; ++q4) tb[i][q4] = *(const f32x4*)(C.ROPE + 2 * (tok * 32 + c4 * 8) + 4 * q4); } } }
#pragma unroll
        for (int i = 0; i < 5; ++i) { const int pc = tid + 512 * i; if (pc < 2 * 272 * 4) { const int half = pc / (272 * 4), rem = pc % (272 * 4), t = rem >> 2, c4 = rem & 3;
                h16x8 y1 = s1[i], y2 = s2[i];
                if (kv == 0) {
#pragma unroll
                    for (int e = 0; e < 8; ++e) { const float cs = tb[i][e >> 1][2 * (e & 1)], sn = tb[i][e >> 1][2 * (e & 1) + 1]; const float a1 = (float)s1[i][e], a2 = (float)s2[i][e];
                        y1[e] = (h16)(a1 * cs - a2 * sn); y2[e] = (h16)(a2 * cs + a1 * sn); } }
                *(h16x8*)(As + (half * 272 + t) * 72 + c4 * 8) = y1; *(h16x8*)(As + (half * 272 + t) * 72 + 32 + c4 * 8) = y2; } } }
    __syncthreads();
    f32x4 acc0 = {0.f, 0.f, 0.f, 0.f}, acc1 = {0.f, 0.f, 0.f, 0.f};
    const h16* brow = W1T + (size_t)(w * 16 + cc) * 2048 + quad * 8;
    const h16* a0p = As + (16 * cc) * 72 + quad * 8; const h16* a1p = a0p + 272 * 72;
#pragma unroll 16
    for (int kk = 0; kk < 64; ++kk) {
        const h16x8 bb = *(const h16x8*)(brow + kk * 32);
        const h16x8 a0 = *(const h16x8*)(a0p + (kk >> 1) * 72 + (kk & 1) * 32);
        const h16x8 a1 = *(const h16x8*)(a1p + (kk >> 1) * 72 + (kk & 1) * 32);
        acc0 = mfma16(a0, bb, acc0); acc1 = mfma16(a1, bb, acc1);
    }
    { const float bias = B1[w * 16 + cc];
#pragma unroll
        for (int j = 0; j < 4; ++j) { Hs[(quad * 4 + j) * 136 + w * 16 + cc] = (h16)gelu_tanh(acc0[j] + bias); Hs[(16 + quad * 4 + j) * 136 + w * 16 + cc] = (h16)gelu_tanh(acc1[j] + bias); } }
    __syncthreads();
    { const int half = w >> 2, wn = w & 3;
        f32x4 o = {0.f, 0.f, 0.f, 0.f};
#pragma unroll
        for (int kk = 0; kk < 4; ++kk) { const h16x8 a = *(const h16x8*)(Hs + (half * 16 + cc) * 136 + kk * 32 + quad * 8); const h16x8 bb = *(const h16x8*)(W2T + (size_t)(wn * 16 + cc) * 128 + kk * 32 + quad * 8); o = mfma16(a, bb, o); }
        h16* dst = (kv ? C.VC : C.KC) + (size_t)((b * 2 + g) * 512 + (mt2 + 16 * half) * 16) * 64;
#pragma unroll
        for (int j = 0; j < 4; ++j) dst[(quad * 4 + j) * 64 + wn * 16 + cc] = (h16)o[j];
    }
    __syncthreads();
}

__device__ __forceinline__ h16x4 tr_read(const h16* p) { typedef short s16x4 __attribute__((ext_vector_type(4))); return __builtin_bit_cast(h16x4, __builtin_amdgcn_ds_read_tr16_b64_v4i16((LAS s16x4*)p)); }
__device__ __forceinline__ h16x8 cat44(h16x4 lo, h16x4 hi) { return (h16x8){lo[0], lo[1], lo[2], lo[3], hi[0], hi[1], hi[2], hi[3]}; }
struct SsdPre { float dt; h16x8 x[2]; h16x8 bq[4]; };
__device__ __forceinline__ void ssd_states_load(const Ctx& C, int u, int tid, SsdPre& P) {
    const int b = u >> 9, c = (u >> 3) & 63, h = u & 7, g = h >> 2; const size_t row0 = (size_t)b * SEQ + c * 128;
    P.dt = (tid < 128) ? C.DTV[(row0 + tid) * 8 + h] : 0.f;
#pragma unroll
    for (int i = 0; i < 2; ++i) { const int ch = tid + 512 * i, tok = ch >> 3, c8 = ch & 7; P.x[i] = *(const h16x8*)(C.XBCC + (row0 + tok) * 1024 + h * 64 + c8 * 8); }
#pragma unroll
    for (int i = 0; i < 4; ++i) { const int ch = tid + 512 * i, tok = ch >> 4, c16 = ch & 15; P.bq[i] = *(const h16x8*)(C.XBCC + (row0 + tok) * 1024 + 512 + g * 128 + c16 * 8); }
}
__device__ __forceinline__ void ssd_states_phase(const Ctx& C, int l, int ufirst, int ustep) {
    TIDS
    const int w = wave, cc = lane & 15, quad = lane >> 4;
    float* acs = (float*)g_lds; float* dtl = acs + 128; float* wl = acs + 256;
    h16* Xs = (h16*)(g_lds + 2048);
    h16* Bs = (h16*)(g_lds + 2048 + 18432);
    h16* Os_ = (h16*)(g_lds + 2048 + 18432 + 34816);
    int u = ufirst; SsdPre pre; if (u < 2048) ssd_states_load(C, u, tid, pre);
    while (u < 2048) {
        const int b = u >> 9, c = (u >> 3) & 63, h = u & 7; const size_t row0 = (size_t)b * SEQ + c * 128;
        const SsdPre cur = pre;
        const float A = -__expf(C.in[16][l * 8 + h]);
        if (tid < 128) dtl[tid] = cur.dt;
        __syncthreads();
        if (w == 0) {
            const float d0 = dtl[2 * lane], d1 = dtl[2 * lane + 1]; const float a0 = d0 * A, a1 = d1 * A, sm = a0 + a1; float incl = sm;
#pragma unroll
            for (int o = 1; o < 64; o <<= 1) { const float t = __shfl_up(incl, o); if (lane >= o) incl += t; }
            const float excl = incl - sm, tot = __shfl(incl, 63); const float c0 = excl + a0, c1 = incl;
            acs[2 * lane] = c0; acs[2 * lane + 1] = c1; wl[2 * lane] = __expf(tot - c0) * d0; wl[2 * lane + 1] = __expf(tot - c1) * d1;
            if (lane == 63) C.CD[(b * 64 + c) * 8 + h] = __expf(tot);
        }
        __syncthreads();
#pragma unroll
        for (int i = 0; i < 2; ++i) { const int ch = tid + 512 * i, tok = ch >> 3, c8 = ch & 7; *(h16x8*)(Xs + tok * 72 + c8 * 8) = cur.x[i]; }
#pragma unroll
        for (int i = 0; i < 4; ++i) { const int ch = tid + 512 * i, tok = ch >> 4, c16 = ch & 15; const float ww = wl[tok]; h16x8 o;
#pragma unroll
            for (int e = 0; e < 8; ++e) o[e] = (h16)((float)cur.bq[i][e] * ww);
            *(h16x8*)(Bs + tok * 136 + c16 * 8) = o; }
        if (tid < 128) C.ACS[(row0 + tid) * 8 + h] = acs[tid];
        const int un = u + ustep; if (un < 2048) ssd_states_load(C, un, tid, pre);
        __syncthreads();
        const int mi = w & 3;
        h16x8 xa[4];
#pragma unroll
        for (int kk = 0; kk < 4; ++kk) { const h16* xp = Xs + (kk * 32 + 8 * quad + (cc >> 2)) * 72 + mi * 16 + 4 * (cc & 3); xa[kk] = cat44(tr_read(xp), tr_read(xp + 4 * 72)); }
        h16* dst = C.SSDST + (size_t)((b * 64 + c) * 8 + h) * 8192;
#pragma unroll
        for (int q = 0; q < 4; ++q) { const int ni = (w >> 2) * 4 + q; f32x4 acc = {0.f, 0.f, 0.f, 0.f};
#pragma unroll
            for (int kk = 0; kk < 4; ++kk) { const h16* bp = Bs + (kk * 32 + 8 * quad + (cc >> 2)) * 136 + ni * 16 + 4 * (cc & 3); acc = mfma16(xa[kk], cat44(tr_read(bp), tr_read(bp + 4 * 136)), acc); }
#pragma unroll
            for (int j = 0; j < 4; ++j) Os_[(mi * 16 + quad * 4 + j) * 136 + ni * 16 + cc] = (h16)acc[j]; }
        __syncthreads();
#pragma unroll
        for (int i = 0; i < 2; ++i) { const int ch = tid + 512 * i, p = ch >> 4, c16 = ch & 15; *(h16x8*)(dst + p * 128 + c16 * 8) = *(const h16x8*)(Os_ + p * 136 + c16 * 8); }
        u = un;
    }
    __syncthreads();
}

struct SsdYPre { float acs, dt; h16x8 x[2], z[2], he[2]; };
struct SsdBC { h16x8 cq[4], bq[4]; };
__device__ __forceinline__ void ssd_y_load(const Ctx& C, int bc, int h, int tid, SsdYPre& P) {
    const int b = bc >> 6, c = bc & 63; const size_t row0 = (size_t)b * SEQ + c * 128;
    P.acs = (tid < 128) ? C.ACS[(row0 + tid) * 8 + h] : 0.f; P.dt = (tid < 128) ? C.DTV[(row0 + tid) * 8 + h] : 0.f;
#pragma unroll
    for (int i = 0; i < 2; ++i) { const int ch = tid + 512 * i, tok = ch >> 3, c8 = ch & 7; P.x[i] = *(const h16x8*)(C.XBCC + (row0 + tok) * 1024 + h * 64 + c8 * 8); P.z[i] = *(const h16x8*)(C.PROJ + (row0 + tok) * PN + C_SZ + h * 64 + c8 * 8); }
    const h16* src = C.SSDST + (size_t)((b * 64 + c) * 8 + h) * 8192;
#pragma unroll
    for (int i = 0; i < 2; ++i) P.he[i] = *(const h16x8*)(src + (tid + 512 * i) * 8);
}
__device__ __forceinline__ void ssd_bc_load(const Ctx& C, int bc, int g, int tid, SsdBC& P) {
    const int b = bc >> 6, c = bc & 63; const size_t row0 = (size_t)b * SEQ + c * 128;
#pragma unroll
    for (int i = 0; i < 4; ++i) { const int ch = tid + 512 * i, tok = ch >> 4, c16 = ch & 15; const h16* src = C.XBCC + (row0 + tok) * 1024 + 512 + g * 128 + c16 * 8; P.bq[i] = *(const h16x8*)src; P.cq[i] = *(const h16x8*)(src + 256); }
}
__device__ __forceinline__ void ssd_y_phase(const Ctx& C, int l, int bcfirst, int bcstep) {
    TIDS
    const int w = wave, cc = lane & 15, quad = lane >> 4;
    float* acs = (float*)g_lds; float* dtl = acs + 128; float* rss = acs + 256;
    h16* Cm = (h16*)(g_lds + 2048);
    h16* Bm = (h16*)(g_lds + 2048 + 34816);
    h16* Xs = (h16*)(g_lds + 2048 + 2 * 34816);
    h16* HE = (h16*)(g_lds + 2048 + 2 * 34816 + 18432);
    h16* Zs = (h16*)(g_lds + 2048 + 2 * 34816 + 18432 + 17408);
    const float* nwp = C.in[18] + l * 512;
    for (int bc = bcfirst; bc < 256; bc += bcstep) {
        const int b = bc >> 6, c = bc & 63; const size_t row0 = (size_t)b * SEQ + c * 128;
        SsdYPre pre; ssd_y_load(C, bc, 0, tid, pre);
        h16x4 cbt[8];
#pragma unroll 1
        for (int h = 0; h < 8; ++h) { const int g = h >> 2;
            __syncthreads();
            if (tid < 128) { acs[tid] = pre.acs; dtl[tid] = pre.dt; if ((h & 3) == 0) rss[tid] = 0.f; }
            if ((h & 3) == 0) { SsdBC pbc; ssd_bc_load(C, bc, g, tid, pbc);
#pragma unroll
                for (int i = 0; i < 4; ++i) { const int ch = tid + 512 * i, tok = ch >> 4, c16 = ch & 15; *(h16x8*)(Bm + tok * 136 + c16 * 8) = pbc.bq[i]; *(h16x8*)(Cm + tok * 136 + c16 * 8) = pbc.cq[i]; } }
#pragma unroll
            for (int i = 0; i < 2; ++i) { const int ch = tid + 512 * i, tok = ch >> 3, c8 = ch & 7; *(h16x8*)(Xs + tok * 72 + c8 * 8) = pre.x[i]; *(h16x8*)(Zs + tok * 72 + c8 * 8) = pre.z[i]; }
#pragma unroll
            for (int i = 0; i < 2; ++i) { const int ch = tid + 512 * i, p = ch >> 4, c16 = ch & 15; *(h16x8*)(HE + p * 136 + c16 * 8) = pre.he[i]; }
            if (h < 7) ssd_y_load(C, bc, h + 1, tid, pre);
            __syncthreads();
            h16x8 ca[4];
#pragma unroll
            for (int kk = 0; kk < 4; ++kk) ca[kk] = *(const h16x8*)(Cm + (w * 16 + cc) * 136 + kk * 32 + quad * 8);
            if ((h & 3) == 0) {
#pragma unroll
                for (int ni = 0; ni < 8; ++ni) { f32x4 acc = {0.f, 0.f, 0.f, 0.f};
#pragma unroll
                    for (int kk = 0; kk < 4; ++kk) { const h16x8 bb = *(const h16x8*)(Bm + (ni * 16 + cc) * 136 + kk * 32 + quad * 8); acc = mfma16(ca[kk], bb, acc); }
                    cbt[ni] = (h16x4){(h16)acc[0], (h16)acc[1], (h16)acc[2], (h16)acc[3]}; }
                __syncthreads();
            }
#pragma unroll
            for (int ni = 0; ni < 8; ++ni) { const int sidx = ni * 16 + cc; const float as_ = acs[sidx], ds_ = dtl[sidx];
#pragma unroll
                for (int j = 0; j < 4; ++j) { const int lr = w * 16 + quad * 4 + j; const float v = (sidx <= lr) ? (float)cbt[ni][j] * __expf(acs[lr] - as_) * ds_ : 0.f; Bm[lr * 136 + sidx] = (h16)v; } }
            __syncthreads();
            const float Dh = C.in[17][l * 8 + h];
            float ssq[4] = {0.f, 0.f, 0.f, 0.f};
            h16x8 ma[4];
#pragma unroll
            for (int kk = 0; kk < 4; ++kk) ma[kk] = *(const h16x8*)(Bm + (w * 16 + cc) * 136 + kk * 32 + quad * 8);
            float ea[4];
#pragma unroll
            for (int j = 0; j < 4; ++j) ea[j] = __expf(acs[w * 16 + quad * 4 + j]);
#pragma unroll
            for (int ni = 0; ni < 4; ++ni) { f32x4 acc = {0.f, 0.f, 0.f, 0.f};
#pragma unroll
                for (int kk = 0; kk < 4; ++kk) { const h16x8 bb = *(const h16x8*)(HE + (ni * 16 + cc) * 136 + kk * 32 + quad * 8); acc = mfma16(ca[kk], bb, acc); }
#pragma unroll
                for (int j = 0; j < 4; ++j) acc[j] *= ea[j];
#pragma unroll
                for (int kk = 0; kk < 4; ++kk) { const h16* xp = Xs + (kk * 32 + 8 * quad + (cc >> 2)) * 72 + ni * 16 + 4 * (cc & 3); acc = mfma16(ma[kk], cat44(tr_read(xp), tr_read(xp + 4 * 72)), acc); }
                const int p = ni * 16 + cc;
#pragma unroll
                for (int j = 0; j < 4; ++j) { const int lr = w * 16 + quad * 4 + j; const float x = (float)Xs[lr * 72 + p]; const float z = (float)Zs[lr * 72 + p];
                    const h16 yh = (h16)((acc[j] + Dh * x) * siluf_(z)); Zs[lr * 72 + p] = yh; const float yr = (float)yh; ssq[j] += yr * yr; } }
#pragma unroll
            for (int j = 0; j < 4; ++j) { float sv = ssq[j]; sv += __shfl_xor(sv, 1); sv += __shfl_xor(sv, 2); sv += __shfl_xor(sv, 4); sv += __shfl_xor(sv, 8);
                if (cc == 0) rss[w * 16 + quad * 4 + j] += sv; }
            __syncthreads();
#pragma unroll
            for (int i = 0; i < 2; ++i) { const int ch = tid + 512 * i, tok = ch >> 3, c8 = ch & 7; *(h16x8*)(C.XN + (row0 + tok) * 1024 + 512 + h * 64 + c8 * 8) = *(const h16x8*)(Zs + tok * 72 + c8 * 8); }
            if ((h & 3) == 3) {
                asm volatile("s_waitcnt vmcnt(0)" ::: "memory");
                __syncthreads();
#pragma unroll
                for (int i = 0; i < 8; ++i) { const int ch = tid + 512 * i, tok = ch >> 5, c8 = ch & 31; const float rs = 1.0f / sqrtf(rss[tok] * (1.f / 256.f) + EPS);
                    h16* p = C.XN + (row0 + tok) * 1024 + 512 + g * 256 + c8 * 8; const h16x8 v = *(const h16x8*)p; const float* nw = nwp + g * 256 + c8 * 8;
                    u32x4 o; o.x = pkb((float)v[0] * rs * nw[0], (float)v[1] * rs * nw[1]); o.y = pkb((float)v[2] * rs * nw[2], (float)v[3] * rs * nw[3]);
                    o.z = pkb((float)v[4] * rs * nw[4], (float)v[5] * rs * nw[5]); o.w = pkb((float)v[6] * rs * nw[6], (float)v[7] * rs * nw[7]); *(u32x4*)p = o; }
            }
        }
    }
    __syncthreads();
}

struct GlaLoad { f32x4 gl[4]; h16x8 q0, k0, vx[2], rx[2]; };
template <int PASS>
__device__ __forceinline__ void gla_load(const Ctx& C, GlaLoad& L, size_t rowh, int h, int lane) {
    const int tl = lane & 15, kq = lane >> 4; const size_t rowt = rowh + tl;
#pragma unroll
    for (int i = 0; i < 4; ++i) L.gl[i] = *(const f32x4*)(C.PSM + rowt * PSM_W + 4 * i);
    L.q0 = *(const h16x8*)(C.PROJ + rowt * PN + C_GQ + h * 32 + kq * 8);
    L.k0 = *(const h16x8*)(C.PROJ + rowt * PN + C_GK + h * 32 + kq * 8);
#pragma unroll
    for (int i = 0; i < 2; ++i) { const int ch = lane + 64 * i, t = ch >> 3, c8 = ch & 7; L.vx[i] = *(const h16x8*)(C.PROJ + (rowh + t) * PN + C_GV + h * 64 + c8 * 8);
        if (PASS == 1) L.rx[i] = *(const h16x8*)(C.PROJ + (rowh + t) * PN + C_GR + h * 64 + c8 * 8); }
}
template <int PASS>
__device__ __forceinline__ void gla_block_unit(const Ctx& C, int l, int bu) {
    TIDS
    const int w = wave; const int wu = bu * 8 + w; const int cc = lane & 15, quad = lane >> 4;
    const int bh = wu >> 7, seg = wu & 127, b = bh >> 2, h = bh & 3;
    const size_t row0 = (size_t)b * SEQ + seg * 64;
    unsigned char* wl = g_lds + w * 11264;
    h16* QT = (h16*)wl; h16* KT = QT + 640; h16* KH = KT + 640;
    h16* VS = KH + 640; h16* RS = VS + 1152;
    float* EM = (float*)(RS + 1152); float* EE = EM + 32;
    float* W2S = EE + 32;
    const int tl = cc, kq = quad;
    const float* gb = C.in[4] + l * 128 + h * 32 + kq * 8;
    { const float* w2g = C.in[3] + (size_t)l * 16 * 128 + h * 32;
#pragma unroll
        for (int i = 0; i < 2; ++i) { const int e4 = lane + 64 * i, r = e4 >> 3, c4 = e4 & 7; *(f32x4*)(W2S + r * 32 + c4 * 4) = *(const f32x4*)(w2g + r * 128 + c4 * 4); } }
    const float* w2 = W2S + kq * 8;
    f32x4 S[2][4];
    float* gst = C.GLAST + (size_t)(bh * 128 + seg) * 2048;
#pragma unroll
    for (int md = 0; md < 2; ++md)
#pragma unroll
        for (int nt = 0; nt < 4; ++nt)
#pragma unroll
            for (int j = 0; j < 4; ++j) S[md][nt][j] = (PASS == 1) ? gst[(16 * md + 4 * quad + j) * 64 + 16 * nt + cc] : 0.f;
    float bsum[8];
#pragma unroll
    for (int k = 0; k < 8; ++k) bsum[k] = 0.f;
    float gnw[4][4];
    if (PASS == 1) {
#pragma unroll
        for (int mt = 0; mt < 4; ++mt)
#pragma unroll
            for (int j = 0; j < 4; ++j) gnw[mt][j] = C.in[5][l * 256 + h * 64 + 16 * mt + 4 * quad + j]; }
    GlaLoad pre, pre2; gla_load<PASS>(C, pre, row0, h, lane); gla_load<PASS>(C, pre2, row0 + 16, h, lane);
#pragma unroll 1
    for (int qt = 0; qt < 4; ++qt) {
        const size_t rowh = row0 + qt * 16;
        const GlaLoad cur = pre; pre = pre2;
        if (qt < 2) gla_load<PASS>(C, pre2, rowh + 32, h, lane);
        float bi[8];
#pragma unroll
        for (int k = 0; k < 8; ++k) bi[k] = gb[k];
#pragma unroll
        for (int r = 0; r < 16; ++r) { const float gv = cur.gl[r >> 2][r & 3]; const f32x4 wa = *(const f32x4*)(w2 + r * 32), wb = *(const f32x4*)(w2 + r * 32 + 4);
#pragma unroll
            for (int k = 0; k < 4; ++k) { bi[k] += gv * wa[k]; bi[4 + k] += gv * wb[k]; } }
#pragma unroll
        for (int k = 0; k < 8; ++k) bi[k] = -0.0625f * __builtin_amdgcn_logf(1.f + ex2(-1.4426950408889634f * bi[k]));
#pragma unroll
        for (int o = 1; o < 16; o <<= 1)
#pragma unroll
            for (int k = 0; k < 8; ++k) { const float t = __shfl_up(bi[k], o, 16); if (tl >= o) bi[k] += t; }
        float bmid[8], bend[8];
#pragma unroll
        for (int k = 0; k < 8; ++k) { bmid[k] = __shfl(bi[k], 7, 16); bend[k] = __shfl(bi[k], 15, 16); bsum[k] += bend[k]; }
        asm volatile("" ::: "memory");
        { h16x8 qo, ko, kh;
#pragma unroll
            for (int k = 0; k < 8; ++k) { const float kf = (float)cur.k0[k]; qo[k] = (h16)((float)cur.q0[k] * 0.17677669529663687f * ex2(bi[k] - bmid[k])); ko[k] = (h16)(kf * ex2(bmid[k] - bi[k])); kh[k] = (h16)(kf * ex2(bend[k] - bi[k])); }
            *(h16x8*)(QT + tl * 40 + kq * 8) = qo; *(h16x8*)(KT + tl * 40 + kq * 8) = ko; *(h16x8*)(KH + tl * 40 + kq * 8) = kh;
            if (tl == 0) {
#pragma unroll
                for (int k4 = 0; k4 < 2; ++k4) { f32x4 em, ee;
#pragma unroll
                    for (int e = 0; e < 4; ++e) { em[e] = ex2(bmid[4 * k4 + e]); ee[e] = ex2(bend[4 * k4 + e]); }
                    *(f32x4*)(EM + kq * 8 + 4 * k4) = em; *(f32x4*)(EE + kq * 8 + 4 * k4) = ee; } } }
#pragma unroll
        for (int i = 0; i < 2; ++i) { const int ch = lane + 64 * i, t = ch >> 3, c8 = ch & 7; *(h16x8*)(VS + t * 72 + c8 * 8) = cur.vx[i]; if (PASS == 1) *(h16x8*)(RS + t * 72 + c8 * 8) = cur.rx[i]; }
        asm volatile("s_waitcnt lgkmcnt(0)" ::: "memory");
        h16x8 vfr[4];
#pragma unroll
        for (int nt = 0; nt < 4; ++nt) { const h16x4 t4 = tr_read(VS + (4 * quad + (cc >> 2)) * 72 + 16 * nt + 4 * (cc & 3)); vfr[nt] = (h16x8){t4[0], t4[1], t4[2], t4[3], (h16)0.f, (h16)0.f, (h16)0.f, (h16)0.f}; }
        if (PASS == 1) {
            f32x4 at = {0.f, 0.f, 0.f, 0.f};
            at = mfma16(*(const h16x8*)(KT + cc * 40 + quad * 8), *(const h16x8*)(QT + cc * 40 + quad * 8), at);
            h16x8 pa;
#pragma unroll
            for (int e = 0; e < 4; ++e) { pa[e] = (h16)((4 * quad + e <= cc) ? at[e] : 0.f); pa[4 + e] = (h16)0.f; }
            const h16x4 ql = *(const h16x4*)(QT + cc * 40 + 4 * quad), qh = *(const h16x4*)(QT + cc * 40 + 16 + 4 * quad);
            const h16x8 qfr = cat44(ql, qh);
            const f32x4 em0 = *(const f32x4*)(EM + 4 * quad), em1 = *(const f32x4*)(EM + 16 + 4 * quad);
            f32x4 ot[4]; float ssq = 0.f;
#pragma unroll
            for (int mt = 0; mt < 4; ++mt) { f32x4 acc = {0.f, 0.f, 0.f, 0.f};
                acc = mfma16(vfr[mt], pa, acc);
                const h16x8 sfr = {(h16)(S[0][mt][0] * em0[0]), (h16)(S[0][mt][1] * em0[1]), (h16)(S[0][mt][2] * em0[2]), (h16)(S[0][mt][3] * em0[3]),
                                   (h16)(S[1][mt][0] * em1[0]), (h16)(S[1][mt][1] * em1[1]), (h16)(S[1][mt][2] * em1[2]), (h16)(S[1][mt][3] * em1[3])};
                acc = mfma16(sfr, qfr, acc);
                ot[mt] = acc; ssq += (acc[0] * acc[0] + acc[1] * acc[1]) + (acc[2] * acc[2] + acc[3] * acc[3]); }
            ssq += __shfl_xor(ssq, 16); ssq += __shfl_xor(ssq, 32);
            const float rs = 1.0f / sqrtf(ssq * (1.f / 64.f) + EPS);
#pragma unroll
            for (int mt = 0; mt < 4; ++mt) { const h16x4 r4 = *(const h16x4*)(RS + cc * 72 + 16 * mt + 4 * quad);
                u32x2 wv; wv.x = pkb(ot[mt][0] * rs * gnw[mt][0] * siluf_((float)r4[0]), ot[mt][1] * rs * gnw[mt][1] * siluf_((float)r4[1]));
                wv.y = pkb(ot[mt][2] * rs * gnw[mt][2] * siluf_((float)r4[2]), ot[mt][3] * rs * gnw[mt][3] * siluf_((float)r4[3]));
                *(u32x2*)(C.XN + (rowh + cc) * 1024 + h * 64 + 16 * mt + 4 * quad) = wv; }
        }
#pragma unroll
        for (int md = 0; md < 2; ++md) { const f32x4 ee = *(const f32x4*)(EE + 16 * md + 4 * quad);
            const h16x4 k4 = tr_read(KH + (4 * quad + (cc >> 2)) * 40 + 16 * md + 4 * (cc & 3));
            const h16x8 kfr = {k4[0], k4[1], k4[2], k4[3], (h16)0.f, (h16)0.f, (h16)0.f, (h16)0.f};
#pragma unroll
            for (int nt = 0; nt < 4; ++nt) { S[md][nt] = S[md][nt] * ee; S[md][nt] = mfma16(kfr, vfr[nt], S[md][nt]); } }
    }
    if (PASS == 0) {
#pragma unroll
        for (int md = 0; md < 2; ++md)
#pragma unroll
            for (int nt = 0; nt < 4; ++nt)
#pragma unroll
                for (int j = 0; j < 4; ++j) gst[(16 * md + 4 * quad + j) * 64 + 16 * nt + cc] = S[md][nt][j];
        if (tl == 0) {
#pragma unroll
            for (int k = 0; k < 8; ++k) C.GLAG[(size_t)(bh * 128 + seg) * 32 + kq * 8 + k] = ex2(bsum[k]); }
    }
}

__device__ __forceinline__ void phase_scans(const Ctx& C) {
    TIDS
    for (int e = C.bid * 512 + tid; e < BATCH * 8 * 4096; e += C.G * 512) {
        const int bh = e >> 12, b = bh >> 3, h = bh & 7, pn = e & 4095;
        h16x2* p = (h16x2*)(C.SSDST + (size_t)(b * 64 * 8 + h) * 8192) + pn; const float* cd = C.CD + b * 64 * 8 + h;
        float s0 = 0.f, s1 = 0.f;
        for (int c0 = 0; c0 < 64; c0 += 16) { h16x2 v[16]; float d[16];
#pragma unroll
            for (int i = 0; i < 16; ++i) { v[i] = p[(size_t)(c0 + i) * 8 * 4096]; d[i] = cd[(c0 + i) * 8]; }
#pragma unroll
            for (int i = 0; i < 16; ++i) { h16x2 o = {(h16)s0, (h16)s1}; p[(size_t)(c0 + i) * 8 * 4096] = o; s0 = d[i] * s0 + (float)v[i][0]; s1 = d[i] * s1 + (float)v[i][1]; } }
    }
    for (int e = C.bid * 512 + tid; e < 16 * 2048; e += C.G * 512) {
        const int bh = e >> 11, kv = e & 2047, k = kv >> 6;
        float* p = C.GLAST + (size_t)bh * 128 * 2048 + kv; const float* gg = C.GLAG + (size_t)bh * 128 * 32 + k;
        float st = 0.f;
        for (int s0 = 0; s0 < 128; s0 += 8) { float v[8], d[8];
#pragma unroll
            for (int i = 0; i < 8; ++i) { v[i] = p[(size_t)(s0 + i) * 2048]; d[i] = gg[(s0 + i) * 32]; }
#pragma unroll
            for (int i = 0; i < 8; ++i) { p[(size_t)(s0 + i) * 2048] = st; st = d[i] * st + v[i]; } }
    }
}

constexpr int KV_LD = 80, KV_TILE = 64 * KV_LD;
__device__ __forceinline__ void qk_tile(f32x4 (&s)[4], const h16* Ks, const h16x8 (&qf)[2], int cc, int quad) {
#pragma unroll
    for (int mt = 0; mt < 4; ++mt) { f32x4 a = {0.f, 0.f, 0.f, 0.f};
#pragma unroll
        for (int ks = 0; ks < 2; ++ks) { const h16x8 kf = *(const h16x8*)(Ks + (mt * 16 + cc) * KV_LD + ks * 32 + quad * 8); a = mfma16(kf, qf[ks], a); }
        s[mt] = a; }
}
__device__ __forceinline__ void pv_tile(f32x4 (&O)[4], const h16* Vs, const f32x4 (&p)[4], int cc, int quad) {
    h16x8 pf[2];
#pragma unroll
    for (int k2 = 0; k2 < 2; ++k2) pf[k2] = (h16x8){(h16)p[2 * k2][0], (h16)p[2 * k2][1], (h16)p[2 * k2][2], (h16)p[2 * k2][3], (h16)p[2 * k2 + 1][0], (h16)p[2 * k2 + 1][1], (h16)p[2 * k2 + 1][2], (h16)p[2 * k2 + 1][3]};
#pragma unroll
    for (int md = 0; md < 4; ++md)
#pragma unroll
        for (int k2 = 0; k2 < 2; ++k2) { const h16* vp = Vs + (32 * k2 + 4 * quad + (cc >> 2)) * KV_LD + md * 16 + 4 * (cc & 3);
            const h16x4 lo = tr_read(vp), hi = tr_read(vp + 16 * KV_LD);
            const h16x8 vf = {lo[0], lo[1], lo[2], lo[3], hi[0], hi[1], hi[2], hi[3]}; O[md] = mfma16(vf, pf[k2], O[md]); }
}
struct FlashState { float mref, l; f32x4 O[4]; bool started; };
template <int MODE, bool MASKED>
__device__ __forceinline__ void flash_tile2(FlashState (&st)[2], const h16* Ks, const h16* Vs, const h16x8 (&qf)[2][2], int kv0, const int (&tq)[2], const bool (&sb)[2], int cc, int quad) {
    if (MODE == 0) { if (!__any(sb[0] || sb[1])) return; }
    h16x8 kf[4][2];
#pragma unroll
    for (int mt = 0; mt < 4; ++mt)
#pragma unroll
        for (int ks = 0; ks < 2; ++ks) kf[mt][ks] = *(const h16x8*)(Ks + (mt * 16 + cc) * KV_LD + ks * 32 + quad * 8);
    f32x4 s[2][4]; float rmax[2];
#pragma unroll
    for (int gi = 0; gi < 2; ++gi) { const float nm = -st[gi].mref; const f32x4 negm = {nm, nm, nm, nm};
#pragma unroll
        for (int mt = 0; mt < 4; ++mt) { f32x4 a = mfma16(kf[mt][0], qf[gi][0], negm); s[gi][mt] = mfma16(kf[mt][1], qf[gi][1], a); } }
#pragma unroll
    for (int gi = 0; gi < 2; ++gi) { float tmax = -INFINITY;
        if (MASKED) {
#pragma unroll
            for (int mt = 0; mt < 4; ++mt)
#pragma unroll
                for (int j = 0; j < 4; ++j) { const int kp = kv0 + mt * 16 + quad * 4 + j; const bool ok = (MODE == 0) ? (kp <= tq[gi]) : (kp <= tq[gi] && kp > tq[gi] - 512);
                    const float v = ok ? s[gi][mt][j] : -INFINITY; s[gi][mt][j] = v; tmax = fmaxf(tmax, v); }
        } else {
            float ta = max3f(s[gi][0][0], s[gi][0][1], s[gi][0][2]), tb = max3f(s[gi][0][3], s[gi][1][0], s[gi][1][1]);
            ta = max3f(ta, s[gi][1][2], s[gi][1][3]); tb = max3f(tb, s[gi][2][0], s[gi][2][1]); ta = max3f(ta, s[gi][2][2], s[gi][2][3]); tb = max3f(tb, s[gi][3][0], s[gi][3][1]);
            tmax = max3f(ta, tb, fmaxf(s[gi][3][2], s[gi][3][3]));
        }
        tmax = fmaxf(tmax, __shfl_xor(tmax, 16)); tmax = fmaxf(tmax, __shfl_xor(tmax, 32));
        rmax[gi] = (MODE == 0 && !sb[gi]) ? -INFINITY : tmax; }
    bool upd[2];
#pragma unroll
    for (int gi = 0; gi < 2; ++gi) upd[gi] = (rmax[gi] > -INFINITY) && (!st[gi].started || rmax[gi] > 8.f);
    if (__any(upd[0] || upd[1])) {
#pragma unroll
        for (int gi = 0; gi < 2; ++gi) { const float dl = upd[gi] ? rmax[gi] : 0.f; const float f = (upd[gi] && st[gi].started) ? ex2(-dl) : 1.f;
            st[gi].mref += dl; st[gi].l *= f; st[gi].started = st[gi].started || upd[gi];
#pragma unroll
            for (int mt = 0; mt < 4; ++mt) { s[gi][mt] = s[gi][mt] - dl; st[gi].O[mt] *= f; } }
    }
    h16x8 pf[2][2];
#pragma unroll
    for (int gi = 0; gi < 2; ++gi) {
#pragma unroll
        for (int mt = 0; mt < 4; ++mt)
#pragma unroll
            for (int j = 0; j < 4; ++j) s[gi][mt][j] = ex2(s[gi][mt][j]);
        const f32x4 ps4 = (s[gi][0] + s[gi][1]) + (s[gi][2] + s[gi][3]);
        float psum = (ps4[0] + ps4[1]) + (ps4[2] + ps4[3]);
        u32x4 w0, w1; w0.x = pkh(s[gi][0][0], s[gi][0][1]); w0.y = pkh(s[gi][0][2], s[gi][0][3]); w0.z = pkh(s[gi][1][0], s[gi][1][1]); w0.w = pkh(s[gi][1][2], s[gi][1][3]);
        w1.x = pkh(s[gi][2][0], s[gi][2][1]); w1.y = pkh(s[gi][2][2], s[gi][2][3]); w1.z = pkh(s[gi][3][0], s[gi][3][1]); w1.w = pkh(s[gi][3][2], s[gi][3][3]);
        if (MODE == 0) { const unsigned mk = sb[gi] ? 0xffffffffu : 0u; w0 = w0 & mk; w1 = w1 & mk; psum = sb[gi] ? psum : 0.f; }
        st[gi].l += psum; pf[gi][0] = __builtin_bit_cast(h16x8, w0); pf[gi][1] = __builtin_bit_cast(h16x8, w1); }
#pragma unroll
    for (int md = 0; md < 4; ++md)
#pragma unroll
        for (int k2 = 0; k2 < 2; ++k2) { const h16* vp = Vs + (32 * k2 + 4 * quad + (cc >> 2)) * KV_LD + md * 16 + 4 * (cc & 3);
            const h16x8 vf = cat44(tr_read(vp), tr_read(vp + 16 * KV_LD));
            st[0].O[md] = mfma16(vf, pf[0][k2], st[0].O[md]); st[1].O[md] = mfma16(vf, pf[1][k2], st[1].O[md]); }
}
template <bool NEEDV, class SrcFn, class CompFn>
__device__ __forceinline__ void kv_pipeline(int n, int tid, h16* Kb, h16* Vb, SrcFn src, CompFn comp) {
    if (n <= 0) return;
    const int key = tid >> 3, c8 = tid & 7; const int loff = key * KV_LD + c8 * 8;
    h16x8 kr, vr = {};
    { const h16 *kp, *vp; size_t stride; src(0, kp, vp, stride); kr = *(const h16x8*)(kp + (size_t)key * stride + c8 * 8); if (NEEDV) vr = *(const h16x8*)(vp + (size_t)key * stride + c8 * 8); }
    *(h16x8*)(Kb + loff) = kr; if (NEEDV) *(h16x8*)(Vb + loff) = vr;
    __syncthreads();
    for (int i = 0; i < n; ++i) {
        const int cur = i & 1; const bool more = (i + 1 < n);
        if (more) { const h16 *kp, *vp; size_t stride; src(i + 1, kp, vp, stride); kr = *(const h16x8*)(kp + (size_t)key * stride + c8 * 8); if (NEEDV) vr = *(const h16x8*)(vp + (size_t)key * stride + c8 * 8); }
        comp(i, Kb + cur * KV_TILE, Vb + cur * KV_TILE);
        if (more) { *(h16x8*)(Kb + (cur ^ 1) * KV_TILE + loff) = kr; if (NEEDV) *(h16x8*)(Vb + (cur ^ 1) * KV_TILE + loff) = vr; }
        __syncthreads();
    }
}
__device__ __forceinline__ void nsa_attn_unit(const Ctx& C, int l, int b, int g, int qq) {
    TIDS
    const int w = wave, cc = lane & 15, quad = lane >> 4;
    const int r = cc >> 3, ti = cc & 7, h = 2 * g + r;
    const int qbw = 2 * qq + (w >> 2), qbh = 2 * qq + 1;
    int tloc[2], tq[2]; size_t rowq[2];
#pragma unroll
    for (int gi = 0; gi < 2; ++gi) { tloc[gi] = 16 * w + 8 * gi + ti; tq[gi] = 128 * qq + tloc[gi]; rowq[gi] = (size_t)b * SEQ + tq[gi]; }
    h16* Kb = (h16*)g_lds; h16* Vb = (h16*)(g_lds + 2 * KV_TILE * 2);
    float* imp = (float*)(g_lds + 40960);
    unsigned* sel = (unsigned*)(g_lds + 40960 + 65536);
    unsigned* uni = sel + 512;
    unsigned char* lst = (unsigned char*)(uni + 8);
    h16x8 qf[2][2];
#pragma unroll
    for (int gi = 0; gi < 2; ++gi) {
        const h16x8 x1 = *(const h16x8*)(C.PROJ + rowq[gi] * PN + C_NQ + h * 64 + quad * 8), x2 = *(const h16x8*)(C.PROJ + rowq[gi] * PN + C_NQ + h * 64 + 32 + quad * 8);
        f32x4 tb[4];
#pragma unroll
        for (int i = 0; i < 4; ++i) tb[i] = *(const f32x4*)(C.ROPE + 2 * (tq[gi] * 32 + quad * 8) + 4 * i);
#pragma unroll
        for (int e = 0; e < 8; ++e) { const float cs = tb[e >> 1][2 * (e & 1)], sn = tb[e >> 1][2 * (e & 1) + 1]; const float a1 = (float)x1[e], a2 = (float)x2[e];
            qf[gi][0][e] = (h16)((a1 * cs - a2 * sn) * 0.18033688011112042f); qf[gi][1][e] = (h16)((a2 * cs + a1 * sn) * 0.18033688011112042f); } }
    const h16* kcb = C.KC + (size_t)(b * 2 + g) * 512 * 64; const h16* vcb = C.VC + (size_t)(b * 2 + g) * 512 * 64;
    const int ncmp = 4 * qbh + 3, ntile_c = (ncmp + 63) >> 6;
    auto src_cmp = [&](int i, const h16*& kp, const h16*& vp, size_t& stride) { kp = kcb + (size_t)i * 64 * 64; vp = vcb + (size_t)i * 64 * 64; stride = 64; };
    float m1[2] = {-INFINITY, -INFINITY}, l1[2] = {0.f, 0.f};
    kv_pipeline<false>(ntile_c, tid, Kb, Vb, src_cmp, [&](int tc, const h16* Ks, const h16*) {
        h16x8 kf[4][2];
#pragma unroll
        for (int mt = 0; mt < 4; ++mt)
#pragma unroll
            for (int ks = 0; ks < 2; ++ks) kf[mt][ks] = *(const h16x8*)(Ks + (mt * 16 + cc) * KV_LD + ks * 32 + quad * 8);
#pragma unroll
        for (int gi = 0; gi < 2; ++gi) { f32x4 s[4]; float tmax = -INFINITY;
#pragma unroll
            for (int mt = 0; mt < 4; ++mt) { f32x4 a = {0.f, 0.f, 0.f, 0.f}; a = mfma16(kf[mt][0], qf[gi][0], a); a = mfma16(kf[mt][1], qf[gi][1], a);
#pragma unroll
                for (int j = 0; j < 4; ++j) { const int n = tc * 64 + mt * 16 + quad * 4 + j; const float v = (16 * n + 31 <= tq[gi]) ? a[j] : -INFINITY; a[j] = v; tmax = fmaxf(tmax, v); }
                s[mt] = a; }
            tmax = fmaxf(tmax, __shfl_xor(tmax, 16)); tmax = fmaxf(tmax, __shfl_xor(tmax, 32));
            const float mnew = fmaxf(m1[gi], tmax), muse = (mnew == -INFINITY) ? 0.f : mnew;
            float ps = 0.f;
#pragma unroll
            for (int mt = 0; mt < 4; ++mt)
#pragma unroll
                for (int j = 0; j < 4; ++j) ps += ex2(s[mt][j] - muse);
            l1[gi] = l1[gi] * ex2(m1[gi] - muse) + ps; m1[gi] = mnew; } });
    float inv1[2], m1u[2];
#pragma unroll
    for (int gi = 0; gi < 2; ++gi) { float t = l1[gi]; t += __shfl_xor(t, 16); t += __shfl_xor(t, 32); inv1[gi] = (t > 0.f) ? 1.f / t : 0.f; m1u[gi] = (m1[gi] == -INFINITY) ? 0.f : m1[gi]; }
    f32x4 Oc[2][4];
#pragma unroll
    for (int gi = 0; gi < 2; ++gi)
#pragma unroll
        for (int md = 0; md < 4; ++md) Oc[gi][md] = (f32x4){0.f, 0.f, 0.f, 0.f};
    float carry_q3[2] = {0.f, 0.f};
    kv_pipeline<true>(ntile_c, tid, Kb, Vb, src_cmp, [&](int tc, const h16* Ks, const h16* Vs) {
        h16x8 kf[4][2]; h16x8 pf[2][2];
#pragma unroll
        for (int mt = 0; mt < 4; ++mt)
#pragma unroll
            for (int ks = 0; ks < 2; ++ks) kf[mt][ks] = *(const h16x8*)(Ks + (mt * 16 + cc) * KV_LD + ks * 32 + quad * 8);
#pragma unroll
        for (int gi = 0; gi < 2; ++gi) { f32x4 s[4];
#pragma unroll
            for (int mt = 0; mt < 4; ++mt) { f32x4 a = {0.f, 0.f, 0.f, 0.f}; a = mfma16(kf[mt][0], qf[gi][0], a); a = mfma16(kf[mt][1], qf[gi][1], a);
#pragma unroll
                for (int j = 0; j < 4; ++j) { const int n = tc * 64 + mt * 16 + quad * 4 + j; a[j] = (16 * n + 31 <= tq[gi]) ? ex2(a[j] - m1u[gi]) * inv1[gi] : 0.f; }
                s[mt] = a;
                const float s4 = (a[0] + a[1]) + (a[2] + a[3]); const float p3 = a[3];
                const float fromprev = __shfl(p3, (lane + 48) & 63);
                const float fromq3 = __shfl(p3, cc + 48);
                float val = s4 + ((quad == 0) ? carry_q3[gi] : fromprev);
                carry_q3[gi] = fromq3;
                val += __shfl_xor(val, 8);
                if (r == 0) imp[tloc[gi] * 128 + tc * 16 + mt * 4 + quad] = val; }
#pragma unroll
            for (int k2 = 0; k2 < 2; ++k2) pf[gi][k2] = (h16x8){(h16)s[2 * k2][0], (h16)s[2 * k2][1], (h16)s[2 * k2][2], (h16)s[2 * k2][3], (h16)s[2 * k2 + 1][0], (h16)s[2 * k2 + 1][1], (h16)s[2 * k2 + 1][2], (h16)s[2 * k2 + 1][3]}; }
#pragma unroll
        for (int md = 0; md < 4; ++md)
#pragma unroll
            for (int k2 = 0; k2 < 2; ++k2) { const h16* vp = Vs + (32 * k2 + 4 * quad + (cc >> 2)) * KV_LD + md * 16 + 4 * (cc & 3);
                const h16x8 vf = cat44(tr_read(vp), tr_read(vp + 16 * KV_LD));
                Oc[0][md] = mfma16(vf, pf[0][k2], Oc[0][md]); Oc[1][md] = mfma16(vf, pf[1][k2], Oc[1][md]); } });
    if (qbw < 16) {
        if (lane < 16) { const unsigned mlo = (2u << qbw) - 1u; const int row = 16 * w + lane; sel[row * 4 + 0] = mlo; sel[row * 4 + 1] = 0u; sel[row * 4 + 2] = 0u; sel[row * 4 + 3] = 0u; }
    } else {
        const int jhi = qbw - 2;
        const unsigned long long lt = __lanemask_lt();
        for (int t16 = 0; t16 < 16; ++t16) { const int row = 16 * w + t16; const float* ir = imp + row * 128;
            const int j1 = lane, j2 = lane + 64; const bool ok1 = (j1 >= 1 && j1 <= jhi), ok2 = (j2 <= jhi);
            const unsigned u1 = ok1 ? __float_as_uint(ir[j1]) + 1u : 0u, u2 = ok2 ? __float_as_uint(ir[j2]) + 1u : 0u;
            unsigned prefix = 0u;
            for (int bit = 30; bit >= 0; --bit) { const unsigned test = prefix | (1u << bit);
                const int cnt = __popcll(__ballot(u1 >= test)) + __popcll(__ballot(u2 >= test)); if (cnt >= 13) prefix = test; }
            const bool gt1 = u1 > prefix, gt2 = u2 > prefix, eq1 = u1 == prefix, eq2 = u2 == prefix;
            const unsigned long long bg1 = __ballot(gt1), bg2 = __ballot(gt2), be1 = __ballot(eq1), be2 = __ballot(eq2);
            const int need = 13 - __popcll(bg1) - __popcll(bg2);
            const bool s1 = gt1 || (eq1 && __popcll(be1 & lt) < need), s2 = gt2 || (eq2 && (__popcll(be1) + __popcll(be2 & lt)) < need);
            unsigned long long blo = __ballot(s1) | 1ull, bhi = __ballot(s2);
            { const int f0 = qbw - 1, f1 = qbw; if (f0 < 64) blo |= 1ull << f0; else bhi |= 1ull << (f0 - 64); if (f1 < 64) blo |= 1ull << f1; else bhi |= 1ull << (f1 - 64); }
            if (lane == 0) { sel[row * 4 + 0] = (unsigned)blo; sel[row * 4 + 1] = (unsigned)(blo >> 32); sel[row * 4 + 2] = (unsigned)bhi; sel[row * 4 + 3] = (unsigned)(bhi >> 32); } }
    }
    __syncthreads();
    if (w == 0) {
        unsigned o0 = sel[lane * 4 + 0] | sel[(lane + 64) * 4 + 0], o1 = sel[lane * 4 + 1] | sel[(lane + 64) * 4 + 1], o2 = sel[lane * 4 + 2] | sel[(lane + 64) * 4 + 2], o3 = sel[lane * 4 + 3] | sel[(lane + 64) * 4 + 3];
#pragma unroll
        for (int sft = 1; sft < 64; sft <<= 1) { o0 |= __shfl_xor(o0, sft); o1 |= __shfl_xor(o1, sft); o2 |= __shfl_xor(o2, sft); o3 |= __shfl_xor(o3, sft); }
        const unsigned long long mlo = ((unsigned long long)o1 << 32) | o0, mhi = ((unsigned long long)o3 << 32) | o2;
        const unsigned long long lt = __lanemask_lt(); const int nlo = __popcll(mlo);
        if ((mlo >> lane) & 1ull) lst[__popcll(mlo & lt)] = (unsigned char)lane;
        if ((mhi >> lane) & 1ull) lst[nlo + __popcll(mhi & lt)] = (unsigned char)(64 + lane);
        if (lane == 0) uni[4] = (unsigned)(nlo + __popcll(mhi));
    }
    __syncthreads();
    { f32x4* park = (f32x4*)imp;
#pragma unroll
        for (int gi = 0; gi < 2; ++gi)
#pragma unroll
            for (int md = 0; md < 4; ++md) park[(gi * 4 + md) * 512 + tid] = Oc[gi][md]; }
    unsigned long long selLo[2], selHi[2];
#pragma unroll
    for (int gi = 0; gi < 2; ++gi) { selLo[gi] = ((unsigned long long)sel[tloc[gi] * 4 + 1] << 32) | sel[tloc[gi] * 4 + 0]; selHi[gi] = ((unsigned long long)sel[tloc[gi] * 4 + 3] << 32) | sel[tloc[gi] * 4 + 2]; }
    const int nlist = (int)uni[4];
    FlashState fs[2];
#pragma unroll
    for (int gi = 0; gi < 2; ++gi) { fs[gi].mref = 0.f; fs[gi].l = 0.f; fs[gi].started = false;
#pragma unroll
        for (int md = 0; md < 4; ++md) fs[gi].O[md] = (f32x4){0.f, 0.f, 0.f, 0.f}; }
    const h16* kslc = C.PROJ + (size_t)b * SEQ * PN + C_KSLC + g * 64; const h16* vslc = C.PROJ + (size_t)b * SEQ * PN + C_VSLC + g * 64;
    kv_pipeline<true>(nlist, tid, Kb, Vb,
        [&](int i, const h16*& kp, const h16*& vp, size_t& stride) { const int j = lst[i]; kp = kslc + (size_t)j * 64 * PN; vp = vslc + (size_t)j * 64 * PN; stride = PN; },
        [&](int i, const h16* Ks, const h16* Vs) { const int j = lst[i]; bool sb[2];
#pragma unroll
            for (int gi = 0; gi < 2; ++gi) { const unsigned long long sw = (j < 64) ? selLo[gi] : selHi[gi]; sb[gi] = ((sw >> (j & 63)) & 1ull) != 0ull; }
            if (j >= 2 * qq) flash_tile2<0, true>(fs, Ks, Vs, qf, j * 64, tq, sb, cc, quad); else flash_tile2<0, false>(fs, Ks, Vs, qf, j * 64, tq, sb, cc, quad); });
    f32x4 Os[2][4];
#pragma unroll
    for (int gi = 0; gi < 2; ++gi) { float ls = fs[gi].l; ls += __shfl_xor(ls, 16); ls += __shfl_xor(ls, 32); const float invs = (ls > 0.f) ? 1.f / ls : 0.f;
#pragma unroll
        for (int md = 0; md < 4; ++md) Os[gi][md] = fs[gi].O[md] * invs; }
#pragma unroll
    for (int gi = 0; gi < 2; ++gi) { fs[gi].mref = 0.f; fs[gi].l = 0.f; fs[gi].started = false;
#pragma unroll
        for (int md = 0; md < 4; ++md) fs[gi].O[md] = (f32x4){0.f, 0.f, 0.f, 0.f}; }
    const h16* kwin = C.PROJ + (size_t)b * SEQ * PN + C_KWIN + g * 64; const h16* vwin = C.PROJ + (size_t)b * SEQ * PN + C_VWIN + g * 64;
    const int jw0 = (2 * qq >= 8 ? 2 * qq - 8 : 0);
    kv_pipeline<true>(qbh - jw0 + 1, tid, Kb, Vb,
        [&](int i, const h16*& kp, const h16*& vp, size_t& stride) { const int j = jw0 + i; kp = kwin + (size_t)j * 64 * PN; vp = vwin + (size_t)j * 64 * PN; stride = PN; },
        [&](int i, const h16* Ks, const h16* Vs) { const int j = jw0 + i; const bool sbt[2] = {true, true};
            if (j >= 2 * qq || j <= 2 * qq - 7) flash_tile2<1, true>(fs, Ks, Vs, qf, j * 64, tq, sbt, cc, quad); else flash_tile2<1, false>(fs, Ks, Vs, qf, j * 64, tq, sbt, cc, quad); });
#pragma unroll
    for (int gi = 0; gi < 2; ++gi) {
        float lw = fs[gi].l; lw += __shfl_xor(lw, 16); lw += __shfl_xor(lw, 32); const float invw = (lw > 0.f) ? 1.f / lw : 0.f;
        const float* gp = C.PSM + rowq[gi] * PSM_W + 16 + h * 3;
        const float g0 = sigmoidf_(gp[0]), g1 = sigmoidf_(gp[1]), g2 = sigmoidf_(gp[2]) * invw;
        float ssq = 0.f; f32x4 o[4];
#pragma unroll
        for (int md = 0; md < 4; ++md) { o[md] = g0 * ((const f32x4*)imp)[(gi * 4 + md) * 512 + tid] + g1 * Os[gi][md] + g2 * fs[gi].O[md]; ssq += (o[md][0] * o[md][0] + o[md][1] * o[md][1]) + (o[md][2] * o[md][2] + o[md][3] * o[md][3]); }
        ssq += __shfl_xor(ssq, 16); ssq += __shfl_xor(ssq, 32);
        const float rs = 1.0f / sqrtf(ssq * (1.f / 64.f) + EPS);
        const float* nw = C.in[12] + l * 256 + h * 64;
#pragma unroll
        for (int md = 0; md < 4; ++md) { const int d = md * 16 + quad * 4; u32x2 wv; wv.x = pkb(o[md][0] * rs * nw[d], o[md][1] * rs * nw[d + 1]); wv.y = pkb(o[md][2] * rs * nw[d + 2], o[md][3] * rs * nw[d + 3]);
            *(u32x2*)(C.XN + rowq[gi] * 1024 + 256 + h * 64 + d) = wv; }
    }
}

__device__ __forceinline__ void phase_ssdnorm(const Ctx& C, int l) {
    TIDS
    const int gw = C.bid * 8 + wave, NGW = C.G * 8; const float* nw = C.in[18] + l * 512 + lane * 8;
    for (int m = gw; m < MTOK; m += NGW) { const int g = lane >> 5; const f32x4 q = *(const f32x4*)(C.SSQ + (size_t)m * 8 + g * 4);
        const float rs = 1.0f / sqrtf(((q.x + q.y) + (q.z + q.w)) * (1.f / 256.f) + EPS);
        h16* p = C.XN + (size_t)m * 1024 + 512 + lane * 8; const h16x8 v = *(const h16x8*)p;
        u32x4 o; o.x = pkh((float)v[0] * rs * nw[0], (float)v[1] * rs * nw[1]); o.y = pkh((float)v[2] * rs * nw[2], (float)v[3] * rs * nw[3]);
        o.z = pkh((float)v[4] * rs * nw[4], (float)v[5] * rs * nw[5]); o.w = pkh((float)v[6] * rs * nw[6], (float)v[7] * rs * nw[7]); *(u32x4*)p = o; }
}
__device__ __forceinline__ void phase_norm(const Ctx& C, const float* src, h16* dst) {
    TIDS
    const int gw = C.bid * 8 + wave, NGW = C.G * 8;
    for (int m = gw; m < MTOK; m += NGW) rms_row_to_h16(src + (size_t)m * DM, dst + (size_t)m * DM, lane);
}
__device__ __forceinline__ void phase_final(const Ctx& C) {
    TIDS
    const int gw = C.bid * 8 + wave, NGW = C.G * 8; const unsigned long long* ssq = C.RSS + (size_t)(2 * DEPTH - 1) * MTOK;
    f32x4 fw[4];
#pragma unroll
    for (int j = 0; j < 4; ++j) fw[j] = *((const f32x4*)C.in[23] + lane + 64 * j);
    for (int m0 = gw * 4; m0 < MTOK; m0 += NGW * 4) { h16x4 v[4][4]; float rs[4];
#pragma unroll
        for (int r = 0; r < 4; ++r) { rs[r] = (float)ssq[m0 + r] * RSS_INV; const h16x4* hr = (const h16x4*)(C.H16 + (size_t)(m0 + r) * DM) + lane;
#pragma unroll
            for (int j = 0; j < 4; ++j) v[r][j] = hr[64 * j]; }
#pragma unroll
        for (int r = 0; r < 4; ++r) { const float sc = 1.0f / sqrtf(rs[r] * (1.f / DM) + EPS); f32x4* xr = (f32x4*)(C.out + (size_t)(m0 + r) * DM) + lane;
#pragma unroll
            for (int j = 0; j < 4; ++j) xr[64 * j] = (f32x4){(float)v[r][j][0], (float)v[r][j][1], (float)v[r][j][2], (float)v[r][j][3]} * sc * fw[j]; } }
}

constexpr int N_PHASES_DECL = 0;
#ifndef PHM
#define PHM 0xffffffffu
#endif
#define EN(k) ((PHM >> (k)) & 1u)
#ifndef PROBE_PH
#define PROBE_PH -1
#define PROBE_REPS 1
#endif
#define REPN(ph) ((ph) == PROBE_PH ? PROBE_REPS : 1)
#ifndef TS_PROBE
#define TS_PROBE 0
#define TS_A 0
#define TS_B 1
#define TS_DIV 4.0f
#endif
#ifndef PROBE_BIT
#define PROBE_BIT -1
#endif
#define RB(k) for (int rb_ = 0; rb_ < ((k) == PROBE_BIT && l == 0 ? 2 : 1); ++rb_)
template <int ph> __device__ __forceinline__ void run_phase(const Params* kp, int rep, int wv) {
    Ctx C; make_ctx(C, kp, wv);
    LAS unsigned char* ldsl = (LAS unsigned char*)g_lds;
    if constexpr (ph == 0) { if (EN(0)) phase_prep(C); return; }
    if constexpr (ph == 1 + 8 * DEPTH) { if (EN(15)) phase_final(C); return; }
    constexpr int l = (ph - 1) / 8, s = (ph - 1) % 8;
    if (s == 0) { if (EN(1)) { pg8::Gemm g{(const pg8::bf16_t*)(l == 0 ? C.XN : C.H16), (const pg8::bf16_t*)(C.WIN + (size_t)l * PN * DM), MTOK, PN, DM}; pg8::StaticOrder S; S.init(MTOK, PN, C.G, C.bid);
        pg8::EpiProj E{C.PROJ, C.PSM, l == 0 ? (const unsigned long long*)nullptr : C.RSS + (size_t)(2 * (l - 1) + 1) * MTOK}; pg8::gemm_phase<pg8::EpiProj>(ldsl, g, S, E, C.wv); } }
    else if (s == 1) { if (EN(2)) phase_tok(C, l); }
    else if (s == 2) { RB(3) for (int u = C.bid; u < 256; u += C.G) nsa_compress_unit(C, l, u);
#if TS_PROBE
        if (l == 0 && blockIdx.x == 0) { __syncthreads(); if (C.wv == 0 && opaque_lane() == 0) ((volatile LAS unsigned long long*)((LAS unsigned char*)g_lds + LDS_MISC + 64))[27] = __builtin_amdgcn_s_memrealtime(); }
#endif
        RB(4) ssd_states_phase(C, l, C.bid, C.G);
#if TS_PROBE
        if (l == 0 && blockIdx.x == 0) { __syncthreads(); if (C.wv == 0 && opaque_lane() == 0) ((volatile LAS unsigned long long*)((LAS unsigned char*)g_lds + LDS_MISC + 64))[28] = __builtin_amdgcn_s_memrealtime(); }
#endif
        RB(5) for (int u = C.bid; u < 256; u += C.G) gla_block_unit<0>(C, l, u); }
    else if (s == 3) { if (EN(6) && rep == 0) phase_scans(C);
#if TS_PROBE
        if (l == 0 && blockIdx.x == 0) { __syncthreads(); if (C.wv == 0 && opaque_lane() == 0) ((volatile LAS unsigned long long*)((LAS unsigned char*)g_lds + LDS_MISC + 64))[30] = __builtin_amdgcn_s_memrealtime(); }
#endif
        if (EN(7)) for (int v = C.bid; v < 512; v += C.G) { const int bg = (v & 255) >> 5, sidx = v & 31, k = v >> 8;
            const int qq = (k == 0) ? sidx : 63 - sidx; nsa_attn_unit(C, l, bg >> 1, bg & 1, qq); } }
    else if (s == 4) { RB(8) ssd_y_phase(C, l, C.bid, C.G);
#if TS_PROBE
        if (l == 0 && blockIdx.x == 0) { __syncthreads(); if (C.wv == 0 && opaque_lane() == 0) ((volatile LAS unsigned long long*)((LAS unsigned char*)g_lds + LDS_MISC + 64))[29] = __builtin_amdgcn_s_memrealtime(); }
#endif
        RB(9) for (int u = C.bid; u < 256; u += C.G) gla_block_unit<1>(C, l, u); }
    else if (s == 5) { if (EN(11)) { pg8::Gemm g{(const pg8::bf16_t*)C.XN, (const pg8::bf16_t*)(C.WOUT + (size_t)l * DM * DM), MTOK, DM, DM}; pg8::StaticOrder S; S.init(MTOK, DM, C.G, C.bid);
        pg8::EpiRes E{l == 0 ? C.in[0] : (const float*)nullptr, C.H16, C.RSS + (size_t)(2 * l) * MTOK}; pg8::gemm_phase<pg8::EpiRes, true>(ldsl, g, S, E, C.wv); } }
    else if (s == 6) { if (EN(13)) { pg8::Gemm g{(const pg8::bf16_t*)C.H16, (const pg8::bf16_t*)(C.WUP + (size_t)l * DFF * DM), MTOK, DFF, DM}; pg8::StaticOrder S; S.init(MTOK, DFF, C.G, C.bid);
        pg8::EpiHid E{C.HID, C.RSS + (size_t)(2 * l) * MTOK}; pg8::gemm_phase<pg8::EpiHid>(ldsl, g, S, E, C.wv); } }
    else if (s == 7) { if (EN(14)) { pg8::Gemm g{(const pg8::bf16_t*)C.HID, (const pg8::bf16_t*)(C.WDN + (size_t)l * DM * DFF), MTOK, DM, DFF}; pg8::StaticOrder S; S.init(MTOK, DM, C.G, C.bid);
        pg8::EpiRes E{(const float*)nullptr, C.H16, C.RSS + (size_t)(2 * l + 1) * MTOK}; pg8::gemm_phase<pg8::EpiRes, true>(ldsl, g, S, E, C.wv); } }
}
constexpr int PH_PER_L = 8;
constexpr int N_PHASES = 1 + PH_PER_L * DEPTH + 1;
template <int PH> __device__ __forceinline__ void phase_seq(const Params* kp, int lo, int hi, cg::grid_group& grid, const XcdBarrier& bar, int wv) {
    if constexpr (PH < N_PHASES) {
        if (lo <= PH && PH < hi) {
            for (int rep = 0; rep < REPN(PH); ++rep) run_phase<PH>(kp, rep, wv);
            if (PH + 1 < hi) { if (MK_COOP && PH == 0) grid.sync(); else xcd_barrier(bar); }
#if TS_PROBE
            if (blockIdx.x == 0 && wv == 0 && opaque_lane() == 0) ((volatile LAS unsigned long long*)((LAS unsigned char*)g_lds + LDS_MISC + 64))[PH + 1] = __builtin_amdgcn_s_memrealtime();
#endif
        }
        phase_seq<PH + 1>(kp, lo, hi, grid, bar, wv);
    }
}
__global__ void __launch_bounds__(512, 2) fwd_kernel(Params P) {
    const Params* kp = &P;
    cg::grid_group grid = cg::this_grid();
    volatile LAS unsigned* st = (volatile LAS unsigned*)((LAS unsigned char*)g_lds + LDS_MISC);
    const int wv = __builtin_amdgcn_readfirstlane((int)threadIdx.x >> 6);
    if (threadIdx.x < 2) st[threadIdx.x] = 0u;
    __syncthreads();
    const XcdBarrier bar = xcd_barrier_post((unsigned*)P.ws, st, wv);
#if TS_PROBE
    if (blockIdx.x == 0 && wv == 0 && opaque_lane() == 0) ((volatile LAS unsigned long long*)((LAS unsigned char*)g_lds + LDS_MISC + 64))[0] = __builtin_amdgcn_s_memrealtime();
#endif
    phase_seq<0>(kp, P.ph_lo, P.ph_hi, grid, bar, wv);
#if TS_PROBE
    if (blockIdx.x == 0 && wv == 0 && opaque_lane() == 0) { volatile LAS unsigned long long* ts = (volatile LAS unsigned long long*)((LAS unsigned char*)g_lds + LDS_MISC + 64);
        const float us = (float)(ts[TS_B] - ts[TS_A]) * 0.01f; P.out[0] = us * (1.0f / TS_DIV); }
#endif
}

extern "C" void kernel_launch(void* const* d_in, const int* in_sizes, int n_in, void* d_out, int out_size, void* d_ws, size_t ws_size, hipStream_t stream) {
    static int grid = 0;
    if (grid == 0) {
        if (n_in != 24 || in_sizes[0] != MTOK * DM || out_size != MTOK * DM || ws_size < WS_END) { fprintf(stderr, "kernel_launch: unexpected shapes (n_in %d, ws %zu)\n", n_in, ws_size); grid = -1; return; }
        int dev = 0, cus = 0, per_cu = 0;
        hipGetDevice(&dev); hipDeviceGetAttribute(&cus, hipDeviceAttributeMultiprocessorCount, dev);
        hipFuncSetAttribute((const void*)fwd_kernel, hipFuncAttributeMaxDynamicSharedMemorySize, LDS_BYTES);
        hipOccupancyMaxActiveBlocksPerMultiprocessor(&per_cu, (const void*)fwd_kernel, 512, LDS_BYTES);
        (void)hipGetLastError();
        if (per_cu < 1) { fprintf(stderr, "kernel_launch: occupancy query says %d blocks/CU\n", per_cu); grid = -1; return; }
        grid = cus;
    }
    if (grid < 0) return;
    (void)hipMemsetAsync(d_ws, 0, 32768, stream);
    Params p{};
    for (int i = 0; i < 24; ++i) p.in[i] = (const float*)d_in[i];
    p.out = (float*)d_out; p.ws = (unsigned char*)d_ws;
#if MK_MULTI_LAUNCH
    for (int ph = 0; ph < N_PHASES; ++ph) { p.ph_lo = ph; p.ph_hi = ph + 1; hipLaunchKernelGGL(fwd_kernel, dim3(grid), dim3(512), LDS_BYTES, stream, p); }
#else
    p.ph_lo = 0; p.ph_hi = N_PHASES;
#if MK_COOP
    void* args[] = {&p};
    hipError_t e = hipLaunchCooperativeKernel((const void*)fwd_kernel, dim3(grid), dim3(512), args, LDS_BYTES, stream);
    if (e != hipSuccess) fprintf(stderr, "cooperative launch failed: %s (grid %d)\n", hipGetErrorString(e), grid);
#else
    hipLaunchKernelGGL(fwd_kernel, dim3(grid), dim3(512), LDS_BYTES, stream, p);
#endif
#endif
}
```

```cpp
#include <hip/hip_runtime.h>
#include <hip/hip_cooperative_groups.h>
#include <cstdio>
#include <cstdint>
namespace cg = cooperative_groups;

#ifndef MK_MULTI_LAUNCH
#define MK_MULTI_LAUNCH 0
#endif
#ifndef MK_COOP
#define MK_COOP 0
#endif

#define LAS __attribute__((address_space(3)))
typedef _Float16 h16;
typedef _Float16 h16x8 __attribute__((ext_vector_type(8)));
typedef _Float16 h16x4 __attribute__((ext_vector_type(4)));
typedef _Float16 h16x2 __attribute__((ext_vector_type(2)));
typedef float f32x4 __attribute__((ext_vector_type(4)));
typedef float f32x2 __attribute__((ext_vector_type(2)));
typedef unsigned u32x4 __attribute__((ext_vector_type(4)));
typedef unsigned u32x2 __attribute__((ext_vector_type(2)));

constexpr int BATCH = 4, SEQ = 8192, DM = 1024, MTOK = BATCH * SEQ, DEPTH = 2;
constexpr int DIN = 3364, PN = 3584, DFF = 4096;
constexpr float EPS = 1e-6f;
constexpr int C_GQ = 0, C_GK = 128, C_GV = 256, C_GR = 512, C_NQ = 768, C_NKV = 1024, C_SZ = 1792, C_SX = 2304, C_SM = 3328;
constexpr int C_KCMP = C_NKV, C_VCMP = C_NKV + 128, C_KSLC = C_NKV + 256, C_VSLC = C_NKV + 384, C_KWIN = C_NKV + 512, C_VWIN = C_NKV + 640;
constexpr int PSM_W = 64;

constexpr size_t MiB = 1u << 20;
constexpr size_t WS_WIN = 2 * MiB;
constexpr size_t WS_WOUT = 16 * MiB;
constexpr size_t WS_WUP = 20 * MiB;
constexpr size_t WS_WDN = 36 * MiB;
constexpr size_t WS_W1T = 52 * MiB;
constexpr size_t WS_W2T = 54 * MiB;
constexpr size_t WS_B1 = 16384;
constexpr size_t WS_ROPE = 55 * MiB;
constexpr size_t WS_XN = 60 * MiB;
constexpr size_t WS_PROJ = 124 * MiB;
constexpr size_t WS_HID = 124 * MiB;
constexpr size_t WS_XBCC = 348 * MiB;
constexpr size_t WS_SSDST = 444 * MiB;
constexpr size_t WS_GLAST = 476 * MiB;
constexpr size_t WS_PSM = 492 * MiB;
constexpr size_t WS_KC = 500 * MiB;
constexpr size_t WS_VC = 500 * MiB + 512 * 1024;
constexpr size_t WS_SSQ = 501 * MiB;
constexpr size_t WS_DTV = 502 * MiB;
constexpr size_t WS_ACS = 503 * MiB;
constexpr size_t WS_CD = 504 * MiB;
constexpr size_t WS_GLAG = 504 * MiB + 64 * 1024;
constexpr size_t WS_RSS = 505 * MiB;
constexpr size_t WS_B1P = 54 * MiB + 256 * 1024;
constexpr size_t WS_H16 = 380 * MiB;
constexpr size_t WS_END = 507 * MiB;

constexpr int LDS_BYTES = 147456;
constexpr int LDS_MISC = 131072;
extern __shared__ __attribute__((aligned(16))) unsigned char g_lds[];

struct Params { const float* in[24]; float* out; unsigned char* ws; int ph_lo, ph_hi; };

__constant__ float ROPE_INV[32] = {
 1.000000000e+00f, 7.498942614e-01f, 5.623413324e-01f, 4.216965139e-01f, 3.162277639e-01f, 2.371373773e-01f, 1.778279394e-01f, 1.333521307e-01f,
 1.000000015e-01f, 7.498941571e-02f, 5.623413250e-02f, 4.216965288e-02f, 3.162277490e-02f, 2.371373773e-02f, 1.778279431e-02f, 1.333521493e-02f,
 9.999999776e-03f, 7.498941850e-03f, 5.623413250e-03f, 4.216964822e-03f, 3.162277630e-03f, 2.371373586e-03f, 1.778279431e-03f, 1.333521446e-03f,
 1.000000047e-03f, 7.498942432e-04f, 5.623413017e-04f, 4.216965172e-04f, 3.162277571e-04f, 2.371373703e-04f, 1.778279402e-04f, 1.333521504e-04f };

__device__ __forceinline__ f32x4 mfma16(h16x8 a, h16x8 b, f32x4 c) { return __builtin_amdgcn_mfma_f32_16x16x32_f16(a, b, c, 0, 0, 0); }
__device__ __forceinline__ float wave_sum(float v) {
#pragma unroll
    for (int o = 1; o < 64; o <<= 1) v += __shfl_xor(v, o);
    return v;
}
__device__ __forceinline__ float ex2(float x) { return __builtin_amdgcn_exp2f(x); }
__device__ __forceinline__ float max3f(float a, float b, float c) { return __builtin_fmaxf(__builtin_fmaxf(a, b), c); }
__device__ __forceinline__ float sigmoidf_(float x) { return 1.f / (1.f + __expf(-x)); }
__device__ __forceinline__ float siluf_(float x) { return x / (1.f + __expf(-x)); }
__device__ __forceinline__ float softplusf_(float x) { return fmaxf(x, 0.f) + log1pf(__expf(-fabsf(x))); }
typedef __bf16 bf16x2_t __attribute__((ext_vector_type(2)));
__device__ __forceinline__ unsigned pkb(float lo, float hi) { f32x2 v = {lo, hi}; bf16x2_t b = __builtin_convertvector(v, bf16x2_t); return __builtin_bit_cast(unsigned, b); }
__device__ __forceinline__ f32x4 unpk_bf4(u32x2 w) { return (f32x4){__uint_as_float(w.x << 16), __uint_as_float(w.x & 0xffff0000u), __uint_as_float(w.y << 16), __uint_as_float(w.y & 0xffff0000u)}; }
__device__ __forceinline__ unsigned pkh(float lo, float hi) { h16x2 v = {(h16)lo, (h16)hi}; return __builtin_bit_cast(unsigned, v); }

__device__ __forceinline__ int opaque_lane() { int t = __builtin_amdgcn_mbcnt_hi(~0u, __builtin_amdgcn_mbcnt_lo(~0u, 0u)); asm volatile("" : "+v"(t)); return t; }
constexpr float RSS_SCALE = 1048576.f, RSS_INV = 1.f / 1048576.f;
namespace pg8 {
typedef unsigned short bf16_t;
typedef __bf16 bf16x8_t __attribute__((ext_vector_type(8)));
constexpr int BM = 256, BK = 64, HALF = 128, HTB = HALF * BK * 2, STAGE_BYTES = 8 * HTB, NXCD = 8, WGM = 8;
__host__ __device__ __forceinline__ int lds_byte(int r, int c) { const int st = (r >> 4) * 2 + (c >> 5), rr = r & 15, cc = c & 31, ob = rr * 64 + cc * 2; return st * 1024 + (ob ^ (((ob >> 9) & 1) << 5)); }
__host__ __device__ __forceinline__ void stage_rc(int b, int& R, int& C) { const int st = b / 1024, sb = b % 1024, swz = sb ^ (((sb >> 9) & 1) << 5); R = (st >> 1) * 16 + swz / 64; C = (st & 1) * 32 + (swz % 64) / 2; }
__host__ __device__ __forceinline__ int perm32(int rho) { const int n = rho >> 4, i = rho & 15; return 8 * (i >> 2) + 4 * n + (i & 3); }
struct Unit { int pm, pn; };
struct Gemm { const bf16_t* A; const bf16_t* Bt; int M, N, K; };
struct StaticOrder {
    int nM, nN, nwg, G, c;
    __device__ void init(int M, int N, int G_, int c_) { nM = M / BM; nN = N / BM; nwg = nM * nN; G = G_; c = c_; }
    __device__ bool next(int i, Unit& u) const {
        const long L = (long)i * G + c; if (L >= nwg) return false;
        int wgid = (int)L; { const int q = nwg / NXCD, r = nwg % NXCD, xcd = wgid % NXCD, off = wgid / NXCD; wgid = (xcd < r ? xcd * (q + 1) : r * (q + 1) + (xcd - r) * q) + off; }
        const int nig = WGM * nN, gid = wgid / nig, fm = gid * WGM, gsz = (nM - fm) < WGM ? (nM - fm) : WGM;
        u.pm = fm + ((wgid % nig) % gsz); u.pn = (wgid % nig) / gsz; return true;
    }
};
struct EpiProj {
    static constexpr bool PERM = true;
    h16* O; float* PSM; const unsigned long long* ssq;
    __device__ __forceinline__ void operator()(const f32x4 (&acc)[2][2][4][2], const Unit& u, int wr, int wc, int fr, int fq) const {
        const int row0 = u.pm * BM + wr * 64 + fr, col0 = u.pn * BM + wc * 32 + 8 * fq;
#pragma unroll
        for (int ai = 0; ai < 2; ++ai)
#pragma unroll
            for (int m = 0; m < 4; ++m) { const int row = row0 + ai * HALF + m * 16; const float rs = ssq ? 1.0f / sqrtf((float)ssq[row] * (RSS_INV / DM) + EPS) : 1.f;
#pragma unroll
                for (int bj = 0; bj < 2; ++bj) { const f32x4 v0 = acc[ai][bj][m][0] * rs, v1 = acc[ai][bj][m][1] * rs; const int c = col0 + bj * HALF;
                    u32x4 w; w.x = pkh(v0[0], v0[1]); w.y = pkh(v0[2], v0[3]); w.z = pkh(v1[0], v1[1]); w.w = pkh(v1[2], v1[3]);
                    *(u32x4*)(O + (size_t)row * PN + c) = w;
                    if (c >= C_SM && c < C_SM + PSM_W) { float* p = PSM + (size_t)row * PSM_W + (c - C_SM); *(f32x4*)p = v0; *(f32x4*)(p + 4) = v1; } } }
    }
};
struct EpiHid {
    static constexpr bool PERM = true;
    h16* O; const unsigned long long* ssq;
    __device__ __forceinline__ void operator()(const f32x4 (&acc)[2][2][4][2], const Unit& u, int wr, int wc, int fr, int fq) const {
        const int row0 = u.pm * BM + wr * 64 + fr, col0 = u.pn * BM + wc * 32 + 8 * fq;
#pragma unroll
        for (int ai = 0; ai < 2; ++ai)
#pragma unroll
            for (int m = 0; m < 4; ++m) { const int row = row0 + ai * HALF + m * 16; const float rs = 1.0f / sqrtf((float)ssq[row] * (RSS_INV / DM) + EPS);
#pragma unroll
                for (int bj = 0; bj < 2; ++bj) { f32x4 v0 = acc[ai][bj][m][0] * rs, v1 = acc[ai][bj][m][1] * rs;
#pragma unroll
                    for (int e = 0; e < 4; ++e) { float a = fmaxf(v0[e], 0.f), b = fmaxf(v1[e], 0.f); v0[e] = a * a; v1[e] = b * b; }
                    u32x4 w; w.x = pkb(v0[0], v0[1]); w.y = pkb(v0[2], v0[3]); w.z = pkb(v1[0], v1[1]); w.w = pkb(v1[2], v1[3]);
                    *(u32x4*)(O + (size_t)row * DFF + col0 + bj * HALF) = w; } }
    }
};
struct EpiRes {
    static constexpr bool PERM = false;
    const float* base32; h16* hs; unsigned long long* ssq;
    __device__ __forceinline__ void operator()(const f32x4 (&acc)[2][2][4][2], const Unit& u, int wr, int wc, int fr, int fq) const {
        const int col0 = u.pn * BM + wc * 32 + 4 * fq;
#pragma unroll
        for (int ai = 0; ai < 2; ++ai)
#pragma unroll
            for (int m = 0; m < 4; ++m) { const int row = u.pm * BM + ai * HALF + wr * 64 + m * 16 + fr; const size_t off = (size_t)row * DM + col0; float sq = 0.f;
#pragma unroll
                for (int bj = 0; bj < 2; ++bj)
#pragma unroll
                    for (int n = 0; n < 2; ++n) { f32x4 bs;
                        if (base32) bs = *(const f32x4*)(base32 + off + bj * HALF + n * 16);
                        else bs = unpk_bf4(*(const u32x2*)(hs + off + bj * HALF + n * 16));
                        const f32x4 hv = bs + acc[ai][bj][m][n];
                        u32x2 w4; w4.x = pkb(hv[0], hv[1]); w4.y = pkb(hv[2], hv[3]); *(u32x2*)(hs + off + bj * HALF + n * 16) = w4;
                        const f32x4 hr4 = unpk_bf4(w4); const float r0 = hr4[0], r1 = hr4[1], r2 = hr4[2], r3 = hr4[3];
                        sq += (r0 * r0 + r1 * r1) + (r2 * r2 + r3 * r3); }
                sq += __shfl_xor(sq, 16); sq += __shfl_xor(sq, 32);
                if (fq == 0) atomicAdd(ssq + row, (unsigned long long)(sq * RSS_SCALE + 0.5f)); }
    }
};

template <class Epi, bool BF = false>
__device__ __forceinline__ void gemm_phase(LAS unsigned char* lds, const Gemm g, const StaticOrder& S, const Epi& E, int wid) {
    const int lane = opaque_lane(), tid = wid * 64 + lane, wr = wid >> 2, wc = wid & 3, fr = lane & 15, fq = lane >> 4;
    const int K = g.K, nt = K / BK;
    unsigned voffA[2], voffB[2];
#pragma unroll
    for (int i = 0; i < 2; ++i) { int R, C; stage_rc(tid * 16 + i * 8192, R, C); const int Rb = Epi::PERM ? ((R & ~31) + perm32(R & 31)) : R;
        voffA[i] = (unsigned)(R * K + C) * 2u; voffB[i] = (unsigned)(Rb * K + C) * 2u; }
    const size_t kstep = (size_t)(BK * 2);
    const size_t hstep = (size_t)HALF * K * 2;
    const size_t tstep = 2 * hstep;
    const unsigned ldsw = (unsigned)wid * 1024u;
    const int aoff = lds_byte(wr * 64 + fr, fq * 8), boff = lds_byte(wc * 32 + fr, fq * 8);
#define PG8_SA(b, h) (((b) * 2 + (h)) * HTB)
#define PG8_SB(b, h) ((4 + (b) * 2 + (h)) * HTB)
#define PG8_STAGE(bufoff, gbase, voff) do { _Pragma("unroll") for (int _i = 0; _i < 2; ++_i) \
        __builtin_amdgcn_global_load_lds((const unsigned*)((const char*)(gbase) + (voff)[_i]), (LAS unsigned*)(lds + (bufoff) + ldsw + _i * 8192), 16, 0, 0); } while (0)
#define PG8_LDA(dst, b, h) do { _Pragma("unroll") for (int m = 0; m < 4; ++m) _Pragma("unroll") for (int k = 0; k < 2; ++k) dst[m][k] = *(const LAS h16x8*)(lds + PG8_SA(b, h) + aoff + m * 2048 + k * 1024); } while (0)
#define PG8_LDB(dst, b, h) do { _Pragma("unroll") for (int n = 0; n < 2; ++n) _Pragma("unroll") for (int k = 0; k < 2; ++k) dst[n][k] = *(const LAS h16x8*)(lds + PG8_SB(b, h) + boff + n * 2048 + k * 1024); } while (0)
#define PG8_MMA(ai, bj, At, Bt) do { __builtin_amdgcn_s_setprio(1); _Pragma("unroll") for (int m = 0; m < 4; ++m) _Pragma("unroll") for (int n = 0; n < 2; ++n) _Pragma("unroll") for (int k = 0; k < 2; ++k) \
        acc[ai][bj][m][n] = BF ? __builtin_amdgcn_mfma_f32_16x16x32_bf16(__builtin_bit_cast(bf16x8_t, Bt[n][k]), __builtin_bit_cast(bf16x8_t, At[m][k]), acc[ai][bj][m][n], 0, 0, 0) : __builtin_amdgcn_mfma_f32_16x16x32_f16(Bt[n][k], At[m][k], acc[ai][bj][m][n], 0, 0, 0); __builtin_amdgcn_s_setprio(0); } while (0)
#define PG8_WAIT_V(n) asm volatile("s_waitcnt vmcnt(" #n ")" ::: "memory")
#define PG8_WAIT_L(n) asm volatile("s_waitcnt lgkmcnt(" #n ")" ::: "memory")
#define PG8_BAR __builtin_amdgcn_s_barrier()
#define PG8_SCHED __builtin_amdgcn_sched_barrier(0)
    Unit cur, nxt; int ui = 0;
    if (!S.next(0, cur)) return;
    f32x4 acc[2][2][4][2];
#pragma unroll
    for (int a = 0; a < 2; ++a)
#pragma unroll
        for (int b = 0; b < 2; ++b)
#pragma unroll
            for (int m = 0; m < 4; ++m)
#pragma unroll
                for (int n = 0; n < 2; ++n) acc[a][b][m][n] = (f32x4){0.f, 0.f, 0.f, 0.f};
    h16x8 At[4][2], B0[2][2], B1[2][2];
    const char* cA = (const char*)g.A + (size_t)cur.pm * tstep; const char* cB = (const char*)g.Bt + (size_t)cur.pn * tstep;
    PG8_STAGE(PG8_SB(0, 0), cB, voffB); PG8_STAGE(PG8_SB(0, 1), cB + hstep, voffB); PG8_STAGE(PG8_SA(0, 0), cA, voffA); PG8_STAGE(PG8_SA(0, 1), cA + hstep, voffA);
    if (wr == 1) PG8_BAR;
    PG8_WAIT_V(2); PG8_BAR;
    PG8_STAGE(PG8_SB(1, 0), cB + kstep, voffB); PG8_STAGE(PG8_SA(1, 0), cA + kstep, voffA); PG8_STAGE(PG8_SB(1, 1), cB + hstep + kstep, voffB);
    PG8_WAIT_V(6); PG8_BAR;
    for (;;) {
        const bool has_next = S.next(ui + 1, nxt);
        const char* nA = has_next ? (const char*)g.A + (size_t)nxt.pm * tstep : cA; const char* nB = has_next ? (const char*)g.Bt + (size_t)nxt.pn * tstep : cB;
        for (int t = 0; t < nt; t += 2) {
            const bool last = (t == nt - 2);
            const char* a1 = cA + (size_t)(t + 1) * kstep;
            const char* a2 = last ? nA : cA + (size_t)(t + 2) * kstep; const char* b2 = last ? nB : cB + (size_t)(t + 2) * kstep;
            const char* a3 = a2 + kstep; const char* b3 = b2 + kstep;
            PG8_LDB(B0, 0, 0); PG8_LDB(B1, 0, 1); PG8_SCHED; PG8_LDA(At, 0, 0); PG8_STAGE(PG8_SA(1, 1), a1 + hstep, voffA);
            PG8_WAIT_V(8); PG8_WAIT_L(0); PG8_BAR; PG8_MMA(0, 0, At, B0); PG8_MMA(0, 1, At, B1); PG8_BAR; PG8_SCHED;
            PG8_LDA(At, 0, 1); PG8_STAGE(PG8_SB(0, 0), b2, voffB); PG8_STAGE(PG8_SB(0, 1), b2 + hstep, voffB); PG8_STAGE(PG8_SA(0, 0), a2, voffA);
            PG8_WAIT_V(8); PG8_WAIT_L(0); PG8_BAR; PG8_MMA(1, 0, At, B0); PG8_MMA(1, 1, At, B1); PG8_BAR; PG8_SCHED;
            PG8_LDB(B0, 1, 0); PG8_LDB(B1, 1, 1); PG8_SCHED; PG8_LDA(At, 1, 0); PG8_STAGE(PG8_SA(0, 1), a2 + hstep, voffA);
            PG8_WAIT_V(8); PG8_WAIT_L(0); PG8_BAR; PG8_MMA(0, 0, At, B0); PG8_MMA(0, 1, At, B1); PG8_BAR; PG8_SCHED;
            PG8_LDA(At, 1, 1); PG8_STAGE(PG8_SB(1, 0), b3, voffB); PG8_STAGE(PG8_SB(1, 1), b3 + hstep, voffB); PG8_STAGE(PG8_SA(1, 0), a3, voffA);
            PG8_WAIT_V(8); PG8_WAIT_L(0); PG8_BAR; PG8_MMA(1, 0, At, B0); PG8_MMA(1, 1, At, B1); PG8_BAR; PG8_SCHED;
        }
        if (wr == 0) PG8_BAR;
        E(acc, cur, wr, wc, fr, fq);
        if (!has_next) break;
#pragma unroll
        for (int a = 0; a < 2; ++a)
#pragma unroll
            for (int b = 0; b < 2; ++b)
#pragma unroll
                for (int m = 0; m < 4; ++m)
#pragma unroll
                    for (int n = 0; n < 2; ++n) acc[a][b][m][n] = (f32x4){0.f, 0.f, 0.f, 0.f};
        cur = nxt; cA = nA; cB = nB; ++ui;
        if (wr == 1) PG8_BAR;
    }
    PG8_WAIT_V(0);
    PG8_BAR;
#undef PG8_SA
#undef PG8_SB
#undef PG8_STAGE
#undef PG8_LDA
#undef PG8_LDB
#undef PG8_MMA
#undef PG8_WAIT_V
#undef PG8_WAIT_L
#undef PG8_BAR
#undef PG8_SCHED
}
}


#define XB_TMO      128
#define XB_XCNT(j)  (256  + 64 * (j))
#define XB_XSUB(j)  (1280 + 64 * (j))
#define XB_XGEN(j)  (2304 + 64 * (j))
#define XB_TOP      3328
#define XB_TOPGEN   3392
#define XCD_BAR_WORDS 3456
#define XB_SPIN_CAP (1u << 18)
__device__ __forceinline__ unsigned xb_ld(unsigned* p)              { return __hip_atomic_load(p, __ATOMIC_RELAXED, __HIP_MEMORY_SCOPE_AGENT); }
__device__ __forceinline__ unsigned xb_add(unsigned* p, unsigned v) { return __hip_atomic_fetch_add(p, v, __ATOMIC_RELAXED, __HIP_MEMORY_SCOPE_AGENT); }
__device__ __forceinline__ unsigned xb_xcc_id() { return (unsigned)__builtin_amdgcn_s_getreg((3 << 11) | 20) & 0xFu; }
#define XB_SPIN(cond, bar) do { unsigned _sp = 0; while (cond) { __builtin_amdgcn_s_sleep(1); \
    if ((++_sp & 255u) == 0u) { if (xb_ld(&(bar)[XB_TMO])) break; if (_sp > XB_SPIN_CAP) { atomicAdd(&(bar)[XB_TMO], 1u); break; } } } } while (0)
struct XcdBarrier { unsigned* bar; unsigned x; volatile LAS unsigned* st; int wv; };
__device__ __forceinline__ XcdBarrier xcd_barrier_post(unsigned* bar, volatile LAS unsigned* st, int wv) {
    XcdBarrier b; b.bar = bar; b.x = xb_xcc_id(); b.st = st; b.wv = wv;
    if (wv == 0 && opaque_lane() == 0) (void)xb_add(&bar[XB_XCNT(b.x)], 1u);
    return b;
}
__device__ __forceinline__ void xcd_barrier_complete(unsigned* bar, unsigned x, unsigned& nloc, unsigned& nx) {
    const unsigned G = gridDim.x * gridDim.y * gridDim.z;
    unsigned sum, cnt, mine, sp = 0u;
    for (;;) {
        sum = 0u; cnt = 0u; mine = 0u;
#pragma unroll
        for (unsigned j = 0; j < 16; ++j) { const unsigned c = xb_ld(&bar[XB_XCNT(j)]); sum += c; cnt += (c > 0u) ? 1u : 0u; mine = (j == x) ? c : mine; }
        if (sum == G) break;
        __builtin_amdgcn_s_sleep(1);
        if ((++sp & 255u) == 0u) { if (xb_ld(&bar[XB_TMO])) break; if (sp > XB_SPIN_CAP) { atomicAdd(&bar[XB_TMO], 1u); break; } }
    }
    nloc = mine > 0u ? mine : 1u; nx = cnt > 0u ? cnt : 1u;
}
__device__ __forceinline__ void xcd_barrier(const XcdBarrier& b) {
    asm volatile("s_waitcnt vmcnt(0)" ::: "memory");
    __syncthreads();
    if (b.wv == 0 && opaque_lane() == 0) {
        unsigned* bar = b.bar;
        __builtin_amdgcn_s_waitcnt(0);
        unsigned nloc = b.st[0], nx = b.st[1];
        if (nloc == 0u) { xcd_barrier_complete(bar, b.x, nloc, nx); b.st[0] = nloc; b.st[1] = nx; }
        const unsigned old = xb_add(&bar[XB_XSUB(b.x)], 1u);
        const unsigned gen = old / nloc;
        if (old + 1u == (gen + 1u) * nloc) {
            __builtin_amdgcn_fence(__ATOMIC_RELEASE, "agent");
            asm volatile("s_waitcnt vmcnt(0)" ::: "memory");
            const unsigned og = xb_add(&bar[XB_TOP], 1u);
            const unsigned tg = og / nx;
            if (og + 1u == (tg + 1u) * nx) xb_add(&bar[XB_TOPGEN], 1u);
            else XB_SPIN(xb_ld(&bar[XB_TOPGEN]) == tg, bar);
            __builtin_amdgcn_fence(__ATOMIC_ACQUIRE, "agent");
            xb_add(&bar[XB_XGEN(b.x)], 1u);
            asm volatile("s_waitcnt vmcnt(0)" ::: "memory");
        } else {
            XB_SPIN(xb_ld(&bar[XB_XGEN(b.x)]) == gen, bar);
            __builtin_amdgcn_fence(__ATOMIC_ACQUIRE, "agent");
            asm volatile("s_waitcnt vmcnt(0)" ::: "memory");
        }
    }
    __syncthreads();
}

#define TIDS const int lane = opaque_lane(); const int wave = C.wv; const int tid = wave * 64 + lane; (void)tid;
struct Ctx {
    const float* in[24]; float* out; unsigned char* ws;
    int G, bid, wv;
    h16 *WIN, *WOUT, *WUP, *WDN, *W1T, *W2T, *XN, *PROJ, *HID, *XBCC, *KC, *VC;
    h16* SSDST; unsigned long long* RSS; float *B1P, *B1, *ROPE, *GLAST, *PSM, *SSQ, *DTV, *ACS, *CD, *GLAG; h16* H16;
};
__device__ __forceinline__ void make_ctx(Ctx& C, const Params* kp, int wv) {
    C.wv = wv;
#pragma unroll
    for (int i = 0; i < 24; ++i) C.in[i] = kp->in[i];
    C.out = kp->out; unsigned char* ws = kp->ws; C.ws = ws; C.G = gridDim.x; C.bid = blockIdx.x;
    C.WIN = (h16*)(ws + WS_WIN); C.WOUT = (h16*)(ws + WS_WOUT); C.WUP = (h16*)(ws + WS_WUP); C.WDN = (h16*)(ws + WS_WDN); C.W1T = (h16*)(ws + WS_W1T); C.W2T = (h16*)(ws + WS_W2T);
    C.XN = (h16*)(ws + WS_XN); C.PROJ = (h16*)(ws + WS_PROJ); C.HID = (h16*)(ws + WS_HID); C.XBCC = (h16*)kp->out;      C.KC = (h16*)(ws + WS_KC); C.VC = (h16*)(ws + WS_VC);
    C.B1 = (float*)(ws + WS_B1); C.B1P = (float*)(ws + WS_B1P); C.ROPE = (float*)(ws + WS_ROPE); C.SSDST = (h16*)(ws + WS_SSDST); C.RSS = (unsigned long long*)(ws + WS_RSS); C.H16 = (h16*)(ws + WS_H16); C.GLAST = (float*)(ws + WS_GLAST); C.PSM = (float*)(ws + WS_PSM);
    C.SSQ = (float*)(ws + WS_SSQ); C.DTV = (float*)(ws + WS_DTV); C.ACS = (float*)(ws + WS_ACS); C.CD = (float*)(ws + WS_CD); C.GLAG = (float*)(ws + WS_GLAG);
}

__device__ __forceinline__ int win_src_col(int n) {
    if (n < 512) return n;
    if (n < 768) return n - 512 + 528;
    if (n < 1024) return n - 768 + 784;
    if (n < 1792) return n - 1024 + 1040;
    if (n < 2304) return n - 1792 + 1820;
    if (n < 3328) return n - 2304 + 2332;
    const int r = n - 3328;
    if (r < 16) return 512 + r;
    if (r < 28) return 1808 + (r - 16);
    if (r < 36) return 3356 + (r - 28);
    return -1;
}
template <bool MAPW, bool OBF = false>
__device__ __forceinline__ void transpose_item(const float* W, int K, int Nsrc, int Ndst, h16* WT, const float* kscale, float* scr, int item, int lane) {
    const int nblk = Ndst / 32, kb = item / nblk, nb = item % nblk, k0 = 64 * kb, n0 = 32 * nb;
    const int nd = n0 + (lane & 31); const int sc = MAPW ? win_src_col(nd) : nd;
    float vv[32];
#pragma unroll
    for (int i = 0; i < 32; ++i) { const int kk = 2 * i + (lane >> 5); vv[i] = (sc >= 0) ? W[(size_t)(k0 + kk) * Nsrc + sc] : 0.f; }
#pragma unroll
    for (int i = 0; i < 32; ++i) { const int kk = 2 * i + (lane >> 5); scr[kk * 33 + (lane & 31)] = kscale ? vv[i] * kscale[k0 + kk] : vv[i]; }
    asm volatile("s_waitcnt lgkmcnt(0)" ::: "memory");
    const int c = lane & 7;
#pragma unroll
    for (int j = 0; j < 4; ++j) { const int n = (lane >> 3) + 8 * j; const float* s = scr + (8 * c) * 33 + n;
        u32x4 o; if (OBF) { o.x = pkb(s[0 * 33], s[1 * 33]); o.y = pkb(s[2 * 33], s[3 * 33]); o.z = pkb(s[4 * 33], s[5 * 33]); o.w = pkb(s[6 * 33], s[7 * 33]); } else { o.x = pkh(s[0 * 33], s[1 * 33]); o.y = pkh(s[2 * 33], s[3 * 33]); o.z = pkh(s[4 * 33], s[5 * 33]); o.w = pkh(s[6 * 33], s[7 * 33]); }
        *(u32x4*)(WT + (size_t)(n0 + n) * K + k0 + 8 * c) = o; }
    asm volatile("s_waitcnt lgkmcnt(0)" ::: "memory");
}
__device__ __forceinline__ void rms_row_to_h16(const float* xrow, h16* orow, int lane) {
    const f32x4* xr = (const f32x4*)xrow + lane; f32x4 v[4]; float s = 0.f;
#pragma unroll
    for (int j = 0; j < 4; ++j) { v[j] = xr[64 * j]; s += (v[j].x * v[j].x + v[j].y * v[j].y) + (v[j].z * v[j].z + v[j].w * v[j].w); }
    const float rs = 1.0f / sqrtf(wave_sum(s) * (1.f / DM) + EPS);
    u32x2* o8 = (u32x2*)orow + lane;
#pragma unroll
    for (int j = 0; j < 4; ++j) { u32x2 w; w.x = pkh(v[j].x * rs, v[j].y * rs); w.y = pkh(v[j].z * rs, v[j].w * rs); o8[64 * j] = w; }
}
__device__ __forceinline__ void sincos_acc(float angf, float& c, float& s) {
    const double x = (double)angf; const double n = __builtin_rint(x * 0.63661977236758134308);
    const double r = __builtin_fma(-n, 1.5707963267948966192, x) - n * 6.123233995736766036e-17;
    const double r2 = r * r;
    double sp = -7.6471637318198164759e-13; sp = sp * r2 + 1.6059043836821614599e-10; sp = sp * r2 - 2.5052108385441718775e-08; sp = sp * r2 + 2.7557319223985890653e-06;
    sp = sp * r2 - 1.9841269841269841270e-04; sp = sp * r2 + 8.3333333333333333333e-03; sp = sp * r2 - 1.6666666666666666667e-01; const double sn = r + r * r2 * sp;
    double cp = 4.7794773323873852974e-14; cp = cp * r2 - 1.1470745597729724714e-11; cp = cp * r2 + 2.0876756987868098979e-09; cp = cp * r2 - 2.7557319223985890653e-07;
    cp = cp * r2 + 2.4801587301587301587e-05; cp = cp * r2 - 1.3888888888888888889e-03; cp = cp * r2 + 4.1666666666666666667e-02; cp = cp * r2 - 0.5; const double cs = 1.0 + r2 * cp;
    const int q = ((int)n) & 3;
    const double so = (q == 0) ? sn : (q == 1) ? cs : (q == 2) ? -sn : -cs;
    const double co = (q == 0) ? cs : (q == 1) ? -sn : (q == 2) ? -cs : sn;
    c = (float)co; s = (float)so;
}
__device__ __forceinline__ void phase_prep(const Ctx& C) {
    TIDS
    float* scr = (float*)(g_lds) + wave * (64 * 33);
    const int gw = C.bid * 8 + wave, NGW = C.G * 8;
    constexpr int I_IN = 16 * (PN / 32), I_OUT = 16 * 32, I_UP = 16 * 128, I_DN = 64 * 32, I_W1 = 32 * 4, I_W2 = 2 * 2;
    constexpr int PER_L = I_IN + I_OUT + I_UP + I_DN + 2 * I_W1 + 2 * I_W2;
    for (int it = gw; it < DEPTH * PER_L; it += NGW) {
        const int l = it / PER_L; int r = it % PER_L;
        if (r < I_IN) { transpose_item<true, true>(C.in[2] + (size_t)l * DM * DIN, DM, DIN, PN, C.WIN + (size_t)l * PN * DM, C.in[1] + l * DM, scr, r, lane); continue; } r -= I_IN;
        if (r < I_OUT) { transpose_item<false, true>(C.in[19] + (size_t)l * DM * DM, DM, DM, DM, C.WOUT + (size_t)l * DM * DM, nullptr, scr, r, lane); continue; } r -= I_OUT;
        if (r < I_UP) { transpose_item<false, true>(C.in[21] + (size_t)l * DM * DFF, DM, DFF, DFF, C.WUP + (size_t)l * DFF * DM, C.in[20] + l * DM, scr, r, lane); continue; } r -= I_UP;
        if (r < I_DN) { transpose_item<false, true>(C.in[22] + (size_t)l * DFF * DM, DFF, DM, DM, C.WDN + (size_t)l * DM * DFF, nullptr, scr, r, lane); continue; } r -= I_DN;
        if (r < 2 * I_W1) { const int kv = r / I_W1; transpose_item<false>(C.in[kv ? 10 : 7] + (size_t)l * 2048 * 128, 2048, 128, 128, C.W1T + (size_t)(l * 2 + kv) * 128 * 2048, nullptr, scr, r % I_W1, lane); continue; } r -= 2 * I_W1;
        { const int kv = r / I_W2; transpose_item<false>(C.in[kv ? 11 : 8] + (size_t)l * 128 * 64, 128, 64, 64, C.W2T + (size_t)(l * 2 + kv) * 64 * 128, nullptr, scr, r % I_W2, lane); }
    }
    for (int it = gw; it < DEPTH * 2 * 32; it += NGW) {
        const int lk = it >> 5, fc = it & 31, l = lk >> 1, kv = lk & 1;
        const float* pos = C.in[kv ? 9 : 6] + (size_t)l * 2048 + fc * 64; const float* w1 = C.in[kv ? 10 : 7] + (size_t)l * 2048 * 128 + (size_t)fc * 64 * 128;
        float s0 = 0.f, s1 = 0.f;
#pragma unroll 16
        for (int f = 0; f < 64; ++f) { const float pv = pos[f]; s0 += pv * w1[f * 128 + lane]; s1 += pv * w1[f * 128 + 64 + lane]; }
        C.B1P[(size_t)it * 128 + lane] = s0; C.B1P[(size_t)it * 128 + 64 + lane] = s1;
    }
    for (int e = C.bid * 512 + tid; e < SEQ * 32; e += C.G * 512) {
        const int pos = e >> 5, i = e & 31; const float ang = (float)pos * ROPE_INV[i];
        float cs, sn; sincos_acc(ang, cs, sn); C.ROPE[2 * e] = cs; C.ROPE[2 * e + 1] = sn;
    }
    for (int e = C.bid * 512 + tid; e < 2 * DEPTH * MTOK; e += C.G * 512) C.RSS[e] = 0ull;
    for (int m0 = gw * 4; m0 < MTOK; m0 += NGW * 4) {
        f32x4 v[4][4]; float ss[4];
#pragma unroll
        for (int r = 0; r < 4; ++r) { const f32x4* xr = (const f32x4*)(C.in[0] + (size_t)(m0 + r) * DM) + lane;
#pragma unroll
            for (int j = 0; j < 4; ++j) v[r][j] = xr[64 * j]; }
#pragma unroll
        for (int r = 0; r < 4; ++r) { float sq = 0.f;
#pragma unroll
            for (int j = 0; j < 4; ++j) sq += (v[r][j].x * v[r][j].x + v[r][j].y * v[r][j].y) + (v[r][j].z * v[r][j].z + v[r][j].w * v[r][j].w);
            ss[r] = sq; }
#pragma unroll
        for (int o = 1; o < 64; o <<= 1) {
#pragma unroll
            for (int r = 0; r < 4; ++r) ss[r] += __shfl_xor(ss[r], o); }
#pragma unroll
        for (int r = 0; r < 4; ++r) { const float rs = 1.0f / sqrtf(ss[r] * (1.f / DM) + EPS); u32x2* o8 = (u32x2*)(C.XN + (size_t)(m0 + r) * DM) + lane;
#pragma unroll
            for (int j = 0; j < 4; ++j) { u32x2 w; w.x = pkb(v[r][j].x * rs, v[r][j].y * rs); w.y = pkb(v[r][j].z * rs, v[r][j].w * rs); o8[64 * j] = w; } }
    }
}

__device__ __forceinline__ void phase_tok(const Ctx& C, int l) {
    TIDS
    const int gw = C.bid * 8 + wave, NGW = C.G * 8;
    if (l == 0 && C.bid == 0) { float sb = 0.f; const float* pp = C.B1P + (size_t)(tid >> 7) * 32 * 128 + (tid & 127);
        for (int fc = 0; fc < 32; ++fc) sb += pp[fc * 128];
        C.B1[tid] = sb; }
    const float* cw = C.in[13] + (size_t)l * 4 * 1024; const float* cb = C.in[14] + (size_t)l * 1024; const float* dtb = C.in[15] + l * 8;
    const int ch = lane * 16;
    float wgt[4][16], bias[16];
#pragma unroll
    for (int e = 0; e < 16; ++e) { bias[e] = cb[ch + e];
#pragma unroll
        for (int i = 0; i < 4; ++i) wgt[i][e] = cw[i * 1024 + ch + e]; }
    const float dbias = (lane < 8) ? dtb[lane] : 0.f;
    const int hd = lane >> 2, c8 = (lane & 3) * 8; const bool rl = lane < 16;
    const int rbase = (hd < 2) ? (C_KSLC + hd * 64) : (C_KWIN + (hd - 2) * 64);
    const float rsc = 1.f;
    for (int run = gw; run < MTOK / 16; run += NGW) {
        const int m0 = run * 16, t0 = m0 & (SEQ - 1);
        h16x8 hist[3][2];
#pragma unroll
        for (int i = 0; i < 3; ++i) { const int tt = t0 - 3 + i;
            if (tt >= 0) { const h16* src = C.PROJ + (size_t)(m0 - 3 + i) * PN + C_SX + ch; hist[i][0] = *(const h16x8*)src; hist[i][1] = *(const h16x8*)(src + 8); }
            else { hist[i][0] = (h16x8){}; hist[i][1] = (h16x8){}; } }
        h16x8 nc0, nc1, nx1 = {}, nx2 = {}; f32x4 ntb[4] = {}; float ndtr = 0.f;
        { const h16* prow = C.PROJ + (size_t)m0 * PN; nc0 = *(const h16x8*)(prow + C_SX + ch); nc1 = *(const h16x8*)(prow + C_SX + ch + 8);
            if (rl) { nx1 = *(const h16x8*)(prow + rbase + c8); nx2 = *(const h16x8*)(prow + rbase + 32 + c8);
#pragma unroll
                for (int i = 0; i < 4; ++i) ntb[i] = *(const f32x4*)(C.ROPE + 2 * (t0 * 32 + c8) + 4 * i); }
            if (lane < 8) ndtr = C.PSM[(size_t)m0 * PSM_W + 28 + lane]; }
#pragma unroll 1
        for (int k = 0; k < 16; ++k) { const int m = m0 + k;
            h16* prow = C.PROJ + (size_t)m * PN;
            const h16x8 c0 = nc0, c1 = nc1, x1 = nx1, x2 = nx2; f32x4 tb[4]; tb[0] = ntb[0]; tb[1] = ntb[1]; tb[2] = ntb[2]; tb[3] = ntb[3]; const float dtr = ndtr;
            if (k < 15) { const h16* pn = prow + PN; nc0 = *(const h16x8*)(pn + C_SX + ch); nc1 = *(const h16x8*)(pn + C_SX + ch + 8);
                if (rl) { nx1 = *(const h16x8*)(pn + rbase + c8); nx2 = *(const h16x8*)(pn + rbase + 32 + c8);
#pragma unroll
                    for (int i = 0; i < 4; ++i) ntb[i] = *(const f32x4*)(C.ROPE + 2 * ((t0 + k + 1) * 32 + c8) + 4 * i); }
                if (lane < 8) ndtr = C.PSM[(size_t)(m + 1) * PSM_W + 28 + lane]; }
            float a[16];
#pragma unroll
            for (int e = 0; e < 8; ++e) { a[e] = bias[e] + wgt[0][e] * (float)hist[0][0][e] + wgt[1][e] * (float)hist[1][0][e] + wgt[2][e] * (float)hist[2][0][e] + wgt[3][e] * (float)c0[e];
                a[8 + e] = bias[8 + e] + wgt[0][8 + e] * (float)hist[0][1][e] + wgt[1][8 + e] * (float)hist[1][1][e] + wgt[2][8 + e] * (float)hist[2][1][e] + wgt[3][8 + e] * (float)c1[e]; }
            hist[0][0] = hist[1][0]; hist[0][1] = hist[1][1]; hist[1][0] = hist[2][0]; hist[1][1] = hist[2][1]; hist[2][0] = c0; hist[2][1] = c1;
            u32x4 o0, o1; o0.x = pkh(siluf_(a[0]), siluf_(a[1])); o0.y = pkh(siluf_(a[2]), siluf_(a[3])); o0.z = pkh(siluf_(a[4]), siluf_(a[5])); o0.w = pkh(siluf_(a[6]), siluf_(a[7]));
            o1.x = pkh(siluf_(a[8]), siluf_(a[9])); o1.y = pkh(siluf_(a[10]), siluf_(a[11])); o1.z = pkh(siluf_(a[12]), siluf_(a[13])); o1.w = pkh(siluf_(a[14]), siluf_(a[15]));
            h16* dst = C.XBCC + (size_t)m * 1024 + ch; *(u32x4*)dst = o0; *(u32x4*)(dst + 8) = o1;
            if (rl) { h16x8 y1, y2;
#pragma unroll
                for (int e = 0; e < 8; ++e) { const float cs = tb[e >> 1][2 * (e & 1)], sn = tb[e >> 1][2 * (e & 1) + 1]; const float a1 = (float)x1[e], a2 = (float)x2[e];
                    y1[e] = (h16)((a1 * cs - a2 * sn) * rsc); y2[e] = (h16)((a2 * cs + a1 * sn) * rsc); }
                *(h16x8*)(prow + rbase + c8) = y1; *(h16x8*)(prow + rbase + 32 + c8) = y2; }
            if (lane < 8) C.DTV[(size_t)m * 8 + lane] = softplusf_(dtr + dbias);
        }
    }
}

__device__ __forceinline__ float gelu_tanh(float x) { const float u = 0.7978845608028654f * (x + 0.044715f * x * x * x); const float e = __expf(2.f * u); const float th = 1.f - 2.f / (e + 1.f); return 0.5f * x * (1.f + th); }
__device__ __forceinline__ void nsa_compress_unit(const Ctx& C, int l, int u) {
    const int kv = u >> 7, b = (u >> 5) & 3, g = (u >> 4) & 1, mt2 = u & 15;
    TIDS
    const int w = wave, cc = lane & 15, quad = lane >> 4;
    h16* As = (h16*)g_lds;
    h16* Hs = (h16*)(g_lds + 2 * 272 * 72 * 2);
    const h16* W1T = C.W1T + (size_t)(l * 2 + kv) * 128 * 2048; const h16* W2T = C.W2T + (size_t)(l * 2 + kv) * 64 * 128; const float* B1 = C.B1 + (l * 2 + kv) * 128;
    const int col = (kv ? C_VCMP : C_KCMP) + g * 64;
    {
        h16x8 s1[5], s2[5]; f32x4 tb[5][4];
#pragma unroll
        for (int i = 0; i < 5; ++i) { const int pc = tid + 512 * i; if (pc < 2 * 272 * 4) { const int half = pc / (272 * 4), rem = pc % (272 * 4), t = rem >> 2, c4 = rem & 3;
                int tok = 256 * mt2 + 4096 * half + t; tok = tok < SEQ ? tok : SEQ - 1; const h16* src = C.PROJ + (size_t)(b * SEQ + tok) * PN + col + c4 * 8;
                s1[i] = *(const h16x8*)src; s2[i] = *(const h16x8*)(src + 32);
                if (kv == 0) {
#pragma unroll
                    for (int q4 = 0; q4 < 4; ++q4) tb[i][q4] = *(const f32x4*)(C.ROPE + 2 * (tok * 32 + c4 * 8) + 4 * q4); } } }
#pragma unroll
        for (int i = 0; i < 5; ++i) { const int pc = tid + 512 * i; if (pc < 2 * 272 * 4) { const int half = pc / (272 * 4), rem = pc % (272 * 4), t = rem >> 2, c4 = rem & 3;
                h16x8 y1 = s1[i], y2 = s2[i];
                if (kv == 0) {
#pragma unroll
                    for (int e = 0; e < 8; ++e) { const float cs = tb[i][e >> 1][2 * (e & 1)], sn = tb[i][e >> 1][2 * (e & 1) + 1]; const float a1 = (float)s1[i][e], a2 = (float)s2[i][e];
                        y1[e] = (h16)(a1 * cs - a2 * sn); y2[e] = (h16)(a2 * cs + a1 * sn); } }
                *(h16x8*)(As + (half * 272 + t) * 72 + c4 * 8) = y1; *(h16x8*)(As + (half * 272 + t) * 72 + 32 + c4 * 8) = y2; } } }
    __syncthreads();
    f32x4 acc0 = {0.f, 0.f, 0.f, 0.f}, acc1 = {0.f, 0.f, 0.f, 0.f};
    const h16* brow = W1T + (size_t)(w * 16 + cc) * 2048 + quad * 8;
    const h16* a0p = As + (16 * cc) * 72 + quad * 8; const h16* a1p = a0p + 272 * 72;
#pragma unroll 16
    for (int kk = 0; kk < 64; ++kk) {
        const h16x8 bb = *(const h16x8*)(brow + kk * 32);
        const h16x8 a0 = *(const h16x8*)(a0p + (kk >> 1) * 72 + (kk & 1) * 32);
        const h16x8 a1 = *(const h16x8*)(a1p + (kk >> 1) * 72 + (kk & 1) * 32);
        acc0 = mfma16(a0, bb, acc0); acc1 = mfma16(a1, bb, acc1);
    }
    { const float bias = B1[w * 16 + cc];
#pragma unroll
        for (int j = 0; j < 4; ++j) { Hs[(quad * 4 + j) * 136 + w * 16 + cc] = (h16)gelu_tanh(acc0[j] + bias); Hs[(16 + quad * 4 + j) * 136 + w * 16 + cc] = (h16)gelu_tanh(acc1[j] + bias); } }
    __syncthreads();
    { const int half = w >> 2, wn = w & 3;
        f32x4 o = {0.f, 0.f, 0.f, 0.f};
#pragma unroll
        for (int kk = 0; kk < 4; ++kk) { const h16x8 a = *(const h16x8*)(Hs + (half * 16 + cc) * 136 + kk * 32 + quad * 8); const h16x8 bb = *(const h16x8*)(W2T + (size_t)(wn * 16 + cc) * 128 + kk * 32 + quad * 8); o = mfma16(a, bb, o); }
        h16* dst = (kv ? C.VC : C.KC) + (size_t)((b * 2 + g) * 512 + (mt2 + 16 * half) * 16) * 64;
#pragma unroll
        for (int j = 0; j < 4; ++j) dst[(quad * 4 + j) * 64 + wn * 16 + cc] = (h16)o[j];
    }
    __syncthreads();
}

__device__ __forceinline__ h16x4 tr_read(const h16* p) { typedef short s16x4 __attribute__((ext_vector_type(4))); return __builtin_bit_cast(h16x4, __builtin_amdgcn_ds_read_tr16_b64_v4i16((LAS s16x4*)p)); }
__device__ __forceinline__ h16x8 cat44(h16x4 lo, h16x4 hi) { return (h16x8){lo[0], lo[1], lo[2], lo[3], hi[0], hi[1], hi[2], hi[3]}; }
struct SsdPre { float dt; h16x8 x[2]; h16x8 bq[4]; };
__device__ __forceinline__ void ssd_states_load(const Ctx& C, int u, int tid, SsdPre& P) {
    const int b = u >> 9, c = (u >> 3) & 63, h = u & 7, g = h >> 2; const size_t row0 = (size_t)b * SEQ + c * 128;
    P.dt = (tid < 128) ? C.DTV[(row0 + tid) * 8 + h] : 0.f;
#pragma unroll
    for (int i = 0; i < 2; ++i) { const int ch = tid + 512 * i, tok = ch >> 3, c8 = ch & 7; P.x[i] = *(const h16x8*)(C.XBCC + (row0 + tok) * 1024 + h * 64 + c8 * 8); }
#pragma unroll
    for (int i = 0; i < 4; ++i) { const int ch = tid + 512 * i, tok = ch >> 4, c16 = ch & 15; P.bq[i] = *(const h16x8*)(C.XBCC + (row0 + tok) * 1024 + 512 + g * 128 + c16 * 8); }
}
__device__ __forceinline__ void ssd_states_phase(const Ctx& C, int l, int ufirst, int ustep) {
    TIDS
    const int w = wave, cc = lane & 15, quad = lane >> 4;
    float* acs = (float*)g_lds; float* dtl = acs + 128; float* wl = acs + 256;
    h16* Xs = (h16*)(g_lds + 2048);
    h16* Bs = (h16*)(g_lds + 2048 + 18432);
    h16* Os_ = (h16*)(g_lds + 2048 + 18432 + 34816);
    int u = ufirst; SsdPre pre; if (u < 2048) ssd_states_load(C, u, tid, pre);
    while (u < 2048) {
        const int b = u >> 9, c = (u >> 3) & 63, h = u & 7; const size_t row0 = (size_t)b * SEQ + c * 128;
        const SsdPre cur = pre;
        const float A = -__expf(C.in[16][l * 8 + h]);
        if (tid < 128) dtl[tid] = cur.dt;
        __syncthreads();
        if (w == 0) {
            const float d0 = dtl[2 * lane], d1 = dtl[2 * lane + 1]; const float a0 = d0 * A, a1 = d1 * A, sm = a0 + a1; float incl = sm;
#pragma unroll
            for (int o = 1; o < 64; o <<= 1) { const float t = __shfl_up(incl, o); if (lane >= o) incl += t; }
            const float excl = incl - sm, tot = __shfl(incl, 63); const float c0 = excl + a0, c1 = incl;
            acs[2 * lane] = c0; acs[2 * lane + 1] = c1; wl[2 * lane] = __expf(tot - c0) * d0; wl[2 * lane + 1] = __expf(tot - c1) * d1;
            if (lane == 63) C.CD[(b * 64 + c) * 8 + h] = __expf(tot);
        }
        __syncthreads();
#pragma unroll
        for (int i = 0; i < 2; ++i) { const int ch = tid + 512 * i, tok = ch >> 3, c8 = ch & 7; *(h16x8*)(Xs + tok * 72 + c8 * 8) = cur.x[i]; }
#pragma unroll
        for (int i = 0; i < 4; ++i) { const int ch = tid + 512 * i, tok = ch >> 4, c16 = ch & 15; const float ww = wl[tok]; h16x8 o;
#pragma unroll
            for (int e = 0; e < 8; ++e) o[e] = (h16)((float)cur.bq[i][e] * ww);
            *(h16x8*)(Bs + tok * 136 + c16 * 8) = o; }
        if (tid < 128) C.ACS[(row0 + tid) * 8 + h] = acs[tid];
        const int un = u + ustep; if (un < 2048) ssd_states_load(C, un, tid, pre);
        __syncthreads();
        const int mi = w & 3;
        h16x8 xa[4];
#pragma unroll
        for (int kk = 0; kk < 4; ++kk) { const h16* xp = Xs + (kk * 32 + 8 * quad + (cc >> 2)) * 72 + mi * 16 + 4 * (cc & 3); xa[kk] = cat44(tr_read(xp), tr_read(xp + 4 * 72)); }
        h16* dst = C.SSDST + (size_t)((b * 64 + c) * 8 + h) * 8192;
#pragma unroll
        for (int q = 0; q < 4; ++q) { const int ni = (w >> 2) * 4 + q; f32x4 acc = {0.f, 0.f, 0.f, 0.f};
#pragma unroll
            for (int kk = 0; kk < 4; ++kk) { const h16* bp = Bs + (kk * 32 + 8 * quad + (cc >> 2)) * 136 + ni * 16 + 4 * (cc & 3); acc = mfma16(xa[kk], cat44(tr_read(bp), tr_read(bp + 4 * 136)), acc); }
#pragma unroll
            for (int j = 0; j < 4; ++j) Os_[(mi * 16 + quad * 4 + j) * 136 + ni * 16 + cc] = (h16)acc[j]; }
        __syncthreads();
#pragma unroll
        for (int i = 0; i < 2; ++i) { const int ch = tid + 512 * i, p = ch >> 4, c16 = ch & 15; *(h16x8*)(dst + p * 128 + c16 * 8) = *(const h16x8*)(Os_ + p * 136 + c16 * 8); }
        u = un;
    }
    __syncthreads();
}

struct SsdYPre { float acs, dt; h16x8 x[2], z[2], he[2]; };
struct SsdBC { h16x8 cq[4], bq[4]; };
__device__ __forceinline__ void ssd_y_load(const Ctx& C, int bc, int h, int tid, SsdYPre& P) {
    const int b = bc >> 6, c = bc & 63; const size_t row0 = (size_t)b * SEQ + c * 128;
    P.acs = (tid < 128) ? C.ACS[(row0 + tid) * 8 + h] : 0.f; P.dt = (tid < 128) ? C.DTV[(row0 + tid) * 8 + h] : 0.f;
#pragma unroll
    for (int i = 0; i < 2; ++i) { const int ch = tid + 512 * i, tok = ch >> 3, c8 = ch & 7; P.x[i] = *(const h16x8*)(C.XBCC + (row0 + tok) * 1024 + h * 64 + c8 * 8); P.z[i] = *(const h16x8*)(C.PROJ + (row0 + tok) * PN + C_SZ + h * 64 + c8 * 8); }
    const h16* src = C.SSDST + (size_t)((b * 64 + c) * 8 + h) * 8192;
#pragma unroll
    for (int i = 0; i < 2; ++i) P.he[i] = *(const h16x8*)(src + (tid + 512 * i) * 8);
}
__device__ __forceinline__ void ssd_bc_load(const Ctx& C, int bc, int g, int tid, SsdBC& P) {
    const int b = bc >> 6, c = bc & 63; const size_t row0 = (size_t)b * SEQ + c * 128;
#pragma unroll
    for (int i = 0; i < 4; ++i) { const int ch = tid + 512 * i, tok = ch >> 4, c16 = ch & 15; const h16* src = C.XBCC + (row0 + tok) * 1024 + 512 + g * 128 + c16 * 8; P.bq[i] = *(const h16x8*)src; P.cq[i] = *(const h16x8*)(src + 256); }
}
__device__ __forceinline__ void ssd_y_phase(const Ctx& C, int l, int bcfirst, int bcstep) {
    TIDS
    const int w = wave, cc = lane & 15, quad = lane >> 4;
    float* acs = (float*)g_lds; float* dtl = acs + 128; float* rss = acs + 256;
    h16* Cm = (h16*)(g_lds + 2048);
    h16* Bm = (h16*)(g_lds + 2048 + 34816);
    h16* Xs = (h16*)(g_lds + 2048 + 2 * 34816);
    h16* HE = (h16*)(g_lds + 2048 + 2 * 34816 + 18432);
    h16* Zs = (h16*)(g_lds + 2048 + 2 * 34816 + 18432 + 17408);
    const float* nwp = C.in[18] + l * 512;
    for (int bc = bcfirst; bc < 256; bc += bcstep) {
        const int b = bc >> 6, c = bc & 63; const size_t row0 = (size_t)b * SEQ + c * 128;
        SsdYPre pre; ssd_y_load(C, bc, 0, tid, pre);
        h16x4 cbt[8];
#pragma unroll 1
        for (int h = 0; h < 8; ++h) { const int g = h >> 2;
            __syncthreads();
            if (tid < 128) { acs[tid] = pre.acs; dtl[tid] = pre.dt; if ((h & 3) == 0) rss[tid] = 0.f; }
            if ((h & 3) == 0) { SsdBC pbc; ssd_bc_load(C, bc, g, tid, pbc);
#pragma unroll
                for (int i = 0; i < 4; ++i) { const int ch = tid + 512 * i, tok = ch >> 4, c16 = ch & 15; *(h16x8*)(Bm + tok * 136 + c16 * 8) = pbc.bq[i]; *(h16x8*)(Cm + tok * 136 + c16 * 8) = pbc.cq[i]; } }
#pragma unroll
            for (int i = 0; i < 2; ++i) { const int ch = tid + 512 * i, tok = ch >> 3, c8 = ch & 7; *(h16x8*)(Xs + tok * 72 + c8 * 8) = pre.x[i]; *(h16x8*)(Zs + tok * 72 + c8 * 8) = pre.z[i]; }
#pragma unroll
            for (int i = 0; i < 2; ++i) { const int ch = tid + 512 * i, p = ch >> 4, c16 = ch & 15; *(h16x8*)(HE + p * 136 + c16 * 8) = pre.he[i]; }
            if (h < 7) ssd_y_load(C, bc, h + 1, tid, pre);
            __syncthreads();
            h16x8 ca[4];
#pragma unroll
            for (int kk = 0; kk < 4; ++kk) ca[kk] = *(const h16x8*)(Cm + (w * 16 + cc) * 136 + kk * 32 + quad * 8);
            if ((h & 3) == 0) {
#pragma unroll
                for (int ni = 0; ni < 8; ++ni) { f32x4 acc = {0.f, 0.f, 0.f, 0.f};
#pragma unroll
                    for (int kk = 0; kk < 4; ++kk) { const h16x8 bb = *(const h16x8*)(Bm + (ni * 16 + cc) * 136 + kk * 32 + quad * 8); acc = mfma16(ca[kk], bb, acc); }
                    cbt[ni] = (h16x4){(h16)acc[0], (h16)acc[1], (h16)acc[2], (h16)acc[3]}; }
                __syncthreads();
            }
#pragma unroll
            for (int ni = 0; ni < 8; ++ni) { const int sidx = ni * 16 + cc; const float as_ = acs[sidx], ds_ = dtl[sidx];
#pragma unroll
                for (int j = 0; j < 4; ++j) { const int lr = w * 16 + quad * 4 + j; const float v = (sidx <= lr) ? (float)cbt[ni][j] * __expf(acs[lr] - as_) * ds_ : 0.f; Bm[lr * 136 + sidx] = (h16)v; } }
            __syncthreads();
            const float Dh = C.in[17][l * 8 + h];
            float ssq[4] = {0.f, 0.f, 0.f, 0.f};
            h16x8 ma[4];
#pragma unroll
            for (int kk = 0; kk < 4; ++kk) ma[kk] = *(const h16x8*)(Bm + (w * 16 + cc) * 136 + kk * 32 + quad * 8);
            float ea[4];
#pragma unroll
            for (int j = 0; j < 4; ++j) ea[j] = __expf(acs[w * 16 + quad * 4 + j]);
#pragma unroll
            for (int ni = 0; ni < 4; ++ni) { f32x4 acc = {0.f, 0.f, 0.f, 0.f};
#pragma unroll
                for (int kk = 0; kk < 4; ++kk) { const h16x8 bb = *(const h16x8*)(HE + (ni * 16 + cc) * 136 + kk * 32 + quad * 8); acc = mfma16(ca[kk], bb, acc); }
#pragma unroll
                for (int j = 0; j < 4; ++j) acc[j] *= ea[j];
#pragma unroll
                for (int kk = 0; kk < 4; ++kk) { const h16* xp = Xs + (kk * 32 + 8 * quad + (cc >> 2)) * 72 + ni * 16 + 4 * (cc & 3); acc = mfma16(ma[kk], cat44(tr_read(xp), tr_read(xp + 4 * 72)), acc); }
                const int p = ni * 16 + cc;
#pragma unroll
                for (int j = 0; j < 4; ++j) { const int lr = w * 16 + quad * 4 + j; const float x = (float)Xs[lr * 72 + p]; const float z = (float)Zs[lr * 72 + p];
                    const h16 yh = (h16)((acc[j] + Dh * x) * siluf_(z)); Zs[lr * 72 + p] = yh; const float yr = (float)yh; ssq[j] += yr * yr; } }
#pragma unroll
            for (int j = 0; j < 4; ++j) { float sv = ssq[j]; sv += __shfl_xor(sv, 1); sv += __shfl_xor(sv, 2); sv += __shfl_xor(sv, 4); sv += __shfl_xor(sv, 8);
                if (cc == 0) rss[w * 16 + quad * 4 + j] += sv; }
            __syncthreads();
#pragma unroll
            for (int i = 0; i < 2; ++i) { const int ch = tid + 512 * i, tok = ch >> 3, c8 = ch & 7; *(h16x8*)(C.XN + (row0 + tok) * 1024 + 512 + h * 64 + c8 * 8) = *(const h16x8*)(Zs + tok * 72 + c8 * 8); }
            if ((h & 3) == 3) {
                asm volatile("s_waitcnt vmcnt(0)" ::: "memory");
                __syncthreads();
#pragma unroll
                for (int i = 0; i < 8; ++i) { const int ch = tid + 512 * i, tok = ch >> 5, c8 = ch & 31; const float rs = 1.0f / sqrtf(rss[tok] * (1.f / 256.f) + EPS);
                    h16* p = C.XN + (row0 + tok) * 1024 + 512 + g * 256 + c8 * 8; const h16x8 v = *(const h16x8*)p; const float* nw = nwp + g * 256 + c8 * 8;
                    u32x4 o; o.x = pkb((float)v[0] * rs * nw[0], (float)v[1] * rs * nw[1]); o.y = pkb((float)v[2] * rs * nw[2], (float)v[3] * rs * nw[3]);
                    o.z = pkb((float)v[4] * rs * nw[4], (float)v[5] * rs * nw[5]); o.w = pkb((float)v[6] * rs * nw[6], (float)v[7] * rs * nw[7]); *(u32x4*)p = o; }
            }
        }
    }
    __syncthreads();
}

struct GlaLoad { f32x4 gl[4]; h16x8 q0, k0, vx[2], rx[2]; };
template <int PASS>
__device__ __forceinline__ void gla_load(const Ctx& C, GlaLoad& L, size_t rowh, int h, int lane) {
    const int tl = lane & 15, kq = lane >> 4; const size_t rowt = rowh + tl;
#pragma unroll
    for (int i = 0; i < 4; ++i) L.gl[i] = *(const f32x4*)(C.PSM + rowt * PSM_W + 4 * i);
    L.q0 = *(const h16x8*)(C.PROJ + rowt * PN + C_GQ + h * 32 + kq * 8);
    L.k0 = *(const h16x8*)(C.PROJ + rowt * PN + C_GK + h * 32 + kq * 8);
#pragma unroll
    for (int i = 0; i < 2; ++i) { const int ch = lane + 64 * i, t = ch >> 3, c8 = ch & 7; L.vx[i] = *(const h16x8*)(C.PROJ + (rowh + t) * PN + C_GV + h * 64 + c8 * 8);
        if (PASS == 1) L.rx[i] = *(const h16x8*)(C.PROJ + (rowh + t) * PN + C_GR + h * 64 + c8 * 8); }
}
template <int PASS>
__device__ __forceinline__ void gla_block_unit(const Ctx& C, int l, int bu) {
    TIDS
    const int w = wave; const int wu = bu * 8 + w; const int cc = lane & 15, quad = lane >> 4;
    const int bh = wu >> 7, seg = wu & 127, b = bh >> 2, h = bh & 3;
    const size_t row0 = (size_t)b * SEQ + seg * 64;
    unsigned char* wl = g_lds + w * 11264;
    h16* QT = (h16*)wl; h16* KT = QT + 640; h16* KH = KT + 640;
    h16* VS = KH + 640; h16* RS = VS + 1152;
    float* EM = (float*)(RS + 1152); float* EE = EM + 32;
    float* W2S = EE + 32;
    const int tl = cc, kq = quad;
    const float* gb = C.in[4] + l * 128 + h * 32 + kq * 8;
    { const float* w2g = C.in[3] + (size_t)l * 16 * 128 + h * 32;
#pragma unroll
        for (int i = 0; i < 2; ++i) { const int e4 = lane + 64 * i, r = e4 >> 3, c4 = e4 & 7; *(f32x4*)(W2S + r * 32 + c4 * 4) = *(const f32x4*)(w2g + r * 128 + c4 * 4); } }
    const float* w2 = W2S + kq * 8;
    f32x4 S[2][4];
    float* gst = C.GLAST + (size_t)(bh * 128 + seg) * 2048;
#pragma unroll
    for (int md = 0; md < 2; ++md)
#pragma unroll
        for (int nt = 0; nt < 4; ++nt)
#pragma unroll
            for (int j = 0; j < 4; ++j) S[md][nt][j] = (PASS == 1) ? gst[(16 * md + 4 * quad + j) * 64 + 16 * nt + cc] : 0.f;
    float bsum[8];
#pragma unroll
    for (int k = 0; k < 8; ++k) bsum[k] = 0.f;
    float gnw[4][4];
    if (PASS == 1) {
#pragma unroll
        for (int mt = 0; mt < 4; ++mt)
#pragma unroll
            for (int j = 0; j < 4; ++j) gnw[mt][j] = C.in[5][l * 256 + h * 64 + 16 * mt + 4 * quad + j]; }
    GlaLoad pre, pre2; gla_load<PASS>(C, pre, row0, h, lane); gla_load<PASS>(C, pre2, row0 + 16, h, lane);
#pragma unroll 1
    for (int qt = 0; qt < 4; ++qt) {
        const size_t rowh = row0 + qt * 16;
        const GlaLoad cur = pre; pre = pre2;
        if (qt < 2) gla_load<PASS>(C, pre2, rowh + 32, h, lane);
        float bi[8];
#pragma unroll
        for (int k = 0; k < 8; ++k) bi[k] = gb[k];
#pragma unroll
        for (int r = 0; r < 16; ++r) { const float gv = cur.gl[r >> 2][r & 3]; const f32x4 wa = *(const f32x4*)(w2 + r * 32), wb = *(const f32x4*)(w2 + r * 32 + 4);
#pragma unroll
            for (int k = 0; k < 4; ++k) { bi[k] += gv * wa[k]; bi[4 + k] += gv * wb[k]; } }
#pragma unroll
        for (int k = 0; k < 8; ++k) bi[k] = -0.0625f * __builtin_amdgcn_logf(1.f + ex2(-1.4426950408889634f * bi[k]));
#pragma unroll
        for (int o = 1; o < 16; o <<= 1)
#pragma unroll
            for (int k = 0; k < 8; ++k) { const float t = __shfl_up(bi[k], o, 16); if (tl >= o) bi[k] += t; }
        float bmid[8], bend[8];
#pragma unroll
        for (int k = 0; k < 8; ++k) { bmid[k] = __shfl(bi[k], 7, 16); bend[k] = __shfl(bi[k], 15, 16); bsum[k] += bend[k]; }
        asm volatile("" ::: "memory");
        { h16x8 qo, ko, kh;
#pragma unroll
            for (int k = 0; k < 8; ++k) { const float kf = (float)cur.k0[k]; qo[k] = (h16)((float)cur.q0[k] * 0.17677669529663687f * ex2(bi[k] - bmid[k])); ko[k] = (h16)(kf * ex2(bmid[k] - bi[k])); kh[k] = (h16)(kf * ex2(bend[k] - bi[k])); }
            *(h16x8*)(QT + tl * 40 + kq * 8) = qo; *(h16x8*)(KT + tl * 40 + kq * 8) = ko; *(h16x8*)(KH + tl * 40 + kq * 8) = kh;
            if (tl == 0) {
#pragma unroll
                for (int k4 = 0; k4 < 2; ++k4) { f32x4 em, ee;
#pragma unroll
                    for (int e = 0; e < 4; ++e) { em[e] = ex2(bmid[4 * k4 + e]); ee[e] = ex2(bend[4 * k4 + e]); }
                    *(f32x4*)(EM + kq * 8 + 4 * k4) = em; *(f32x4*)(EE + kq * 8 + 4 * k4) = ee; } } }
#pragma unroll
        for (int i = 0; i < 2; ++i) { const int ch = lane + 64 * i, t = ch >> 3, c8 = ch & 7; *(h16x8*)(VS + t * 72 + c8 * 8) = cur.vx[i]; if (PASS == 1) *(h16x8*)(RS + t * 72 + c8 * 8) = cur.rx[i]; }
        asm volatile("s_waitcnt lgkmcnt(0)" ::: "memory");
        h16x8 vfr[4];
#pragma unroll
        for (int nt = 0; nt < 4; ++nt) { const h16x4 t4 = tr_read(VS + (4 * quad + (cc >> 2)) * 72 + 16 * nt + 4 * (cc & 3)); vfr[nt] = (h16x8){t4[0], t4[1], t4[2], t4[3], (h16)0.f, (h16)0.f, (h16)0.f, (h16)0.f}; }
        if (PASS == 1) {
            f32x4 at = {0.f, 0.f, 0.f, 0.f};
            at = mfma16(*(const h16x8*)(KT + cc * 40 + quad * 8), *(const h16x8*)(QT + cc * 40 + quad * 8), at);
            h16x8 pa;
#pragma unroll
            for (int e = 0; e < 4; ++e) { pa[e] = (h16)((4 * quad + e <= cc) ? at[e] : 0.f); pa[4 + e] = (h16)0.f; }
            const h16x4 ql = *(const h16x4*)(QT + cc * 40 + 4 * quad), qh = *(const h16x4*)(QT + cc * 40 + 16 + 4 * quad);
            const h16x8 qfr = cat44(ql, qh);
            const f32x4 em0 = *(const f32x4*)(EM + 4 * quad), em1 = *(const f32x4*)(EM + 16 + 4 * quad);
            f32x4 ot[4]; float ssq = 0.f;
#pragma unroll
            for (int mt = 0; mt < 4; ++mt) { f32x4 acc = {0.f, 0.f, 0.f, 0.f};
                acc = mfma16(vfr[mt], pa, acc);
                const h16x8 sfr = {(h16)(S[0][mt][0] * em0[0]), (h16)(S[0][mt][1] * em0[1]), (h16)(S[0][mt][2] * em0[2]), (h16)(S[0][mt][3] * em0[3]),
                                   (h16)(S[1][mt][0] * em1[0]), (h16)(S[1][mt][1] * em1[1]), (h16)(S[1][mt][2] * em1[2]), (h16)(S[1][mt][3] * em1[3])};
                acc = mfma16(sfr, qfr, acc);
                ot[mt] = acc; ssq += (acc[0] * acc[0] + acc[1] * acc[1]) + (acc[2] * acc[2] + acc[3] * acc[3]); }
            ssq += __shfl_xor(ssq, 16); ssq += __shfl_xor(ssq, 32);
            const float rs = 1.0f / sqrtf(ssq * (1.f / 64.f) + EPS);
#pragma unroll
            for (int mt = 0; mt < 4; ++mt) { const h16x4 r4 = *(const h16x4*)(RS + cc * 72 + 16 * mt + 4 * quad);
                u32x2 wv; wv.x = pkb(ot[mt][0] * rs * gnw[mt][0] * siluf_((float)r4[0]), ot[mt][1] * rs * gnw[mt][1] * siluf_((float)r4[1]));
                wv.y = pkb(ot[mt][2] * rs * gnw[mt][2] * siluf_((float)r4[2]), ot[mt][3] * rs * gnw[mt][3] * siluf_((float)r4[3]));
                *(u32x2*)(C.XN + (rowh + cc) * 1024 + h * 64 + 16 * mt + 4 * quad) = wv; }
        }
#pragma unroll
        for (int md = 0; md < 2; ++md) { const f32x4 ee = *(const f32x4*)(EE + 16 * md + 4 * quad);
            const h16x4 k4 = tr_read(KH + (4 * quad + (cc >> 2)) * 40 + 16 * md + 4 * (cc & 3));
            const h16x8 kfr = {k4[0], k4[1], k4[2], k4[3], (h16)0.f, (h16)0.f, (h16)0.f, (h16)0.f};
#pragma unroll
            for (int nt = 0; nt < 4; ++nt) { S[md][nt] = S[md][nt] * ee; S[md][nt] = mfma16(kfr, vfr[nt], S[md][nt]); } }
    }
    if (PASS == 0) {
#pragma unroll
        for (int md = 0; md < 2; ++md)
#pragma unroll
            for (int nt = 0; nt < 4; ++nt)
#pragma unroll
                for (int j = 0; j < 4; ++j) gst[(16 * md + 4 * quad + j) * 64 + 16 * nt + cc] = S[md][nt][j];
        if (tl == 0) {
#pragma unroll
            for (int k = 0; k < 8; ++k) C.GLAG[(size_t)(bh * 128 + seg) * 32 + kq * 8 + k] = ex2(bsum[k]); }
    }
}

__device__ __forceinline__ void phase_scans(const Ctx& C) {
    TIDS
    for (int e = C.bid * 512 + tid; e < BATCH * 8 * 4096; e += C.G * 512) {
        const int bh = e >> 12, b = bh >> 3, h = bh & 7, pn = e & 4095;
        h16x2* p = (h16x2*)(C.SSDST + (size_t)(b * 64 * 8 + h) * 8192) + pn; const float* cd = C.CD + b * 64 * 8 + h;
        float s0 = 0.f, s1 = 0.f;
        for (int c0 = 0; c0 < 64; c0 += 16) { h16x2 v[16]; float d[16];
#pragma unroll
            for (int i = 0; i < 16; ++i) { v[i] = p[(size_t)(c0 + i) * 8 * 4096]; d[i] = cd[(c0 + i) * 8]; }
#pragma unroll
            for (int i = 0; i < 16; ++i) { h16x2 o = {(h16)s0, (h16)s1}; p[(size_t)(c0 + i) * 8 * 4096] = o; s0 = d[i] * s0 + (float)v[i][0]; s1 = d[i] * s1 + (float)v[i][1]; } }
    }
    for (int e = C.bid * 512 + tid; e < 16 * 2048; e += C.G * 512) {
        const int bh = e >> 11, kv = e & 2047, k = kv >> 6;
        float* p = C.GLAST + (size_t)bh * 128 * 2048 + kv; const float* gg = C.GLAG + (size_t)bh * 128 * 32 + k;
        float st = 0.f;
        for (int s0 = 0; s0 < 128; s0 += 8) { float v[8], d[8];
#pragma unroll
            for (int i = 0; i < 8; ++i) { v[i] = p[(size_t)(s0 + i) * 2048]; d[i] = gg[(s0 + i) * 32]; }
#pragma unroll
            for (int i = 0; i < 8; ++i) { p[(size_t)(s0 + i) * 2048] = st; st = d[i] * st + v[i]; } }
    }
}

constexpr int KV_LD = 80, KV_TILE = 64 * KV_LD;
__device__ __forceinline__ void qk_tile(f32x4 (&s)[4], const h16* Ks, const h16x8 (&qf)[2], int cc, int quad) {
#pragma unroll
    for (int mt = 0; mt < 4; ++mt) { f32x4 a = {0.f, 0.f, 0.f, 0.f};
#pragma unroll
        for (int ks = 0; ks < 2; ++ks) { const h16x8 kf = *(const h16x8*)(Ks + (mt * 16 + cc) * KV_LD + ks * 32 + quad * 8); a = mfma16(kf, qf[ks], a); }
        s[mt] = a; }
}
__device__ __forceinline__ void pv_tile(f32x4 (&O)[4], const h16* Vs, const f32x4 (&p)[4], int cc, int quad) {
    h16x8 pf[2];
#pragma unroll
    for (int k2 = 0; k2 < 2; ++k2) pf[k2] = (h16x8){(h16)p[2 * k2][0], (h16)p[2 * k2][1], (h16)p[2 * k2][2], (h16)p[2 * k2][3], (h16)p[2 * k2 + 1][0], (h16)p[2 * k2 + 1][1], (h16)p[2 * k2 + 1][2], (h16)p[2 * k2 + 1][3]};
#pragma unroll
    for (int md = 0; md < 4; ++md)
#pragma unroll
        for (int k2 = 0; k2 < 2; ++k2) { const h16* vp = Vs + (32 * k2 + 4 * quad + (cc >> 2)) * KV_LD + md * 16 + 4 * (cc & 3);
            const h16x4 lo = tr_read(vp), hi = tr_read(vp + 16 * KV_LD);
            const h16x8 vf = {lo[0], lo[1], lo[2], lo[3], hi[0], hi[1], hi[2], hi[3]}; O[md] = mfma16(vf, pf[k2], O[md]); }
}
struct FlashState { float mref, l; f32x4 O[4]; bool started; };
template <int MODE, bool MASKED>
__device__ __forceinline__ void flash_tile2(FlashState (&st)[2], const h16* Ks, const h16* Vs, const h16x8 (&qf)[2][2], int kv0, const int (&tq)[2], const bool (&sb)[2], int cc, int quad) {
    if (MODE == 0) { if (!__any(sb[0] || sb[1])) return; }
    h16x8 kf[4][2];
#pragma unroll
    for (int mt = 0; mt < 4; ++mt)
#pragma unroll
        for (int ks = 0; ks < 2; ++ks) kf[mt][ks] = *(const h16x8*)(Ks + (mt * 16 + cc) * KV_LD + ks * 32 + quad * 8);
    f32x4 s[2][4]; float rmax[2];
#pragma unroll
    for (int gi = 0; gi < 2; ++gi) { const float nm = -st[gi].mref; const f32x4 negm = {nm, nm, nm, nm};
#pragma unroll
        for (int mt = 0; mt < 4; ++mt) { f32x4 a = mfma16(kf[mt][0], qf[gi][0], negm); s[gi][mt] = mfma16(kf[mt][1], qf[gi][1], a); } }
#pragma unroll
    for (int gi = 0; gi < 2; ++gi) { float tmax = -INFINITY;
        if (MASKED) {
#pragma unroll
            for (int mt = 0; mt < 4; ++mt)
#pragma unroll
                for (int j = 0; j < 4; ++j) { const int kp = kv0 + mt * 16 + quad * 4 + j; const bool ok = (MODE == 0) ? (kp <= tq[gi]) : (kp <= tq[gi] && kp > tq[gi] - 512);
                    const float v = ok ? s[gi][mt][j] : -INFINITY; s[gi][mt][j] = v; tmax = fmaxf(tmax, v); }
        } else {
            float ta = max3f(s[gi][0][0], s[gi][0][1], s[gi][0][2]), tb = max3f(s[gi][0][3], s[gi][1][0], s[gi][1][1]);
            ta = max3f(ta, s[gi][1][2], s[gi][1][3]); tb = max3f(tb, s[gi][2][0], s[gi][2][1]); ta = max3f(ta, s[gi][2][2], s[gi][2][3]); tb = max3f(tb, s[gi][3][0], s[gi][3][1]);
            tmax = max3f(ta, tb, fmaxf(s[gi][3][2], s[gi][3][3]));
        }
        tmax = fmaxf(tmax, __shfl_xor(tmax, 16)); tmax = fmaxf(tmax, __shfl_xor(tmax, 32));
        rmax[gi] = (MODE == 0 && !sb[gi]) ? -INFINITY : tmax; }
    bool upd[2];
#pragma unroll
    for (int gi = 0; gi < 2; ++gi) upd[gi] = (rmax[gi] > -INFINITY) && (!st[gi].started || rmax[gi] > 8.f);
    if (__any(upd[0] || upd[1])) {
#pragma unroll
        for (int gi = 0; gi < 2; ++gi) { const float dl = upd[gi] ? rmax[gi] : 0.f; const float f = (upd[gi] && st[gi].started) ? ex2(-dl) : 1.f;
            st[gi].mref += dl; st[gi].l *= f; st[gi].started = st[gi].started || upd[gi];
#pragma unroll
            for (int mt = 0; mt < 4; ++mt) { s[gi][mt] = s[gi][mt] - dl; st[gi].O[mt] *= f; } }
    }
    h16x8 pf[2][2];
#pragma unroll
    for (int gi = 0; gi < 2; ++gi) {
#pragma unroll
        for (int mt = 0; mt < 4; ++mt)
#pragma unroll
            for (int j = 0; j < 4; ++j) s[gi][mt][j] = ex2(s[gi][mt][j]);
        const f32x4 ps4 = (s[gi][0] + s[gi][1]) + (s[gi][2] + s[gi][3]);
        float psum = (ps4[0] + ps4[1]) + (ps4[2] + ps4[3]);
        u32x4 w0, w1; w0.x = pkh(s[gi][0][0], s[gi][0][1]); w0.y = pkh(s[gi][0][2], s[gi][0][3]); w0.z = pkh(s[gi][1][0], s[gi][1][1]); w0.w = pkh(s[gi][1][2], s[gi][1][3]);
        w1.x = pkh(s[gi][2][0], s[gi][2][1]); w1.y = pkh(s[gi][2][2], s[gi][2][3]); w1.z = pkh(s[gi][3][0], s[gi][3][1]); w1.w = pkh(s[gi][3][2], s[gi][3][3]);
        if (MODE == 0) { const unsigned mk = sb[gi] ? 0xffffffffu : 0u; w0 = w0 & mk; w1 = w1 & mk; psum = sb[gi] ? psum : 0.f; }
        st[gi].l += psum; pf[gi][0] = __builtin_bit_cast(h16x8, w0); pf[gi][1] = __builtin_bit_cast(h16x8, w1); }
#pragma unroll
    for (int md = 0; md < 4; ++md)
#pragma unroll
        for (int k2 = 0; k2 < 2; ++k2) { const h16* vp = Vs + (32 * k2 + 4 * quad + (cc >> 2)) * KV_LD + md * 16 + 4 * (cc & 3);
            const h16x8 vf = cat44(tr_read(vp), tr_read(vp + 16 * KV_LD));
            st[0].O[md] = mfma16(vf, pf[0][k2], st[0].O[md]); st[1].O[md] = mfma16(vf, pf[1][k2], st[1].O[md]); }
}
template <bool NEEDV, class SrcFn, class CompFn>
__device__ __forceinline__ void kv_pipeline(int n, int tid, h16* Kb, h16* Vb, SrcFn src, CompFn comp) {
    if (n <= 0) return;
    const int key = tid >> 3, c8 = tid & 7; const int loff = key * KV_LD + c8 * 8;
    h16x8 kr, vr = {};
    { const h16 *kp, *vp; size_t stride; src(0, kp, vp, stride); kr = *(const h16x8*)(kp + (size_t)key * stride + c8 * 8); if (NEEDV) vr = *(const h16x8*)(vp + (size_t)key * stride + c8 * 8); }
    *(h16x8*)(Kb + loff) = kr; if (NEEDV) *(h16x8*)(Vb + loff) = vr;
    __syncthreads();
    for (int i = 0; i < n; ++i) {
        const int cur = i & 1; const bool more = (i + 1 < n);
        if (more) { const h16 *kp, *vp; size_t stride; src(i + 1, kp, vp, stride); kr = *(const h16x8*)(kp + (size_t)key * stride + c8 * 8); if (NEEDV) vr = *(const h16x8*)(vp + (size_t)key * stride + c8 * 8); }
        comp(i, Kb + cur * KV_TILE, Vb + cur * KV_TILE);
        if (more) { *(h16x8*)(Kb + (cur ^ 1) * KV_TILE + loff) = kr; if (NEEDV) *(h16x8*)(Vb + (cur ^ 1) * KV_TILE + loff) = vr; }
        __syncthreads();
    }
}
__device__ __forceinline__ void nsa_attn_unit(const Ctx& C, int l, int b, int g, int qq) {
    TIDS
    const int w = wave, cc = lane & 15, quad = lane >> 4;
    const int r = cc >> 3, ti = cc & 7, h = 2 * g + r;
    const int qbw = 2 * qq + (w >> 2), qbh = 2 * qq + 1;
    int tloc[2], tq[2]; size_t rowq[2];
#pragma unroll
    for (int gi = 0; gi < 2; ++gi) { tloc[gi] = 16 * w + 8 * gi + ti; tq[gi] = 128 * qq + tloc[gi]; rowq[gi] = (size_t)b * SEQ + tq[gi]; }
    h16* Kb = (h16*)g_lds; h16* Vb = (h16*)(g_lds + 2 * KV_TILE * 2);
    float* imp = (float*)(g_lds + 40960);
    unsigned* sel = (unsigned*)(g_lds + 40960 + 65536);
    unsigned* uni = sel + 512;
    unsigned char* lst = (unsigned char*)(uni + 8);
    h16x8 qf[2][2];
#pragma unroll
    for (int gi = 0; gi < 2; ++gi) {
        const h16x8 x1 = *(const h16x8*)(C.PROJ + rowq[gi] * PN + C_NQ + h * 64 + quad * 8), x2 = *(const h16x8*)(C.PROJ + rowq[gi] * PN + C_NQ + h * 64 + 32 + quad * 8);
        f32x4 tb[4];
#pragma unroll
        for (int i = 0; i < 4; ++i) tb[i] = *(const f32x4*)(C.ROPE + 2 * (tq[gi] * 32 + quad * 8) + 4 * i);
#pragma unroll
        for (int e = 0; e < 8; ++e) { const float cs = tb[e >> 1][2 * (e & 1)], sn = tb[e >> 1][2 * (e & 1) + 1]; const float a1 = (float)x1[e], a2 = (float)x2[e];
            qf[gi][0][e] = (h16)((a1 * cs - a2 * sn) * 0.18033688011112042f); qf[gi][1][e] = (h16)((a2 * cs + a1 * sn) * 0.18033688011112042f); } }
    const h16* kcb = C.KC + (size_t)(b * 2 + g) * 512 * 64; const h16* vcb = C.VC + (size_t)(b * 2 + g) * 512 * 64;
    const int ncmp = 4 * qbh + 3, ntile_c = (ncmp + 63) >> 6;
    auto src_cmp = [&](int i, const h16*& kp, const h16*& vp, size_t& stride) { kp = kcb + (size_t)i * 64 * 64; vp = vcb + (size_t)i * 64 * 64; stride = 64; };
    float m1[2] = {-INFINITY, -INFINITY}, l1[2] = {0.f, 0.f};
    kv_pipeline<false>(ntile_c, tid, Kb, Vb, src_cmp, [&](int tc, const h16* Ks, const h16*) {
        h16x8 kf[4][2];
#pragma unroll
        for (int mt = 0; mt < 4; ++mt)
#pragma unroll
            for (int ks = 0; ks < 2; ++ks) kf[mt][ks] = *(const h16x8*)(Ks + (mt * 16 + cc) * KV_LD + ks * 32 + quad * 8);
#pragma unroll
        for (int gi = 0; gi < 2; ++gi) { f32x4 s[4]; float tmax = -INFINITY;
#pragma unroll
            for (int mt = 0; mt < 4; ++mt) { f32x4 a = {0.f, 0.f, 0.f, 0.f}; a = mfma16(kf[mt][0], qf[gi][0], a); a = mfma16(kf[mt][1], qf[gi][1], a);
#pragma unroll
                for (int j = 0; j < 4; ++j) { const int n = tc * 64 + mt * 16 + quad * 4 + j; const float v = (16 * n + 31 <= tq[gi]) ? a[j] : -INFINITY; a[j] = v; tmax = fmaxf(tmax, v); }
                s[mt] = a; }
            tmax = fmaxf(tmax, __shfl_xor(tmax, 16)); tmax = fmaxf(tmax, __shfl_xor(tmax, 32));
            const float mnew = fmaxf(m1[gi], tmax), muse = (mnew == -INFINITY) ? 0.f : mnew;
            float ps = 0.f;
#pragma unroll
            for (int mt = 0; mt < 4; ++mt)
#pragma unroll
                for (int j = 0; j < 4; ++j) ps += ex2(s[mt][j] - muse);
            l1[gi] = l1[gi] * ex2(m1[gi] - muse) + ps; m1[gi] = mnew; } });
    float inv1[2], m1u[2];
#pragma unroll
    for (int gi = 0; gi < 2; ++gi) { float t = l1[gi]; t += __shfl_xor(t, 16); t += __shfl_xor(t, 32); inv1[gi] = (t > 0.f) ? 1.f / t : 0.f; m1u[gi] = (m1[gi] == -INFINITY) ? 0.f : m1[gi]; }
    f32x4 Oc[2][4];
#pragma unroll
    for (int gi = 0; gi < 2; ++gi)
#pragma unroll
        for (int md = 0; md < 4; ++md) Oc[gi][md] = (f32x4){0.f, 0.f, 0.f, 0.f};
    float carry_q3[2] = {0.f, 0.f};
    kv_pipeline<true>(ntile_c, tid, Kb, Vb, src_cmp, [&](int tc, const h16* Ks, const h16* Vs) {
        h16x8 kf[4][2]; h16x8 pf[2][2];
#pragma unroll
        for (int mt = 0; mt < 4; ++mt)
#pragma unroll
            for (int ks = 0; ks < 2; ++ks) kf[mt][ks] = *(const h16x8*)(Ks + (mt * 16 + cc) * KV_LD + ks * 32 + quad * 8);
#pragma unroll
        for (int gi = 0; gi < 2; ++gi) { f32x4 s[4];
#pragma unroll
            for (int mt = 0; mt < 4; ++mt) { f32x4 a = {0.f, 0.f, 0.f, 0.f}; a = mfma16(kf[mt][0], qf[gi][0], a); a = mfma16(kf[mt][1], qf[gi][1], a);
#pragma unroll
                for (int j = 0; j < 4; ++j) { const int n = tc * 64 + mt * 16 + quad * 4 + j; a[j] = (16 * n + 31 <= tq[gi]) ? ex2(a[j] - m1u[gi]) * inv1[gi] : 0.f; }
                s[mt] = a;
                const float s4 = (a[0] + a[1]) + (a[2] + a[3]); const float p3 = a[3];
                const float fromprev = __shfl(p3, (lane + 48) & 63);
                const float fromq3 = __shfl(p3, cc + 48);
                float val = s4 + ((quad == 0) ? carry_q3[gi] : fromprev);
                carry_q3[gi] = fromq3;
                val += __shfl_xor(val, 8);
                if (r == 0) imp[tloc[gi] * 128 + tc * 16 + mt * 4 + quad] = val; }
#pragma unroll
            for (int k2 = 0; k2 < 2; ++k2) pf[gi][k2] = (h16x8){(h16)s[2 * k2][0], (h16)s[2 * k2][1], (h16)s[2 * k2][2], (h16)s[2 * k2][3], (h16)s[2 * k2 + 1][0], (h16)s[2 * k2 + 1][1], (h16)s[2 * k2 + 1][2], (h16)s[2 * k2 + 1][3]}; }
#pragma unroll
        for (int md = 0; md < 4; ++md)
#pragma unroll
            for (int k2 = 0; k2 < 2; ++k2) { const h16* vp = Vs + (32 * k2 + 4 * quad + (cc >> 2)) * KV_LD + md * 16 + 4 * (cc & 3);
                const h16x8 vf = cat44(tr_read(vp), tr_read(vp + 16 * KV_LD));
                Oc[0][md] = mfma16(vf, pf[0][k2], Oc[0][md]); Oc[1][md] = mfma16(vf, pf[1][k2], Oc[1][md]); } });
    if (qbw < 16) {
        if (lane < 16) { const unsigned mlo = (2u << qbw) - 1u; const int row = 16 * w + lane; sel[row * 4 + 0] = mlo; sel[row * 4 + 1] = 0u; sel[row * 4 + 2] = 0u; sel[row * 4 + 3] = 0u; }
    } else {
        const int jhi = qbw - 2;
        const unsigned long long lt = __lanemask_lt();
        for (int t16 = 0; t16 < 16; ++t16) { const int row = 16 * w + t16; const float* ir = imp + row * 128;
            const int j1 = lane, j2 = lane + 64; const bool ok1 = (j1 >= 1 && j1 <= jhi), ok2 = (j2 <= jhi);
            const unsigned u1 = ok1 ? __float_as_uint(ir[j1]) + 1u : 0u, u2 = ok2 ? __float_as_uint(ir[j2]) + 1u : 0u;
            unsigned prefix = 0u;
            for (int bit = 30; bit >= 0; --bit) { const unsigned test = prefix | (1u << bit);
                const int cnt = __popcll(__ballot(u1 >= test)) + __popcll(__ballot(u2 >= test)); if (cnt >= 13) prefix = test; }
            const bool gt1 = u1 > prefix, gt2 = u2 > prefix, eq1 = u1 == prefix, eq2 = u2 == prefix;
            const unsigned long long bg1 = __ballot(gt1), bg2 = __ballot(gt2), be1 = __ballot(eq1), be2 = __ballot(eq2);
            const int need = 13 - __popcll(bg1) - __popcll(bg2);
            const bool s1 = gt1 || (eq1 && __popcll(be1 & lt) < need), s2 = gt2 || (eq2 && (__popcll(be1) + __popcll(be2 & lt)) < need);
            unsigned long long blo = __ballot(s1) | 1ull, bhi = __ballot(s2);
            { const int f0 = qbw - 1, f1 = qbw; if (f0 < 64) blo |= 1ull << f0; else bhi |= 1ull << (f0 - 64); if (f1 < 64) blo |= 1ull << f1; else bhi |= 1ull << (f1 - 64); }
            if (lane == 0) { sel[row * 4 + 0] = (unsigned)blo; sel[row * 4 + 1] = (unsigned)(blo >> 32); sel[row * 4 + 2] = (unsigned)bhi; sel[row * 4 + 3] = (unsigned)(bhi >> 32); } }
    }
    __syncthreads();
    if (w == 0) {
        unsigned o0 = sel[lane * 4 + 0] | sel[(lane + 64) * 4 + 0], o1 = sel[lane * 4 + 1] | sel[(lane + 64) * 4 + 1], o2 = sel[lane * 4 + 2] | sel[(lane + 64) * 4 + 2], o3 = sel[lane * 4 + 3] | sel[(lane + 64) * 4 + 3];
#pragma unroll
        for (int sft = 1; sft < 64; sft <<= 1) { o0 |= __shfl_xor(o0, sft); o1 |= __shfl_xor(o1, sft); o2 |= __shfl_xor(o2, sft); o3 |= __shfl_xor(o3, sft); }
        const unsigned long long mlo = ((unsigned long long)o1 << 32) | o0, mhi = ((unsigned long long)o3 << 32) | o2;
        const unsigned long long lt = __lanemask_lt(); const int nlo = __popcll(mlo);
        if ((mlo >> lane) & 1ull) lst[__popcll(mlo & lt)] = (unsigned char)lane;
        if ((mhi >> lane) & 1ull) lst[nlo + __popcll(mhi & lt)] = (unsigned char)(64 + lane);
        if (lane == 0) uni[4] = (unsigned)(nlo + __popcll(mhi));
    }
    __syncthreads();
    { f32x4* park = (f32x4*)imp;
#pragma unroll
        for (int gi = 0; gi < 2; ++gi)
#pragma unroll
            for (int md = 0; md < 4; ++md) park[(gi * 4 + md) * 512 + tid] = Oc[gi][md]; }
    unsigned long long selLo[2], selHi[2];
#pragma unroll
    for (int gi = 0; gi < 2; ++gi) { selLo[gi] = ((unsigned long long)sel[tloc[gi] * 4 + 1] << 32) | sel[tloc[gi] * 4 + 0]; selHi[gi] = ((unsigned long long)sel[tloc[gi] * 4 + 3] << 32) | sel[tloc[gi] * 4 + 2]; }
    const int nlist = (int)uni[4];
    FlashState fs[2];
#pragma unroll
    for (int gi = 0; gi < 2; ++gi) { fs[gi].mref = 0.f; fs[gi].l = 0.f; fs[gi].started = false;
#pragma unroll
        for (int md = 0; md < 4; ++md) fs[gi].O[md] = (f32x4){0.f, 0.f, 0.f, 0.f}; }
    const h16* kslc = C.PROJ + (size_t)b * SEQ * PN + C_KSLC + g * 64; const h16* vslc = C.PROJ + (size_t)b * SEQ * PN + C_VSLC + g * 64;
    kv_pipeline<true>(nlist, tid, Kb, Vb,
        [&](int i, const h16*& kp, const h16*& vp, size_t& stride) { const int j = lst[i]; kp = kslc + (size_t)j * 64 * PN; vp = vslc + (size_t)j * 64 * PN; stride = PN; },
        [&](int i, const h16* Ks, const h16* Vs) { const int j = lst[i]; bool sb[2];
#pragma unroll
            for (int gi = 0; gi < 2; ++gi) { const unsigned long long sw = (j < 64) ? selLo[gi] : selHi[gi]; sb[gi] = ((sw >> (j & 63)) & 1ull) != 0ull; }
            if (j >= 2 * qq) flash_tile2<0, true>(fs, Ks, Vs, qf, j * 64, tq, sb, cc, quad); else flash_tile2<0, false>(fs, Ks, Vs, qf, j * 64, tq, sb, cc, quad); });
    f32x4 Os[2][4];
#pragma unroll
    for (int gi = 0; gi < 2; ++gi) { float ls = fs[gi].l; ls += __shfl_xor(ls, 16); ls += __shfl_xor(ls, 32); const float invs = (ls > 0.f) ? 1.f / ls : 0.f;
#pragma unroll
        for (int md = 0; md < 4; ++md) Os[gi][md] = fs[gi].O[md] * invs; }
#pragma unroll
    for (int gi = 0; gi < 2; ++gi) { fs[gi].mref = 0.f; fs[gi].l = 0.f; fs[gi].started = false;
#pragma unroll
        for (int md = 0; md < 4; ++md) fs[gi].O[md] = (f32x4){0.f, 0.f, 0.f, 0.f}; }
    const h16* kwin = C.PROJ + (size_t)b * SEQ * PN + C_KWIN + g * 64; const h16* vwin = C.PROJ + (size_t)b * SEQ * PN + C_VWIN + g * 64;
    const int jw0 = (2 * qq >= 8 ? 2 * qq - 8 : 0);
    kv_pipeline<true>(qbh - jw0 + 1, tid, Kb, Vb,
        [&](int i, const h16*& kp, const h16*& vp, size_t& stride) { const int j = jw0 + i; kp = kwin + (size_t)j * 64 * PN; vp = vwin + (size_t)j * 64 * PN; stride = PN; },
        [&](int i, const h16* Ks, const h16* Vs) { const int j = jw0 + i; const bool sbt[2] = {true, true};
            if (j >= 2 * qq || j <= 2 * qq - 7) flash_tile2<1, true>(fs, Ks, Vs, qf, j * 64, tq, sbt, cc, quad); else flash_tile2<1, false>(fs, Ks, Vs, qf, j * 64, tq, sbt, cc, quad); });
#pragma unroll
    for (int gi = 0; gi < 2; ++gi) {
        float lw = fs[gi].l; lw += __shfl_xor(lw, 16); lw += __shfl_xor(lw, 32); const float invw = (lw > 0.f) ? 1.f / lw : 0.f;
        const float* gp = C.PSM + rowq[gi] * PSM_W + 16 + h * 3;
        const float g0 = sigmoidf_(gp[0]), g1 = sigmoidf_(gp[1]), g2 = sigmoidf_(gp[2]) * invw;
        float ssq = 0.f; f32x4 o[4];
#pragma unroll
        for (int md = 0; md < 4; ++md) { o[md] = g0 * ((const f32x4*)imp)[(gi * 4 + md) * 512 + tid] + g1 * Os[gi][md] + g2 * fs[gi].O[md]; ssq += (o[md][0] * o[md][0] + o[md][1] * o[md][1]) + (o[md][2] * o[md][2] + o[md][3] * o[md][3]); }
        ssq += __shfl_xor(ssq, 16); ssq += __shfl_xor(ssq, 32);
        const float rs = 1.0f / sqrtf(ssq * (1.f / 64.f) + EPS);
        const float* nw = C.in[12] + l * 256 + h * 64;
#pragma unroll
        for (int md = 0; md < 4; ++md) { const int d = md * 16 + quad * 4; u32x2 wv; wv.x = pkb(o[md][0] * rs * nw[d], o[md][1] * rs * nw[d + 1]); wv.y = pkb(o[md][2] * rs * nw[d + 2], o[md][3] * rs * nw[d + 3]);
            *(u32x2*)(C.XN + rowq[gi] * 1024 + 256 + h * 64 + d) = wv; }
    }
}

__device__ __forceinline__ void phase_ssdnorm(const Ctx& C, int l) {
    TIDS
    const int gw = C.bid * 8 + wave, NGW = C.G * 8; const float* nw = C.in[18] + l * 512 + lane * 8;
    for (int m = gw; m < MTOK; m += NGW) { const int g = lane >> 5; const f32x4 q = *(const f32x4*)(C.SSQ + (size_t)m * 8 + g * 4);
        const float rs = 1.0f / sqrtf(((q.x + q.y) + (q.z + q.w)) * (1.f / 256.f) + EPS);
        h16* p = C.XN + (size_t)m * 1024 + 512 + lane * 8; const h16x8 v = *(const h16x8*)p;
        u32x4 o; o.x = pkh((float)v[0] * rs * nw[0], (float)v[1] * rs * nw[1]); o.y = pkh((float)v[2] * rs * nw[2], (float)v[3] * rs * nw[3]);
        o.z = pkh((float)v[4] * rs * nw[4], (float)v[5] * rs * nw[5]); o.w = pkh((float)v[6] * rs * nw[6], (float)v[7] * rs * nw[7]); *(u32x4*)p = o; }
}
__device__ __forceinline__ void phase_norm(const Ctx& C, const float* src, h16* dst) {
    TIDS
    const int gw = C.bid * 8 + wave, NGW = C.G * 8;
    for (int m = gw; m < MTOK; m += NGW) rms_row_to_h16(src + (size_t)m * DM, dst + (size_t)m * DM, lane);
}
__device__ __forceinline__ void phase_final(const Ctx& C) {
    TIDS
    const int gw = C.bid * 8 + wave, NGW = C.G * 8; const unsigned long long* ssq = C.RSS + (size_t)(2 * DEPTH - 1) * MTOK;
    f32x4 fw[4];
#pragma unroll
    for (int j = 0; j < 4; ++j) fw[j] = *((const f32x4*)C.in[23] + lane + 64 * j);
    for (int m0 = gw * 4; m0 < MTOK; m0 += NGW * 4) { u32x2 v[4][4]; float rs[4];
#pragma unroll
        for (int r = 0; r < 4; ++r) { rs[r] = (float)ssq[m0 + r] * RSS_INV; const u32x2* hr = (const u32x2*)(C.H16 + (size_t)(m0 + r) * DM) + lane;
#pragma unroll
            for (int j = 0; j < 4; ++j) v[r][j] = hr[64 * j]; }
#pragma unroll
        for (int r = 0; r < 4; ++r) { const float sc = 1.0f / sqrtf(rs[r] * (1.f / DM) + EPS); f32x4* xr = (f32x4*)(C.out + (size_t)(m0 + r) * DM) + lane;
#pragma unroll
            for (int j = 0; j < 4; ++j) xr[64 * j] = unpk_bf4(v[r][j]) * sc * fw[j]; } }
}

constexpr int N_PHASES_DECL = 0;
#ifndef PHM
#define PHM 0xffffffffu
#endif
#define EN(k) ((PHM >> (k)) & 1u)
#ifndef PROBE_PH
#define PROBE_PH -1
#define PROBE_REPS 1
#endif
#define REPN(ph) ((ph) == PROBE_PH ? PROBE_REPS : 1)
#ifndef TS_PROBE
#define TS_PROBE 0
#define TS_A 0
#define TS_B 1
#define TS_DIV 4.0f
#endif
#ifndef PROBE_BIT
#define PROBE_BIT -1
#endif
#define RB(k) for (int rb_ = 0; rb_ < ((k) == PROBE_BIT && l == 0 ? 2 : 1); ++rb_)
template <int ph> __device__ __forceinline__ void run_phase(const Params* kp, int rep, int wv) {
    Ctx C; make_ctx(C, kp, wv);
    LAS unsigned char* ldsl = (LAS unsigned char*)g_lds;
    if constexpr (ph == 0) { if (EN(0)) phase_prep(C); return; }
    if constexpr (ph == 1 + 8 * DEPTH) { if (EN(15)) phase_final(C); return; }
    constexpr int l = (ph - 1) / 8, s = (ph - 1) % 8;
    if (s == 0) { if (EN(1)) { pg8::Gemm g{(const pg8::bf16_t*)(l == 0 ? C.XN : C.H16), (const pg8::bf16_t*)(C.WIN + (size_t)l * PN * DM), MTOK, PN, DM}; pg8::StaticOrder S; S.init(MTOK, PN, C.G, C.bid);
        pg8::EpiProj E{C.PROJ, C.PSM, l == 0 ? (const unsigned long long*)nullptr : C.RSS + (size_t)(2 * (l - 1) + 1) * MTOK}; pg8::gemm_phase<pg8::EpiProj, true>(ldsl, g, S, E, C.wv); } }
    else if (s == 1) { if (EN(2)) phase_tok(C, l); }
    else if (s == 2) { RB(3) for (int u = C.bid; u < 256; u += C.G) nsa_compress_unit(C, l, u);
#if TS_PROBE
        if (l == 0 && blockIdx.x == 0) { __syncthreads(); if (C.wv == 0 && opaque_lane() == 0) ((volatile LAS unsigned long long*)((LAS unsigned char*)g_lds + LDS_MISC + 64))[27] = __builtin_amdgcn_s_memrealtime(); }
#endif
        RB(4) ssd_states_phase(C, l, C.bid, C.G);
#if TS_PROBE
        if (l == 0 && blockIdx.x == 0) { __syncthreads(); if (C.wv == 0 && opaque_lane() == 0) ((volatile LAS unsigned long long*)((LAS unsigned char*)g_lds + LDS_MISC + 64))[28] = __builtin_amdgcn_s_memrealtime(); }
#endif
        RB(5) for (int u = C.bid; u < 256; u += C.G) gla_block_unit<0>(C, l, u); }
    else if (s == 3) { if (EN(6) && rep == 0) phase_scans(C);
#if TS_PROBE
        if (l == 0 && blockIdx.x == 0) { __syncthreads(); if (C.wv == 0 && opaque_lane() == 0) ((volatile LAS unsigned long long*)((LAS unsigned char*)g_lds + LDS_MISC + 64))[30] = __builtin_amdgcn_s_memrealtime(); }
#endif
        if (EN(7)) for (int v = C.bid; v < 512; v += C.G) { const int bg = (v & 255) >> 5, sidx = v & 31, k = v >> 8;
            const int qq = (k == 0) ? sidx : 63 - sidx; nsa_attn_unit(C, l, bg >> 1, bg & 1, qq); } }
    else if (s == 4) { RB(8) ssd_y_phase(C, l, C.bid, C.G);
#if TS_PROBE
        if (l == 0 && blockIdx.x == 0) { __syncthreads(); if (C.wv == 0 && opaque_lane() == 0) ((volatile LAS unsigned long long*)((LAS unsigned char*)g_lds + LDS_MISC + 64))[29] = __builtin_amdgcn_s_memrealtime(); }
#endif
        RB(9) for (int u = C.bid; u < 256; u += C.G) gla_block_unit<1>(C, l, u); }
    else if (s == 5) { if (EN(11)) { pg8::Gemm g{(const pg8::bf16_t*)C.XN, (const pg8::bf16_t*)(C.WOUT + (size_t)l * DM * DM), MTOK, DM, DM}; pg8::StaticOrder S; S.init(MTOK, DM, C.G, C.bid);
        pg8::EpiRes E{l == 0 ? C.in[0] : (const float*)nullptr, C.H16, C.RSS + (size_t)(2 * l) * MTOK}; pg8::gemm_phase<pg8::EpiRes, true>(ldsl, g, S, E, C.wv); } }
    else if (s == 6) { if (EN(13)) { pg8::Gemm g{(const pg8::bf16_t*)C.H16, (const pg8::bf16_t*)(C.WUP + (size_t)l * DFF * DM), MTOK, DFF, DM}; pg8::StaticOrder S; S.init(MTOK, DFF, C.G, C.bid);
        pg8::EpiHid E{C.HID, C.RSS + (size_t)(2 * l) * MTOK}; pg8::gemm_phase<pg8::EpiHid, true>(ldsl, g, S, E, C.wv); } }
    else if (s == 7) { if (EN(14)) { pg8::Gemm g{(const pg8::bf16_t*)C.HID, (const pg8::bf16_t*)(C.WDN + (size_t)l * DM * DFF), MTOK, DM, DFF}; pg8::StaticOrder S; S.init(MTOK, DM, C.G, C.bid);
        pg8::EpiRes E{(const float*)nullptr, C.H16, C.RSS + (size_t)(2 * l + 1) * MTOK}; pg8::gemm_phase<pg8::EpiRes, true>(ldsl, g, S, E, C.wv); } }
}
constexpr int PH_PER_L = 8;
constexpr int N_PHASES = 1 + PH_PER_L * DEPTH + 1;
template <int PH> __device__ __forceinline__ void phase_seq(const Params* kp, int lo, int hi, cg::grid_group& grid, const XcdBarrier& bar, int wv) {
    if constexpr (PH < N_PHASES) {
        if (lo <= PH && PH < hi) {
            for (int rep = 0; rep < REPN(PH); ++rep) run_phase<PH>(kp, rep, wv);
            if (PH + 1 < hi) { if (MK_COOP && PH == 0) grid.sync(); else xcd_barrier(bar); }
#if TS_PROBE
            if (blockIdx.x == 0 && wv == 0 && opaque_lane() == 0) ((volatile LAS unsigned long long*)((LAS unsigned char*)g_lds + LDS_MISC + 64))[PH + 1] = __builtin_amdgcn_s_memrealtime();
#endif
        }
        phase_seq<PH + 1>(kp, lo, hi, grid, bar, wv);
    }
}
__global__ void __launch_bounds__(512, 2) fwd_kernel(Params P) {
    const Params* kp = &P;
    cg::grid_group grid = cg::this_grid();
    volatile LAS unsigned* st = (volatile LAS unsigned*)((LAS unsigned char*)g_lds + LDS_MISC);
    const int wv = __builtin_amdgcn_readfirstlane((int)threadIdx.x >> 6);
    if (threadIdx.x < 2) st[threadIdx.x] = 0u;
    __syncthreads();
    const XcdBarrier bar = xcd_barrier_post((unsigned*)P.ws, st, wv);
#if TS_PROBE
    if (blockIdx.x == 0 && wv == 0 && opaque_lane() == 0) ((volatile LAS unsigned long long*)((LAS unsigned char*)g_lds + LDS_MISC + 64))[0] = __builtin_amdgcn_s_memrealtime();
#endif
    phase_seq<0>(kp, P.ph_lo, P.ph_hi, grid, bar, wv);
#if TS_PROBE
    if (blockIdx.x == 0 && wv == 0 && opaque_lane() == 0) { volatile LAS unsigned long long* ts = (volatile LAS unsigned long long*)((LAS unsigned char*)g_lds + LDS_MISC + 64);
        const float us = (float)(ts[TS_B] - ts[TS_A]) * 0.01f; P.out[0] = us * (1.0f / TS_DIV); }
#endif
}

extern "C" void kernel_launch(void* const* d_in, const int* in_sizes, int n_in, void* d_out, int out_size, void* d_ws, size_t ws_size, hipStream_t stream) {
    static int grid = 0;
    if (grid == 0) {
        if (n_in != 24 || in_sizes[0] != MTOK * DM || out_size != MTOK * DM || ws_size < WS_END) { fprintf(stderr, "kernel_launch: unexpected shapes (n_in %d, ws %zu)\n", n_in, ws_size); grid = -1; return; }
        int dev = 0, cus = 0, per_cu = 0;
        hipGetDevice(&dev); hipDeviceGetAttribute(&cus, hipDeviceAttributeMultiprocessorCount, dev);
        hipFuncSetAttribute((const void*)fwd_kernel, hipFuncAttributeMaxDynamicSharedMemorySize, LDS_BYTES);
        hipOccupancyMaxActiveBlocksPerMultiprocessor(&per_cu, (const void*)fwd_kernel, 512, LDS_BYTES);
        (void)hipGetLastError();
        if (per_cu < 1) { fprintf(stderr, "kernel_launch: occupancy query says %d blocks/CU\n", per_cu); grid = -1; return; }
        grid = cus;
    }
    if (grid < 0) return;
    (void)hipMemsetAsync(d_ws, 0, 32768, stream);
    Params p{};
    for (int i = 0; i < 24; ++i) p.in[i] = (const float*)d_in[i];
    p.out = (float*)d_out; p.ws = (unsigned char*)d_ws;
#if MK_MULTI_LAUNCH
    for (int ph = 0; ph < N_PHASES; ++ph) { p.ph_lo = ph; p.ph_hi = ph + 1; hipLaunchKernelGGL(fwd_kernel, dim3(grid), dim3(512), LDS_BYTES, stream, p); }
#else
    p.ph_lo = 0; p.ph_hi = N_PHASES;
#if MK_COOP
    void* args[] = {&p};
    hipError_t e = hipLaunchCooperativeKernel((const void*)fwd_kernel, dim3(grid), dim3(512), args, LDS_BYTES, stream);
    if (e != hipSuccess) fprintf(stderr, "cooperative launch failed: %s (grid %d)\n", hipGetErrorString(e), grid);
#else
    hipLaunchKernelGGL(fwd_kernel, dim3(grid), dim3(512), LDS_BYTES, stream, p);
#endif
#endif
}
```

```cpp
#include <hip/hip_runtime.h>
#include <hip/hip_cooperative_groups.h>
#include <cstdio>
#include <cstdint>
namespace cg = cooperative_groups;

#ifndef MK_MULTI_LAUNCH
#define MK_MULTI_LAUNCH 0
#endif
#ifndef MK_COOP
#define MK_COOP 0
#endif

#define LAS __attribute__((address_space(3)))
typedef _Float16 h16;
typedef _Float16 h16x8 __attribute__((ext_vector_type(8)));
typedef _Float16 h16x4 __attribute__((ext_vector_type(4)));
typedef _Float16 h16x2 __attribute__((ext_vector_type(2)));
typedef float f32x4 __attribute__((ext_vector_type(4)));
typedef float f32x2 __attribute__((ext_vector_type(2)));
typedef unsigned u32x4 __attribute__((ext_vector_type(4)));
typedef unsigned u32x2 __attribute__((ext_vector_type(2)));

constexpr int BATCH = 4, SEQ = 8192, DM = 1024, MTOK = BATCH * SEQ, DEPTH = 2;
constexpr int DIN = 3364, PN = 3584, DFF = 4096;
constexpr float EPS = 1e-6f;
constexpr int C_GQ = 0, C_GK = 128, C_GV = 256, C_GR = 512, C_NQ = 768, C_NKV = 1024, C_SZ = 1792, C_SX = 2304, C_SM = 3328;
constexpr int C_KCMP = C_NKV, C_VCMP = C_NKV + 128, C_KSLC = C_NKV + 256, C_VSLC = C_NKV + 384, C_KWIN = C_NKV + 512, C_VWIN = C_NKV + 640;
constexpr int PSM_W = 64;

constexpr size_t MiB = 1u << 20;
constexpr size_t WS_WIN = 2 * MiB;
constexpr size_t WS_WOUT = 16 * MiB;
constexpr size_t WS_WUP = 20 * MiB;
constexpr size_t WS_WDN = 36 * MiB;
constexpr size_t WS_W1T = 52 * MiB;
constexpr size_t WS_W2T = 54 * MiB;
constexpr size_t WS_B1 = 16384;
constexpr size_t WS_ROPE = 55 * MiB;
constexpr size_t WS_XN = 60 * MiB;
constexpr size_t WS_PROJ = 124 * MiB;
constexpr size_t WS_HID = 124 * MiB;
constexpr size_t WS_XBCC = 348 * MiB;
constexpr size_t WS_SSDST = 444 * MiB;
constexpr size_t WS_GLAST = 476 * MiB;
constexpr size_t WS_PSM = 492 * MiB;
constexpr size_t WS_KC = 500 * MiB;
constexpr size_t WS_VC = 500 * MiB + 512 * 1024;
constexpr size_t WS_SSQ = 501 * MiB;
constexpr size_t WS_DTV = 502 * MiB;
constexpr size_t WS_ACS = 503 * MiB;
constexpr size_t WS_CD = 504 * MiB;
constexpr size_t WS_GLAG = 504 * MiB + 64 * 1024;
constexpr size_t WS_RSS = 505 * MiB;
constexpr size_t WS_B1P = 54 * MiB + 256 * 1024;
constexpr size_t WS_H16 = 380 * MiB;
constexpr size_t WS_END = 507 * MiB;

constexpr int LDS_BYTES = 147456;
constexpr int LDS_MISC = 131072;
extern __shared__ __attribute__((aligned(16))) unsigned char g_lds[];

struct Params { const float* in[24]; float* out; unsigned char* ws; int ph_lo, ph_hi; };

__constant__ float ROPE_INV[32] = {
 1.000000000e+00f, 7.498942614e-01f, 5.623413324e-01f, 4.216965139e-01f, 3.162277639e-01f, 2.371373773e-01f, 1.778279394e-01f, 1.333521307e-01f,
 1.000000015e-01f, 7.498941571e-02f, 5.623413250e-02f, 4.216965288e-02f, 3.162277490e-02f, 2.371373773e-02f, 1.778279431e-02f, 1.333521493e-02f,
 9.999999776e-03f, 7.498941850e-03f, 5.623413250e-03f, 4.216964822e-03f, 3.162277630e-03f, 2.371373586e-03f, 1.778279431e-03f, 1.333521446e-03f,
 1.000000047e-03f, 7.498942432e-04f, 5.623413017e-04f, 4.216965172e-04f, 3.162277571e-04f, 2.371373703e-04f, 1.778279402e-04f, 1.333521504e-04f };

__device__ __forceinline__ f32x4 mfma16(h16x8 a, h16x8 b, f32x4 c) { return __builtin_amdgcn_mfma_f32_16x16x32_f16(a, b, c, 0, 0, 0); }
__device__ __forceinline__ float wave_sum(float v) {
#pragma unroll
    for (int o = 1; o < 64; o <<= 1) v += __shfl_xor(v, o);
    return v;
}
__device__ __forceinline__ float ex2(float x) { return __builtin_amdgcn_exp2f(x); }
__device__ __forceinline__ float max3f(float a, float b, float c) { return __builtin_fmaxf(__builtin_fmaxf(a, b), c); }
__device__ __forceinline__ float sigmoidf_(float x) { return 1.f / (1.f + __expf(-x)); }
__device__ __forceinline__ float siluf_(float x) { return x / (1.f + __expf(-x)); }
__device__ __forceinline__ float softplusf_(float x) { return fmaxf(x, 0.f) + log1pf(__expf(-fabsf(x))); }
typedef __bf16 bf16x2_t __attribute__((ext_vector_type(2)));
__device__ __forceinline__ unsigned pkb(float lo, float hi) { f32x2 v = {lo, hi}; bf16x2_t b = __builtin_convertvector(v, bf16x2_t); return __builtin_bit_cast(unsigned, b); }
__device__ __forceinline__ f32x4 unpk_bf4(u32x2 w) { return (f32x4){__uint_as_float(w.x << 16), __uint_as_float(w.x & 0xffff0000u), __uint_as_float(w.y << 16), __uint_as_float(w.y & 0xffff0000u)}; }
__device__ __forceinline__ unsigned pkh(float lo, float hi) { h16x2 v = {(h16)lo, (h16)hi}; return __builtin_bit_cast(unsigned, v); }

__device__ __forceinline__ int opaque_lane() { int t = __builtin_amdgcn_mbcnt_hi(~0u, __builtin_amdgcn_mbcnt_lo(~0u, 0u)); asm volatile("" : "+v"(t)); return t; }
constexpr float RSS_SCALE = 1048576.f, RSS_INV = 1.f / 1048576.f;
namespace pg8 {
typedef unsigned short bf16_t;
typedef __bf16 bf16x8_t __attribute__((ext_vector_type(8)));
constexpr int BM = 256, BK = 64, HALF = 128, HTB = HALF * BK * 2, STAGE_BYTES = 8 * HTB, NXCD = 8, WGM = 8;
__host__ __device__ __forceinline__ int lds_byte(int r, int c) { const int st = (r >> 4) * 2 + (c >> 5), rr = r & 15, cc = c & 31, ob = rr * 64 + cc * 2; return st * 1024 + (ob ^ (((ob >> 9) & 1) << 5)); }
__host__ __device__ __forceinline__ void stage_rc(int b, int& R, int& C) { const int st = b / 1024, sb = b % 1024, swz = sb ^ (((sb >> 9) & 1) << 5); R = (st >> 1) * 16 + swz / 64; C = (st & 1) * 32 + (swz % 64) / 2; }
__host__ __device__ __forceinline__ int perm32(int rho) { const int n = rho >> 4, i = rho & 15; return 8 * (i >> 2) + 4 * n + (i & 3); }
struct Unit { int pm, pn; };
struct Gemm { const bf16_t* A; const bf16_t* Bt; int M, N, K; };
struct StaticOrder {
    int nM, nN, nwg, G, c;
    __device__ void init(int M, int N, int G_, int c_) { nM = M / BM; nN = N / BM; nwg = nM * nN; G = G_; c = c_; }
    __device__ bool next(int i, Unit& u) const {
        const long L = (long)i * G + c; if (L >= nwg) return false;
        int wgid = (int)L; { const int q = nwg / NXCD, r = nwg % NXCD, xcd = wgid % NXCD, off = wgid / NXCD; wgid = (xcd < r ? xcd * (q + 1) : r * (q + 1) + (xcd - r) * q) + off; }
        const int nig = WGM * nN, gid = wgid / nig, fm = gid * WGM, gsz = (nM - fm) < WGM ? (nM - fm) : WGM;
        u.pm = fm + ((wgid % nig) % gsz); u.pn = (wgid % nig) / gsz; return true;
    }
};
struct EpiProj {
    static constexpr bool PERM = true;
    h16* O; float* PSM; const unsigned long long* ssq;
    __device__ __forceinline__ void operator()(const f32x4 (&acc)[2][2][4][2], const Unit& u, int wr, int wc, int fr, int fq) const {
        const int row0 = u.pm * BM + wr * 64 + fr, col0 = u.pn * BM + wc * 32 + 8 * fq;
#pragma unroll
        for (int ai = 0; ai < 2; ++ai)
#pragma unroll
            for (int m = 0; m < 4; ++m) { const int row = row0 + ai * HALF + m * 16; const float rs = ssq ? 1.0f / sqrtf((float)ssq[row] * (RSS_INV / DM) + EPS) : 1.f;
#pragma unroll
                for (int bj = 0; bj < 2; ++bj) { const f32x4 v0 = acc[ai][bj][m][0] * rs, v1 = acc[ai][bj][m][1] * rs; const int c = col0 + bj * HALF;
                    u32x4 w; w.x = pkh(v0[0], v0[1]); w.y = pkh(v0[2], v0[3]); w.z = pkh(v1[0], v1[1]); w.w = pkh(v1[2], v1[3]);
                    *(u32x4*)(O + (size_t)row * PN + c) = w;
                    if (c >= C_SM && c < C_SM + PSM_W) { float* p = PSM + (size_t)row * PSM_W + (c - C_SM); *(f32x4*)p = v0; *(f32x4*)(p + 4) = v1; } } }
    }
};
struct EpiHid {
    static constexpr bool PERM = true;
    h16* O; const unsigned long long* ssq;
    __device__ __forceinline__ void operator()(const f32x4 (&acc)[2][2][4][2], const Unit& u, int wr, int wc, int fr, int fq) const {
        const int row0 = u.pm * BM + wr * 64 + fr, col0 = u.pn * BM + wc * 32 + 8 * fq;
#pragma unroll
        for (int ai = 0; ai < 2; ++ai)
#pragma unroll
            for (int m = 0; m < 4; ++m) { const int row = row0 + ai * HALF + m * 16; const float rs = 1.0f / sqrtf((float)ssq[row] * (RSS_INV / DM) + EPS);
#pragma unroll
                for (int bj = 0; bj < 2; ++bj) { f32x4 v0 = acc[ai][bj][m][0] * rs, v1 = acc[ai][bj][m][1] * rs;
#pragma unroll
                    for (int e = 0; e < 4; ++e) { float a = fmaxf(v0[e], 0.f), b = fmaxf(v1[e], 0.f); v0[e] = a * a; v1[e] = b * b; }
                    u32x4 w; w.x = pkb(v0[0], v0[1]); w.y = pkb(v0[2], v0[3]); w.z = pkb(v1[0], v1[1]); w.w = pkb(v1[2], v1[3]);
                    *(u32x4*)(O + (size_t)row * DFF + col0 + bj * HALF) = w; } }
    }
};
struct EpiRes {
    static constexpr bool PERM = false;
    const float* base32; h16* hs; unsigned long long* ssq;
    __device__ __forceinline__ void operator()(const f32x4 (&acc)[2][2][4][2], const Unit& u, int wr, int wc, int fr, int fq) const {
        const int col0 = u.pn * BM + wc * 32 + 4 * fq;
#pragma unroll
        for (int ai = 0; ai < 2; ++ai)
#pragma unroll
            for (int m = 0; m < 4; ++m) { const int row = u.pm * BM + ai * HALF + wr * 64 + m * 16 + fr; const size_t off = (size_t)row * DM + col0; float sq = 0.f;
#pragma unroll
                for (int bj = 0; bj < 2; ++bj)
#pragma unroll
                    for (int n = 0; n < 2; ++n) { f32x4 bs;
                        if (base32) bs = *(const f32x4*)(base32 + off + bj * HALF + n * 16);
                        else bs = unpk_bf4(*(const u32x2*)(hs + off + bj * HALF + n * 16));
                        const f32x4 hv = bs + acc[ai][bj][m][n];
                        u32x2 w4; w4.x = pkb(hv[0], hv[1]); w4.y = pkb(hv[2], hv[3]); *(u32x2*)(hs + off + bj * HALF + n * 16) = w4;
                        const f32x4 hr4 = unpk_bf4(w4); const float r0 = hr4[0], r1 = hr4[1], r2 = hr4[2], r3 = hr4[3];
                        sq += (r0 * r0 + r1 * r1) + (r2 * r2 + r3 * r3); }
                sq += __shfl_xor(sq, 16); sq += __shfl_xor(sq, 32);
                if (fq == 0) atomicAdd(ssq + row, (unsigned long long)(sq * RSS_SCALE + 0.5f)); }
    }
};

template <class Epi, bool BF = false>
__device__ __forceinline__ void gemm_phase(LAS unsigned char* lds, const Gemm g, const StaticOrder& S, const Epi& E, int wid) {
    const int lane = opaque_lane(), tid = wid * 64 + lane, wr = wid >> 2, wc = wid & 3, fr = lane & 15, fq = lane >> 4;
    const int K = g.K, nt = K / BK;
    unsigned voffA[2], voffB[2];
#pragma unroll
    for (int i = 0; i < 2; ++i) { int R, C; stage_rc(tid * 16 + i * 8192, R, C); const int Rb = Epi::PERM ? ((R & ~31) + perm32(R & 31)) : R;
        voffA[i] = (unsigned)(R * K + C) * 2u; voffB[i] = (unsigned)(Rb * K + C) * 2u; }
    const size_t kstep = (size_t)(BK * 2);
    const size_t hstep = (size_t)HALF * K * 2;
    const size_t tstep = 2 * hstep;
    const unsigned ldsw = (unsigned)wid * 1024u;
    const int aoff = lds_byte(wr * 64 + fr, fq * 8), boff = lds_byte(wc * 32 + fr, fq * 8);
#define PG8_SA(b, h) (((b) * 2 + (h)) * HTB)
#define PG8_SB(b, h) ((4 + (b) * 2 + (h)) * HTB)
#define PG8_STAGE(bufoff, gbase, voff) do { _Pragma("unroll") for (int _i = 0; _i < 2; ++_i) \
        __builtin_amdgcn_global_load_lds((const unsigned*)((const char*)(gbase) + (voff)[_i]), (LAS unsigned*)(lds + (bufoff) + ldsw + _i * 8192), 16, 0, 0); } while (0)
#define PG8_LDA(dst, b, h) do { _Pragma("unroll") for (int m = 0; m < 4; ++m) _Pragma("unroll") for (int k = 0; k < 2; ++k) dst[m][k] = *(const LAS h16x8*)(lds + PG8_SA(b, h) + aoff + m * 2048 + k * 1024); } while (0)
#define PG8_LDB(dst, b, h) do { _Pragma("unroll") for (int n = 0; n < 2; ++n) _Pragma("unroll") for (int k = 0; k < 2; ++k) dst[n][k] = *(const LAS h16x8*)(lds + PG8_SB(b, h) + boff + n * 2048 + k * 1024); } while (0)
#define PG8_MMA(ai, bj, At, Bt) do { __builtin_amdgcn_s_setprio(1); _Pragma("unroll") for (int m = 0; m < 4; ++m) _Pragma("unroll") for (int n = 0; n < 2; ++n) _Pragma("unroll") for (int k = 0; k < 2; ++k) \
        acc[ai][bj][m][n] = BF ? __builtin_amdgcn_mfma_f32_16x16x32_bf16(__builtin_bit_cast(bf16x8_t, Bt[n][k]), __builtin_bit_cast(bf16x8_t, At[m][k]), acc[ai][bj][m][n], 0, 0, 0) : __builtin_amdgcn_mfma_f32_16x16x32_f16(Bt[n][k], At[m][k], acc[ai][bj][m][n], 0, 0, 0); __builtin_amdgcn_s_setprio(0); } while (0)
#define PG8_WAIT_V(n) asm volatile("s_waitcnt vmcnt(" #n ")" ::: "memory")
#define PG8_WAIT_L(n) asm volatile("s_waitcnt lgkmcnt(" #n ")" ::: "memory")
#define PG8_BAR __builtin_amdgcn_s_barrier()
#define PG8_SCHED __builtin_amdgcn_sched_barrier(0)
    Unit cur, nxt; int ui = 0;
    if (!S.next(0, cur)) return;
    f32x4 acc[2][2][4][2];
#pragma unroll
    for (int a = 0; a < 2; ++a)
#pragma unroll
        for (int b = 0; b < 2; ++b)
#pragma unroll
            for (int m = 0; m < 4; ++m)
#pragma unroll
                for (int n = 0; n < 2; ++n) acc[a][b][m][n] = (f32x4){0.f, 0.f, 0.f, 0.f};
    h16x8 At[4][2], B0[2][2], B1[2][2];
    const char* cA = (const char*)g.A + (size_t)cur.pm * tstep; const char* cB = (const char*)g.Bt + (size_t)cur.pn * tstep;
    PG8_STAGE(PG8_SB(0, 0), cB, voffB); PG8_STAGE(PG8_SB(0, 1), cB + hstep, voffB); PG8_STAGE(PG8_SA(0, 0), cA, voffA); PG8_STAGE(PG8_SA(0, 1), cA + hstep, voffA);
    if (wr == 1) PG8_BAR;
    PG8_WAIT_V(2); PG8_BAR;
    PG8_STAGE(PG8_SB(1, 0), cB + kstep, voffB); PG8_STAGE(PG8_SA(1, 0), cA + kstep, voffA); PG8_STAGE(PG8_SB(1, 1), cB + hstep + kstep, voffB);
    PG8_WAIT_V(6); PG8_BAR;
    for (;;) {
        const bool has_next = S.next(ui + 1, nxt);
        const char* nA = has_next ? (const char*)g.A + (size_t)nxt.pm * tstep : cA; const char* nB = has_next ? (const char*)g.Bt + (size_t)nxt.pn * tstep : cB;
        for (int t = 0; t < nt; t += 2) {
            const bool last = (t == nt - 2);
            const char* a1 = cA + (size_t)(t + 1) * kstep;
            const char* a2 = last ? nA : cA + (size_t)(t + 2) * kstep; const char* b2 = last ? nB : cB + (size_t)(t + 2) * kstep;
            const char* a3 = a2 + kstep; const char* b3 = b2 + kstep;
            PG8_LDB(B0, 0, 0); PG8_LDB(B1, 0, 1); PG8_SCHED; PG8_LDA(At, 0, 0); PG8_STAGE(PG8_SA(1, 1), a1 + hstep, voffA);
            PG8_WAIT_V(8); PG8_WAIT_L(0); PG8_BAR; PG8_MMA(0, 0, At, B0); PG8_MMA(0, 1, At, B1); PG8_BAR; PG8_SCHED;
            PG8_LDA(At, 0, 1); PG8_STAGE(PG8_SB(0, 0), b2, voffB); PG8_STAGE(PG8_SB(0, 1), b2 + hstep, voffB); PG8_STAGE(PG8_SA(0, 0), a2, voffA);
            PG8_WAIT_V(8); PG8_WAIT_L(0); PG8_BAR; PG8_MMA(1, 0, At, B0); PG8_MMA(1, 1, At, B1); PG8_BAR; PG8_SCHED;
            PG8_LDB(B0, 1, 0); PG8_LDB(B1, 1, 1); PG8_SCHED; PG8_LDA(At, 1, 0); PG8_STAGE(PG8_SA(0, 1), a2 + hstep, voffA);
            PG8_WAIT_V(8); PG8_WAIT_L(0); PG8_BAR; PG8_MMA(0, 0, At, B0); PG8_MMA(0, 1, At, B1); PG8_BAR; PG8_SCHED;
            PG8_LDA(At, 1, 1); PG8_STAGE(PG8_SB(1, 0), b3, voffB); PG8_STAGE(PG8_SB(1, 1), b3 + hstep, voffB); PG8_STAGE(PG8_SA(1, 0), a3, voffA);
            PG8_WAIT_V(8); PG8_WAIT_L(0); PG8_BAR; PG8_MMA(1, 0, At, B0); PG8_MMA(1, 1, At, B1); PG8_BAR; PG8_SCHED;
        }
        if (wr == 0) PG8_BAR;
        E(acc, cur, wr, wc, fr, fq);
        if (!has_next) break;
#pragma unroll
        for (int a = 0; a < 2; ++a)
#pragma unroll
            for (int b = 0; b < 2; ++b)
#pragma unroll
                for (int m = 0; m < 4; ++m)
#pragma unroll
                    for (int n = 0; n < 2; ++n) acc[a][b][m][n] = (f32x4){0.f, 0.f, 0.f, 0.f};
        cur = nxt; cA = nA; cB = nB; ++ui;
        if (wr == 1) PG8_BAR;
    }
    PG8_WAIT_V(0);
    PG8_BAR;
#undef PG8_SA
#undef PG8_SB
#undef PG8_STAGE
#undef PG8_LDA
#undef PG8_LDB
#undef PG8_MMA
#undef PG8_WAIT_V
#undef PG8_WAIT_L
#undef PG8_BAR
#undef PG8_SCHED
}
}


#define XB_TMO      128
#define XB_XCNT(j)  (256  + 64 * (j))
#define XB_XSUB(j)  (1280 + 64 * (j))
#define XB_XGEN(j)  (2304 + 64 * (j))
#define XB_TOP      3328
#define XB_TOPGEN   3392
#define XCD_BAR_WORDS 3456
#define XB_SPIN_CAP (1u << 18)
__device__ __forceinline__ unsigned xb_ld(unsigned* p)              { return __hip_atomic_load(p, __ATOMIC_RELAXED, __HIP_MEMORY_SCOPE_AGENT); }
__device__ __forceinline__ unsigned xb_add(unsigned* p, unsigned v) { return __hip_atomic_fetch_add(p, v, __ATOMIC_RELAXED, __HIP_MEMORY_SCOPE_AGENT); }
__device__ __forceinline__ unsigned xb_xcc_id() { return (unsigned)__builtin_amdgcn_s_getreg((3 << 11) | 20) & 0xFu; }
#define XB_SPIN(cond, bar) do { unsigned _sp = 0; while (cond) { __builtin_amdgcn_s_sleep(1); \
    if ((++_sp & 255u) == 0u) { if (xb_ld(&(bar)[XB_TMO])) break; if (_sp > XB_SPIN_CAP) { atomicAdd(&(bar)[XB_TMO], 1u); break; } } } } while (0)
struct XcdBarrier { unsigned* bar; unsigned x; volatile LAS unsigned* st; int wv; };
__device__ __forceinline__ XcdBarrier xcd_barrier_post(unsigned* bar, volatile LAS unsigned* st, int wv) {
    XcdBarrier b; b.bar = bar; b.x = xb_xcc_id(); b.st = st; b.wv = wv;
    if (wv == 0 && opaque_lane() == 0) (void)xb_add(&bar[XB_XCNT(b.x)], 1u);
    return b;
}
__device__ __forceinline__ void xcd_barrier_complete(unsigned* bar, unsigned x, unsigned& nloc, unsigned& nx) {
    const unsigned G = gridDim.x * gridDim.y * gridDim.z;
    unsigned sum, cnt, mine, sp = 0u;
    for (;;) {
        sum = 0u; cnt = 0u; mine = 0u;
#pragma unroll
        for (unsigned j = 0; j < 16; ++j) { const unsigned c = xb_ld(&bar[XB_XCNT(j)]); sum += c; cnt += (c > 0u) ? 1u : 0u; mine = (j == x) ? c : mine; }
        if (sum == G) break;
        __builtin_amdgcn_s_sleep(1);
        if ((++sp & 255u) == 0u) { if (xb_ld(&bar[XB_TMO])) break; if (sp > XB_SPIN_CAP) { atomicAdd(&bar[XB_TMO], 1u); break; } }
    }
    nloc = mine > 0u ? mine : 1u; nx = cnt > 0u ? cnt : 1u;
}
__device__ __forceinline__ void xcd_barrier(const XcdBarrier& b) {
    asm volatile("s_waitcnt vmcnt(0)" ::: "memory");
    __syncthreads();
    if (b.wv == 0 && opaque_lane() == 0) {
        unsigned* bar = b.bar;
        __builtin_amdgcn_s_waitcnt(0);
        unsigned nloc = b.st[0], nx = b.st[1];
        if (nloc == 0u) { xcd_barrier_complete(bar, b.x, nloc, nx); b.st[0] = nloc; b.st[1] = nx; }
        const unsigned old = xb_add(&bar[XB_XSUB(b.x)], 1u);
        const unsigned gen = old / nloc;
        if (old + 1u == (gen + 1u) * nloc) {
            __builtin_amdgcn_fence(__ATOMIC_RELEASE, "agent");
            asm volatile("s_waitcnt vmcnt(0)" ::: "memory");
            const unsigned og = xb_add(&bar[XB_TOP], 1u);
            const unsigned tg = og / nx;
            if (og + 1u == (tg + 1u) * nx) xb_add(&bar[XB_TOPGEN], 1u);
            else XB_SPIN(xb_ld(&bar[XB_TOPGEN]) == tg, bar);
            __builtin_amdgcn_fence(__ATOMIC_ACQUIRE, "agent");
            xb_add(&bar[XB_XGEN(b.x)], 1u);
            asm volatile("s_waitcnt vmcnt(0)" ::: "memory");
        } else {
            XB_SPIN(xb_ld(&bar[XB_XGEN(b.x)]) == gen, bar);
            __builtin_amdgcn_fence(__ATOMIC_ACQUIRE, "agent");
            asm volatile("s_waitcnt vmcnt(0)" ::: "memory");
        }
    }
    __syncthreads();
}

#define TIDS const int lane = opaque_lane(); const int wave = C.wv; const int tid = wave * 64 + lane; (void)tid;
struct Ctx {
    const float* in[24]; float* out; unsigned char* ws;
    int G, bid, wv;
    h16 *WIN, *WOUT, *WUP, *WDN, *W1T, *W2T, *XN, *PROJ, *HID, *XBCC, *KC, *VC;
    h16* SSDST; unsigned long long* RSS; float *B1P, *B1, *ROPE, *GLAST, *PSM, *SSQ, *DTV, *ACS, *CD, *GLAG; h16* H16;
};
__device__ __forceinline__ void make_ctx(Ctx& C, const Params* kp, int wv) {
    C.wv = wv;
#pragma unroll
    for (int i = 0; i < 24; ++i) C.in[i] = kp->in[i];
    C.out = kp->out; unsigned char* ws = kp->ws; C.ws = ws; C.G = gridDim.x; C.bid = blockIdx.x;
    C.WIN = (h16*)(ws + WS_WIN); C.WOUT = (h16*)(ws + WS_WOUT); C.WUP = (h16*)(ws + WS_WUP); C.WDN = (h16*)(ws + WS_WDN); C.W1T = (h16*)(ws + WS_W1T); C.W2T = (h16*)(ws + WS_W2T);
    C.XN = (h16*)(ws + WS_XN); C.PROJ = (h16*)(ws + WS_PROJ); C.HID = (h16*)(ws + WS_HID); C.XBCC = (h16*)kp->out;      C.KC = (h16*)(ws + WS_KC); C.VC = (h16*)(ws + WS_VC);
    C.B1 = (float*)(ws + WS_B1); C.B1P = (float*)(ws + WS_B1P); C.ROPE = (float*)(ws + WS_ROPE); C.SSDST = (h16*)(ws + WS_SSDST); C.RSS = (unsigned long long*)(ws + WS_RSS); C.H16 = (h16*)(ws + WS_H16); C.GLAST = (float*)(ws + WS_GLAST); C.PSM = (float*)(ws + WS_PSM);
    C.SSQ = (float*)(ws + WS_SSQ); C.DTV = (float*)(ws + WS_DTV); C.ACS = (float*)(ws + WS_ACS); C.CD = (float*)(ws + WS_CD); C.GLAG = (float*)(ws + WS_GLAG);
}

__device__ __forceinline__ int win_src_col(int n) {
    if (n < 512) return n;
    if (n < 768) return n - 512 + 528;
    if (n < 1024) return n - 768 + 784;
    if (n < 1792) return n - 1024 + 1040;
    if (n < 2304) return n - 1792 + 1820;
    if (n < 3328) return n - 2304 + 2332;
    const int r = n - 3328;
    if (r < 16) return 512 + r;
    if (r < 28) return 1808 + (r - 16);
    if (r < 36) return 3356 + (r - 28);
    return -1;
}
template <bool MAPW, bool OBF = false>
__device__ __forceinline__ void transpose_item(const float* W, int K, int Nsrc, int Ndst, h16* WT, const float* kscale, float* scr, int item, int lane) {
    const int nblk = Ndst / 32, kb = item / nblk, nb = item % nblk, k0 = 64 * kb, n0 = 32 * nb;
    const int nd = n0 + (lane & 31); const int sc = MAPW ? win_src_col(nd) : nd;
    float vv[32];
#pragma unroll
    for (int i = 0; i < 32; ++i) { const int kk = 2 * i + (lane >> 5); vv[i] = (sc >= 0) ? W[(size_t)(k0 + kk) * Nsrc + sc] : 0.f; }
#pragma unroll
    for (int i = 0; i < 32; ++i) { const int kk = 2 * i + (lane >> 5); scr[kk * 33 + (lane & 31)] = kscale ? vv[i] * kscale[k0 + kk] : vv[i]; }
    asm volatile("s_waitcnt lgkmcnt(0)" ::: "memory");
    const int c = lane & 7;
#pragma unroll
    for (int j = 0; j < 4; ++j) { const int n = (lane >> 3) + 8 * j; const float* s = scr + (8 * c) * 33 + n;
        u32x4 o; if (OBF) { o.x = pkb(s[0 * 33], s[1 * 33]); o.y = pkb(s[2 * 33], s[3 * 33]); o.z = pkb(s[4 * 33], s[5 * 33]); o.w = pkb(s[6 * 33], s[7 * 33]); } else { o.x = pkh(s[0 * 33], s[1 * 33]); o.y = pkh(s[2 * 33], s[3 * 33]); o.z = pkh(s[4 * 33], s[5 * 33]); o.w = pkh(s[6 * 33], s[7 * 33]); }
        *(u32x4*)(WT + (size_t)(n0 + n) * K + k0 + 8 * c) = o; }
    asm volatile("s_waitcnt lgkmcnt(0)" ::: "memory");
}
__device__ __forceinline__ void rms_row_to_h16(const float* xrow, h16* orow, int lane) {
    const f32x4* xr = (const f32x4*)xrow + lane; f32x4 v[4]; float s = 0.f;
#pragma unroll
    for (int j = 0; j < 4; ++j) { v[j] = xr[64 * j]; s += (v[j].x * v[j].x + v[j].y * v[j].y) + (v[j].z * v[j].z + v[j].w * v[j].w); }
    const float rs = 1.0f / sqrtf(wave_sum(s) * (1.f / DM) + EPS);
    u32x2* o8 = (u32x2*)orow + lane;
#pragma unroll
    for (int j = 0; j < 4; ++j) { u32x2 w; w.x = pkh(v[j].x * rs, v[j].y * rs); w.y = pkh(v[j].z * rs, v[j].w * rs); o8[64 * j] = w; }
}
__device__ __forceinline__ void sincos_acc(float angf, float& c, float& s) {
    const double x = (double)angf; const double n = __builtin_rint(x * 0.63661977236758134308);
    const double r = __builtin_fma(-n, 1.5707963267948966192, x) - n * 6.123233995736766036e-17;
    const double r2 = r * r;
    double sp = -7.6471637318198164759e-13; sp = sp * r2 + 1.6059043836821614599e-10; sp = sp * r2 - 2.5052108385441718775e-08; sp = sp * r2 + 2.7557319223985890653e-06;
    sp = sp * r2 - 1.9841269841269841270e-04; sp = sp * r2 + 8.3333333333333333333e-03; sp = sp * r2 - 1.6666666666666666667e-01; const double sn = r + r * r2 * sp;
    double cp = 4.7794773323873852974e-14; cp = cp * r2 - 1.1470745597729724714e-11; cp = cp * r2 + 2.0876756987868098979e-09; cp = cp * r2 - 2.7557319223985890653e-07;
    cp = cp * r2 + 2.4801587301587301587e-05; cp = cp * r2 - 1.3888888888888888889e-03; cp = cp * r2 + 4.1666666666666666667e-02; cp = cp * r2 - 0.5; const double cs = 1.0 + r2 * cp;
    const int q = ((int)n) & 3;
    const double so = (q == 0) ? sn : (q == 1) ? cs : (q == 2) ? -sn : -cs;
    const double co = (q == 0) ? cs : (q == 1) ? -sn : (q == 2) ? -cs : sn;
    c = (float)co; s = (float)so;
}
__device__ __forceinline__ void phase_prep(const Ctx& C) {
    TIDS
    float* scr = (float*)(g_lds) + wave * (64 * 33);
    const int gw = C.bid * 8 + wave, NGW = C.G * 8;
    constexpr int I_IN = 16 * (PN / 32), I_OUT = 16 * 32, I_UP = 16 * 128, I_DN = 64 * 32, I_W1 = 32 * 4, I_W2 = 2 * 2;
    constexpr int PER_L = I_IN + I_OUT + I_UP + I_DN + 2 * I_W1 + 2 * I_W2;
    for (int it = gw; it < DEPTH * PER_L; it += NGW) {
        const int l = it / PER_L; int r = it % PER_L;
        if (r < I_IN) { transpose_item<true, true>(C.in[2] + (size_t)l * DM * DIN, DM, DIN, PN, C.WIN + (size_t)l * PN * DM, C.in[1] + l * DM, scr, r, lane); continue; } r -= I_IN;
        if (r < I_OUT) { transpose_item<false, true>(C.in[19] + (size_t)l * DM * DM, DM, DM, DM, C.WOUT + (size_t)l * DM * DM, nullptr, scr, r, lane); continue; } r -= I_OUT;
        if (r < I_UP) { transpose_item<false, true>(C.in[21] + (size_t)l * DM * DFF, DM, DFF, DFF, C.WUP + (size_t)l * DFF * DM, C.in[20] + l * DM, scr, r, lane); continue; } r -= I_UP;
        if (r < I_DN) { transpose_item<false, true>(C.in[22] + (size_t)l * DFF * DM, DFF, DM, DM, C.WDN + (size_t)l * DM * DFF, nullptr, scr, r, lane); continue; } r -= I_DN;
        if (r < 2 * I_W1) { const int kv = r / I_W1; transpose_item<false>(C.in[kv ? 10 : 7] + (size_t)l * 2048 * 128, 2048, 128, 128, C.W1T + (size_t)(l * 2 + kv) * 128 * 2048, nullptr, scr, r % I_W1, lane); continue; } r -= 2 * I_W1;
        { const int kv = r / I_W2; transpose_item<false>(C.in[kv ? 11 : 8] + (size_t)l * 128 * 64, 128, 64, 64, C.W2T + (size_t)(l * 2 + kv) * 64 * 128, nullptr, scr, r % I_W2, lane); }
    }
    for (int it = gw; it < DEPTH * 2 * 32; it += NGW) {
        const int lk = it >> 5, fc = it & 31, l = lk >> 1, kv = lk & 1;
        const float* pos = C.in[kv ? 9 : 6] + (size_t)l * 2048 + fc * 64; const float* w1 = C.in[kv ? 10 : 7] + (size_t)l * 2048 * 128 + (size_t)fc * 64 * 128;
        float s0 = 0.f, s1 = 0.f;
#pragma unroll 16
        for (int f = 0; f < 64; ++f) { const float pv = pos[f]; s0 += pv * w1[f * 128 + lane]; s1 += pv * w1[f * 128 + 64 + lane]; }
        C.B1P[(size_t)it * 128 + lane] = s0; C.B1P[(size_t)it * 128 + 64 + lane] = s1;
    }
    for (int e = C.bid * 512 + tid; e < SEQ * 32; e += C.G * 512) {
        const int pos = e >> 5, i = e & 31; const float ang = (float)pos * ROPE_INV[i];
        float cs, sn; sincos_acc(ang, cs, sn); C.ROPE[2 * e] = cs; C.ROPE[2 * e + 1] = sn;
    }
    for (int e = C.bid * 512 + tid; e < 2 * DEPTH * MTOK; e += C.G * 512) C.RSS[e] = 0ull;
    for (int m0 = gw * 4; m0 < MTOK; m0 += NGW * 4) {
        f32x4 v[4][4]; float ss[4];
#pragma unroll
        for (int r = 0; r < 4; ++r) { const f32x4* xr = (const f32x4*)(C.in[0] + (size_t)(m0 + r) * DM) + lane;
#pragma unroll
            for (int j = 0; j < 4; ++j) v[r][j] = xr[64 * j]; }
#pragma unroll
        for (int r = 0; r < 4; ++r) { float sq = 0.f;
#pragma unroll
            for (int j = 0; j < 4; ++j) sq += (v[r][j].x * v[r][j].x + v[r][j].y * v[r][j].y) + (v[r][j].z * v[r][j].z + v[r][j].w * v[r][j].w);
            ss[r] = sq; }
#pragma unroll
        for (int o = 1; o < 64; o <<= 1) {
#pragma unroll
            for (int r = 0; r < 4; ++r) ss[r] += __shfl_xor(ss[r], o); }
#pragma unroll
        for (int r = 0; r < 4; ++r) { const float rs = 1.0f / sqrtf(ss[r] * (1.f / DM) + EPS); u32x2* o8 = (u32x2*)(C.XN + (size_t)(m0 + r) * DM) + lane;
#pragma unroll
            for (int j = 0; j < 4; ++j) { u32x2 w; w.x = pkb(v[r][j].x * rs, v[r][j].y * rs); w.y = pkb(v[r][j].z * rs, v[r][j].w * rs); o8[64 * j] = w; } }
    }
}

__device__ __forceinline__ void phase_tok(const Ctx& C, int l) {
    TIDS
    const int gw = C.bid * 8 + wave, NGW = C.G * 8;
    if (l == 0 && C.bid == 0) { float sb = 0.f; const float* pp = C.B1P + (size_t)(tid >> 7) * 32 * 128 + (tid & 127);
        for (int fc = 0; fc < 32; ++fc) sb += pp[fc * 128];
        C.B1[tid] = sb; }
    float* Wl = (float*)g_lds;
    { const float* cw = C.in[13] + (size_t)l * 4 * 1024; const float* cb = C.in[14] + (size_t)l * 1024;
        for (int e = tid; e < 5 * 256; e += 512) { const int r = e >> 8, c4 = e & 255; *(f32x4*)(Wl + r * 1024 + c4 * 4) = (r < 4) ? *(const f32x4*)(cw + r * 1024 + c4 * 4) : *(const f32x4*)(cb + c4 * 4); } }
    __syncthreads();
    const float* dtb = C.in[15] + l * 8;
    const int ch = lane * 16;
    const int rtk = lane >> 4, hd = (lane >> 2) & 3, c8 = (lane & 3) * 8;
    const int rbase = (hd < 2) ? (C_KSLC + hd * 64) : (C_KWIN + (hd - 2) * 64);
    const float dbias = dtb[lane & 7];
    for (int run = gw; run < MTOK / 16; run += NGW) {
        const int m0 = run * 16, t0 = m0 & (SEQ - 1);
        h16x8 hist[3][2];
#pragma unroll
        for (int i = 0; i < 3; ++i) { const int tt = t0 - 3 + i;
            if (tt >= 0) { const h16* src = C.PROJ + (size_t)(m0 - 3 + i) * PN + C_SX + ch; hist[i][0] = *(const h16x8*)src; hist[i][1] = *(const h16x8*)(src + 8); }
            else { hist[i][0] = (h16x8){}; hist[i][1] = (h16x8){}; } }
#pragma unroll 1
        for (int half = 0; half < 2; ++half) { const int mb = m0 + 8 * half, tb0 = t0 + 8 * half;
            h16x8 cr[8][2];
#pragma unroll
            for (int k = 0; k < 8; ++k) { const h16* src = C.PROJ + (size_t)(mb + k) * PN + C_SX + ch; cr[k][0] = *(const h16x8*)src; cr[k][1] = *(const h16x8*)(src + 8); }
            h16x8 x1[2], x2[2];
#pragma unroll
            for (int rb = 0; rb < 2; ++rb) { const int k = 4 * rb + rtk; const h16* prow = C.PROJ + (size_t)(mb + k) * PN;
                x1[rb] = *(const h16x8*)(prow + rbase + c8); x2[rb] = *(const h16x8*)(prow + rbase + 32 + c8); }
            const float dtr = C.PSM[(size_t)(mb + (lane >> 3)) * PSM_W + 28 + (lane & 7)];
            C.DTV[(size_t)(mb + (lane >> 3)) * 8 + (lane & 7)] = softplusf_(dtr + dbias);
#pragma unroll
            for (int rb = 0; rb < 2; ++rb) { const int k = 4 * rb + rtk; h16* prow = C.PROJ + (size_t)(mb + k) * PN; h16x8 y1, y2; f32x4 tb[4];
#pragma unroll
                for (int i = 0; i < 4; ++i) tb[i] = *(const f32x4*)(C.ROPE + 2 * ((tb0 + k) * 32 + c8) + 4 * i);
#pragma unroll
                for (int e = 0; e < 8; ++e) { const float cs = tb[e >> 1][2 * (e & 1)], sn = tb[e >> 1][2 * (e & 1) + 1]; const float a1 = (float)x1[rb][e], a2 = (float)x2[rb][e];
                    y1[e] = (h16)(a1 * cs - a2 * sn); y2[e] = (h16)(a2 * cs + a1 * sn); }
                *(h16x8*)(prow + rbase + c8) = y1; *(h16x8*)(prow + rbase + 32 + c8) = y2; }
#pragma unroll
            for (int k = 0; k < 8; ++k) { float a[16];
#pragma unroll
                for (int q4 = 0; q4 < 4; ++q4) { const f32x4 bv = *(const f32x4*)(Wl + 4 * 1024 + ch + 4 * q4), w0 = *(const f32x4*)(Wl + ch + 4 * q4), w1 = *(const f32x4*)(Wl + 1024 + ch + 4 * q4),
                        w2 = *(const f32x4*)(Wl + 2048 + ch + 4 * q4), w3 = *(const f32x4*)(Wl + 3072 + ch + 4 * q4);
#pragma unroll
                    for (int e = 0; e < 4; ++e) { const int ee = 4 * q4 + e, hh = ee >> 3, ei = ee & 7;
                        a[ee] = bv[e] + w0[e] * (float)hist[0][hh][ei] + w1[e] * (float)hist[1][hh][ei] + w2[e] * (float)hist[2][hh][ei] + w3[e] * (float)cr[k][hh][ei]; } }
                hist[0][0] = hist[1][0]; hist[0][1] = hist[1][1]; hist[1][0] = hist[2][0]; hist[1][1] = hist[2][1]; hist[2][0] = cr[k][0]; hist[2][1] = cr[k][1];
                u32x4 o0, o1; o0.x = pkh(siluf_(a[0]), siluf_(a[1])); o0.y = pkh(siluf_(a[2]), siluf_(a[3])); o0.z = pkh(siluf_(a[4]), siluf_(a[5])); o0.w = pkh(siluf_(a[6]), siluf_(a[7]));
                o1.x = pkh(siluf_(a[8]), siluf_(a[9])); o1.y = pkh(siluf_(a[10]), siluf_(a[11])); o1.z = pkh(siluf_(a[12]), siluf_(a[13])); o1.w = pkh(siluf_(a[14]), siluf_(a[15]));
                h16* dst = C.XBCC + (size_t)(mb + k) * 1024 + ch; *(u32x4*)dst = o0; *(u32x4*)(dst + 8) = o1; }
        }
    }
    __syncthreads();
}

__device__ __forceinline__ float gelu_tanh(float x) { const float u = 0.7978845608028654f * (x + 0.044715f * x * x * x); const float e = __expf(2.f * u); const float th = 1.f - 2.f / (e + 1.f); return 0.5f * x * (1.f + th); }
__device__ __forceinline__ void nsa_compress_unit(const Ctx& C, int l, int u) {
    const int kv = u >> 7, b = (u >> 5) & 3, g = (u >> 4) & 1, mt2 = u & 15;
    TIDS
    const int w = wave, cc = lane & 15, quad = lane >> 4;
    h16* As = (h16*)g_lds;
    h16* Hs = (h16*)(g_lds + 2 * 272 * 72 * 2);
    const h16* W1T = C.W1T + (size_t)(l * 2 + kv) * 128 * 2048; const h16* W2T = C.W2T + (size_t)(l * 2 + kv) * 64 * 128; const float* B1 = C.B1 + (l * 2 + kv) * 128;
    const int col = (kv ? C_VCMP : C_KCMP) + g * 64;
    {
        h16x8 s1[5], s2[5]; f32x4 tb[5][4];
#pragma unroll
        for (int i = 0; i < 5; ++i) { const int pc = tid + 512 * i; if (pc < 2 * 272 * 4) { const int half = pc / (272 * 4), rem = pc % (272 * 4), t = rem >> 2, c4 = rem & 3;
                int tok = 256 * mt2 + 4096 * half + t; tok = tok < SEQ ? tok : SEQ - 1; const h16* src = C.PROJ + (size_t)(b * SEQ + tok) * PN + col + c4 * 8;
                s1[i] = *(const h16x8*)src; s2[i] = *(const h16x8*)(src + 32);
                if (kv == 0) {
#pragma unroll
                    for (int q4 = 0; q4 < 4; ++q4) tb[i][q4] = *(const f32x4*)(C.ROPE + 2 * (tok * 32 + c4 * 8) + 4 * q4); } } }
#pragma unroll
        for (int i = 0; i < 5; ++i) { const int pc = tid + 512 * i; if (pc < 2 * 272 * 4) { const int half = pc / (272 * 4), rem = pc % (272 * 4), t = rem >> 2, c4 = rem & 3;
                h16x8 y1 = s1[i], y2 = s2[i];
                if (kv == 0) {
#pragma unroll
                    for (int e = 0; e < 8; ++e) { const float cs = tb[i][e >> 1][2 * (e & 1)], sn = tb[i][e >> 1][2 * (e & 1) + 1]; const float a1 = (float)s1[i][e], a2 = (float)s2[i][e];
                        y1[e] = (h16)(a1 * cs - a2 * sn); y2[e] = (h16)(a2 * cs + a1 * sn); } }
                *(h16x8*)(As + (half * 272 + t) * 72 + c4 * 8) = y1; *(h16x8*)(As + (half * 272 + t) * 72 + 32 + c4 * 8) = y2; } } }
    __syncthreads();
    f32x4 acc0 = {0.f, 0.f, 0.f, 0.f}, acc1 = {0.f, 0.f, 0.f, 0.f};
    const h16* brow = W1T + (size_t)(w * 16 + cc) * 2048 + quad * 8;
    const h16* a0p = As + (16 * cc) * 72 + quad * 8; const h16* a1p = a0p + 272 * 72;
#pragma unroll 16
    for (int kk = 0; kk < 64; ++kk) {
        const h16x8 bb = *(const h16x8*)(brow + kk * 32);
        const h16x8 a0 = *(const h16x8*)(a0p + (kk >> 1) * 72 + (kk & 1) * 32);
        const h16x8 a1 = *(const h16x8*)(a1p + (kk >> 1) * 72 + (kk & 1) * 32);
        acc0 = mfma16(a0, bb, acc0); acc1 = mfma16(a1, bb, acc1);
    }
    { const float bias = B1[w * 16 + cc];
#pragma unroll
        for (int j = 0; j < 4; ++j) { Hs[(quad * 4 + j) * 136 + w * 16 + cc] = (h16)gelu_tanh(acc0[j] + bias); Hs[(16 + quad * 4 + j) * 136 + w * 16 + cc] = (h16)gelu_tanh(acc1[j] + bias); } }
    __syncthreads();
    { const int half = w >> 2, wn = w & 3;
        f32x4 o = {0.f, 0.f, 0.f, 0.f};
#pragma unroll
        for (int kk = 0; kk < 4; ++kk) { const h16x8 a = *(const h16x8*)(Hs + (half * 16 + cc) * 136 + kk * 32 + quad * 8); const h16x8 bb = *(const h16x8*)(W2T + (size_t)(wn * 16 + cc) * 128 + kk * 32 + quad * 8); o = mfma16(a, bb, o); }
        h16* dst = (kv ? C.VC : C.KC) + (size_t)((b * 2 + g) * 512 + (mt2 + 16 * half) * 16) * 64;
#pragma unroll
        for (int j = 0; j < 4; ++j) dst[(quad * 4 + j) * 64 + wn * 16 + cc] = (h16)o[j];
    }
    __syncthreads();
}

__device__ __forceinline__ h16x4 tr_read(const h16* p) { typedef short s16x4 __attribute__((ext_vector_type(4))); return __builtin_bit_cast(h16x4, __builtin_amdgcn_ds_read_tr16_b64_v4i16((LAS s16x4*)p)); }
__device__ __forceinline__ h16x8 cat44(h16x4 lo, h16x4 hi) { return (h16x8){lo[0], lo[1], lo[2], lo[3], hi[0], hi[1], hi[2], hi[3]}; }
struct SsdPre { float dt; h16x8 x[2]; h16x8 bq[4]; };
__device__ __forceinline__ void ssd_states_load(const Ctx& C, int u, int tid, SsdPre& P) {
    const int b = u >> 9, c = (u >> 3) & 63, h = u & 7, g = h >> 2; const size_t row0 = (size_t)b * SEQ + c * 128;
    P.dt = (tid < 128) ? C.DTV[(row0 + tid) * 8 + h] : 0.f;
#pragma unroll
    for (int i = 0; i < 2; ++i) { const int ch = tid + 512 * i, tok = ch >> 3, c8 = ch & 7; P.x[i] = *(const h16x8*)(C.XBCC + (row0 + tok) * 1024 + h * 64 + c8 * 8); }
#pragma unroll
    for (int i = 0; i < 4; ++i) { const int ch = tid + 512 * i, tok = ch >> 4, c16 = ch & 15; P.bq[i] = *(const h16x8*)(C.XBCC + (row0 + tok) * 1024 + 512 + g * 128 + c16 * 8); }
}
__device__ __forceinline__ void ssd_states_phase(const Ctx& C, int l, int ufirst, int ustep) {
    TIDS
    const int w = wave, cc = lane & 15, quad = lane >> 4;
    float* acs = (float*)g_lds; float* dtl = acs + 128; float* wl = acs + 256;
    h16* Xs = (h16*)(g_lds + 2048);
    h16* Bs = (h16*)(g_lds + 2048 + 18432);
    h16* Os_ = (h16*)(g_lds + 2048 + 18432 + 34816);
    int u = ufirst; SsdPre pre; if (u < 2048) ssd_states_load(C, u, tid, pre);
    while (u < 2048) {
        const int b = u >> 9, c = (u >> 3) & 63, h = u & 7; const size_t row0 = (size_t)b * SEQ + c * 128;
        const SsdPre cur = pre;
        const float A = -__expf(C.in[16][l * 8 + h]);
        if (tid < 128) dtl[tid] = cur.dt;
        __syncthreads();
        if (w == 0) {
            const float d0 = dtl[2 * lane], d1 = dtl[2 * lane + 1]; const float a0 = d0 * A, a1 = d1 * A, sm = a0 + a1; float incl = sm;
#pragma unroll
            for (int o = 1; o < 64; o <<= 1) { const float t = __shfl_up(incl, o); if (lane >= o) incl += t; }
            const float excl = incl - sm, tot = __shfl(incl, 63); const float c0 = excl + a0, c1 = incl;
            acs[2 * lane] = c0; acs[2 * lane + 1] = c1; wl[2 * lane] = __expf(tot - c0) * d0; wl[2 * lane + 1] = __expf(tot - c1) * d1;
            if (lane == 63) C.CD[(b * 64 + c) * 8 + h] = __expf(tot);
        }
        __syncthreads();
#pragma unroll
        for (int i = 0; i < 2; ++i) { const int ch = tid + 512 * i, tok = ch >> 3, c8 = ch & 7; *(h16x8*)(Xs + tok * 72 + c8 * 8) = cur.x[i]; }
#pragma unroll
        for (int i = 0; i < 4; ++i) { const int ch = tid + 512 * i, tok = ch >> 4, c16 = ch & 15; const float ww = wl[tok]; h16x8 o;
#pragma unroll
            for (int e = 0; e < 8; ++e) o[e] = (h16)((float)cur.bq[i][e] * ww);
            *(h16x8*)(Bs + tok * 136 + c16 * 8) = o; }
        if (tid < 128) C.ACS[(row0 + tid) * 8 + h] = acs[tid];
        const int un = u + ustep; if (un < 2048) ssd_states_load(C, un, tid, pre);
        __syncthreads();
        const int mi = w & 3;
        h16x8 xa[4];
#pragma unroll
        for (int kk = 0; kk < 4; ++kk) { const h16* xp = Xs + (kk * 32 + 8 * quad + (cc >> 2)) * 72 + mi * 16 + 4 * (cc & 3); xa[kk] = cat44(tr_read(xp), tr_read(xp + 4 * 72)); }
        h16* dst = C.SSDST + (size_t)((b * 64 + c) * 8 + h) * 8192;
#pragma unroll
        for (int q = 0; q < 4; ++q) { const int ni = (w >> 2) * 4 + q; f32x4 acc = {0.f, 0.f, 0.f, 0.f};
#pragma unroll
            for (int kk = 0; kk < 4; ++kk) { const h16* bp = Bs + (kk * 32 + 8 * quad + (cc >> 2)) * 136 + ni * 16 + 4 * (cc & 3); acc = mfma16(xa[kk], cat44(tr_read(bp), tr_read(bp + 4 * 136)), acc); }
#pragma unroll
            for (int j = 0; j < 4; ++j) Os_[(mi * 16 + quad * 4 + j) * 136 + ni * 16 + cc] = (h16)acc[j]; }
        __syncthreads();
#pragma unroll
        for (int i = 0; i < 2; ++i) { const int ch = tid + 512 * i, p = ch >> 4, c16 = ch & 15; *(h16x8*)(dst + p * 128 + c16 * 8) = *(const h16x8*)(Os_ + p * 136 + c16 * 8); }
        u = un;
    }
    __syncthreads();
}

struct SsdYPre { float acs, dt; h16x8 x[2], z[2], he[2]; };
struct SsdBC { h16x8 cq[4], bq[4]; };
__device__ __forceinline__ void ssd_y_load(const Ctx& C, int bc, int h, int tid, SsdYPre& P) {
    const int b = bc >> 6, c = bc & 63; const size_t row0 = (size_t)b * SEQ + c * 128;
    P.acs = (tid < 128) ? C.ACS[(row0 + tid) * 8 + h] : 0.f; P.dt = (tid < 128) ? C.DTV[(row0 + tid) * 8 + h] : 0.f;
#pragma unroll
    for (int i = 0; i < 2; ++i) { const int ch = tid + 512 * i, tok = ch >> 3, c8 = ch & 7; P.x[i] = *(const h16x8*)(C.XBCC + (row0 + tok) * 1024 + h * 64 + c8 * 8); P.z[i] = *(const h16x8*)(C.PROJ + (row0 + tok) * PN + C_SZ + h * 64 + c8 * 8); }
    const h16* src = C.SSDST + (size_t)((b * 64 + c) * 8 + h) * 8192;
#pragma unroll
    for (int i = 0; i < 2; ++i) P.he[i] = *(const h16x8*)(src + (tid + 512 * i) * 8);
}
__device__ __forceinline__ void ssd_bc_load(const Ctx& C, int bc, int g, int tid, SsdBC& P) {
    const int b = bc >> 6, c = bc & 63; const size_t row0 = (size_t)b * SEQ + c * 128;
#pragma unroll
    for (int i = 0; i < 4; ++i) { const int ch = tid + 512 * i, tok = ch >> 4, c16 = ch & 15; const h16* src = C.XBCC + (row0 + tok) * 1024 + 512 + g * 128 + c16 * 8; P.bq[i] = *(const h16x8*)src; P.cq[i] = *(const h16x8*)(src + 256); }
}
__device__ __forceinline__ void ssd_y_phase(const Ctx& C, int l, int bcfirst, int bcstep) {
    TIDS
    const int w = wave, cc = lane & 15, quad = lane >> 4;
    float* acs = (float*)g_lds; float* dtl = acs + 128; float* rss = acs + 256;
    h16* Cm = (h16*)(g_lds + 2048);
    h16* Bm = (h16*)(g_lds + 2048 + 34816);
    h16* Xs = (h16*)(g_lds + 2048 + 2 * 34816);
    h16* HE = (h16*)(g_lds + 2048 + 2 * 34816 + 18432);
    h16* Zs = (h16*)(g_lds + 2048 + 2 * 34816 + 18432 + 17408);
    const float* nwp = C.in[18] + l * 512;
    for (int bc = bcfirst; bc < 256; bc += bcstep) {
        const int b = bc >> 6, c = bc & 63; const size_t row0 = (size_t)b * SEQ + c * 128;
        SsdYPre pre; ssd_y_load(C, bc, 0, tid, pre);
        h16x4 cbt[8];
#pragma unroll 1
        for (int h = 0; h < 8; ++h) { const int g = h >> 2;
            __syncthreads();
            if (tid < 128) { acs[tid] = pre.acs; dtl[tid] = pre.dt; if ((h & 3) == 0) rss[tid] = 0.f; }
            if ((h & 3) == 0) { SsdBC pbc; ssd_bc_load(C, bc, g, tid, pbc);
#pragma unroll
                for (int i = 0; i < 4; ++i) { const int ch = tid + 512 * i, tok = ch >> 4, c16 = ch & 15; *(h16x8*)(Bm + tok * 136 + c16 * 8) = pbc.bq[i]; *(h16x8*)(Cm + tok * 136 + c16 * 8) = pbc.cq[i]; } }
#pragma unroll
            for (int i = 0; i < 2; ++i) { const int ch = tid + 512 * i, tok = ch >> 3, c8 = ch & 7; *(h16x8*)(Xs + tok * 72 + c8 * 8) = pre.x[i]; *(h16x8*)(Zs + tok * 72 + c8 * 8) = pre.z[i]; }
#pragma unroll
            for (int i = 0; i < 2; ++i) { const int ch = tid + 512 * i, p = ch >> 4, c16 = ch & 15; *(h16x8*)(HE + p * 136 + c16 * 8) = pre.he[i]; }
            if (h < 7) ssd_y_load(C, bc, h + 1, tid, pre);
            __syncthreads();
            h16x8 ca[4];
#pragma unroll
            for (int kk = 0; kk < 4; ++kk) ca[kk] = *(const h16x8*)(Cm + (w * 16 + cc) * 136 + kk * 32 + quad * 8);
            if ((h & 3) == 0) {
#pragma unroll
                for (int ni = 0; ni < 8; ++ni) { f32x4 acc = {0.f, 0.f, 0.f, 0.f};
#pragma unroll
                    for (int kk = 0; kk < 4; ++kk) { const h16x8 bb = *(const h16x8*)(Bm + (ni * 16 + cc) * 136 + kk * 32 + quad * 8); acc = mfma16(ca[kk], bb, acc); }
                    cbt[ni] = (h16x4){(h16)acc[0], (h16)acc[1], (h16)acc[2], (h16)acc[3]}; }
                __syncthreads();
            }
#pragma unroll
            for (int ni = 0; ni < 8; ++ni) { const int sidx = ni * 16 + cc; const float as_ = acs[sidx], ds_ = dtl[sidx];
#pragma unroll
                for (int j = 0; j < 4; ++j) { const int lr = w * 16 + quad * 4 + j; const float v = (sidx <= lr) ? (float)cbt[ni][j] * __expf(acs[lr] - as_) * ds_ : 0.f; Bm[lr * 136 + sidx] = (h16)v; } }
            __syncthreads();
            const float Dh = C.in[17][l * 8 + h];
            float ssq[4] = {0.f, 0.f, 0.f, 0.f};
            h16x8 ma[4];
#pragma unroll
            for (int kk = 0; kk < 4; ++kk) ma[kk] = *(const h16x8*)(Bm + (w * 16 + cc) * 136 + kk * 32 + quad * 8);
            float ea[4];
#pragma unroll
            for (int j = 0; j < 4; ++j) ea[j] = __expf(acs[w * 16 + quad * 4 + j]);
#pragma unroll
            for (int ni = 0; ni < 4; ++ni) { f32x4 acc = {0.f, 0.f, 0.f, 0.f};
#pragma unroll
                for (int kk = 0; kk < 4; ++kk) { const h16x8 bb = *(const h16x8*)(HE + (ni * 16 + cc) * 136 + kk * 32 + quad * 8); acc = mfma16(ca[kk], bb, acc); }
#pragma unroll
                for (int j = 0; j < 4; ++j) acc[j] *= ea[j];
#pragma unroll
                for (int kk = 0; kk < 4; ++kk) { const h16* xp = Xs + (kk * 32 + 8 * quad + (cc >> 2)) * 72 + ni * 16 + 4 * (cc & 3); acc = mfma16(ma[kk], cat44(tr_read(xp), tr_read(xp + 4 * 72)), acc); }
                const int p = ni * 16 + cc;
#pragma unroll
                for (int j = 0; j < 4; ++j) { const int lr = w * 16 + quad * 4 + j; const float x = (float)Xs[lr * 72 + p]; const float z = (float)Zs[lr * 72 + p];
                    const h16 yh = (h16)((acc[j] + Dh * x) * siluf_(z)); Zs[lr * 72 + p] = yh; const float yr = (float)yh; ssq[j] += yr * yr; } }
#pragma unroll
            for (int j = 0; j < 4; ++j) { float sv = ssq[j]; sv += __shfl_xor(sv, 1); sv += __shfl_xor(sv, 2); sv += __shfl_xor(sv, 4); sv += __shfl_xor(sv, 8);
                if (cc == 0) rss[w * 16 + quad * 4 + j] += sv; }
            __syncthreads();
#pragma unroll
            for (int i = 0; i < 2; ++i) { const int ch = tid + 512 * i, tok = ch >> 3, c8 = ch & 7; *(h16x8*)(C.XN + (row0 + tok) * 1024 + 512 + h * 64 + c8 * 8) = *(const h16x8*)(Zs + tok * 72 + c8 * 8); }
            if ((h & 3) == 3) {
                asm volatile("s_waitcnt vmcnt(0)" ::: "memory");
                __syncthreads();
#pragma unroll
                for (int i = 0; i < 8; ++i) { const int ch = tid + 512 * i, tok = ch >> 5, c8 = ch & 31; const float rs = 1.0f / sqrtf(rss[tok] * (1.f / 256.f) + EPS);
                    h16* p = C.XN + (row0 + tok) * 1024 + 512 + g * 256 + c8 * 8; const h16x8 v = *(const h16x8*)p; const float* nw = nwp + g * 256 + c8 * 8;
                    u32x4 o; o.x = pkb((float)v[0] * rs * nw[0], (float)v[1] * rs * nw[1]); o.y = pkb((float)v[2] * rs * nw[2], (float)v[3] * rs * nw[3]);
                    o.z = pkb((float)v[4] * rs * nw[4], (float)v[5] * rs * nw[5]); o.w = pkb((float)v[6] * rs * nw[6], (float)v[7] * rs * nw[7]); *(u32x4*)p = o; }
            }
        }
    }
    __syncthreads();
}

struct GlaLoad { f32x4 gl[4]; h16x8 q0, k0, vx[2], rx[2]; };
template <int PASS>
__device__ __forceinline__ void gla_load(const Ctx& C, GlaLoad& L, size_t rowh, int h, int lane) {
    const int tl = lane & 15, kq = lane >> 4; const size_t rowt = rowh + tl;
#pragma unroll
    for (int i = 0; i < 4; ++i) L.gl[i] = *(const f32x4*)(C.PSM + rowt * PSM_W + 4 * i);
    L.q0 = *(const h16x8*)(C.PROJ + rowt * PN + C_GQ + h * 32 + kq * 8);
    L.k0 = *(const h16x8*)(C.PROJ + rowt * PN + C_GK + h * 32 + kq * 8);
#pragma unroll
    for (int i = 0; i < 2; ++i) { const int ch = lane + 64 * i, t = ch >> 3, c8 = ch & 7; L.vx[i] = *(const h16x8*)(C.PROJ + (rowh + t) * PN + C_GV + h * 64 + c8 * 8);
        if (PASS == 1) L.rx[i] = *(const h16x8*)(C.PROJ + (rowh + t) * PN + C_GR + h * 64 + c8 * 8); }
}
template <int PASS>
__device__ __forceinline__ void gla_block_unit(const Ctx& C, int l, int bu) {
    TIDS
    const int w = wave; const int wu = bu * 8 + w; const int cc = lane & 15, quad = lane >> 4;
    const int bh = wu >> 7, seg = wu & 127, b = bh >> 2, h = bh & 3;
    const size_t row0 = (size_t)b * SEQ + seg * 64;
    unsigned char* wl = g_lds + w * 11264;
    h16* QT = (h16*)wl; h16* KT = QT + 640; h16* KH = KT + 640;
    h16* VS = KH + 640; h16* RS = VS + 1152;
    float* EM = (float*)(RS + 1152); float* EE = EM + 32;
    float* W2S = EE + 32;
    const int tl = cc, kq = quad;
    const float* gb = C.in[4] + l * 128 + h * 32 + kq * 8;
    { const float* w2g = C.in[3] + (size_t)l * 16 * 128 + h * 32;
#pragma unroll
        for (int i = 0; i < 2; ++i) { const int e4 = lane + 64 * i, r = e4 >> 3, c4 = e4 & 7; *(f32x4*)(W2S + r * 32 + c4 * 4) = *(const f32x4*)(w2g + r * 128 + c4 * 4); } }
    const float* w2 = W2S + kq * 8;
    f32x4 S[2][4];
    float* gst = C.GLAST + (size_t)(bh * 128 + seg) * 2048;
#pragma unroll
    for (int md = 0; md < 2; ++md)
#pragma unroll
        for (int nt = 0; nt < 4; ++nt)
#pragma unroll
            for (int j = 0; j < 4; ++j) S[md][nt][j] = (PASS == 1) ? gst[(16 * md + 4 * quad + j) * 64 + 16 * nt + cc] : 0.f;
    float bsum[8];
#pragma unroll
    for (int k = 0; k < 8; ++k) bsum[k] = 0.f;
    float gnw[4][4];
    if (PASS == 1) {
#pragma unroll
        for (int mt = 0; mt < 4; ++mt)
#pragma unroll
            for (int j = 0; j < 4; ++j) gnw[mt][j] = C.in[5][l * 256 + h * 64 + 16 * mt + 4 * quad + j]; }
    GlaLoad pre, pre2; gla_load<PASS>(C, pre, row0, h, lane); gla_load<PASS>(C, pre2, row0 + 16, h, lane);
#pragma unroll 1
    for (int qt = 0; qt < 4; ++qt) {
        const size_t rowh = row0 + qt * 16;
        const GlaLoad cur = pre; pre = pre2;
        if (qt < 2) gla_load<PASS>(C, pre2, rowh + 32, h, lane);
        float bi[8];
#pragma unroll
        for (int k = 0; k < 8; ++k) bi[k] = gb[k];
#pragma unroll
        for (int r = 0; r < 16; ++r) { const float gv = cur.gl[r >> 2][r & 3]; const f32x4 wa = *(const f32x4*)(w2 + r * 32), wb = *(const f32x4*)(w2 + r * 32 + 4);
#pragma unroll
            for (int k = 0; k < 4; ++k) { bi[k] += gv * wa[k]; bi[4 + k] += gv * wb[k]; } }
#pragma unroll
        for (int k = 0; k < 8; ++k) bi[k] = -0.0625f * __builtin_amdgcn_logf(1.f + ex2(-1.4426950408889634f * bi[k]));
#pragma unroll
        for (int o = 1; o < 16; o <<= 1)
#pragma unroll
            for (int k = 0; k < 8; ++k) { const float t = __shfl_up(bi[k], o, 16); if (tl >= o) bi[k] += t; }
        float bmid[8], bend[8];
#pragma unroll
        for (int k = 0; k < 8; ++k) { bmid[k] = __shfl(bi[k], 7, 16); bend[k] = __shfl(bi[k], 15, 16); bsum[k] += bend[k]; }
        asm volatile("" ::: "memory");
        { h16x8 qo, ko, kh;
#pragma unroll
            for (int k = 0; k < 8; ++k) { const float kf = (float)cur.k0[k]; qo[k] = (h16)((float)cur.q0[k] * 0.17677669529663687f * ex2(bi[k] - bmid[k])); ko[k] = (h16)(kf * ex2(bmid[k] - bi[k])); kh[k] = (h16)(kf * ex2(bend[k] - bi[k])); }
            *(h16x8*)(QT + tl * 40 + kq * 8) = qo; *(h16x8*)(KT + tl * 40 + kq * 8) = ko; *(h16x8*)(KH + tl * 40 + kq * 8) = kh;
            if (tl == 0) {
#pragma unroll
                for (int k4 = 0; k4 < 2; ++k4) { f32x4 em, ee;
#pragma unroll
                    for (int e = 0; e < 4; ++e) { em[e] = ex2(bmid[4 * k4 + e]); ee[e] = ex2(bend[4 * k4 + e]); }
                    *(f32x4*)(EM + kq * 8 + 4 * k4) = em; *(f32x4*)(EE + kq * 8 + 4 * k4) = ee; } } }
#pragma unroll
        for (int i = 0; i < 2; ++i) { const int ch = lane + 64 * i, t = ch >> 3, c8 = ch & 7; *(h16x8*)(VS + t * 72 + c8 * 8) = cur.vx[i]; if (PASS == 1) *(h16x8*)(RS + t * 72 + c8 * 8) = cur.rx[i]; }
        asm volatile("s_waitcnt lgkmcnt(0)" ::: "memory");
        h16x8 vfr[4];
#pragma unroll
        for (int nt = 0; nt < 4; ++nt) { const h16x4 t4 = tr_read(VS + (4 * quad + (cc >> 2)) * 72 + 16 * nt + 4 * (cc & 3)); vfr[nt] = (h16x8){t4[0], t4[1], t4[2], t4[3], (h16)0.f, (h16)0.f, (h16)0.f, (h16)0.f}; }
        if (PASS == 1) {
            f32x4 at = {0.f, 0.f, 0.f, 0.f};
            at = mfma16(*(const h16x8*)(KT + cc * 40 + quad * 8), *(const h16x8*)(QT + cc * 40 + quad * 8), at);
            h16x8 pa;
#pragma unroll
            for (int e = 0; e < 4; ++e) { pa[e] = (h16)((4 * quad + e <= cc) ? at[e] : 0.f); pa[4 + e] = (h16)0.f; }
            const h16x4 ql = *(const h16x4*)(QT + cc * 40 + 4 * quad), qh = *(const h16x4*)(QT + cc * 40 + 16 + 4 * quad);
            const h16x8 qfr = cat44(ql, qh);
            const f32x4 em0 = *(const f32x4*)(EM + 4 * quad), em1 = *(const f32x4*)(EM + 16 + 4 * quad);
            f32x4 ot[4]; float ssq = 0.f;
#pragma unroll
            for (int mt = 0; mt < 4; ++mt) { f32x4 acc = {0.f, 0.f, 0.f, 0.f};
                acc = mfma16(vfr[mt], pa, acc);
                const h16x8 sfr = {(h16)(S[0][mt][0] * em0[0]), (h16)(S[0][mt][1] * em0[1]), (h16)(S[0][mt][2] * em0[2]), (h16)(S[0][mt][3] * em0[3]),
                                   (h16)(S[1][mt][0] * em1[0]), (h16)(S[1][mt][1] * em1[1]), (h16)(S[1][mt][2] * em1[2]), (h16)(S[1][mt][3] * em1[3])};
                acc = mfma16(sfr, qfr, acc);
                ot[mt] = acc; ssq += (acc[0] * acc[0] + acc[1] * acc[1]) + (acc[2] * acc[2] + acc[3] * acc[3]); }
            ssq += __shfl_xor(ssq, 16); ssq += __shfl_xor(ssq, 32);
            const float rs = 1.0f / sqrtf(ssq * (1.f / 64.f) + EPS);
#pragma unroll
            for (int mt = 0; mt < 4; ++mt) { const h16x4 r4 = *(const h16x4*)(RS + cc * 72 + 16 * mt + 4 * quad);
                u32x2 wv; wv.x = pkb(ot[mt][0] * rs * gnw[mt][0] * siluf_((float)r4[0]), ot[mt][1] * rs * gnw[mt][1] * siluf_((float)r4[1]));
                wv.y = pkb(ot[mt][2] * rs * gnw[mt][2] * siluf_((float)r4[2]), ot[mt][3] * rs * gnw[mt][3] * siluf_((float)r4[3]));
                *(u32x2*)(C.XN + (rowh + cc) * 1024 + h * 64 + 16 * mt + 4 * quad) = wv; }
        }
#pragma unroll
        for (int md = 0; md < 2; ++md) { const f32x4 ee = *(const f32x4*)(EE + 16 * md + 4 * quad);
            const h16x4 k4 = tr_read(KH + (4 * quad + (cc >> 2)) * 40 + 16 * md + 4 * (cc & 3));
            const h16x8 kfr = {k4[0], k4[1], k4[2], k4[3], (h16)0.f, (h16)0.f, (h16)0.f, (h16)0.f};
#pragma unroll
            for (int nt = 0; nt < 4; ++nt) { S[md][nt] = S[md][nt] * ee; S[md][nt] = mfma16(kfr, vfr[nt], S[md][nt]); } }
    }
    if (PASS == 0) {
#pragma unroll
        for (int md = 0; md < 2; ++md)
#pragma unroll
            for (int nt = 0; nt < 4; ++nt)
#pragma unroll
                for (int j = 0; j < 4; ++j) gst[(16 * md + 4 * quad + j) * 64 + 16 * nt + cc] = S[md][nt][j];
        if (tl == 0) {
#pragma unroll
            for (int k = 0; k < 8; ++k) C.GLAG[(size_t)(bh * 128 + seg) * 32 + kq * 8 + k] = ex2(bsum[k]); }
    }
}

__device__ __forceinline__ void phase_scans(const Ctx& C) {
    TIDS
    for (int e = C.bid * 512 + tid; e < BATCH * 8 * 4096; e += C.G * 512) {
        const int bh = e >> 12, b = bh >> 3, h = bh & 7, pn = e & 4095;
        h16x2* p = (h16x2*)(C.SSDST + (size_t)(b * 64 * 8 + h) * 8192) + pn; const float* cd = C.CD + b * 64 * 8 + h;
        float s0 = 0.f, s1 = 0.f;
        for (int c0 = 0; c0 < 64; c0 += 16) { h16x2 v[16]; float d[16];
#pragma unroll
            for (int i = 0; i < 16; ++i) { v[i] = p[(size_t)(c0 + i) * 8 * 4096]; d[i] = cd[(c0 + i) * 8]; }
#pragma unroll
            for (int i = 0; i < 16; ++i) { h16x2 o = {(h16)s0, (h16)s1}; p[(size_t)(c0 + i) * 8 * 4096] = o; s0 = d[i] * s0 + (float)v[i][0]; s1 = d[i] * s1 + (float)v[i][1]; } }
    }
    for (int e = C.bid * 512 + tid; e < 16 * 2048; e += C.G * 512) {
        const int bh = e >> 11, kv = e & 2047, k = kv >> 6;
        float* p = C.GLAST + (size_t)bh * 128 * 2048 + kv; const float* gg = C.GLAG + (size_t)bh * 128 * 32 + k;
        float st = 0.f;
        for (int s0 = 0; s0 < 128; s0 += 8) { float v[8], d[8];
#pragma unroll
            for (int i = 0; i < 8; ++i) { v[i] = p[(size_t)(s0 + i) * 2048]; d[i] = gg[(s0 + i) * 32]; }
#pragma unroll
            for (int i = 0; i < 8; ++i) { p[(size_t)(s0 + i) * 2048] = st; st = d[i] * st + v[i]; } }
    }
}

constexpr int KV_LD = 80, KV_TILE = 64 * KV_LD;
__device__ __forceinline__ void qk_tile(f32x4 (&s)[4], const h16* Ks, const h16x8 (&qf)[2], int cc, int quad) {
#pragma unroll
    for (int mt = 0; mt < 4; ++mt) { f32x4 a = {0.f, 0.f, 0.f, 0.f};
#pragma unroll
        for (int ks = 0; ks < 2; ++ks) { const h16x8 kf = *(const h16x8*)(Ks + (mt * 16 + cc) * KV_LD + ks * 32 + quad * 8); a = mfma16(kf, qf[ks], a); }
        s[mt] = a; }
}
__device__ __forceinline__ void pv_tile(f32x4 (&O)[4], const h16* Vs, const f32x4 (&p)[4], int cc, int quad) {
    h16x8 pf[2];
#pragma unroll
    for (int k2 = 0; k2 < 2; ++k2) pf[k2] = (h16x8){(h16)p[2 * k2][0], (h16)p[2 * k2][1], (h16)p[2 * k2][2], (h16)p[2 * k2][3], (h16)p[2 * k2 + 1][0], (h16)p[2 * k2 + 1][1], (h16)p[2 * k2 + 1][2], (h16)p[2 * k2 + 1][3]};
#pragma unroll
    for (int md = 0; md < 4; ++md)
#pragma unroll
        for (int k2 = 0; k2 < 2; ++k2) { const h16* vp = Vs + (32 * k2 + 4 * quad + (cc >> 2)) * KV_LD + md * 16 + 4 * (cc & 3);
            const h16x4 lo = tr_read(vp), hi = tr_read(vp + 16 * KV_LD);
            const h16x8 vf = {lo[0], lo[1], lo[2], lo[3], hi[0], hi[1], hi[2], hi[3]}; O[md] = mfma16(vf, pf[k2], O[md]); }
}
struct FlashState { float mref, l; f32x4 O[4]; bool started; };
template <int MODE, bool MASKED>
__device__ __forceinline__ void flash_tile2(FlashState (&st)[2], const h16* Ks, const h16* Vs, const h16x8 (&qf)[2][2], int kv0, const int (&tq)[2], const bool (&sb)[2], int cc, int quad) {
    if (MODE == 0) { if (!__any(sb[0] || sb[1])) return; }
    h16x8 kf[4][2];
#pragma unroll
    for (int mt = 0; mt < 4; ++mt)
#pragma unroll
        for (int ks = 0; ks < 2; ++ks) kf[mt][ks] = *(const h16x8*)(Ks + (mt * 16 + cc) * KV_LD + ks * 32 + quad * 8);
    f32x4 s[2][4]; float rmax[2];
#pragma unroll
    for (int gi = 0; gi < 2; ++gi) { const float nm = -st[gi].mref; const f32x4 negm = {nm, nm, nm, nm};
#pragma unroll
        for (int mt = 0; mt < 4; ++mt) { f32x4 a = mfma16(kf[mt][0], qf[gi][0], negm); s[gi][mt] = mfma16(kf[mt][1], qf[gi][1], a); } }
#pragma unroll
    for (int gi = 0; gi < 2; ++gi) { float tmax = -INFINITY;
        if (MASKED) {
#pragma unroll
            for (int mt = 0; mt < 4; ++mt)
#pragma unroll
                for (int j = 0; j < 4; ++j) { const int kp = kv0 + mt * 16 + quad * 4 + j; const bool ok = (MODE == 0) ? (kp <= tq[gi]) : (kp <= tq[gi] && kp > tq[gi] - 512);
                    const float v = ok ? s[gi][mt][j] : -INFINITY; s[gi][mt][j] = v; tmax = fmaxf(tmax, v); }
        } else {
            float ta = max3f(s[gi][0][0], s[gi][0][1], s[gi][0][2]), tb = max3f(s[gi][0][3], s[gi][1][0], s[gi][1][1]);
            ta = max3f(ta, s[gi][1][2], s[gi][1][3]); tb = max3f(tb, s[gi][2][0], s[gi][2][1]); ta = max3f(ta, s[gi][2][2], s[gi][2][3]); tb = max3f(tb, s[gi][3][0], s[gi][3][1]);
            tmax = max3f(ta, tb, fmaxf(s[gi][3][2], s[gi][3][3]));
        }
        tmax = fmaxf(tmax, __shfl_xor(tmax, 16)); tmax = fmaxf(tmax, __shfl_xor(tmax, 32));
        rmax[gi] = (MODE == 0 && !sb[gi]) ? -INFINITY : tmax; }
    bool upd[2];
#pragma unroll
    for (int gi = 0; gi < 2; ++gi) upd[gi] = (rmax[gi] > -INFINITY) && (!st[gi].started || rmax[gi] > 8.f);
    if (__any(upd[0] || upd[1])) {
#pragma unroll
        for (int gi = 0; gi < 2; ++gi) { const float dl = upd[gi] ? rmax[gi] : 0.f; const float f = (upd[gi] && st[gi].started) ? ex2(-dl) : 1.f;
            st[gi].mref += dl; st[gi].l *= f; st[gi].started = st[gi].started || upd[gi];
#pragma unroll
            for (int mt = 0; mt < 4; ++mt) { s[gi][mt] = s[gi][mt] - dl; st[gi].O[mt] *= f; } }
    }
    h16x8 pf[2][2];
#pragma unroll
    for (int gi = 0; gi < 2; ++gi) {
#pragma unroll
        for (int mt = 0; mt < 4; ++mt)
#pragma unroll
            for (int j = 0; j < 4; ++j) s[gi][mt][j] = ex2(s[gi][mt][j]);
        const f32x4 ps4 = (s[gi][0] + s[gi][1]) + (s[gi][2] + s[gi][3]);
        float psum = (ps4[0] + ps4[1]) + (ps4[2] + ps4[3]);
        u32x4 w0, w1; w0.x = pkh(s[gi][0][0], s[gi][0][1]); w0.y = pkh(s[gi][0][2], s[gi][0][3]); w0.z = pkh(s[gi][1][0], s[gi][1][1]); w0.w = pkh(s[gi][1][2], s[gi][1][3]);
        w1.x = pkh(s[gi][2][0], s[gi][2][1]); w1.y = pkh(s[gi][2][2], s[gi][2][3]); w1.z = pkh(s[gi][3][0], s[gi][3][1]); w1.w = pkh(s[gi][3][2], s[gi][3][3]);
        if (MODE == 0) { const unsigned mk = sb[gi] ? 0xffffffffu : 0u; w0 = w0 & mk; w1 = w1 & mk; psum = sb[gi] ? psum : 0.f; }
        st[gi].l += psum; pf[gi][0] = __builtin_bit_cast(h16x8, w0); pf[gi][1] = __builtin_bit_cast(h16x8, w1); }
#pragma unroll
    for (int md = 0; md < 4; ++md)
#pragma unroll
        for (int k2 = 0; k2 < 2; ++k2) { const h16* vp = Vs + (32 * k2 + 4 * quad + (cc >> 2)) * KV_LD + md * 16 + 4 * (cc & 3);
            const h16x8 vf = cat44(tr_read(vp), tr_read(vp + 16 * KV_LD));
            st[0].O[md] = mfma16(vf, pf[0][k2], st[0].O[md]); st[1].O[md] = mfma16(vf, pf[1][k2], st[1].O[md]); }
}
template <bool NEEDV, class SrcFn, class CompFn>
__device__ __forceinline__ void kv_pipeline(int n, int tid, h16* Kb, h16* Vb, SrcFn src, CompFn comp) {
    if (n <= 0) return;
    const int key = tid >> 3, c8 = tid & 7; const int loff = key * KV_LD + c8 * 8;
    h16x8 kr, vr = {};
    { const h16 *kp, *vp; size_t stride; src(0, kp, vp, stride); kr = *(const h16x8*)(kp + (size_t)key * stride + c8 * 8); if (NEEDV) vr = *(const h16x8*)(vp + (size_t)key * stride + c8 * 8); }
    *(h16x8*)(Kb + loff) = kr; if (NEEDV) *(h16x8*)(Vb + loff) = vr;
    __syncthreads();
    for (int i = 0; i < n; ++i) {
        const int cur = i & 1; const bool more = (i + 1 < n);
        if (more) { const h16 *kp, *vp; size_t stride; src(i + 1, kp, vp, stride); kr = *(const h16x8*)(kp + (size_t)key * stride + c8 * 8); if (NEEDV) vr = *(const h16x8*)(vp + (size_t)key * stride + c8 * 8); }
        comp(i, Kb + cur * KV_TILE, Vb + cur * KV_TILE);
        if (more) { *(h16x8*)(Kb + (cur ^ 1) * KV_TILE + loff) = kr; if (NEEDV) *(h16x8*)(Vb + (cur ^ 1) * KV_TILE + loff) = vr; }
        __syncthreads();
    }
}
__device__ __forceinline__ void nsa_attn_unit(const Ctx& C, int l, int b, int g, int qq) {
    TIDS
    const int w = wave, cc = lane & 15, quad = lane >> 4;
    const int r = cc >> 3, ti = cc & 7, h = 2 * g + r;
    const int qbw = 2 * qq + (w >> 2), qbh = 2 * qq + 1;
    int tloc[2], tq[2]; size_t rowq[2];
#pragma unroll
    for (int gi = 0; gi < 2; ++gi) { tloc[gi] = 16 * w + 8 * gi + ti; tq[gi] = 128 * qq + tloc[gi]; rowq[gi] = (size_t)b * SEQ + tq[gi]; }
    h16* Kb = (h16*)g_lds; h16* Vb = (h16*)(g_lds + 2 * KV_TILE * 2);
    float* imp = (float*)(g_lds + 40960);
    unsigned* sel = (unsigned*)(g_lds + 40960 + 65536);
    unsigned* uni = sel + 512;
    unsigned char* lst = (unsigned char*)(uni + 8);
    h16x8 qf[2][2];
#pragma unroll
    for (int gi = 0; gi < 2; ++gi) {
        const h16x8 x1 = *(const h16x8*)(C.PROJ + rowq[gi] * PN + C_NQ + h * 64 + quad * 8), x2 = *(const h16x8*)(C.PROJ + rowq[gi] * PN + C_NQ + h * 64 + 32 + quad * 8);
        f32x4 tb[4];
#pragma unroll
        for (int i = 0; i < 4; ++i) tb[i] = *(const f32x4*)(C.ROPE + 2 * (tq[gi] * 32 + quad * 8) + 4 * i);
#pragma unroll
        for (int e = 0; e < 8; ++e) { const float cs = tb[e >> 1][2 * (e & 1)], sn = tb[e >> 1][2 * (e & 1) + 1]; const float a1 = (float)x1[e], a2 = (float)x2[e];
            qf[gi][0][e] = (h16)((a1 * cs - a2 * sn) * 0.18033688011112042f); qf[gi][1][e] = (h16)((a2 * cs + a1 * sn) * 0.18033688011112042f); } }
    const h16* kcb = C.KC + (size_t)(b * 2 + g) * 512 * 64; const h16* vcb = C.VC + (size_t)(b * 2 + g) * 512 * 64;
    const int ncmp = 4 * qbh + 3, ntile_c = (ncmp + 63) >> 6;
    auto src_cmp = [&](int i, const h16*& kp, const h16*& vp, size_t& stride) { kp = kcb + (size_t)i * 64 * 64; vp = vcb + (size_t)i * 64 * 64; stride = 64; };
    float m1[2] = {-INFINITY, -INFINITY}, l1[2] = {0.f, 0.f};
    kv_pipeline<false>(ntile_c, tid, Kb, Vb, src_cmp, [&](int tc, const h16* Ks, const h16*) {
        h16x8 kf[4][2];
#pragma unroll
        for (int mt = 0; mt < 4; ++mt)
#pragma unroll
            for (int ks = 0; ks < 2; ++ks) kf[mt][ks] = *(const h16x8*)(Ks + (mt * 16 + cc) * KV_LD + ks * 32 + quad * 8);
#pragma unroll
        for (int gi = 0; gi < 2; ++gi) { f32x4 s[4]; float tmax = -INFINITY;
#pragma unroll
            for (int mt = 0; mt < 4; ++mt) { f32x4 a = {0.f, 0.f, 0.f, 0.f}; a = mfma16(kf[mt][0], qf[gi][0], a); a = mfma16(kf[mt][1], qf[gi][1], a);
#pragma unroll
                for (int j = 0; j < 4; ++j) { const int n = tc * 64 + mt * 16 + quad * 4 + j; const float v = (16 * n + 31 <= tq[gi]) ? a[j] : -INFINITY; a[j] = v; tmax = fmaxf(tmax, v); }
                s[mt] = a; }
            tmax = fmaxf(tmax, __shfl_xor(tmax, 16)); tmax = fmaxf(tmax, __shfl_xor(tmax, 32));
            const float mnew = fmaxf(m1[gi], tmax), muse = (mnew == -INFINITY) ? 0.f : mnew;
            float ps = 0.f;
#pragma unroll
            for (int mt = 0; mt < 4; ++mt)
#pragma unroll
                for (int j = 0; j < 4; ++j) ps += ex2(s[mt][j] - muse);
            l1[gi] = l1[gi] * ex2(m1[gi] - muse) + ps; m1[gi] = mnew; } });
    float inv1[2], m1u[2];
#pragma unroll
    for (int gi = 0; gi < 2; ++gi) { float t = l1[gi]; t += __shfl_xor(t, 16); t += __shfl_xor(t, 32); inv1[gi] = (t > 0.f) ? 1.f / t : 0.f; m1u[gi] = (m1[gi] == -INFINITY) ? 0.f : m1[gi]; }
    f32x4 Oc[2][4];
#pragma unroll
    for (int gi = 0; gi < 2; ++gi)
#pragma unroll
        for (int md = 0; md < 4; ++md) Oc[gi][md] = (f32x4){0.f, 0.f, 0.f, 0.f};
    float carry_q3[2] = {0.f, 0.f};
    kv_pipeline<true>(ntile_c, tid, Kb, Vb, src_cmp, [&](int tc, const h16* Ks, const h16* Vs) {
        h16x8 kf[4][2]; h16x8 pf[2][2];
#pragma unroll
        for (int mt = 0; mt < 4; ++mt)
#pragma unroll
            for (int ks = 0; ks < 2; ++ks) kf[mt][ks] = *(const h16x8*)(Ks + (mt * 16 + cc) * KV_LD + ks * 32 + quad * 8);
#pragma unroll
        for (int gi = 0; gi < 2; ++gi) { f32x4 s[4];
#pragma unroll
            for (int mt = 0; mt < 4; ++mt) { f32x4 a = {0.f, 0.f, 0.f, 0.f}; a = mfma16(kf[mt][0], qf[gi][0], a); a = mfma16(kf[mt][1], qf[gi][1], a);
#pragma unroll
                for (int j = 0; j < 4; ++j) { const int n = tc * 64 + mt * 16 + quad * 4 + j; a[j] = (16 * n + 31 <= tq[gi]) ? ex2(a[j] - m1u[gi]) * inv1[gi] : 0.f; }
                s[mt] = a;
                const float s4 = (a[0] + a[1]) + (a[2] + a[3]); const float p3 = a[3];
                const float fromprev = __shfl(p3, (lane + 48) & 63);
                const float fromq3 = __shfl(p3, cc + 48);
                float val = s4 + ((quad == 0) ? carry_q3[gi] : fromprev);
                carry_q3[gi] = fromq3;
                val += __shfl_xor(val, 8);
                if (r == 0) imp[tloc[gi] * 128 + tc * 16 + mt * 4 + quad] = val; }
#pragma unroll
            for (int k2 = 0; k2 < 2; ++k2) pf[gi][k2] = (h16x8){(h16)s[2 * k2][0], (h16)s[2 * k2][1], (h16)s[2 * k2][2], (h16)s[2 * k2][3], (h16)s[2 * k2 + 1][0], (h16)s[2 * k2 + 1][1], (h16)s[2 * k2 + 1][2], (h16)s[2 * k2 + 1][3]}; }
#pragma unroll
        for (int md = 0; md < 4; ++md)
#pragma unroll
            for (int k2 = 0; k2 < 2; ++k2) { const h16* vp = Vs + (32 * k2 + 4 * quad + (cc >> 2)) * KV_LD + md * 16 + 4 * (cc & 3);
                const h16x8 vf = cat44(tr_read(vp), tr_read(vp + 16 * KV_LD));
                Oc[0][md] = mfma16(vf, pf[0][k2], Oc[0][md]); Oc[1][md] = mfma16(vf, pf[1][k2], Oc[1][md]); } });
    if (qbw < 16) {
        if (lane < 16) { const unsigned mlo = (2u << qbw) - 1u; const int row = 16 * w + lane; sel[row * 4 + 0] = mlo; sel[row * 4 + 1] = 0u; sel[row * 4 + 2] = 0u; sel[row * 4 + 3] = 0u; }
    } else {
        const int jhi = qbw - 2;
        const unsigned long long lt = __lanemask_lt();
        for (int t16 = 0; t16 < 16; ++t16) { const int row = 16 * w + t16; const float* ir = imp + row * 128;
            const int j1 = lane, j2 = lane + 64; const bool ok1 = (j1 >= 1 && j1 <= jhi), ok2 = (j2 <= jhi);
            const unsigned u1 = ok1 ? __float_as_uint(ir[j1]) + 1u : 0u, u2 = ok2 ? __float_as_uint(ir[j2]) + 1u : 0u;
            unsigned prefix = 0u;
            for (int bit = 30; bit >= 0; --bit) { const unsigned test = prefix | (1u << bit);
                const int cnt = __popcll(__ballot(u1 >= test)) + __popcll(__ballot(u2 >= test)); if (cnt >= 13) prefix = test; }
            const bool gt1 = u1 > prefix, gt2 = u2 > prefix, eq1 = u1 == prefix, eq2 = u2 == prefix;
            const unsigned long long bg1 = __ballot(gt1), bg2 = __ballot(gt2), be1 = __ballot(eq1), be2 = __ballot(eq2);
            const int need = 13 - __popcll(bg1) - __popcll(bg2);
            const bool s1 = gt1 || (eq1 && __popcll(be1 & lt) < need), s2 = gt2 || (eq2 && (__popcll(be1) + __popcll(be2 & lt)) < need);
            unsigned long long blo = __ballot(s1) | 1ull, bhi = __ballot(s2);
            { const int f0 = qbw - 1, f1 = qbw; if (f0 < 64) blo |= 1ull << f0; else bhi |= 1ull << (f0 - 64); if (f1 < 64) blo |= 1ull << f1; else bhi |= 1ull << (f1 - 64); }
            if (lane == 0) { sel[row * 4 + 0] = (unsigned)blo; sel[row * 4 + 1] = (unsigned)(blo >> 32); sel[row * 4 + 2] = (unsigned)bhi; sel[row * 4 + 3] = (unsigned)(bhi >> 32); } }
    }
    __syncthreads();
    if (w == 0) {
        unsigned o0 = sel[lane * 4 + 0] | sel[(lane + 64) * 4 + 0], o1 = sel[lane * 4 + 1] | sel[(lane + 64) * 4 + 1], o2 = sel[lane * 4 + 2] | sel[(lane + 64) * 4 + 2], o3 = sel[lane * 4 + 3] | sel[(lane + 64) * 4 + 3];
#pragma unroll
        for (int sft = 1; sft < 64; sft <<= 1) { o0 |= __shfl_xor(o0, sft); o1 |= __shfl_xor(o1, sft); o2 |= __shfl_xor(o2, sft); o3 |= __shfl_xor(o3, sft); }
        const unsigned long long mlo = ((unsigned long long)o1 << 32) | o0, mhi = ((unsigned long long)o3 << 32) | o2;
        const unsigned long long lt = __lanemask_lt(); const int nlo = __popcll(mlo);
        if ((mlo >> lane) & 1ull) lst[__popcll(mlo & lt)] = (unsigned char)lane;
        if ((mhi >> lane) & 1ull) lst[nlo + __popcll(mhi & lt)] = (unsigned char)(64 + lane);
        if (lane == 0) uni[4] = (unsigned)(nlo + __popcll(mhi));
    }
    __syncthreads();
    { f32x4* park = (f32x4*)imp;
#pragma unroll
        for (int gi = 0; gi < 2; ++gi)
#pragma unroll
            for (int md = 0; md < 4; ++md) park[(gi * 4 + md) * 512 + tid] = Oc[gi][md]; }
    unsigned long long selLo[2], selHi[2];
#pragma unroll
    for (int gi = 0; gi < 2; ++gi) { selLo[gi] = ((unsigned long long)sel[tloc[gi] * 4 + 1] << 32) | sel[tloc[gi] * 4 + 0]; selHi[gi] = ((unsigned long long)sel[tloc[gi] * 4 + 3] << 32) | sel[tloc[gi] * 4 + 2]; }
    const int nlist = (int)uni[4];
    FlashState fs[2];
#pragma unroll
    for (int gi = 0; gi < 2; ++gi) { fs[gi].mref = 0.f; fs[gi].l = 0.f; fs[gi].started = false;
#pragma unroll
        for (int md = 0; md < 4; ++md) fs[gi].O[md] = (f32x4){0.f, 0.f, 0.f, 0.f}; }
    const h16* kslc = C.PROJ + (size_t)b * SEQ * PN + C_KSLC + g * 64; const h16* vslc = C.PROJ + (size_t)b * SEQ * PN + C_VSLC + g * 64;
    kv_pipeline<true>(nlist, tid, Kb, Vb,
        [&](int i, const h16*& kp, const h16*& vp, size_t& stride) { const int j = lst[i]; kp = kslc + (size_t)j * 64 * PN; vp = vslc + (size_t)j * 64 * PN; stride = PN; },
        [&](int i, const h16* Ks, const h16* Vs) { const int j = lst[i]; bool sb[2];
#pragma unroll
            for (int gi = 0; gi < 2; ++gi) { const unsigned long long sw = (j < 64) ? selLo[gi] : selHi[gi]; sb[gi] = ((sw >> (j & 63)) & 1ull) != 0ull; }
            if (j >= 2 * qq) flash_tile2<0, true>(fs, Ks, Vs, qf, j * 64, tq, sb, cc, quad); else flash_tile2<0, false>(fs, Ks, Vs, qf, j * 64, tq, sb, cc, quad); });
    f32x4 Os[2][4];
#pragma unroll
    for (int gi = 0; gi < 2; ++gi) { float ls = fs[gi].l; ls += __shfl_xor(ls, 16); ls += __shfl_xor(ls, 32); const float invs = (ls > 0.f) ? 1.f / ls : 0.f;
#pragma unroll
        for (int md = 0; md < 4; ++md) Os[gi][md] = fs[gi].O[md] * invs; }
#pragma unroll
    for (int gi = 0; gi < 2; ++gi) { fs[gi].mref = 0.f; fs[gi].l = 0.f; fs[gi].started = false;
#pragma unroll
        for (int md = 0; md < 4; ++md) fs[gi].O[md] = (f32x4){0.f, 0.f, 0.f, 0.f}; }
    const h16* kwin = C.PROJ + (size_t)b * SEQ * PN + C_KWIN + g * 64; const h16* vwin = C.PROJ + (size_t)b * SEQ * PN + C_VWIN + g * 64;
    const int jw0 = (2 * qq >= 8 ? 2 * qq - 8 : 0);
    kv_pipeline<true>(qbh - jw0 + 1, tid, Kb, Vb,
        [&](int i, const h16*& kp, const h16*& vp, size_t& stride) { const int j = jw0 + i; kp = kwin + (size_t)j * 64 * PN; vp = vwin + (size_t)j * 64 * PN; stride = PN; },
        [&](int i, const h16* Ks, const h16* Vs) { const int j = jw0 + i; const bool sbt[2] = {true, true};
            if (j >= 2 * qq || j <= 2 * qq - 7) flash_tile2<1, true>(fs, Ks, Vs, qf, j * 64, tq, sbt, cc, quad); else flash_tile2<1, false>(fs, Ks, Vs, qf, j * 64, tq, sbt, cc, quad); });
#pragma unroll
    for (int gi = 0; gi < 2; ++gi) {
        float lw = fs[gi].l; lw += __shfl_xor(lw, 16); lw += __shfl_xor(lw, 32); const float invw = (lw > 0.f) ? 1.f / lw : 0.f;
        const float* gp = C.PSM + rowq[gi] * PSM_W + 16 + h * 3;
        const float g0 = sigmoidf_(gp[0]), g1 = sigmoidf_(gp[1]), g2 = sigmoidf_(gp[2]) * invw;
        float ssq = 0.f; f32x4 o[4];
#pragma unroll
        for (int md = 0; md < 4; ++md) { o[md] = g0 * ((const f32x4*)imp)[(gi * 4 + md) * 512 + tid] + g1 * Os[gi][md] + g2 * fs[gi].O[md]; ssq += (o[md][0] * o[md][0] + o[md][1] * o[md][1]) + (o[md][2] * o[md][2] + o[md][3] * o[md][3]); }
        ssq += __shfl_xor(ssq, 16); ssq += __shfl_xor(ssq, 32);
        const float rs = 1.0f / sqrtf(ssq * (1.f / 64.f) + EPS);
        const float* nw = C.in[12] + l * 256 + h * 64;
#pragma unroll
        for (int md = 0; md < 4; ++md) { const int d = md * 16 + quad * 4; u32x2 wv; wv.x = pkb(o[md][0] * rs * nw[d], o[md][1] * rs * nw[d + 1]); wv.y = pkb(o[md][2] * rs * nw[d + 2], o[md][3] * rs * nw[d + 3]);
            *(u32x2*)(C.XN + rowq[gi] * 1024 + 256 + h * 64 + d) = wv; }
    }
}

__device__ __forceinline__ void phase_ssdnorm(const Ctx& C, int l) {
    TIDS
    const int gw = C.bid * 8 + wave, NGW = C.G * 8; const float* nw = C.in[18] + l * 512 + lane * 8;
    for (int m = gw; m < MTOK; m += NGW) { const int g = lane >> 5; const f32x4 q = *(const f32x4*)(C.SSQ + (size_t)m * 8 + g * 4);
        const float rs = 1.0f / sqrtf(((q.x + q.y) + (q.z + q.w)) * (1.f / 256.f) + EPS);
        h16* p = C.XN + (size_t)m * 1024 + 512 + lane * 8; const h16x8 v = *(const h16x8*)p;
        u32x4 o; o.x = pkh((float)v[0] * rs * nw[0], (float)v[1] * rs * nw[1]); o.y = pkh((float)v[2] * rs * nw[2], (float)v[3] * rs * nw[3]);
        o.z = pkh((float)v[4] * rs * nw[4], (float)v[5] * rs * nw[5]); o.w = pkh((float)v[6] * rs * nw[6], (float)v[7] * rs * nw[7]); *(u32x4*)p = o; }
}
__device__ __forceinline__ void phase_norm(const Ctx& C, const float* src, h16* dst) {
    TIDS
    const int gw = C.bid * 8 + wave, NGW = C.G * 8;
    for (int m = gw; m < MTOK; m += NGW) rms_row_to_h16(src + (size_t)m * DM, dst + (size_t)m * DM, lane);
}
__device__ __forceinline__ void phase_final(const Ctx& C) {
    TIDS
    const int gw = C.bid * 8 + wave, NGW = C.G * 8; const unsigned long long* ssq = C.RSS + (size_t)(2 * DEPTH - 1) * MTOK;
    f32x4 fw[4];
#pragma unroll
    for (int j = 0; j < 4; ++j) fw[j] = *((const f32x4*)C.in[23] + lane + 64 * j);
    for (int m0 = gw * 4; m0 < MTOK; m0 += NGW * 4) { u32x2 v[4][4]; float rs[4];
#pragma unroll
        for (int r = 0; r < 4; ++r) { rs[r] = (float)ssq[m0 + r] * RSS_INV; const u32x2* hr = (const u32x2*)(C.H16 + (size_t)(m0 + r) * DM) + lane;
#pragma unroll
            for (int j = 0; j < 4; ++j) v[r][j] = hr[64 * j]; }
#pragma unroll
        for (int r = 0; r < 4; ++r) { const float sc = 1.0f / sqrtf(rs[r] * (1.f / DM) + EPS); f32x4* xr = (f32x4*)(C.out + (size_t)(m0 + r) * DM) + lane;
#pragma unroll
            for (int j = 0; j < 4; ++j) xr[64 * j] = unpk_bf4(v[r][j]) * sc * fw[j]; } }
}

constexpr int N_PHASES_DECL = 0;
#ifndef PHM
#define PHM 0xffffffffu
#endif
#define EN(k) ((PHM >> (k)) & 1u)
#ifndef PROBE_PH
#define PROBE_PH -1
#define PROBE_REPS 1
#endif
#define REPN(ph) ((ph) == PROBE_PH ? PROBE_REPS : 1)
#ifndef TS_PROBE
#define TS_PROBE 0
#define TS_A 0
#define TS_B 1
#define TS_DIV 4.0f
#endif
#ifndef PROBE_BIT
#define PROBE_BIT -1
#endif
#define RB(k) for (int rb_ = 0; rb_ < ((k) == PROBE_BIT && l == 0 ? 2 : 1); ++rb_)
template <int ph> __device__ __forceinline__ void run_phase(const Params* kp, int rep, int wv) {
    Ctx C; make_ctx(C, kp, wv);
    LAS unsigned char* ldsl = (LAS unsigned char*)g_lds;
    if constexpr (ph == 0) { if (EN(0)) phase_prep(C); return; }
    if constexpr (ph == 1 + 8 * DEPTH) { if (EN(15)) phase_final(C); return; }
    constexpr int l = (ph - 1) / 8, s = (ph - 1) % 8;
    if (s == 0) { if (EN(1)) { pg8::Gemm g{(const pg8::bf16_t*)(l == 0 ? C.XN : C.H16), (const pg8::bf16_t*)(C.WIN + (size_t)l * PN * DM), MTOK, PN, DM}; pg8::StaticOrder S; S.init(MTOK, PN, C.G, C.bid);
        pg8::EpiProj E{C.PROJ, C.PSM, l == 0 ? (const unsigned long long*)nullptr : C.RSS + (size_t)(2 * (l - 1) + 1) * MTOK}; pg8::gemm_phase<pg8::EpiProj, true>(ldsl, g, S, E, C.wv); } }
    else if (s == 1) { if (EN(2)) phase_tok(C, l); }
    else if (s == 2) { RB(3) for (int u = C.bid; u < 256; u += C.G) nsa_compress_unit(C, l, u);
#if TS_PROBE
        if (l == 0 && blockIdx.x == 0) { __syncthreads(); if (C.wv == 0 && opaque_lane() == 0) ((volatile LAS unsigned long long*)((LAS unsigned char*)g_lds + LDS_MISC + 64))[27] = __builtin_amdgcn_s_memrealtime(); }
#endif
        RB(4) ssd_states_phase(C, l, C.bid, C.G);
#if TS_PROBE
        if (l == 0 && blockIdx.x == 0) { __syncthreads(); if (C.wv == 0 && opaque_lane() == 0) ((volatile LAS unsigned long long*)((LAS unsigned char*)g_lds + LDS_MISC + 64))[28] = __builtin_amdgcn_s_memrealtime(); }
#endif
        RB(5) for (int u = C.bid; u < 256; u += C.G) gla_block_unit<0>(C, l, u); }
    else if (s == 3) { if (EN(6) && rep == 0) phase_scans(C);
#if TS_PROBE
        if (l == 0 && blockIdx.x == 0) { __syncthreads(); if (C.wv == 0 && opaque_lane() == 0) ((volatile LAS unsigned long long*)((LAS unsigned char*)g_lds + LDS_MISC + 64))[30] = __builtin_amdgcn_s_memrealtime(); }
#endif
        if (EN(7)) for (int v = C.bid; v < 512; v += C.G) { const int bg = (v & 255) >> 5, sidx = v & 31, k = v >> 8;
            const int qq = (k == 0) ? sidx : 63 - sidx; nsa_attn_unit(C, l, bg >> 1, bg & 1, qq); } }
    else if (s == 4) { RB(8) ssd_y_phase(C, l, C.bid, C.G);
#if TS_PROBE
        if (l == 0 && blockIdx.x == 0) { __syncthreads(); if (C.wv == 0 && opaque_lane() == 0) ((volatile LAS unsigned long long*)((LAS unsigned char*)g_lds + LDS_MISC + 64))[29] = __builtin_amdgcn_s_memrealtime(); }
#endif
        RB(9) for (int u = C.bid; u < 256; u += C.G) gla_block_unit<1>(C, l, u); }
    else if (s == 5) { if (EN(11)) { pg8::Gemm g{(const pg8::bf16_t*)C.XN, (const pg8::bf16_t*)(C.WOUT + (size_t)l * DM * DM), MTOK, DM, DM}; pg8::StaticOrder S; S.init(MTOK, DM, C.G, C.bid);
        pg8::EpiRes E{l == 0 ? C.in[0] : (const float*)nullptr, C.H16, C.RSS + (size_t)(2 * l) * MTOK}; pg8::gemm_phase<pg8::EpiRes, true>(ldsl, g, S, E, C.wv); } }
    else if (s == 6) { if (EN(13)) { pg8::Gemm g{(const pg8::bf16_t*)C.H16, (const pg8::bf16_t*)(C.WUP + (size_t)l * DFF * DM), MTOK, DFF, DM}; pg8::StaticOrder S; S.init(MTOK, DFF, C.G, C.bid);
        pg8::EpiHid E{C.HID, C.RSS + (size_t)(2 * l) * MTOK}; pg8::gemm_phase<pg8::EpiHid, true>(ldsl, g, S, E, C.wv); } }
    else if (s == 7) { if (EN(14)) { pg8::Gemm g{(const pg8::bf16_t*)C.HID, (const pg8::bf16_t*)(C.WDN + (size_t)l * DM * DFF), MTOK, DM, DFF}; pg8::StaticOrder S; S.init(MTOK, DM, C.G, C.bid);
        pg8::EpiRes E{(const float*)nullptr, C.H16, C.RSS + (size_t)(2 * l + 1) * MTOK}; pg8::gemm_phase<pg8::EpiRes, true>(ldsl, g, S, E, C.wv); } }
}
constexpr int PH_PER_L = 8;
constexpr int N_PHASES = 1 + PH_PER_L * DEPTH + 1;
template <int PH> __device__ __forceinline__ void phase_seq(const Params* kp, int lo, int hi, cg::grid_group& grid, const XcdBarrier& bar, int wv) {
    if constexpr (PH < N_PHASES) {
        if (lo <= PH && PH < hi) {
            for (int rep = 0; rep < REPN(PH); ++rep) run_phase<PH>(kp, rep, wv);
            if (PH + 1 < hi) { if (MK_COOP && PH == 0) grid.sync(); else xcd_barrier(bar); }
#if TS_PROBE
            if (blockIdx.x == 0 && wv == 0 && opaque_lane() == 0) ((volatile LAS unsigned long long*)((LAS unsigned char*)g_lds + LDS_MISC + 64))[PH + 1] = __builtin_amdgcn_s_memrealtime();
#endif
        }
        phase_seq<PH + 1>(kp, lo, hi, grid, bar, wv);
    }
}
__global__ void __launch_bounds__(512, 2) fwd_kernel(Params P) {
    const Params* kp = &P;
    cg::grid_group grid = cg::this_grid();
    volatile LAS unsigned* st = (volatile LAS unsigned*)((LAS unsigned char*)g_lds + LDS_MISC);
    const int wv = __builtin_amdgcn_readfirstlane((int)threadIdx.x >> 6);
    if (threadIdx.x < 2) st[threadIdx.x] = 0u;
    __syncthreads();
    const XcdBarrier bar = xcd_barrier_post((unsigned*)P.ws, st, wv);
#if TS_PROBE
    if (blockIdx.x == 0 && wv == 0 && opaque_lane() == 0) ((volatile LAS unsigned long long*)((LAS unsigned char*)g_lds + LDS_MISC + 64))[0] = __builtin_amdgcn_s_memrealtime();
#endif
    phase_seq<0>(kp, P.ph_lo, P.ph_hi, grid, bar, wv);
#if TS_PROBE
    if (blockIdx.x == 0 && wv == 0 && opaque_lane() == 0) { volatile LAS unsigned long long* ts = (volatile LAS unsigned long long*)((LAS unsigned char*)g_lds + LDS_MISC + 64);
        const float us = (float)(ts[TS_B] - ts[TS_A]) * 0.01f; P.out[0] = us * (1.0f / TS_DIV); }
#endif
}

extern "C" void kernel_launch(void* const* d_in, const int* in_sizes, int n_in, void* d_out, int out_size, void* d_ws, size_t ws_size, hipStream_t stream) {
    static int grid = 0;
    if (grid == 0) {
        if (n_in != 24 || in_sizes[0] != MTOK * DM || out_size != MTOK * DM || ws_size < WS_END) { fprintf(stderr, "kernel_launch: unexpected shapes (n_in %d, ws %zu)\n", n_in, ws_size); grid = -1; return; }
        int dev = 0, cus = 0, per_cu = 0;
        hipGetDevice(&dev); hipDeviceGetAttribute(&cus, hipDeviceAttributeMultiprocessorCount, dev);
        hipFuncSetAttribute((const void*)fwd_kernel, hipFuncAttributeMaxDynamicSharedMemorySize, LDS_BYTES);
        hipOccupancyMaxActiveBlocksPerMultiprocessor(&per_cu, (const void*)fwd_kernel, 512, LDS_BYTES);
        (void)hipGetLastError();
        if (per_cu < 1) { fprintf(stderr, "kernel_launch: occupancy query says %d blocks/CU\n", per_cu); grid = -1; return; }
        grid = cus;
    }
    if (grid < 0) return;
    (void)hipMemsetAsync(d_ws, 0, 32768, stream);
    Params p{};
    for (int i = 0; i < 24; ++i) p.in[i] = (const float*)d_in[i];
    p.out = (float*)d_out; p.ws = (unsigned char*)d_ws;
#if MK_MULTI_LAUNCH
    for (int ph = 0; ph < N_PHASES; ++ph) { p.ph_lo = ph; p.ph_hi = ph + 1; hipLaunchKernelGGL(fwd_kernel, dim3(grid), dim3(512), LDS_BYTES, stream, p); }
#else
    p.ph_lo = 0; p.ph_hi = N_PHASES;
#if MK_COOP
    void* args[] = {&p};
    hipError_t e = hipLaunchCooperativeKernel((const void*)fwd_kernel, dim3(grid), dim3(512), args, LDS_BYTES, stream);
    if (e != hipSuccess) fprintf(stderr, "cooperative launch failed: %s (grid %d)\n", hipGetErrorString(e), grid);
#else
    hipLaunchKernelGGL(fwd_kernel, dim3(grid), dim3(512), LDS_BYTES, stream, p);
#endif
#endif
}
```

```cpp
#include <hip/hip_runtime.h>
#include <hip/hip_cooperative_groups.h>
#include <cstdio>
#include <cstdint>
namespace cg = cooperative_groups;

#ifndef MK_MULTI_LAUNCH
#define MK_MULTI_LAUNCH 0
#endif
#ifndef MK_COOP
#define MK_COOP 0
#endif

#define LAS __attribute__((address_space(3)))
typedef _Float16 h16;
typedef _Float16 h16x8 __attribute__((ext_vector_type(8)));
typedef _Float16 h16x4 __attribute__((ext_vector_type(4)));
typedef _Float16 h16x2 __attribute__((ext_vector_type(2)));
typedef float f32x4 __attribute__((ext_vector_type(4)));
typedef float f32x2 __attribute__((ext_vector_type(2)));
typedef unsigned u32x4 __attribute__((ext_vector_type(4)));
typedef unsigned u32x2 __attribute__((ext_vector_type(2)));

constexpr int BATCH = 4, SEQ = 8192, DM = 1024, MTOK = BATCH * SEQ, DEPTH = 2;
constexpr int DIN = 3364, PN = 3584, DFF = 4096;
constexpr float EPS = 1e-6f;
constexpr int C_GQ = 0, C_GK = 128, C_GV = 256, C_GR = 512, C_NQ = 768, C_NKV = 1024, C_SZ = 1792, C_SX = 2304, C_SM = 3328;
constexpr int C_KCMP = C_NKV, C_VCMP = C_NKV + 128, C_KSLC = C_NKV + 256, C_VSLC = C_NKV + 384, C_KWIN = C_NKV + 512, C_VWIN = C_NKV + 640;
constexpr int PSM_W = 64;

constexpr size_t MiB = 1u << 20;
constexpr size_t WS_WIN = 2 * MiB;
constexpr size_t WS_WOUT = 16 * MiB;
constexpr size_t WS_WUP = 20 * MiB;
constexpr size_t WS_WDN = 36 * MiB;
constexpr size_t WS_W1T = 52 * MiB;
constexpr size_t WS_W2T = 54 * MiB;
constexpr size_t WS_B1 = 16384;
constexpr size_t WS_ROPE = 55 * MiB;
constexpr size_t WS_XN = 60 * MiB;
constexpr size_t WS_PROJ = 124 * MiB;
constexpr size_t WS_HID = 124 * MiB;
constexpr size_t WS_XBCC = 348 * MiB;
constexpr size_t WS_SSDST = 444 * MiB;
constexpr size_t WS_GLAST = 476 * MiB;
constexpr size_t WS_PSM = 492 * MiB;
constexpr size_t WS_KC = 500 * MiB;
constexpr size_t WS_VC = 500 * MiB + 512 * 1024;
constexpr size_t WS_SSQ = 501 * MiB;
constexpr size_t WS_DTV = 502 * MiB;
constexpr size_t WS_ACS = 503 * MiB;
constexpr size_t WS_CD = 504 * MiB;
constexpr size_t WS_GLAG = 504 * MiB + 64 * 1024;
constexpr size_t WS_RSS = 505 * MiB;
constexpr size_t WS_B1P = 54 * MiB + 256 * 1024;
constexpr size_t WS_H16 = 380 * MiB;
constexpr size_t WS_END = 507 * MiB;

constexpr int LDS_BYTES = 147456;
constexpr int LDS_MISC = 131072;
extern __shared__ __attribute__((aligned(16))) unsigned char g_lds[];

struct Params { const float* in[24]; float* out; unsigned char* ws; int ph_lo, ph_hi; };

__constant__ float ROPE_INV[32] = {
 1.000000000e+00f, 7.498942614e-01f, 5.623413324e-01f, 4.216965139e-01f, 3.162277639e-01f, 2.371373773e-01f, 1.778279394e-01f, 1.333521307e-01f,
 1.000000015e-01f, 7.498941571e-02f, 5.623413250e-02f, 4.216965288e-02f, 3.162277490e-02f, 2.371373773e-02f, 1.778279431e-02f, 1.333521493e-02f,
 9.999999776e-03f, 7.498941850e-03f, 5.623413250e-03f, 4.216964822e-03f, 3.162277630e-03f, 2.371373586e-03f, 1.778279431e-03f, 1.333521446e-03f,
 1.000000047e-03f, 7.498942432e-04f, 5.623413017e-04f, 4.216965172e-04f, 3.162277571e-04f, 2.371373703e-04f, 1.778279402e-04f, 1.333521504e-04f };

__device__ __forceinline__ f32x4 mfma16(h16x8 a, h16x8 b, f32x4 c) { return __builtin_amdgcn_mfma_f32_16x16x32_f16(a, b, c, 0, 0, 0); }
__device__ __forceinline__ float wave_sum(float v) {
#pragma unroll
    for (int o = 1; o < 64; o <<= 1) v += __shfl_xor(v, o);
    return v;
}
__device__ __forceinline__ float ex2(float x) { return __builtin_amdgcn_exp2f(x); }
__device__ __forceinline__ float max3f(float a, float b, float c) { return __builtin_fmaxf(__builtin_fmaxf(a, b), c); }
__device__ __forceinline__ float rcp_(float x) { return __builtin_amdgcn_rcpf(x); }
__device__ __forceinline__ float rsq_(float x) { return __builtin_amdgcn_rsqf(x); }
__device__ __forceinline__ float sigmoidf_(float x) { return rcp_(1.f + __expf(-x)); }
__device__ __forceinline__ float siluf_(float x) { return x * rcp_(1.f + __expf(-x)); }
__device__ __forceinline__ float softplusf_(float x) { return fmaxf(x, 0.f) + log1pf(__expf(-fabsf(x))); }
typedef __bf16 bf16x2_t __attribute__((ext_vector_type(2)));
__device__ __forceinline__ unsigned pkb(float lo, float hi) { f32x2 v = {lo, hi}; bf16x2_t b = __builtin_convertvector(v, bf16x2_t); return __builtin_bit_cast(unsigned, b); }
__device__ __forceinline__ f32x4 unpk_bf4(u32x2 w) { return (f32x4){__uint_as_float(w.x << 16), __uint_as_float(w.x & 0xffff0000u), __uint_as_float(w.y << 16), __uint_as_float(w.y & 0xffff0000u)}; }
__device__ __forceinline__ unsigned pkh(float lo, float hi) { h16x2 v = {(h16)lo, (h16)hi}; return __builtin_bit_cast(unsigned, v); }

__device__ __forceinline__ int opaque_lane() { int t = __builtin_amdgcn_mbcnt_hi(~0u, __builtin_amdgcn_mbcnt_lo(~0u, 0u)); asm volatile("" : "+v"(t)); return t; }
constexpr float RSS_SCALE = 1048576.f, RSS_INV = 1.f / 1048576.f;
namespace pg8 {
typedef unsigned short bf16_t;
typedef __bf16 bf16x8_t __attribute__((ext_vector_type(8)));
constexpr int BM = 256, BK = 64, HALF = 128, HTB = HALF * BK * 2, STAGE_BYTES = 8 * HTB, NXCD = 8, WGM = 8;
__host__ __device__ __forceinline__ int lds_byte(int r, int c) { const int st = (r >> 4) * 2 + (c >> 5), rr = r & 15, cc = c & 31, ob = rr * 64 + cc * 2; return st * 1024 + (ob ^ (((ob >> 9) & 1) << 5)); }
__host__ __device__ __forceinline__ void stage_rc(int b, int& R, int& C) { const int st = b / 1024, sb = b % 1024, swz = sb ^ (((sb >> 9) & 1) << 5); R = (st >> 1) * 16 + swz / 64; C = (st & 1) * 32 + (swz % 64) / 2; }
__host__ __device__ __forceinline__ int perm32(int rho) { const int n = rho >> 4, i = rho & 15; return 8 * (i >> 2) + 4 * n + (i & 3); }
struct Unit { int pm, pn; };
struct Gemm { const bf16_t* A; const bf16_t* Bt; int M, N, K; };
struct StaticOrder {
    int nM, nN, nwg, G, c;
    __device__ void init(int M, int N, int G_, int c_) { nM = M / BM; nN = N / BM; nwg = nM * nN; G = G_; c = c_; }
    __device__ bool next(int i, Unit& u) const {
        const long L = (long)i * G + c; if (L >= nwg) return false;
        int wgid = (int)L; { const int q = nwg / NXCD, r = nwg % NXCD, xcd = wgid % NXCD, off = wgid / NXCD; wgid = (xcd < r ? xcd * (q + 1) : r * (q + 1) + (xcd - r) * q) + off; }
        const int nig = WGM * nN, gid = wgid / nig, fm = gid * WGM, gsz = (nM - fm) < WGM ? (nM - fm) : WGM;
        u.pm = fm + ((wgid % nig) % gsz); u.pn = (wgid % nig) / gsz; return true;
    }
};
struct EpiProj {
    static constexpr bool PERM = true;
    h16* O; float* PSM; const unsigned long long* ssq;
    __device__ __forceinline__ void operator()(const f32x4 (&acc)[2][2][4][2], const Unit& u, int wr, int wc, int fr, int fq) const {
        const int row0 = u.pm * BM + wr * 64 + fr, col0 = u.pn * BM + wc * 32 + 8 * fq;
        float rsv[2][4];
#pragma unroll
        for (int ai = 0; ai < 2; ++ai)
#pragma unroll
            for (int m = 0; m < 4; ++m) rsv[ai][m] = ssq ? (float)ssq[row0 + ai * HALF + m * 16] : 0.f;
#pragma unroll
        for (int ai = 0; ai < 2; ++ai)
#pragma unroll
            for (int m = 0; m < 4; ++m) rsv[ai][m] = ssq ? rsq_(rsv[ai][m] * (RSS_INV / DM) + EPS) : 1.f;
#pragma unroll
        for (int ai = 0; ai < 2; ++ai)
#pragma unroll
            for (int m = 0; m < 4; ++m) { const int row = row0 + ai * HALF + m * 16; const float rs = rsv[ai][m];
#pragma unroll
                for (int bj = 0; bj < 2; ++bj) { const f32x4 v0 = acc[ai][bj][m][0] * rs, v1 = acc[ai][bj][m][1] * rs; const int c = col0 + bj * HALF;
                    u32x4 w; w.x = pkh(v0[0], v0[1]); w.y = pkh(v0[2], v0[3]); w.z = pkh(v1[0], v1[1]); w.w = pkh(v1[2], v1[3]);
                    *(u32x4*)(O + (size_t)row * PN + c) = w;
                    if (c >= C_SM && c < C_SM + PSM_W) { float* p = PSM + (size_t)row * PSM_W + (c - C_SM); *(f32x4*)p = v0; *(f32x4*)(p + 4) = v1; } } }
    }
};
struct EpiHid {
    static constexpr bool PERM = true;
    h16* O; const unsigned long long* ssq;
    __device__ __forceinline__ void operator()(const f32x4 (&acc)[2][2][4][2], const Unit& u, int wr, int wc, int fr, int fq) const {
        const int row0 = u.pm * BM + wr * 64 + fr, col0 = u.pn * BM + wc * 32 + 8 * fq;
        float rsv[2][4];
#pragma unroll
        for (int ai = 0; ai < 2; ++ai)
#pragma unroll
            for (int m = 0; m < 4; ++m) rsv[ai][m] = (float)ssq[row0 + ai * HALF + m * 16];
#pragma unroll
        for (int ai = 0; ai < 2; ++ai)
#pragma unroll
            for (int m = 0; m < 4; ++m) rsv[ai][m] = rsq_(rsv[ai][m] * (RSS_INV / DM) + EPS);
#pragma unroll
        for (int ai = 0; ai < 2; ++ai)
#pragma unroll
            for (int m = 0; m < 4; ++m) { const int row = row0 + ai * HALF + m * 16; const float rs = rsv[ai][m];
#pragma unroll
                for (int bj = 0; bj < 2; ++bj) { f32x4 v0 = acc[ai][bj][m][0] * rs, v1 = acc[ai][bj][m][1] * rs;
#pragma unroll
                    for (int e = 0; e < 4; ++e) { float a = fmaxf(v0[e], 0.f), b = fmaxf(v1[e], 0.f); v0[e] = a * a; v1[e] = b * b; }
                    u32x4 w; w.x = pkb(v0[0], v0[1]); w.y = pkb(v0[2], v0[3]); w.z = pkb(v1[0], v1[1]); w.w = pkb(v1[2], v1[3]);
                    *(u32x4*)(O + (size_t)row * DFF + col0 + bj * HALF) = w; } }
    }
};
struct EpiRes {
    static constexpr bool PERM = true;
    const float* base32; h16* hs; unsigned long long* ssq;
    __device__ __forceinline__ float piece(size_t o, const f32x4& b0, const f32x4& b1, const f32x4& a0, const f32x4& a1) const {
        const f32x4 h0 = b0 + a0, h1 = b1 + a1;
        u32x4 w; w.x = pkb(h0[0], h0[1]); w.y = pkb(h0[2], h0[3]); w.z = pkb(h1[0], h1[1]); w.w = pkb(h1[2], h1[3]);
        *(u32x4*)(hs + o) = w;
        const f32x4 r0 = unpk_bf4((u32x2){w.x, w.y}), r1 = unpk_bf4((u32x2){w.z, w.w});
        return ((r0[0] * r0[0] + r0[1] * r0[1]) + (r0[2] * r0[2] + r0[3] * r0[3])) + ((r1[0] * r1[0] + r1[1] * r1[1]) + (r1[2] * r1[2] + r1[3] * r1[3]));
    }
    __device__ __forceinline__ void operator()(const f32x4 (&acc)[2][2][4][2], const Unit& u, int wr, int wc, int fr, int fq) const {
        const int col0 = u.pn * BM + wc * 32 + 8 * fq;
#pragma unroll
        for (int ai = 0; ai < 2; ++ai) { const int rowb = u.pm * BM + ai * HALF + wr * 64 + fr;
            if (base32) { f32x4 bf[4][2][2];
#pragma unroll
                for (int m = 0; m < 4; ++m)
#pragma unroll
                    for (int bj = 0; bj < 2; ++bj) { const float* bp = base32 + (size_t)(rowb + m * 16) * DM + col0 + bj * HALF; bf[m][bj][0] = *(const f32x4*)bp; bf[m][bj][1] = *(const f32x4*)(bp + 4); }
#pragma unroll
                for (int m = 0; m < 4; ++m) { const int row = rowb + m * 16; const size_t off = (size_t)row * DM + col0;
                    float sq = piece(off, bf[m][0][0], bf[m][0][1], acc[ai][0][m][0], acc[ai][0][m][1]) + piece(off + HALF, bf[m][1][0], bf[m][1][1], acc[ai][1][m][0], acc[ai][1][m][1]);
                    sq += __shfl_xor(sq, 16); sq += __shfl_xor(sq, 32);
                    if (fq == 0) atomicAdd(ssq + row, (unsigned long long)(sq * RSS_SCALE + 0.5f)); }
            } else { u32x4 bw[4][2];
#pragma unroll
                for (int m = 0; m < 4; ++m)
#pragma unroll
                    for (int bj = 0; bj < 2; ++bj) bw[m][bj] = *(const u32x4*)(hs + (size_t)(rowb + m * 16) * DM + col0 + bj * HALF);
#pragma unroll
                for (int m = 0; m < 4; ++m) { const int row = rowb + m * 16; const size_t off = (size_t)row * DM + col0;
                    float sq = piece(off, unpk_bf4((u32x2){bw[m][0].x, bw[m][0].y}), unpk_bf4((u32x2){bw[m][0].z, bw[m][0].w}), acc[ai][0][m][0], acc[ai][0][m][1])
                             + piece(off + HALF, unpk_bf4((u32x2){bw[m][1].x, bw[m][1].y}), unpk_bf4((u32x2){bw[m][1].z, bw[m][1].w}), acc[ai][1][m][0], acc[ai][1][m][1]);
                    sq += __shfl_xor(sq, 16); sq += __shfl_xor(sq, 32);
                    if (fq == 0) atomicAdd(ssq + row, (unsigned long long)(sq * RSS_SCALE + 0.5f)); }
            } }
    }
};

template <class Epi, bool BF = false>
__device__ __forceinline__ void gemm_phase(LAS unsigned char* lds, const Gemm g, const StaticOrder& S, const Epi& E, int wid) {
    const int lane = opaque_lane(), tid = wid * 64 + lane, wr = wid >> 2, wc = wid & 3, fr = lane & 15, fq = lane >> 4;
    const int K = g.K, nt = K / BK;
    unsigned voffA[2], voffB[2];
#pragma unroll
    for (int i = 0; i < 2; ++i) { int R, C; stage_rc(tid * 16 + i * 8192, R, C); const int Rb = Epi::PERM ? ((R & ~31) + perm32(R & 31)) : R;
        voffA[i] = (unsigned)(R * K + C) * 2u; voffB[i] = (unsigned)(Rb * K + C) * 2u; }
    const size_t kstep = (size_t)(BK * 2);
    const size_t hstep = (size_t)HALF * K * 2;
    const size_t tstep = 2 * hstep;
    const unsigned ldsw = (unsigned)wid * 1024u;
    const int aoff = lds_byte(wr * 64 + fr, fq * 8), boff = lds_byte(wc * 32 + fr, fq * 8);
#define PG8_SA(b, h) (((b) * 2 + (h)) * HTB)
#define PG8_SB(b, h) ((4 + (b) * 2 + (h)) * HTB)
#define PG8_STAGE(bufoff, gbase, voff) do { _Pragma("unroll") for (int _i = 0; _i < 2; ++_i) \
        __builtin_amdgcn_global_load_lds((const unsigned*)((const char*)(gbase) + (voff)[_i]), (LAS unsigned*)(lds + (bufoff) + ldsw + _i * 8192), 16, 0, 0); } while (0)
#define PG8_LDA(dst, b, h) do { _Pragma("unroll") for (int m = 0; m < 4; ++m) _Pragma("unroll") for (int k = 0; k < 2; ++k) dst[m][k] = *(const LAS h16x8*)(lds + PG8_SA(b, h) + aoff + m * 2048 + k * 1024); } while (0)
#define PG8_LDB(dst, b, h) do { _Pragma("unroll") for (int n = 0; n < 2; ++n) _Pragma("unroll") for (int k = 0; k < 2; ++k) dst[n][k] = *(const LAS h16x8*)(lds + PG8_SB(b, h) + boff + n * 2048 + k * 1024); } while (0)
#define PG8_MMA(ai, bj, At, Bt) do { __builtin_amdgcn_s_setprio(1); _Pragma("unroll") for (int m = 0; m < 4; ++m) _Pragma("unroll") for (int n = 0; n < 2; ++n) _Pragma("unroll") for (int k = 0; k < 2; ++k) \
        acc[ai][bj][m][n] = BF ? __builtin_amdgcn_mfma_f32_16x16x32_bf16(__builtin_bit_cast(bf16x8_t, Bt[n][k]), __builtin_bit_cast(bf16x8_t, At[m][k]), acc[ai][bj][m][n], 0, 0, 0) : __builtin_amdgcn_mfma_f32_16x16x32_f16(Bt[n][k], At[m][k], acc[ai][bj][m][n], 0, 0, 0); __builtin_amdgcn_s_setprio(0); } while (0)
#define PG8_WAIT_V(n) asm volatile("s_waitcnt vmcnt(" #n ")" ::: "memory")
#define PG8_WAIT_L(n) asm volatile("s_waitcnt lgkmcnt(" #n ")" ::: "memory")
#define PG8_BAR __builtin_amdgcn_s_barrier()
#define PG8_SCHED __builtin_amdgcn_sched_barrier(0)
    Unit cur, nxt; int ui = 0;
    if (!S.next(0, cur)) return;
    f32x4 acc[2][2][4][2];
#pragma unroll
    for (int a = 0; a < 2; ++a)
#pragma unroll
        for (int b = 0; b < 2; ++b)
#pragma unroll
            for (int m = 0; m < 4; ++m)
#pragma unroll
                for (int n = 0; n < 2; ++n) acc[a][b][m][n] = (f32x4){0.f, 0.f, 0.f, 0.f};
    h16x8 At[4][2], B0[2][2], B1[2][2];
    const char* cA = (const char*)g.A + (size_t)cur.pm * tstep; const char* cB = (const char*)g.Bt + (size_t)cur.pn * tstep;
    PG8_STAGE(PG8_SB(0, 0), cB, voffB); PG8_STAGE(PG8_SB(0, 1), cB + hstep, voffB); PG8_STAGE(PG8_SA(0, 0), cA, voffA); PG8_STAGE(PG8_SA(0, 1), cA + hstep, voffA);
    if (wr == 1) PG8_BAR;
    PG8_WAIT_V(2); PG8_BAR;
    PG8_STAGE(PG8_SB(1, 0), cB + kstep, voffB); PG8_STAGE(PG8_SA(1, 0), cA + kstep, voffA); PG8_STAGE(PG8_SB(1, 1), cB + hstep + kstep, voffB);
    PG8_WAIT_V(6); PG8_BAR;
    for (;;) {
        const bool has_next = S.next(ui + 1, nxt);
        const char* nA = has_next ? (const char*)g.A + (size_t)nxt.pm * tstep : cA; const char* nB = has_next ? (const char*)g.Bt + (size_t)nxt.pn * tstep : cB;
        for (int t = 0; t < nt; t += 2) {
            const bool last = (t == nt - 2);
            const char* a1 = cA + (size_t)(t + 1) * kstep;
            const char* a2 = last ? nA : cA + (size_t)(t + 2) * kstep; const char* b2 = last ? nB : cB + (size_t)(t + 2) * kstep;
            const char* a3 = a2 + kstep; const char* b3 = b2 + kstep;
            PG8_LDB(B0, 0, 0); PG8_LDB(B1, 0, 1); PG8_SCHED; PG8_LDA(At, 0, 0); PG8_STAGE(PG8_SA(1, 1), a1 + hstep, voffA);
            PG8_WAIT_V(8); PG8_WAIT_L(0); PG8_BAR; PG8_MMA(0, 0, At, B0); PG8_MMA(0, 1, At, B1); PG8_BAR; PG8_SCHED;
            PG8_LDA(At, 0, 1); PG8_STAGE(PG8_SB(0, 0), b2, voffB); PG8_STAGE(PG8_SB(0, 1), b2 + hstep, voffB); PG8_STAGE(PG8_SA(0, 0), a2, voffA);
            PG8_WAIT_V(8); PG8_WAIT_L(0); PG8_BAR; PG8_MMA(1, 0, At, B0); PG8_MMA(1, 1, At, B1); PG8_BAR; PG8_SCHED;
            PG8_LDB(B0, 1, 0); PG8_LDB(B1, 1, 1); PG8_SCHED; PG8_LDA(At, 1, 0); PG8_STAGE(PG8_SA(0, 1), a2 + hstep, voffA);
            PG8_WAIT_V(8); PG8_WAIT_L(0); PG8_BAR; PG8_MMA(0, 0, At, B0); PG8_MMA(0, 1, At, B1); PG8_BAR; PG8_SCHED;
            PG8_LDA(At, 1, 1); PG8_STAGE(PG8_SB(1, 0), b3, voffB); PG8_STAGE(PG8_SB(1, 1), b3 + hstep, voffB); PG8_STAGE(PG8_SA(1, 0), a3, voffA);
            PG8_WAIT_V(8); PG8_WAIT_L(0); PG8_BAR; PG8_MMA(1, 0, At, B0); PG8_MMA(1, 1, At, B1); PG8_BAR; PG8_SCHED;
        }
        if (wr == 0) PG8_BAR;
        E(acc, cur, wr, wc, fr, fq);
        if (!has_next) break;
#pragma unroll
        for (int a = 0; a < 2; ++a)
#pragma unroll
            for (int b = 0; b < 2; ++b)
#pragma unroll
                for (int m = 0; m < 4; ++m)
#pragma unroll
                    for (int n = 0; n < 2; ++n) acc[a][b][m][n] = (f32x4){0.f, 0.f, 0.f, 0.f};
        cur = nxt; cA = nA; cB = nB; ++ui;
        if (wr == 1) PG8_BAR;
    }
    PG8_WAIT_V(0);
    PG8_BAR;
#undef PG8_SA
#undef PG8_SB
#undef PG8_STAGE
#undef PG8_LDA
#undef PG8_LDB
#undef PG8_MMA
#undef PG8_WAIT_V
#undef PG8_WAIT_L
#undef PG8_BAR
#undef PG8_SCHED
}
}


#define XB_TMO      128
#define XB_XCNT(j)  (256  + 64 * (j))
#define XB_XSUB(j)  (1280 + 64 * (j))
#define XB_XGEN(j)  (2304 + 64 * (j))
#define XB_TOP      3328
#define XB_TOPGEN   3392
#define XCD_BAR_WORDS 3456
#define XB_SPIN_CAP (1u << 18)
__device__ __forceinline__ unsigned xb_ld(unsigned* p)              { return __hip_atomic_load(p, __ATOMIC_RELAXED, __HIP_MEMORY_SCOPE_AGENT); }
__device__ __forceinline__ unsigned xb_add(unsigned* p, unsigned v) { return __hip_atomic_fetch_add(p, v, __ATOMIC_RELAXED, __HIP_MEMORY_SCOPE_AGENT); }
__device__ __forceinline__ unsigned xb_xcc_id() { return (unsigned)__builtin_amdgcn_s_getreg((3 << 11) | 20) & 0xFu; }
#define XB_SPIN(cond, bar) do { unsigned _sp = 0; while (cond) { __builtin_amdgcn_s_sleep(1); \
    if ((++_sp & 255u) == 0u) { if (xb_ld(&(bar)[XB_TMO])) break; if (_sp > XB_SPIN_CAP) { atomicAdd(&(bar)[XB_TMO], 1u); break; } } } } while (0)
struct XcdBarrier { unsigned* bar; unsigned x; volatile LAS unsigned* st; int wv; };
__device__ __forceinline__ XcdBarrier xcd_barrier_post(unsigned* bar, volatile LAS unsigned* st, int wv) {
    XcdBarrier b; b.bar = bar; b.x = xb_xcc_id(); b.st = st; b.wv = wv;
    if (wv == 0 && opaque_lane() == 0) (void)xb_add(&bar[XB_XCNT(b.x)], 1u);
    return b;
}
__device__ __forceinline__ void xcd_barrier_complete(unsigned* bar, unsigned x, unsigned& nloc, unsigned& nx) {
    const unsigned G = gridDim.x * gridDim.y * gridDim.z;
    unsigned sum, cnt, mine, sp = 0u;
    for (;;) {
        sum = 0u; cnt = 0u; mine = 0u;
#pragma unroll
        for (unsigned j = 0; j < 16; ++j) { const unsigned c = xb_ld(&bar[XB_XCNT(j)]); sum += c; cnt += (c > 0u) ? 1u : 0u; mine = (j == x) ? c : mine; }
        if (sum == G) break;
        __builtin_amdgcn_s_sleep(1);
        if ((++sp & 255u) == 0u) { if (xb_ld(&bar[XB_TMO])) break; if (sp > XB_SPIN_CAP) { atomicAdd(&bar[XB_TMO], 1u); break; } }
    }
    nloc = mine > 0u ? mine : 1u; nx = cnt > 0u ? cnt : 1u;
}
__device__ __forceinline__ void xcd_barrier(const XcdBarrier& b) {
    asm volatile("s_waitcnt vmcnt(0)" ::: "memory");
    __syncthreads();
    if (b.wv == 0 && opaque_lane() == 0) {
        unsigned* bar = b.bar;
        __builtin_amdgcn_s_waitcnt(0);
        unsigned nloc = b.st[0], nx = b.st[1];
        if (nloc == 0u) { xcd_barrier_complete(bar, b.x, nloc, nx); b.st[0] = nloc; b.st[1] = nx; }
        const unsigned old = xb_add(&bar[XB_XSUB(b.x)], 1u);
        const unsigned gen = old / nloc;
        if (old + 1u == (gen + 1u) * nloc) {
            __builtin_amdgcn_fence(__ATOMIC_RELEASE, "agent");
            asm volatile("s_waitcnt vmcnt(0)" ::: "memory");
            const unsigned og = xb_add(&bar[XB_TOP], 1u);
            const unsigned tg = og / nx;
            if (og + 1u == (tg + 1u) * nx) xb_add(&bar[XB_TOPGEN], 1u);
            else XB_SPIN(xb_ld(&bar[XB_TOPGEN]) == tg, bar);
            __builtin_amdgcn_fence(__ATOMIC_ACQUIRE, "agent");
            xb_add(&bar[XB_XGEN(b.x)], 1u);
            asm volatile("s_waitcnt vmcnt(0)" ::: "memory");
        } else {
            XB_SPIN(xb_ld(&bar[XB_XGEN(b.x)]) == gen, bar);
            __builtin_amdgcn_fence(__ATOMIC_ACQUIRE, "agent");
            asm volatile("s_waitcnt vmcnt(0)" ::: "memory");
        }
    }
    __syncthreads();
}

#define TIDS const int lane = opaque_lane(); const int wave = C.wv; const int tid = wave * 64 + lane; (void)tid;
struct Ctx {
    const float* in[24]; float* out; unsigned char* ws;
    int G, bid, wv;
    h16 *WIN, *WOUT, *WUP, *WDN, *W1T, *W2T, *XN, *PROJ, *HID, *XBCC, *KC, *VC;
    h16* SSDST; unsigned long long* RSS; float *B1P, *B1, *ROPE, *GLAST, *PSM, *SSQ, *DTV, *ACS, *CD, *GLAG; h16* H16;
};
__device__ __forceinline__ void make_ctx(Ctx& C, const Params* kp, int wv) {
    C.wv = wv;
#pragma unroll
    for (int i = 0; i < 24; ++i) C.in[i] = kp->in[i];
    C.out = kp->out; unsigned char* ws = kp->ws; C.ws = ws; C.G = gridDim.x; C.bid = blockIdx.x;
    C.WIN = (h16*)(ws + WS_WIN); C.WOUT = (h16*)(ws + WS_WOUT); C.WUP = (h16*)(ws + WS_WUP); C.WDN = (h16*)(ws + WS_WDN); C.W1T = (h16*)(ws + WS_W1T); C.W2T = (h16*)(ws + WS_W2T);
    C.XN = (h16*)(ws + WS_XN); C.PROJ = (h16*)(ws + WS_PROJ); C.HID = (h16*)(ws + WS_HID); C.XBCC = (h16*)kp->out;      C.KC = (h16*)(ws + WS_KC); C.VC = (h16*)(ws + WS_VC);
    C.B1 = (float*)(ws + WS_B1); C.B1P = (float*)(ws + WS_B1P); C.ROPE = (float*)(ws + WS_ROPE); C.SSDST = (h16*)(ws + WS_SSDST); C.RSS = (unsigned long long*)(ws + WS_RSS); C.H16 = (h16*)(ws + WS_H16); C.GLAST = (float*)(ws + WS_GLAST); C.PSM = (float*)(ws + WS_PSM);
    C.SSQ = (float*)(ws + WS_SSQ); C.DTV = (float*)(ws + WS_DTV); C.ACS = (float*)(ws + WS_ACS); C.CD = (float*)(ws + WS_CD); C.GLAG = (float*)(ws + WS_GLAG);
}

__device__ __forceinline__ int win_src_col(int n) {
    if (n < 512) return n;
    if (n < 768) return n - 512 + 528;
    if (n < 1024) return n - 768 + 784;
    if (n < 1792) return n - 1024 + 1040;
    if (n < 2304) return n - 1792 + 1820;
    if (n < 3328) return n - 2304 + 2332;
    const int r = n - 3328;
    if (r < 16) return 512 + r;
    if (r < 28) return 1808 + (r - 16);
    if (r < 36) return 3356 + (r - 28);
    return -1;
}
template <bool MAPW, bool OBF = false>
__device__ __forceinline__ void transpose_item(const float* W, int K, int Nsrc, int Ndst, h16* WT, const float* kscale, float* scr, int item, int lane) {
    const int nblk = Ndst / 32, kb = item / nblk, nb = item % nblk, k0 = 64 * kb, n0 = 32 * nb;
    const int nd = n0 + (lane & 31); const int sc = MAPW ? win_src_col(nd) : nd;
    float vv[32];
#pragma unroll
    for (int i = 0; i < 32; ++i) { const int kk = 2 * i + (lane >> 5); vv[i] = (sc >= 0) ? W[(size_t)(k0 + kk) * Nsrc + sc] : 0.f; }
#pragma unroll
    for (int i = 0; i < 32; ++i) { const int kk = 2 * i + (lane >> 5); scr[kk * 33 + (lane & 31)] = kscale ? vv[i] * kscale[k0 + kk] : vv[i]; }
    asm volatile("s_waitcnt lgkmcnt(0)" ::: "memory");
    const int c = lane & 7;
#pragma unroll
    for (int j = 0; j < 4; ++j) { const int n = (lane >> 3) + 8 * j; const float* s = scr + (8 * c) * 33 + n;
        u32x4 o; if (OBF) { o.x = pkb(s[0 * 33], s[1 * 33]); o.y = pkb(s[2 * 33], s[3 * 33]); o.z = pkb(s[4 * 33], s[5 * 33]); o.w = pkb(s[6 * 33], s[7 * 33]); } else { o.x = pkh(s[0 * 33], s[1 * 33]); o.y = pkh(s[2 * 33], s[3 * 33]); o.z = pkh(s[4 * 33], s[5 * 33]); o.w = pkh(s[6 * 33], s[7 * 33]); }
        *(u32x4*)(WT + (size_t)(n0 + n) * K + k0 + 8 * c) = o; }
    asm volatile("s_waitcnt lgkmcnt(0)" ::: "memory");
}
__device__ __forceinline__ void rms_row_to_h16(const float* xrow, h16* orow, int lane) {
    const f32x4* xr = (const f32x4*)xrow + lane; f32x4 v[4]; float s = 0.f;
#pragma unroll
    for (int j = 0; j < 4; ++j) { v[j] = xr[64 * j]; s += (v[j].x * v[j].x + v[j].y * v[j].y) + (v[j].z * v[j].z + v[j].w * v[j].w); }
    const float rs = rsq_(wave_sum(s) * (1.f / DM) + EPS);
    u32x2* o8 = (u32x2*)orow + lane;
#pragma unroll
    for (int j = 0; j < 4; ++j) { u32x2 w; w.x = pkh(v[j].x * rs, v[j].y * rs); w.y = pkh(v[j].z * rs, v[j].w * rs); o8[64 * j] = w; }
}
__device__ __forceinline__ void sincos_acc(float angf, float& c, float& s) {
    const double x = (double)angf; const double n = __builtin_rint(x * 0.63661977236758134308);
    const double r = __builtin_fma(-n, 1.5707963267948966192, x) - n * 6.123233995736766036e-17;
    const double r2 = r * r;
    double sp = -7.6471637318198164759e-13; sp = sp * r2 + 1.6059043836821614599e-10; sp = sp * r2 - 2.5052108385441718775e-08; sp = sp * r2 + 2.7557319223985890653e-06;
    sp = sp * r2 - 1.9841269841269841270e-04; sp = sp * r2 + 8.3333333333333333333e-03; sp = sp * r2 - 1.6666666666666666667e-01; const double sn = r + r * r2 * sp;
    double cp = 4.7794773323873852974e-14; cp = cp * r2 - 1.1470745597729724714e-11; cp = cp * r2 + 2.0876756987868098979e-09; cp = cp * r2 - 2.7557319223985890653e-07;
    cp = cp * r2 + 2.4801587301587301587e-05; cp = cp * r2 - 1.3888888888888888889e-03; cp = cp * r2 + 4.1666666666666666667e-02; cp = cp * r2 - 0.5; const double cs = 1.0 + r2 * cp;
    const int q = ((int)n) & 3;
    const double so = (q == 0) ? sn : (q == 1) ? cs : (q == 2) ? -sn : -cs;
    const double co = (q == 0) ? cs : (q == 1) ? -sn : (q == 2) ? -cs : sn;
    c = (float)co; s = (float)so;
}
__device__ __forceinline__ void phase_prep(const Ctx& C) {
    TIDS
    float* scr = (float*)(g_lds) + wave * (64 * 33);
    const int gw = C.bid * 8 + wave, NGW = C.G * 8;
    constexpr int I_IN = 16 * (PN / 32), I_OUT = 16 * 32, I_UP = 16 * 128, I_DN = 64 * 32, I_W1 = 32 * 4, I_W2 = 2 * 2;
    constexpr int PER_L = I_IN + I_OUT + I_UP + I_DN + 2 * I_W1 + 2 * I_W2;
    for (int it = gw; it < DEPTH * PER_L; it += NGW) {
        const int l = it / PER_L; int r = it % PER_L;
        if (r < I_IN) { transpose_item<true, true>(C.in[2] + (size_t)l * DM * DIN, DM, DIN, PN, C.WIN + (size_t)l * PN * DM, C.in[1] + l * DM, scr, r, lane); continue; } r -= I_IN;
        if (r < I_OUT) { transpose_item<false, true>(C.in[19] + (size_t)l * DM * DM, DM, DM, DM, C.WOUT + (size_t)l * DM * DM, nullptr, scr, r, lane); continue; } r -= I_OUT;
        if (r < I_UP) { transpose_item<false, true>(C.in[21] + (size_t)l * DM * DFF, DM, DFF, DFF, C.WUP + (size_t)l * DFF * DM, C.in[20] + l * DM, scr, r, lane); continue; } r -= I_UP;
        if (r < I_DN) { transpose_item<false, true>(C.in[22] + (size_t)l * DFF * DM, DFF, DM, DM, C.WDN + (size_t)l * DM * DFF, nullptr, scr, r, lane); continue; } r -= I_DN;
        if (r < 2 * I_W1) { const int kv = r / I_W1; transpose_item<false>(C.in[kv ? 10 : 7] + (size_t)l * 2048 * 128, 2048, 128, 128, C.W1T + (size_t)(l * 2 + kv) * 128 * 2048, nullptr, scr, r % I_W1, lane); continue; } r -= 2 * I_W1;
        { const int kv = r / I_W2; transpose_item<false>(C.in[kv ? 11 : 8] + (size_t)l * 128 * 64, 128, 64, 64, C.W2T + (size_t)(l * 2 + kv) * 64 * 128, nullptr, scr, r % I_W2, lane); }
    }
    for (int it = gw; it < DEPTH * 2 * 32; it += NGW) {
        const int lk = it >> 5, fc = it & 31, l = lk >> 1, kv = lk & 1;
        const float* pos = C.in[kv ? 9 : 6] + (size_t)l * 2048 + fc * 64; const float* w1 = C.in[kv ? 10 : 7] + (size_t)l * 2048 * 128 + (size_t)fc * 64 * 128;
        float s0 = 0.f, s1 = 0.f;
#pragma unroll 16
        for (int f = 0; f < 64; ++f) { const float pv = pos[f]; s0 += pv * w1[f * 128 + lane]; s1 += pv * w1[f * 128 + 64 + lane]; }
        C.B1P[(size_t)it * 128 + lane] = s0; C.B1P[(size_t)it * 128 + 64 + lane] = s1;
    }
    for (int e = C.bid * 512 + tid; e < SEQ * 32; e += C.G * 512) {
        const int pos = e >> 5, i = e & 31; const float ang = (float)pos * ROPE_INV[i];
        float cs, sn; sincos_acc(ang, cs, sn); C.ROPE[2 * e] = cs; C.ROPE[2 * e + 1] = sn;
    }
    for (int e = C.bid * 512 + tid; e < 2 * DEPTH * MTOK; e += C.G * 512) C.RSS[e] = 0ull;
    for (int m0 = gw * 4; m0 < MTOK; m0 += NGW * 4) {
        f32x4 v[4][4]; float ss[4];
#pragma unroll
        for (int r = 0; r < 4; ++r) { const f32x4* xr = (const f32x4*)(C.in[0] + (size_t)(m0 + r) * DM) + lane;
#pragma unroll
            for (int j = 0; j < 4; ++j) v[r][j] = xr[64 * j]; }
#pragma unroll
        for (int r = 0; r < 4; ++r) { float sq = 0.f;
#pragma unroll
            for (int j = 0; j < 4; ++j) sq += (v[r][j].x * v[r][j].x + v[r][j].y * v[r][j].y) + (v[r][j].z * v[r][j].z + v[r][j].w * v[r][j].w);
            ss[r] = sq; }
#pragma unroll
        for (int o = 1; o < 64; o <<= 1) {
#pragma unroll
            for (int r = 0; r < 4; ++r) ss[r] += __shfl_xor(ss[r], o); }
#pragma unroll
        for (int r = 0; r < 4; ++r) { const float rs = rsq_(ss[r] * (1.f / DM) + EPS); u32x2* o8 = (u32x2*)(C.XN + (size_t)(m0 + r) * DM) + lane;
#pragma unroll
            for (int j = 0; j < 4; ++j) { u32x2 w; w.x = pkb(v[r][j].x * rs, v[r][j].y * rs); w.y = pkb(v[r][j].z * rs, v[r][j].w * rs); o8[64 * j] = w; } }
    }
}

__device__ __forceinline__ void phase_tok(const Ctx& C, int l) {
    TIDS
    const int gw = C.bid * 8 + wave, NGW = C.G * 8;
    if (l == 0 && C.bid == 0) { float sb = 0.f; const float* pp = C.B1P + (size_t)(tid >> 7) * 32 * 128 + (tid & 127);
        for (int fc = 0; fc < 32; ++fc) sb += pp[fc * 128];
        C.B1[tid] = sb; }
    float* Wl = (float*)g_lds;
    { const float* cw = C.in[13] + (size_t)l * 4 * 1024; const float* cb = C.in[14] + (size_t)l * 1024;
        for (int e = tid; e < 5 * 256; e += 512) { const int r = e >> 8, c4 = e & 255; *(f32x4*)(Wl + r * 1024 + c4 * 4) = (r < 4) ? *(const f32x4*)(cw + r * 1024 + c4 * 4) : *(const f32x4*)(cb + c4 * 4); } }
    __syncthreads();
    const float* dtb = C.in[15] + l * 8;
    const int ch = lane * 16;
    const int rtk = lane >> 4, hd = (lane >> 2) & 3, c8 = (lane & 3) * 8;
    const int rbase = (hd < 2) ? (C_KSLC + hd * 64) : (C_KWIN + (hd - 2) * 64);
    const float dbias = dtb[lane & 7];
    for (int run = gw; run < MTOK / 16; run += NGW) {
        const int m0 = run * 16, t0 = m0 & (SEQ - 1);
        h16x8 hist[3][2];
#pragma unroll
        for (int i = 0; i < 3; ++i) { const int tt = t0 - 3 + i;
            if (tt >= 0) { const h16* src = C.PROJ + (size_t)(m0 - 3 + i) * PN + C_SX + ch; hist[i][0] = *(const h16x8*)src; hist[i][1] = *(const h16x8*)(src + 8); }
            else { hist[i][0] = (h16x8){}; hist[i][1] = (h16x8){}; } }
#pragma unroll 1
        for (int half = 0; half < 2; ++half) { const int mb = m0 + 8 * half, tb0 = t0 + 8 * half;
            h16x8 cr[8][2];
#pragma unroll
            for (int k = 0; k < 8; ++k) { const h16* src = C.PROJ + (size_t)(mb + k) * PN + C_SX + ch; cr[k][0] = *(const h16x8*)src; cr[k][1] = *(const h16x8*)(src + 8); }
            h16x8 x1[2], x2[2];
#pragma unroll
            for (int rb = 0; rb < 2; ++rb) { const int k = 4 * rb + rtk; const h16* prow = C.PROJ + (size_t)(mb + k) * PN;
                x1[rb] = *(const h16x8*)(prow + rbase + c8); x2[rb] = *(const h16x8*)(prow + rbase + 32 + c8); }
            const float dtr = C.PSM[(size_t)(mb + (lane >> 3)) * PSM_W + 28 + (lane & 7)];
            C.DTV[(size_t)(mb + (lane >> 3)) * 8 + (lane & 7)] = softplusf_(dtr + dbias);
#pragma unroll
            for (int rb = 0; rb < 2; ++rb) { const int k = 4 * rb + rtk; h16* prow = C.PROJ + (size_t)(mb + k) * PN; h16x8 y1, y2; f32x4 tb[4];
#pragma unroll
                for (int i = 0; i < 4; ++i) tb[i] = *(const f32x4*)(C.ROPE + 2 * ((tb0 + k) * 32 + c8) + 4 * i);
#pragma unroll
                for (int e = 0; e < 8; ++e) { const float cs = tb[e >> 1][2 * (e & 1)], sn = tb[e >> 1][2 * (e & 1) + 1]; const float a1 = (float)x1[rb][e], a2 = (float)x2[rb][e];
                    y1[e] = (h16)(a1 * cs - a2 * sn); y2[e] = (h16)(a2 * cs + a1 * sn); }
                *(h16x8*)(prow + rbase + c8) = y1; *(h16x8*)(prow + rbase + 32 + c8) = y2; }
#pragma unroll
            for (int k = 0; k < 8; ++k) { float a[16];
#pragma unroll
                for (int q4 = 0; q4 < 4; ++q4) { const f32x4 bv = *(const f32x4*)(Wl + 4 * 1024 + ch + 4 * q4), w0 = *(const f32x4*)(Wl + ch + 4 * q4), w1 = *(const f32x4*)(Wl + 1024 + ch + 4 * q4),
                        w2 = *(const f32x4*)(Wl + 2048 + ch + 4 * q4), w3 = *(const f32x4*)(Wl + 3072 + ch + 4 * q4);
#pragma unroll
                    for (int e = 0; e < 4; ++e) { const int ee = 4 * q4 + e, hh = ee >> 3, ei = ee & 7;
                        a[ee] = bv[e] + w0[e] * (float)hist[0][hh][ei] + w1[e] * (float)hist[1][hh][ei] + w2[e] * (float)hist[2][hh][ei] + w3[e] * (float)cr[k][hh][ei]; } }
                hist[0][0] = hist[1][0]; hist[0][1] = hist[1][1]; hist[1][0] = hist[2][0]; hist[1][1] = hist[2][1]; hist[2][0] = cr[k][0]; hist[2][1] = cr[k][1];
                u32x4 o0, o1; o0.x = pkh(siluf_(a[0]), siluf_(a[1])); o0.y = pkh(siluf_(a[2]), siluf_(a[3])); o0.z = pkh(siluf_(a[4]), siluf_(a[5])); o0.w = pkh(siluf_(a[6]), siluf_(a[7]));
                o1.x = pkh(siluf_(a[8]), siluf_(a[9])); o1.y = pkh(siluf_(a[10]), siluf_(a[11])); o1.z = pkh(siluf_(a[12]), siluf_(a[13])); o1.w = pkh(siluf_(a[14]), siluf_(a[15]));
                h16* dst = C.XBCC + (size_t)(mb + k) * 1024 + ch; *(u32x4*)dst = o0; *(u32x4*)(dst + 8) = o1; }
        }
    }
    __syncthreads();
}

__device__ __forceinline__ float gelu_tanh(float x) { const float u = 0.7978845608028654f * (x + 0.044715f * x * x * x); const float e = __expf(2.f * u); const float th = 1.f - 2.f * rcp_(e + 1.f); return 0.5f * x * (1.f + th); }
__device__ __forceinline__ void nsa_compress_unit(const Ctx& C, int l, int u) {
    const int kv = u >> 7, b = (u >> 5) & 3, g = (u >> 4) & 1, mt2 = u & 15;
    TIDS
    const int w = wave, cc = lane & 15, quad = lane >> 4;
    h16* As = (h16*)g_lds;
    h16* Hs = (h16*)(g_lds + 2 * 272 * 72 * 2);
    const h16* W1T = C.W1T + (size_t)(l * 2 + kv) * 128 * 2048; const h16* W2T = C.W2T + (size_t)(l * 2 + kv) * 64 * 128; const float* B1 = C.B1 + (l * 2 + kv) * 128;
    const int col = (kv ? C_VCMP : C_KCMP) + g * 64;
    const h16* brow = W1T + (size_t)(w * 16 + cc) * 2048 + quad * 8;
    h16x8 wc[16], w2f[4];
#pragma unroll
    for (int i = 0; i < 16; ++i) wc[i] = *(const h16x8*)(brow + i * 32);
#pragma unroll
    for (int kk = 0; kk < 4; ++kk) w2f[kk] = *(const h16x8*)(W2T + (size_t)((w & 3) * 16 + cc) * 128 + kk * 32 + quad * 8);
    {
        h16x8 s1[5], s2[5]; f32x4 tb[5][4];
#pragma unroll
        for (int i = 0; i < 5; ++i) { const int pc = tid + 512 * i; if (pc < 2 * 272 * 4) { const int half = pc / (272 * 4), rem = pc % (272 * 4), t = rem >> 2, c4 = rem & 3;
                int tok = 256 * mt2 + 4096 * half + t; tok = tok < SEQ ? tok : SEQ - 1; const h16* src = C.PROJ + (size_t)(b * SEQ + tok) * PN + col + c4 * 8;
                s1[i] = *(const h16x8*)src; s2[i] = *(const h16x8*)(src + 32);
                if (kv == 0) {
#pragma unroll
                    for (int q4 = 0; q4 < 4; ++q4) tb[i][q4] = *(const f32x4*)(C.ROPE + 2 * (tok * 32 + c4 * 8) + 4 * q4); } } }
#pragma unroll
        for (int i = 0; i < 5; ++i) { const int pc = tid + 512 * i; if (pc < 2 * 272 * 4) { const int half = pc / (272 * 4), rem = pc % (272 * 4), t = rem >> 2, c4 = rem & 3;
                h16x8 y1 = s1[i], y2 = s2[i];
                if (kv == 0) {
#pragma unroll
                    for (int e = 0; e < 8; ++e) { const float cs = tb[i][e >> 1][2 * (e & 1)], sn = tb[i][e >> 1][2 * (e & 1) + 1]; const float a1 = (float)s1[i][e], a2 = (float)s2[i][e];
                        y1[e] = (h16)(a1 * cs - a2 * sn); y2[e] = (h16)(a2 * cs + a1 * sn); } }
                *(h16x8*)(As + (half * 272 + t) * 72 + c4 * 8) = y1; *(h16x8*)(As + (half * 272 + t) * 72 + 32 + c4 * 8) = y2; } } }
    __syncthreads();
    f32x4 acc0 = {0.f, 0.f, 0.f, 0.f}, acc1 = {0.f, 0.f, 0.f, 0.f};
    const h16* a0p = As + (16 * cc) * 72 + quad * 8; const h16* a1p = a0p + 272 * 72;
#pragma unroll
    for (int bt = 0; bt < 4; ++bt) { h16x8 wn[16];
        if (bt < 3) {
#pragma unroll
            for (int i = 0; i < 16; ++i) wn[i] = *(const h16x8*)(brow + (16 * (bt + 1) + i) * 32); }
        __builtin_amdgcn_sched_barrier(0);
#pragma unroll
        for (int i = 0; i < 16; ++i) { const int kk = 16 * bt + i;
            const h16x8 a0 = *(const h16x8*)(a0p + (kk >> 1) * 72 + (kk & 1) * 32);
            const h16x8 a1 = *(const h16x8*)(a1p + (kk >> 1) * 72 + (kk & 1) * 32);
            acc0 = mfma16(a0, wc[i], acc0); acc1 = mfma16(a1, wc[i], acc1); }
        if (bt < 3) {
#pragma unroll
            for (int i = 0; i < 16; ++i) wc[i] = wn[i]; } }
    { const float bias = B1[w * 16 + cc];
#pragma unroll
        for (int j = 0; j < 4; ++j) { Hs[(quad * 4 + j) * 136 + w * 16 + cc] = (h16)gelu_tanh(acc0[j] + bias); Hs[(16 + quad * 4 + j) * 136 + w * 16 + cc] = (h16)gelu_tanh(acc1[j] + bias); } }
    __syncthreads();
    { const int half = w >> 2, wn = w & 3;
        f32x4 o = {0.f, 0.f, 0.f, 0.f};
#pragma unroll
        for (int kk = 0; kk < 4; ++kk) { const h16x8 a = *(const h16x8*)(Hs + (half * 16 + cc) * 136 + kk * 32 + quad * 8); o = mfma16(a, w2f[kk], o); }
        h16* dst = (kv ? C.VC : C.KC) + (size_t)((b * 2 + g) * 512 + (mt2 + 16 * half) * 16) * 64;
#pragma unroll
        for (int j = 0; j < 4; ++j) dst[(quad * 4 + j) * 64 + wn * 16 + cc] = (h16)o[j];
    }
    __syncthreads();
}

__device__ __forceinline__ h16x4 tr_read(const h16* p) { typedef short s16x4 __attribute__((ext_vector_type(4))); return __builtin_bit_cast(h16x4, __builtin_amdgcn_ds_read_tr16_b64_v4i16((LAS s16x4*)p)); }
__device__ __forceinline__ h16x8 cat44(h16x4 lo, h16x4 hi) { return (h16x8){lo[0], lo[1], lo[2], lo[3], hi[0], hi[1], hi[2], hi[3]}; }
struct SsdPre { float dt, alog; h16x8 x[2]; h16x8 bq[4]; };
__device__ __forceinline__ void ssd_states_load(const Ctx& C, int l, int u, int tid, SsdPre& P) {
    const int b = u >> 9, c = (u >> 3) & 63, h = u & 7, g = h >> 2; const size_t row0 = (size_t)b * SEQ + c * 128;
    P.alog = C.in[16][l * 8 + h];
    P.dt = (tid < 128) ? C.DTV[(row0 + tid) * 8 + h] : 0.f;
#pragma unroll
    for (int i = 0; i < 2; ++i) { const int ch = tid + 512 * i, tok = ch >> 3, c8 = ch & 7; P.x[i] = *(const h16x8*)(C.XBCC + (row0 + tok) * 1024 + h * 64 + c8 * 8); }
#pragma unroll
    for (int i = 0; i < 4; ++i) { const int ch = tid + 512 * i, tok = ch >> 4, c16 = ch & 15; P.bq[i] = *(const h16x8*)(C.XBCC + (row0 + tok) * 1024 + 512 + g * 128 + c16 * 8); }
}
__device__ __forceinline__ void ssd_states_phase(const Ctx& C, int l, int ufirst, int ustep) {
    TIDS
    const int w = wave, cc = lane & 15, quad = lane >> 4;
    float* acs = (float*)g_lds; float* dtl = acs + 128; float* wl = acs + 256;
    h16* Xs = (h16*)(g_lds + 2048);
    h16* Bs = (h16*)(g_lds + 2048 + 18432);
    h16* Os_ = (h16*)(g_lds + 2048 + 18432 + 34816);
    int u = ufirst; SsdPre pre; if (u < 2048) ssd_states_load(C, l, u, tid, pre);
    while (u < 2048) {
        const int b = u >> 9, c = (u >> 3) & 63, h = u & 7; const size_t row0 = (size_t)b * SEQ + c * 128;
        const SsdPre cur = pre;
        const float A = -__expf(cur.alog);
        if (tid < 128) dtl[tid] = cur.dt;
        __syncthreads();
        if (w == 0) {
            const float d0 = dtl[2 * lane], d1 = dtl[2 * lane + 1]; const float a0 = d0 * A, a1 = d1 * A, sm = a0 + a1; float incl = sm;
#pragma unroll
            for (int o = 1; o < 64; o <<= 1) { const float t = __shfl_up(incl, o); if (lane >= o) incl += t; }
            const float excl = incl - sm, tot = __shfl(incl, 63); const float c0 = excl + a0, c1 = incl;
            acs[2 * lane] = c0; acs[2 * lane + 1] = c1; wl[2 * lane] = __expf(tot - c0) * d0; wl[2 * lane + 1] = __expf(tot - c1) * d1;
            if (lane == 63) C.CD[(b * 64 + c) * 8 + h] = __expf(tot);
        }
        __syncthreads();
#pragma unroll
        for (int i = 0; i < 2; ++i) { const int ch = tid + 512 * i, tok = ch >> 3, c8 = ch & 7; *(h16x8*)(Xs + tok * 72 + c8 * 8) = cur.x[i]; }
#pragma unroll
        for (int i = 0; i < 4; ++i) { const int ch = tid + 512 * i, tok = ch >> 4, c16 = ch & 15; const float ww = wl[tok]; h16x8 o;
#pragma unroll
            for (int e = 0; e < 8; ++e) o[e] = (h16)((float)cur.bq[i][e] * ww);
            *(h16x8*)(Bs + tok * 136 + c16 * 8) = o; }
        if (tid < 128) C.ACS[(row0 + tid) * 8 + h] = acs[tid];
        const int un = u + ustep; if (un < 2048) ssd_states_load(C, l, un, tid, pre);
        __syncthreads();
        const int mi = w & 3;
        h16x8 xa[4];
#pragma unroll
        for (int kk = 0; kk < 4; ++kk) { const h16* xp = Xs + (kk * 32 + 8 * quad + (cc >> 2)) * 72 + mi * 16 + 4 * (cc & 3); xa[kk] = cat44(tr_read(xp), tr_read(xp + 4 * 72)); }
        h16* dst = C.SSDST + (size_t)((b * 64 + c) * 8 + h) * 8192;
#pragma unroll
        for (int q = 0; q < 4; ++q) { const int ni = (w >> 2) * 4 + q; f32x4 acc = {0.f, 0.f, 0.f, 0.f};
#pragma unroll
            for (int kk = 0; kk < 4; ++kk) { const h16* bp = Bs + (kk * 32 + 8 * quad + (cc >> 2)) * 136 + ni * 16 + 4 * (cc & 3); acc = mfma16(xa[kk], cat44(tr_read(bp), tr_read(bp + 4 * 136)), acc); }
#pragma unroll
            for (int j = 0; j < 4; ++j) Os_[(mi * 16 + quad * 4 + j) * 136 + ni * 16 + cc] = (h16)acc[j]; }
        __syncthreads();
#pragma unroll
        for (int i = 0; i < 2; ++i) { const int ch = tid + 512 * i, p = ch >> 4, c16 = ch & 15; *(h16x8*)(dst + p * 128 + c16 * 8) = *(const h16x8*)(Os_ + p * 136 + c16 * 8); }
        u = un;
    }
    __syncthreads();
}

template <class T> __device__ __forceinline__ T* opq(T* p) { asm volatile("" : "+s"(p)); return p; }
struct SsdYPre { float acs, dt; h16x8 x[2], he[2]; h16x4 z[4]; };
struct SsdBC { h16x8 bq[4], cq[4]; };
__device__ __forceinline__ void ssd_y_load(const Ctx& C, int bc, int h, int tid, int w, int cc, int quad, SsdYPre& P) {
    const int b = bc >> 6, c = bc & 63; const size_t row0 = (size_t)b * SEQ + c * 128;
    { const float* ab = opq(C.ACS + row0 * 8 + h); const float* db = opq(C.DTV + row0 * 8 + h); const unsigned o = (unsigned)(tid & 127) * 8u; const float a = ab[o], d = db[o]; P.acs = a; P.dt = d; }
    const h16* xb = opq(C.XBCC + row0 * 1024 + h * 64);
#pragma unroll
    for (int i = 0; i < 2; ++i) { const unsigned ch = tid + 512 * i, tok = ch >> 3, c8 = ch & 7; P.x[i] = *(const h16x8*)(xb + (tok * 1024u + c8 * 8u)); }
    const h16* src = opq(C.SSDST + (size_t)((b * 64 + c) * 8 + h) * 8192);
#pragma unroll
    for (int i = 0; i < 2; ++i) P.he[i] = *(const h16x8*)(src + (unsigned)(tid + 512 * i) * 8u);
    const h16* zp = opq(C.PROJ + (row0 + w * 16) * PN + C_SZ + h * 64);
#pragma unroll
    for (int pt = 0; pt < 4; ++pt) P.z[pt] = *(const h16x4*)(zp + ((unsigned)cc * (unsigned)PN + 4u * quad + 16u * pt));
}
__device__ __forceinline__ void ssd_bc_load(const Ctx& C, int bc, int g, int tid, int w, int cc, int quad, SsdBC& P) {
    const int b = bc >> 6, c = bc & 63; const size_t row0 = (size_t)b * SEQ + c * 128;
    const h16* bb = opq(C.XBCC + row0 * 1024 + 512 + g * 128);
#pragma unroll
    for (int i = 0; i < 4; ++i) { const unsigned ch = tid + 512 * i, tok = ch >> 4, c16 = ch & 15; P.bq[i] = *(const h16x8*)(bb + (tok * 1024u + c16 * 8u)); }
    const h16* cb = opq(C.XBCC + (row0 + w * 16) * 1024 + 768 + g * 128);
#pragma unroll
    for (int kk = 0; kk < 4; ++kk) P.cq[kk] = *(const h16x8*)(cb + ((unsigned)cc * 1024u + kk * 32u + quad * 8u));
}
__device__ __forceinline__ void ssd_y_phase(const Ctx& C, int l, int bcfirst, int bcstep) {
    TIDS
    const int w = wave, cc = lane & 15, quad = lane >> 4;
    float* sm = (float*)g_lds;
    h16* Bm = (h16*)(g_lds + 2048);
    h16* XsB = (h16*)(g_lds + 2048 + 34816);
    h16* HEB = (h16*)(g_lds + 2048 + 34816 + 2 * 18432);
    const float* nwp = C.in[18] + l * 512;
    for (int bc = bcfirst; bc < 256; bc += bcstep) {
        const int b = bc >> 6, c = bc & 63; const size_t row0 = (size_t)b * SEQ + c * 128;
        SsdYPre pre; ssd_y_load(C, bc, 0, tid, w, cc, quad, pre);
        SsdBC nb; ssd_bc_load(C, bc, 0, tid, w, cc, quad, nb);
        h16x4 cbt[8]; h16x8 ca[4]; float rssacc = 0.f;
#pragma unroll 1
        for (int h = 0; h < 8; ++h) { const int g = h >> 2, par = h & 1;
            float* acs = sm + par * 256; float* dtl = acs + 128; h16* Xs = XsB + par * (128 * 72); h16* HE = HEB + par * (64 * 136);
            const float Dh = C.in[17][l * 8 + h];
            if (tid < 128) { acs[tid] = pre.acs; dtl[tid] = pre.dt; }
            if ((h & 3) == 0) { rssacc = 0.f;
#pragma unroll
                for (int i = 0; i < 4; ++i) { const int ch = tid + 512 * i, tok = ch >> 4, c16 = ch & 15; *(h16x8*)(Bm + tok * 136 + c16 * 8) = nb.bq[i]; }
#pragma unroll
                for (int kk = 0; kk < 4; ++kk) ca[kk] = nb.cq[kk]; }
#pragma unroll
            for (int i = 0; i < 2; ++i) { const int ch = tid + 512 * i, tok = ch >> 3, c8 = ch & 7; *(h16x8*)(Xs + tok * 72 + c8 * 8) = pre.x[i]; }
#pragma unroll
            for (int i = 0; i < 2; ++i) { const int ch = tid + 512 * i, p = ch >> 4, c16 = ch & 15; *(h16x8*)(HE + p * 136 + c16 * 8) = pre.he[i]; }
            h16x4 zc[4];
#pragma unroll
            for (int pt = 0; pt < 4; ++pt) zc[pt] = pre.z[pt];
            if (h < 7) ssd_y_load(C, bc, h + 1, tid, w, cc, quad, pre);
            if (h == 3) ssd_bc_load(C, bc, 1, tid, w, cc, quad, nb);
            __syncthreads();
            if ((h & 3) == 0) {
#pragma unroll
                for (int ni = 0; ni < 8; ++ni) { f32x4 acc = {0.f, 0.f, 0.f, 0.f};
                    if (ni <= w) {
#pragma unroll
                        for (int kk = 0; kk < 4; ++kk) { const h16x8 bb = *(const h16x8*)(Bm + (ni * 16 + cc) * 136 + kk * 32 + quad * 8); acc = mfma16(bb, ca[kk], acc); } }
                    cbt[ni] = (h16x4){(h16)acc[0], (h16)acc[1], (h16)acc[2], (h16)acc[3]}; }
            }
            int ccl = cc; asm volatile("" : "+v"(ccl));
            const float al = acs[w * 16 + ccl];
            h16x4 mt[8];
#pragma unroll
            for (int ni = 0; ni < 8; ++ni) { f32x4 mv = {0.f, 0.f, 0.f, 0.f};
                if (ni <= w) { const f32x4 as4 = *(const f32x4*)(acs + ni * 16 + 4 * quad), ds4 = *(const f32x4*)(dtl + ni * 16 + 4 * quad);
#pragma unroll
                    for (int j = 0; j < 4; ++j) mv[j] = (float)cbt[ni][j] * __expf(al - as4[j]) * ds4[j];
                    if (ni == w) {
#pragma unroll
                        for (int j = 0; j < 4; ++j) { const int sj = 4 * quad + j; float v = (sj <= ccl) ? mv[j] : 0.f; if (sj == ccl) v += Dh; mv[j] = v; } } }
                mt[ni] = (h16x4){(h16)mv[0], (h16)mv[1], (h16)mv[2], (h16)mv[3]}; }
            const float ea = __expf(al);
            float ssq = 0.f;
            h16* yout = opq(C.XN + (row0 + w * 16) * 1024 + 512 + h * 64); const unsigned yo = (unsigned)cc * 1024u + 4u * quad;
#pragma unroll
            for (int pt = 0; pt < 4; ++pt) { f32x4 acc = {0.f, 0.f, 0.f, 0.f};
#pragma unroll
                for (int kk = 0; kk < 4; ++kk) { const h16x8 hh = *(const h16x8*)(HE + (pt * 16 + cc) * 136 + kk * 32 + quad * 8); acc = mfma16(hh, ca[kk], acc); }
#pragma unroll
                for (int j = 0; j < 4; ++j) acc[j] *= ea;
#pragma unroll
                for (int kk = 0; kk < 4; ++kk) if (2 * kk <= w) { const h16* xp = Xs + (kk * 32 + 4 * quad + (cc >> 2)) * 72 + pt * 16 + 4 * (cc & 3);
                    acc = mfma16(cat44(tr_read(xp), tr_read(xp + 16 * 72)), cat44(mt[2 * kk], mt[2 * kk + 1]), acc); }
                h16x4 yv;
#pragma unroll
                for (int j = 0; j < 4; ++j) { const h16 yh = (h16)(acc[j] * siluf_((float)zc[pt][j])); yv[j] = yh; const float yr = (float)yh; ssq += yr * yr; }
                *(h16x4*)(yout + (yo + 16u * pt)) = yv; }
            ssq += __shfl_xor(ssq, 16); ssq += __shfl_xor(ssq, 32); rssacc += ssq;
            if ((h & 3) == 3) {
                const float rs = rsq_(rssacc * (1.f / 256.f) + EPS);
                asm volatile("s_waitcnt vmcnt(0)" ::: "memory");
                h16* nbase = opq(C.XN + (row0 + w * 16) * 1024 + 512 + g * 256); const float* nwb = opq(nwp + g * 256);
                const unsigned c8 = lane & 31; h16x8 vv[8];
#pragma unroll
                for (int i = 0; i < 8; ++i) vv[i] = *(const h16x8*)(nbase + ((unsigned)(i * 2 + (lane >> 5)) * 1024u + c8 * 8u));
                const f32x4 nw0 = *(const f32x4*)(nwb + c8 * 8u), nw1 = *(const f32x4*)(nwb + c8 * 8u + 4);
#pragma unroll
                for (int i = 0; i < 8; ++i) { const int r = i * 2 + (lane >> 5); const float rsr = __shfl(rs, r); const h16x8 v = vv[i];
                    h16* p = nbase + ((unsigned)r * 1024u + c8 * 8u);
                    u32x4 o; o.x = pkb((float)v[0] * rsr * nw0[0], (float)v[1] * rsr * nw0[1]); o.y = pkb((float)v[2] * rsr * nw0[2], (float)v[3] * rsr * nw0[3]);
                    o.z = pkb((float)v[4] * rsr * nw1[0], (float)v[5] * rsr * nw1[1]); o.w = pkb((float)v[6] * rsr * nw1[2], (float)v[7] * rsr * nw1[3]); *(u32x4*)p = o; }
            }
        }
    }
    __syncthreads();
}

struct GlaLoad { f32x4 gl[2]; h16x4 q0[2], k0[2]; h16x8 vx[2], rx[2]; };
template <int PASS>
__device__ __forceinline__ void gla_load(const Ctx& C, GlaLoad& L, size_t rowh, int h, int lane) {
    const int tl = lane & 15, kq = lane >> 4; const size_t rowt = rowh + tl;
#pragma unroll
    for (int i = 0; i < 2; ++i) L.gl[i] = *(const f32x4*)(C.PSM + rowt * PSM_W + 8 * (kq & 1) + 4 * i);
#pragma unroll
    for (int i = 0; i < 2; ++i) { L.q0[i] = *(const h16x4*)(C.PROJ + rowt * PN + C_GQ + h * 32 + 16 * i + kq * 4); L.k0[i] = *(const h16x4*)(C.PROJ + rowt * PN + C_GK + h * 32 + 16 * i + kq * 4); }
#pragma unroll
    for (int i = 0; i < 2; ++i) { const int ch = lane + 64 * i, t = ch >> 3, c8 = ch & 7; L.vx[i] = *(const h16x8*)(C.PROJ + (rowh + t) * PN + C_GV + h * 64 + c8 * 8);
        if (PASS == 1) L.rx[i] = *(const h16x8*)(C.PROJ + (rowh + t) * PN + C_GR + h * 64 + c8 * 8); }
}
template <int O> __device__ __forceinline__ float row_shr0(float v) { return __int_as_float(__builtin_amdgcn_update_dpp(0, __float_as_int(v), 0x110 + O, 0xf, 0xf, false)); }
template <int N> __device__ __forceinline__ float row_bcast(float v) { return __int_as_float(__builtin_amdgcn_update_dpp(0, __float_as_int(v), 0x150 + N, 0xf, 0xf, false)); }
template <int PASS>
__device__ __forceinline__ void gla_block_unit(const Ctx& C, int l, int bu) {
    TIDS
    const int w = wave; const int wu = bu * 8 + w; const int cc = lane & 15, quad = lane >> 4;
    const int bh = wu >> 7, seg = wu & 127, b = bh >> 2, h = bh & 3;
    const size_t row0 = (size_t)b * SEQ + seg * 64;
    unsigned char* wl = g_lds + w * 11264;
    h16* QT = (h16*)wl; h16* KT = QT + 640; h16* KH = KT + 640;
    h16* VS = KH + 640; h16* RS = VS + 1152;
    float* EM = (float*)(RS + 1152); float* EE = EM + 32;
    const int tl = cc, kq = quad;
    f32x4 gbi[2]; h16x8 w2a[2];
    { const float* gb = C.in[4] + l * 128 + h * 32; const float* w2g = C.in[3] + (size_t)l * 16 * 128 + h * 32;
#pragma unroll
        for (int i = 0; i < 2; ++i) { gbi[i] = *(const f32x4*)(gb + 16 * i + 4 * kq);
#pragma unroll
            for (int j = 0; j < 8; ++j) { const float wv = w2g[(8 * (kq & 1) + j) * 128 + 16 * i + cc]; w2a[i][j] = (h16)((kq < 2) ? wv : 0.f); } } }
    f32x4 S[2][4];
    float* gst = C.GLAST + (size_t)(bh * 128 + seg) * 2048;
#pragma unroll
    for (int md = 0; md < 2; ++md)
#pragma unroll
        for (int nt = 0; nt < 4; ++nt)
#pragma unroll
            for (int j = 0; j < 4; ++j) S[md][nt][j] = (PASS == 1) ? gst[(16 * md + 4 * quad + j) * 64 + 16 * nt + cc] : 0.f;
    float bsum[8];
#pragma unroll
    for (int k = 0; k < 8; ++k) bsum[k] = 0.f;
    float gnw[4][4];
    if (PASS == 1) {
#pragma unroll
        for (int mt = 0; mt < 4; ++mt)
#pragma unroll
            for (int j = 0; j < 4; ++j) gnw[mt][j] = C.in[5][l * 256 + h * 64 + 16 * mt + 4 * quad + j]; }
    GlaLoad pre, pre2; gla_load<PASS>(C, pre, row0, h, lane); gla_load<PASS>(C, pre2, row0 + 16, h, lane);
#pragma unroll
    for (int qt = 0; qt < 4; ++qt) {
        const size_t rowh = row0 + qt * 16;
        const GlaLoad cur = pre; pre = pre2;
        if (qt < 2) gla_load<PASS>(C, pre2, rowh + 32, h, lane);
        float bi[8];
        { h16x8 gf;
#pragma unroll
            for (int j = 0; j < 8; ++j) gf[j] = (h16)((kq < 2) ? cur.gl[j >> 2][j & 3] : 0.f);
#pragma unroll
            for (int i = 0; i < 2; ++i) { const f32x4 z = mfma16(w2a[i], gf, gbi[i]);
#pragma unroll
                for (int j = 0; j < 4; ++j) bi[4 * i + j] = z[j]; } }
#pragma unroll
        for (int k = 0; k < 8; ++k) bi[k] = -0.0625f * __builtin_amdgcn_logf(1.f + ex2(-1.4426950408889634f * bi[k]));
#pragma unroll
        for (int k = 0; k < 8; ++k) { bi[k] += row_shr0<1>(bi[k]); bi[k] += row_shr0<2>(bi[k]); bi[k] += row_shr0<4>(bi[k]); bi[k] += row_shr0<8>(bi[k]); }
        float bmid[8], bend[8];
#pragma unroll
        for (int k = 0; k < 8; ++k) { bmid[k] = row_bcast<7>(bi[k]); bend[k] = row_bcast<15>(bi[k]); bsum[k] += bend[k]; }
        asm volatile("" ::: "memory");
        h16x8 qo;
        { h16x4 ko[2], kh[2];
#pragma unroll
            for (int k = 0; k < 8; ++k) { const float kf = (float)cur.k0[k >> 2][k & 3]; qo[k] = (h16)((float)cur.q0[k >> 2][k & 3] * 0.17677669529663687f * ex2(bi[k] - bmid[k])); ko[k >> 2][k & 3] = (h16)(kf * ex2(bmid[k] - bi[k])); kh[k >> 2][k & 3] = (h16)(kf * ex2(bend[k] - bi[k])); }
#pragma unroll
            for (int i = 0; i < 2; ++i) { if (PASS == 1) { *(h16x4*)(QT + tl * 40 + 16 * i + kq * 4) = (h16x4){qo[4 * i], qo[4 * i + 1], qo[4 * i + 2], qo[4 * i + 3]}; *(h16x4*)(KT + tl * 40 + 16 * i + kq * 4) = ko[i]; }
                *(h16x4*)(KH + tl * 40 + 16 * i + kq * 4) = kh[i]; }
            if (tl == 0) {
#pragma unroll
                for (int k4 = 0; k4 < 2; ++k4) { f32x4 em, ee;
#pragma unroll
                    for (int e = 0; e < 4; ++e) { em[e] = ex2(bmid[4 * k4 + e]); ee[e] = ex2(bend[4 * k4 + e]); }
                    if (PASS == 1) *(f32x4*)(EM + 16 * k4 + kq * 4) = em;
                    *(f32x4*)(EE + 16 * k4 + kq * 4) = ee; } } }
#pragma unroll
        for (int i = 0; i < 2; ++i) { const int ch = lane + 64 * i, t = ch >> 3, c8 = ch & 7; *(h16x8*)(VS + t * 72 + c8 * 8) = cur.vx[i]; if (PASS == 1) *(h16x8*)(RS + t * 72 + c8 * 8) = cur.rx[i]; }
        asm volatile("s_waitcnt lgkmcnt(0)" ::: "memory");
        h16x8 vfr[4];
#pragma unroll
        for (int nt = 0; nt < 4; ++nt) { const h16x4 t4 = tr_read(VS + (4 * quad + (cc >> 2)) * 72 + 16 * nt + 4 * (cc & 3)); vfr[nt] = (h16x8){t4[0], t4[1], t4[2], t4[3], (h16)0.f, (h16)0.f, (h16)0.f, (h16)0.f}; }
        if (PASS == 1) {
            f32x4 at = {0.f, 0.f, 0.f, 0.f};
            at = mfma16(*(const h16x8*)(KT + cc * 40 + quad * 8), *(const h16x8*)(QT + cc * 40 + quad * 8), at);
            h16x8 pa;
#pragma unroll
            for (int e = 0; e < 4; ++e) { pa[e] = (h16)((4 * quad + e <= cc) ? at[e] : 0.f); pa[4 + e] = (h16)0.f; }
            const h16x8 qfr = qo;
            const f32x4 em0 = *(const f32x4*)(EM + 4 * quad), em1 = *(const f32x4*)(EM + 16 + 4 * quad);
            f32x4 ot[4]; float ssq = 0.f;
#pragma unroll
            for (int mt = 0; mt < 4; ++mt) { f32x4 acc = {0.f, 0.f, 0.f, 0.f};
                acc = mfma16(vfr[mt], pa, acc);
                const h16x8 sfr = {(h16)(S[0][mt][0] * em0[0]), (h16)(S[0][mt][1] * em0[1]), (h16)(S[0][mt][2] * em0[2]), (h16)(S[0][mt][3] * em0[3]),
                                   (h16)(S[1][mt][0] * em1[0]), (h16)(S[1][mt][1] * em1[1]), (h16)(S[1][mt][2] * em1[2]), (h16)(S[1][mt][3] * em1[3])};
                acc = mfma16(sfr, qfr, acc);
                ot[mt] = acc; ssq += (acc[0] * acc[0] + acc[1] * acc[1]) + (acc[2] * acc[2] + acc[3] * acc[3]); }
            ssq += __shfl_xor(ssq, 16); ssq += __shfl_xor(ssq, 32);
            const float rs = rsq_(ssq * (1.f / 64.f) + EPS);
#pragma unroll
            for (int mt = 0; mt < 4; ++mt) { const h16x4 r4 = *(const h16x4*)(RS + cc * 72 + 16 * mt + 4 * quad);
                u32x2 wv; wv.x = pkb(ot[mt][0] * rs * gnw[mt][0] * siluf_((float)r4[0]), ot[mt][1] * rs * gnw[mt][1] * siluf_((float)r4[1]));
                wv.y = pkb(ot[mt][2] * rs * gnw[mt][2] * siluf_((float)r4[2]), ot[mt][3] * rs * gnw[mt][3] * siluf_((float)r4[3]));
                *(u32x2*)(C.XN + (rowh + cc) * 1024 + h * 64 + 16 * mt + 4 * quad) = wv; }
        }
#pragma unroll
        for (int md = 0; md < 2; ++md) { const f32x4 ee = *(const f32x4*)(EE + 16 * md + 4 * quad);
            const h16x4 k4 = tr_read(KH + (4 * quad + (cc >> 2)) * 40 + 16 * md + 4 * (cc & 3));
            const h16x8 kfr = {k4[0], k4[1], k4[2], k4[3], (h16)0.f, (h16)0.f, (h16)0.f, (h16)0.f};
#pragma unroll
            for (int nt = 0; nt < 4; ++nt) { S[md][nt] = S[md][nt] * ee; S[md][nt] = mfma16(kfr, vfr[nt], S[md][nt]); } }
    }
    if (PASS == 0) {
#pragma unroll
        for (int md = 0; md < 2; ++md)
#pragma unroll
            for (int nt = 0; nt < 4; ++nt)
#pragma unroll
                for (int j = 0; j < 4; ++j) gst[(16 * md + 4 * quad + j) * 64 + 16 * nt + cc] = S[md][nt][j];
        if (tl == 0) {
#pragma unroll
            for (int k = 0; k < 8; ++k) C.GLAG[(size_t)(bh * 128 + seg) * 32 + 16 * (k >> 2) + kq * 4 + (k & 3)] = ex2(bsum[k]); }
    }
}

__device__ __forceinline__ void phase_scans(const Ctx& C) {
    TIDS
    for (int e = C.bid * 512 + tid; e < BATCH * 8 * 4096; e += C.G * 512) {
        const int bh = e >> 12, b = bh >> 3, h = bh & 7, pn = e & 4095;
        h16x2* p = (h16x2*)(C.SSDST + (size_t)(b * 64 * 8 + h) * 8192) + pn; const float* cd = C.CD + b * 64 * 8 + h;
        float s0 = 0.f, s1 = 0.f;
        for (int c0 = 0; c0 < 64; c0 += 32) { h16x2 v[32]; float d[32];
#pragma unroll
            for (int i = 0; i < 32; ++i) { v[i] = p[(size_t)(c0 + i) * 8 * 4096]; d[i] = cd[(c0 + i) * 8]; }
#pragma unroll
            for (int i = 0; i < 32; ++i) { h16x2 o = {(h16)s0, (h16)s1}; p[(size_t)(c0 + i) * 8 * 4096] = o; s0 = d[i] * s0 + (float)v[i][0]; s1 = d[i] * s1 + (float)v[i][1]; } }
    }
    if (tid < 128)
    for (int e = C.bid * 128 + tid; e < 16 * 2048; e += C.G * 128) {
        const int bh = e >> 11, kv = e & 2047, k = kv >> 6;
        float* p = C.GLAST + (size_t)bh * 128 * 2048 + kv; const float* gg = C.GLAG + (size_t)bh * 128 * 32 + k;
        float st = 0.f;
        for (int s0 = 0; s0 < 128; s0 += 32) { float v[32], d[32];
#pragma unroll
            for (int i = 0; i < 32; ++i) { v[i] = p[(size_t)(s0 + i) * 2048]; d[i] = gg[(s0 + i) * 32]; }
#pragma unroll
            for (int i = 0; i < 32; ++i) { p[(size_t)(s0 + i) * 2048] = st; st = d[i] * st + v[i]; } }
    }
}

constexpr int KV_LD = 80, KV_TILE = 64 * KV_LD;
__device__ __forceinline__ void qk_tile(f32x4 (&s)[4], const h16* Ks, const h16x8 (&qf)[2], int cc, int quad) {
#pragma unroll
    for (int mt = 0; mt < 4; ++mt) { f32x4 a = {0.f, 0.f, 0.f, 0.f};
#pragma unroll
        for (int ks = 0; ks < 2; ++ks) { const h16x8 kf = *(const h16x8*)(Ks + (mt * 16 + cc) * KV_LD + ks * 32 + quad * 8); a = mfma16(kf, qf[ks], a); }
        s[mt] = a; }
}
__device__ __forceinline__ void pv_tile(f32x4 (&O)[4], const h16* Vs, const f32x4 (&p)[4], int cc, int quad) {
    h16x8 pf[2];
#pragma unroll
    for (int k2 = 0; k2 < 2; ++k2) pf[k2] = (h16x8){(h16)p[2 * k2][0], (h16)p[2 * k2][1], (h16)p[2 * k2][2], (h16)p[2 * k2][3], (h16)p[2 * k2 + 1][0], (h16)p[2 * k2 + 1][1], (h16)p[2 * k2 + 1][2], (h16)p[2 * k2 + 1][3]};
#pragma unroll
    for (int md = 0; md < 4; ++md)
#pragma unroll
        for (int k2 = 0; k2 < 2; ++k2) { const h16* vp = Vs + (32 * k2 + 4 * quad + (cc >> 2)) * KV_LD + md * 16 + 4 * (cc & 3);
            const h16x4 lo = tr_read(vp), hi = tr_read(vp + 16 * KV_LD);
            const h16x8 vf = {lo[0], lo[1], lo[2], lo[3], hi[0], hi[1], hi[2], hi[3]}; O[md] = mfma16(vf, pf[k2], O[md]); }
}
struct FlashState { float mref, l; f32x4 O[4]; bool started; };
template <int MODE>
__device__ __forceinline__ void flash_tile2(FlashState (&st)[2], const h16* Ks, const h16* Vs, const h16x8 (&qf)[2][2], int kv0, const int (&tq)[2], const bool (&sb)[2], bool masked, int cc, int quad) {
    h16x8 kf[4][2];
#pragma unroll
    for (int mt = 0; mt < 4; ++mt)
#pragma unroll
        for (int ks = 0; ks < 2; ++ks) kf[mt][ks] = *(const h16x8*)(Ks + (mt * 16 + cc) * KV_LD + ks * 32 + quad * 8);
    f32x4 s[2][4]; float rmax[2];
    if (masked) {
#pragma unroll
        for (int gi = 0; gi < 2; ++gi) { const float nm = (MODE == 0 && !sb[gi]) ? -INFINITY : -st[gi].mref;
#pragma unroll
            for (int mt = 0; mt < 4; ++mt) { f32x4 ci;
#pragma unroll
                for (int j = 0; j < 4; ++j) { const int kp = kv0 + mt * 16 + quad * 4 + j; const bool ok = (MODE == 0) ? (kp <= tq[gi]) : (kp <= tq[gi] && kp > tq[gi] - 512); ci[j] = ok ? nm : -INFINITY; }
                f32x4 a = mfma16(kf[mt][0], qf[gi][0], ci); s[gi][mt] = mfma16(kf[mt][1], qf[gi][1], a); } }
    } else {
#pragma unroll
        for (int gi = 0; gi < 2; ++gi) { const float nm = (MODE == 0 && !sb[gi]) ? -INFINITY : -st[gi].mref; const f32x4 negm = {nm, nm, nm, nm};
#pragma unroll
            for (int mt = 0; mt < 4; ++mt) { f32x4 a = mfma16(kf[mt][0], qf[gi][0], negm); s[gi][mt] = mfma16(kf[mt][1], qf[gi][1], a); } }
    }
#pragma unroll
    for (int gi = 0; gi < 2; ++gi) {
        float ta = max3f(s[gi][0][0], s[gi][0][1], s[gi][0][2]), tb = max3f(s[gi][0][3], s[gi][1][0], s[gi][1][1]);
        ta = max3f(ta, s[gi][1][2], s[gi][1][3]); tb = max3f(tb, s[gi][2][0], s[gi][2][1]); ta = max3f(ta, s[gi][2][2], s[gi][2][3]); tb = max3f(tb, s[gi][3][0], s[gi][3][1]);
        rmax[gi] = max3f(ta, tb, fmaxf(s[gi][3][2], s[gi][3][3])); }
    bool pu[2];
#pragma unroll
    for (int gi = 0; gi < 2; ++gi) pu[gi] = (rmax[gi] > -INFINITY) && (!st[gi].started || rmax[gi] > 8.f);
    if (__any(pu[0] || pu[1])) {
#pragma unroll
        for (int gi = 0; gi < 2; ++gi) { float tmax = rmax[gi]; tmax = fmaxf(tmax, __shfl_xor(tmax, 16)); tmax = fmaxf(tmax, __shfl_xor(tmax, 32));
            const bool upd = (tmax > -INFINITY) && (!st[gi].started || tmax > 8.f);
            const float dl = upd ? tmax : 0.f; const float f = (upd && st[gi].started) ? ex2(-dl) : 1.f;
            st[gi].mref += dl; st[gi].l *= f; st[gi].started = st[gi].started || upd;
#pragma unroll
            for (int mt = 0; mt < 4; ++mt) { s[gi][mt] = s[gi][mt] - dl; st[gi].O[mt] *= f; } }
    }
    h16x8 pf[2][2];
#pragma unroll
    for (int gi = 0; gi < 2; ++gi) {
#pragma unroll
        for (int mt = 0; mt < 4; ++mt)
#pragma unroll
            for (int j = 0; j < 4; ++j) s[gi][mt][j] = ex2(s[gi][mt][j]);
        const f32x4 ps4 = (s[gi][0] + s[gi][1]) + (s[gi][2] + s[gi][3]);
        float psum = (ps4[0] + ps4[1]) + (ps4[2] + ps4[3]);
        u32x4 w0, w1; w0.x = pkh(s[gi][0][0], s[gi][0][1]); w0.y = pkh(s[gi][0][2], s[gi][0][3]); w0.z = pkh(s[gi][1][0], s[gi][1][1]); w0.w = pkh(s[gi][1][2], s[gi][1][3]);
        w1.x = pkh(s[gi][2][0], s[gi][2][1]); w1.y = pkh(s[gi][2][2], s[gi][2][3]); w1.z = pkh(s[gi][3][0], s[gi][3][1]); w1.w = pkh(s[gi][3][2], s[gi][3][3]);
        st[gi].l += psum; pf[gi][0] = __builtin_bit_cast(h16x8, w0); pf[gi][1] = __builtin_bit_cast(h16x8, w1); }
#pragma unroll
    for (int md = 0; md < 4; ++md)
#pragma unroll
        for (int k2 = 0; k2 < 2; ++k2) { const h16* vp = Vs + (32 * k2 + 4 * quad + (cc >> 2)) * KV_LD + md * 16 + 4 * (cc & 3);
            const h16x8 vf = cat44(tr_read(vp), tr_read(vp + 16 * KV_LD));
            st[0].O[md] = mfma16(vf, pf[0][k2], st[0].O[md]); st[1].O[md] = mfma16(vf, pf[1][k2], st[1].O[md]); }
}
struct NoTail { __device__ __forceinline__ void operator()() const {} };
template <bool NEEDV, bool HAVE0, class SrcFn, class CompFn, class TailFn>
__device__ __forceinline__ void kv_pipeline(int n, int tid, h16* Kb, h16* Vb, SrcFn src, CompFn comp, TailFn tail, h16x8 k0 = (h16x8){}, h16x8 v0 = (h16x8){}) {
    if (n <= 0) return;
    const int key = tid >> 3, c8 = tid & 7; const int loff = key * KV_LD + c8 * 8;
    h16x8 kr = k0, vr = v0;
    if (!HAVE0) { const h16 *kp, *vp; size_t stride; src(0, kp, vp, stride); kr = *(const h16x8*)(kp + (size_t)key * stride + c8 * 8); if (NEEDV) vr = *(const h16x8*)(vp + (size_t)key * stride + c8 * 8); }
    *(h16x8*)(Kb + loff) = kr; if (NEEDV) *(h16x8*)(Vb + loff) = vr;
    __syncthreads();
    for (int i = 0; i < n; ++i) {
        const int cur = i & 1; const bool more = (i + 1 < n);
        if (more) { const h16 *kp, *vp; size_t stride; src(i + 1, kp, vp, stride); kr = *(const h16x8*)(kp + (size_t)key * stride + c8 * 8); if (NEEDV) vr = *(const h16x8*)(vp + (size_t)key * stride + c8 * 8); }
        else tail();
        comp(i, Kb + cur * KV_TILE, Vb + cur * KV_TILE);
        if (more) { *(h16x8*)(Kb + (cur ^ 1) * KV_TILE + loff) = kr; if (NEEDV) *(h16x8*)(Vb + (cur ^ 1) * KV_TILE + loff) = vr; }
        __syncthreads();
    }
}
__device__ __forceinline__ void nsa_attn_unit(const Ctx& C, int l, int b, int g, int qq) {
    TIDS
    const int w = wave, cc = lane & 15, quad = lane >> 4;
    const int r = cc >> 3, ti = cc & 7, h = 2 * g + r;
    const int qbw = 2 * qq + (w >> 2), qbh = 2 * qq + 1;
    int tloc[2], tq[2]; size_t rowq[2];
#pragma unroll
    for (int gi = 0; gi < 2; ++gi) { tloc[gi] = 16 * w + 8 * gi + ti; tq[gi] = 128 * qq + tloc[gi]; rowq[gi] = (size_t)b * SEQ + tq[gi]; }
    h16* Kb = (h16*)g_lds; h16* Vb = (h16*)(g_lds + 2 * KV_TILE * 2);
    float* imp = (float*)(g_lds + 40960);
    unsigned* sel = (unsigned*)(g_lds + 40960 + 65536);
    unsigned* uni = sel + 512;
    unsigned char* lst = (unsigned char*)(uni + 8);
    h16x8 qf[2][2];
#pragma unroll
    for (int gi = 0; gi < 2; ++gi) {
        const h16x8 x1 = *(const h16x8*)(C.PROJ + rowq[gi] * PN + C_NQ + h * 64 + quad * 8), x2 = *(const h16x8*)(C.PROJ + rowq[gi] * PN + C_NQ + h * 64 + 32 + quad * 8);
        f32x4 tb[4];
#pragma unroll
        for (int i = 0; i < 4; ++i) tb[i] = *(const f32x4*)(C.ROPE + 2 * (tq[gi] * 32 + quad * 8) + 4 * i);
#pragma unroll
        for (int e = 0; e < 8; ++e) { const float cs = tb[e >> 1][2 * (e & 1)], sn = tb[e >> 1][2 * (e & 1) + 1]; const float a1 = (float)x1[e], a2 = (float)x2[e];
            qf[gi][0][e] = (h16)((a1 * cs - a2 * sn) * 0.18033688011112042f); qf[gi][1][e] = (h16)((a2 * cs + a1 * sn) * 0.18033688011112042f); } }
    const h16* kcb = C.KC + (size_t)(b * 2 + g) * 512 * 64; const h16* vcb = C.VC + (size_t)(b * 2 + g) * 512 * 64;
    const int ncmp = 4 * qbh + 3, ntile_c = (ncmp + 63) >> 6;
    auto src_cmp = [&](int i, const h16*& kp, const h16*& vp, size_t& stride) { kp = kcb + (size_t)i * 64 * 64; vp = vcb + (size_t)i * 64 * 64; stride = 64; };
    const int skey = tid >> 3, sc8 = tid & 7;
    h16x8 pk0, pv0;
    const h16* kslc = C.PROJ + (size_t)b * SEQ * PN + C_KSLC + g * 64; const h16* vslc = C.PROJ + (size_t)b * SEQ * PN + C_VSLC + g * 64;
    const h16* kwin = C.PROJ + (size_t)b * SEQ * PN + C_KWIN + g * 64; const h16* vwin = C.PROJ + (size_t)b * SEQ * PN + C_VWIN + g * 64;
    const int jw0 = (2 * qq >= 8 ? 2 * qq - 8 : 0);
    float m1[2] = {-INFINITY, -INFINITY}, l1[2] = {0.f, 0.f};
    kv_pipeline<false, false>(ntile_c, tid, Kb, Vb, src_cmp, [&](int tc, const h16* Ks, const h16*) {
        h16x8 kf[4][2];
#pragma unroll
        for (int mt = 0; mt < 4; ++mt)
#pragma unroll
            for (int ks = 0; ks < 2; ++ks) kf[mt][ks] = *(const h16x8*)(Ks + (mt * 16 + cc) * KV_LD + ks * 32 + quad * 8);
        const bool cmask = !(1024 * tc + 1039 <= 128 * qq);
#pragma unroll
        for (int gi = 0; gi < 2; ++gi) { f32x4 s[4];
            if (cmask) {
#pragma unroll
                for (int mt = 0; mt < 4; ++mt) { f32x4 ci;
#pragma unroll
                    for (int j = 0; j < 4; ++j) { const int n = tc * 64 + mt * 16 + quad * 4 + j; ci[j] = (16 * n + 31 <= tq[gi]) ? 0.f : -INFINITY; }
                    f32x4 a = mfma16(kf[mt][0], qf[gi][0], ci); s[mt] = mfma16(kf[mt][1], qf[gi][1], a); }
            } else {
#pragma unroll
                for (int mt = 0; mt < 4; ++mt) { f32x4 a = {0.f, 0.f, 0.f, 0.f}; a = mfma16(kf[mt][0], qf[gi][0], a); s[mt] = mfma16(kf[mt][1], qf[gi][1], a); }
            }
            float ta = max3f(s[0][0], s[0][1], s[0][2]), tb = max3f(s[0][3], s[1][0], s[1][1]);
            ta = max3f(ta, s[1][2], s[1][3]); tb = max3f(tb, s[2][0], s[2][1]); ta = max3f(ta, s[2][2], s[2][3]); tb = max3f(tb, s[3][0], s[3][1]);
            float tmax = max3f(ta, tb, fmaxf(s[3][2], s[3][3]));
            tmax = fmaxf(tmax, __shfl_xor(tmax, 16)); tmax = fmaxf(tmax, __shfl_xor(tmax, 32));
            const float mnew = fmaxf(m1[gi], tmax), muse = (mnew == -INFINITY) ? 0.f : mnew;
            float ps = 0.f;
#pragma unroll
            for (int mt = 0; mt < 4; ++mt)
#pragma unroll
                for (int j = 0; j < 4; ++j) ps += ex2(s[mt][j] - muse);
            l1[gi] = l1[gi] * ex2(m1[gi] - muse) + ps; m1[gi] = mnew; } },
        [&]() { pk0 = *(const h16x8*)(kcb + (size_t)skey * 64 + sc8 * 8); pv0 = *(const h16x8*)(vcb + (size_t)skey * 64 + sc8 * 8); });
    float inv1[2], m1u[2];
#pragma unroll
    for (int gi = 0; gi < 2; ++gi) { float t = l1[gi]; t += __shfl_xor(t, 16); t += __shfl_xor(t, 32); inv1[gi] = (t > 0.f) ? 1.f / t : 0.f; m1u[gi] = (m1[gi] == -INFINITY) ? 0.f : m1[gi]; }
    f32x4 Oc[2][4];
#pragma unroll
    for (int gi = 0; gi < 2; ++gi)
#pragma unroll
        for (int md = 0; md < 4; ++md) Oc[gi][md] = (f32x4){0.f, 0.f, 0.f, 0.f};
    float carry_q3[2] = {0.f, 0.f};
    kv_pipeline<true, true>(ntile_c, tid, Kb, Vb, src_cmp, [&](int tc, const h16* Ks, const h16* Vs) {
        h16x8 kf[4][2]; h16x8 pf[2][2];
#pragma unroll
        for (int mt = 0; mt < 4; ++mt)
#pragma unroll
            for (int ks = 0; ks < 2; ++ks) kf[mt][ks] = *(const h16x8*)(Ks + (mt * 16 + cc) * KV_LD + ks * 32 + quad * 8);
        const bool cmask = !(1024 * tc + 1039 <= 128 * qq);
#pragma unroll
        for (int gi = 0; gi < 2; ++gi) { f32x4 s[4]; const float nm = -m1u[gi];
            if (cmask) {
#pragma unroll
                for (int mt = 0; mt < 4; ++mt) { f32x4 ci;
#pragma unroll
                    for (int j = 0; j < 4; ++j) { const int n = tc * 64 + mt * 16 + quad * 4 + j; ci[j] = (16 * n + 31 <= tq[gi]) ? nm : -INFINITY; }
                    f32x4 a = mfma16(kf[mt][0], qf[gi][0], ci); s[mt] = mfma16(kf[mt][1], qf[gi][1], a); }
            } else { const f32x4 ci = {nm, nm, nm, nm};
#pragma unroll
                for (int mt = 0; mt < 4; ++mt) { f32x4 a = mfma16(kf[mt][0], qf[gi][0], ci); s[mt] = mfma16(kf[mt][1], qf[gi][1], a); }
            }
#pragma unroll
            for (int mt = 0; mt < 4; ++mt) { f32x4 a;
#pragma unroll
                for (int j = 0; j < 4; ++j) a[j] = ex2(s[mt][j]) * inv1[gi];
                s[mt] = a;
                const float s4 = (a[0] + a[1]) + (a[2] + a[3]); const float p3 = a[3];
                const float fromprev = __shfl(p3, (lane + 48) & 63);
                const float fromq3 = __shfl(p3, cc + 48);
                float val = s4 + ((quad == 0) ? carry_q3[gi] : fromprev);
                carry_q3[gi] = fromq3;
                val += __shfl_xor(val, 8);
                if (r == 0) imp[tloc[gi] * 128 + tc * 16 + mt * 4 + quad] = val; }
#pragma unroll
            for (int k2 = 0; k2 < 2; ++k2) pf[gi][k2] = (h16x8){(h16)s[2 * k2][0], (h16)s[2 * k2][1], (h16)s[2 * k2][2], (h16)s[2 * k2][3], (h16)s[2 * k2 + 1][0], (h16)s[2 * k2 + 1][1], (h16)s[2 * k2 + 1][2], (h16)s[2 * k2 + 1][3]}; }
#pragma unroll
        for (int md = 0; md < 4; ++md)
#pragma unroll
            for (int k2 = 0; k2 < 2; ++k2) { const h16* vp = Vs + (32 * k2 + 4 * quad + (cc >> 2)) * KV_LD + md * 16 + 4 * (cc & 3);
                const h16x8 vf = cat44(tr_read(vp), tr_read(vp + 16 * KV_LD));
                Oc[0][md] = mfma16(vf, pf[0][k2], Oc[0][md]); Oc[1][md] = mfma16(vf, pf[1][k2], Oc[1][md]); } },
        [&]() { pk0 = *(const h16x8*)(kslc + (size_t)skey * PN + sc8 * 8); pv0 = *(const h16x8*)(vslc + (size_t)skey * PN + sc8 * 8); }, pk0, pv0);
    if (qbw < 16) {
        if (lane < 16) { const unsigned mlo = (2u << qbw) - 1u; const int row = 16 * w + lane; sel[row * 4 + 0] = mlo; sel[row * 4 + 1] = 0u; sel[row * 4 + 2] = 0u; sel[row * 4 + 3] = 0u; }
    } else {
        const int jhi = qbw - 2;
        const unsigned long long lt = __lanemask_lt();
        for (int t16 = 0; t16 < 16; ++t16) { const int row = 16 * w + t16; const float* ir = imp + row * 128;
            const int j1 = lane, j2 = lane + 64; const bool ok1 = (j1 >= 1 && j1 <= jhi), ok2 = (j2 <= jhi);
            const unsigned u1 = ok1 ? __float_as_uint(ir[j1]) + 1u : 0u, u2 = ok2 ? __float_as_uint(ir[j2]) + 1u : 0u;
            unsigned prefix = 0u;
            for (int bit = 30; bit >= 0; --bit) { const unsigned test = prefix | (1u << bit);
                const int cnt = __popcll(__ballot(u1 >= test)) + __popcll(__ballot(u2 >= test)); if (cnt >= 13) prefix = test; }
            const bool gt1 = u1 > prefix, gt2 = u2 > prefix, eq1 = u1 == prefix, eq2 = u2 == prefix;
            const unsigned long long bg1 = __ballot(gt1), bg2 = __ballot(gt2), be1 = __ballot(eq1), be2 = __ballot(eq2);
            const int need = 13 - __popcll(bg1) - __popcll(bg2);
            const bool s1 = gt1 || (eq1 && __popcll(be1 & lt) < need), s2 = gt2 || (eq2 && (__popcll(be1) + __popcll(be2 & lt)) < need);
            unsigned long long blo = __ballot(s1) | 1ull, bhi = __ballot(s2);
            { const int f0 = qbw - 1, f1 = qbw; if (f0 < 64) blo |= 1ull << f0; else bhi |= 1ull << (f0 - 64); if (f1 < 64) blo |= 1ull << f1; else bhi |= 1ull << (f1 - 64); }
            if (lane == 0) { sel[row * 4 + 0] = (unsigned)blo; sel[row * 4 + 1] = (unsigned)(blo >> 32); sel[row * 4 + 2] = (unsigned)bhi; sel[row * 4 + 3] = (unsigned)(bhi >> 32); } }
    }
    __syncthreads();
    if (w == 0) {
        unsigned o0 = sel[lane * 4 + 0] | sel[(lane + 64) * 4 + 0], o1 = sel[lane * 4 + 1] | sel[(lane + 64) * 4 + 1], o2 = sel[lane * 4 + 2] | sel[(lane + 64) * 4 + 2], o3 = sel[lane * 4 + 3] | sel[(lane + 64) * 4 + 3];
#pragma unroll
        for (int sft = 1; sft < 64; sft <<= 1) { o0 |= __shfl_xor(o0, sft); o1 |= __shfl_xor(o1, sft); o2 |= __shfl_xor(o2, sft); o3 |= __shfl_xor(o3, sft); }
        const unsigned long long mlo = ((unsigned long long)o1 << 32) | o0, mhi = ((unsigned long long)o3 << 32) | o2;
        if (lane == 0) { uni[0] = o0; uni[1] = o1; uni[2] = o2; uni[3] = o3; }
    }
    __syncthreads();
    { f32x4* park = (f32x4*)imp;
#pragma unroll
        for (int gi = 0; gi < 2; ++gi)
#pragma unroll
            for (int md = 0; md < 4; ++md) park[(gi * 4 + md) * 512 + tid] = Oc[gi][md]; }
    unsigned long long selLo[2], selHi[2];
#pragma unroll
    for (int gi = 0; gi < 2; ++gi) { selLo[gi] = ((unsigned long long)sel[tloc[gi] * 4 + 1] << 32) | sel[tloc[gi] * 4 + 0]; selHi[gi] = ((unsigned long long)sel[tloc[gi] * 4 + 3] << 32) | sel[tloc[gi] * 4 + 2]; }
    unsigned long long um0 = ((unsigned long long)(unsigned)__builtin_amdgcn_readfirstlane((int)uni[1]) << 32) | (unsigned)__builtin_amdgcn_readfirstlane((int)uni[0]);
    unsigned long long um1 = ((unsigned long long)(unsigned)__builtin_amdgcn_readfirstlane((int)uni[3]) << 32) | (unsigned)__builtin_amdgcn_readfirstlane((int)uni[2]);
    const int nlist = __popcll(um0) + __popcll(um1);
    um0 &= ~1ull;
    int jc = 0, jn = 0;
    auto pop_block = [&]() { int j; if (um0) { j = __builtin_ctzll(um0); um0 &= um0 - 1ull; } else { j = 64 + __builtin_ctzll(um1); um1 &= um1 - 1ull; } return j; };
    FlashState fs[2];
#pragma unroll
    for (int gi = 0; gi < 2; ++gi) { fs[gi].mref = 0.f; fs[gi].l = 0.f; fs[gi].started = false;
#pragma unroll
        for (int md = 0; md < 4; ++md) fs[gi].O[md] = (f32x4){0.f, 0.f, 0.f, 0.f}; }
    kv_pipeline<true, true>(nlist, tid, Kb, Vb,
        [&](int i, const h16*& kp, const h16*& vp, size_t& stride) { jn = pop_block(); kp = kslc + (size_t)jn * 64 * PN; vp = vslc + (size_t)jn * 64 * PN; stride = PN; },
        [&](int i, const h16* Ks, const h16* Vs) { const int j = jc; bool sb[2];
#pragma unroll
            for (int gi = 0; gi < 2; ++gi) { const unsigned long long sw = (j < 64) ? selLo[gi] : selHi[gi]; sb[gi] = ((sw >> (j & 63)) & 1ull) != 0ull; }
            flash_tile2<0>(fs, Ks, Vs, qf, j * 64, tq, sb, j >= 2 * qq, cc, quad); jc = jn; },
        [&]() { pk0 = *(const h16x8*)(kwin + ((size_t)jw0 * 64 + skey) * PN + sc8 * 8); pv0 = *(const h16x8*)(vwin + ((size_t)jw0 * 64 + skey) * PN + sc8 * 8); }, pk0, pv0);
    f32x4 Os[2][4];
#pragma unroll
    for (int gi = 0; gi < 2; ++gi) { float ls = fs[gi].l; ls += __shfl_xor(ls, 16); ls += __shfl_xor(ls, 32); const float invs = (ls > 0.f) ? 1.f / ls : 0.f;
#pragma unroll
        for (int md = 0; md < 4; ++md) Os[gi][md] = fs[gi].O[md] * invs; }
#pragma unroll
    for (int gi = 0; gi < 2; ++gi) { fs[gi].mref = 0.f; fs[gi].l = 0.f; fs[gi].started = false;
#pragma unroll
        for (int md = 0; md < 4; ++md) fs[gi].O[md] = (f32x4){0.f, 0.f, 0.f, 0.f}; }
    kv_pipeline<true, true>(qbh - jw0 + 1, tid, Kb, Vb,
        [&](int i, const h16*& kp, const h16*& vp, size_t& stride) { const int j = jw0 + i; kp = kwin + (size_t)j * 64 * PN; vp = vwin + (size_t)j * 64 * PN; stride = PN; },
        [&](int i, const h16* Ks, const h16* Vs) { const int j = jw0 + i; const bool sbt[2] = {true, true};
            flash_tile2<1>(fs, Ks, Vs, qf, j * 64, tq, sbt, j >= 2 * qq || j <= 2 * qq - 7, cc, quad); },
        NoTail(), pk0, pv0);
    float gv[2][3]; f32x4 nwv[4];
#pragma unroll
    for (int gi = 0; gi < 2; ++gi) { const float* gp = C.PSM + rowq[gi] * PSM_W + 16 + h * 3; gv[gi][0] = gp[0]; gv[gi][1] = gp[1]; gv[gi][2] = gp[2]; }
#pragma unroll
    for (int md = 0; md < 4; ++md) nwv[md] = *(const f32x4*)(C.in[12] + l * 256 + h * 64 + md * 16 + quad * 4);
#pragma unroll
    for (int gi = 0; gi < 2; ++gi) {
        float lw = fs[gi].l; lw += __shfl_xor(lw, 16); lw += __shfl_xor(lw, 32); const float invw = (lw > 0.f) ? 1.f / lw : 0.f;
        const float g0 = sigmoidf_(gv[gi][0]), g1 = sigmoidf_(gv[gi][1]), g2 = sigmoidf_(gv[gi][2]) * invw;
        float ssq = 0.f; f32x4 o[4];
#pragma unroll
        for (int md = 0; md < 4; ++md) { o[md] = g0 * ((const f32x4*)imp)[(gi * 4 + md) * 512 + tid] + g1 * Os[gi][md] + g2 * fs[gi].O[md]; ssq += (o[md][0] * o[md][0] + o[md][1] * o[md][1]) + (o[md][2] * o[md][2] + o[md][3] * o[md][3]); }
        ssq += __shfl_xor(ssq, 16); ssq += __shfl_xor(ssq, 32);
        const float rs = rsq_(ssq * (1.f / 64.f) + EPS);
#pragma unroll
        for (int md = 0; md < 4; ++md) { const int d = md * 16 + quad * 4; u32x2 wv; wv.x = pkb(o[md][0] * rs * nwv[md][0], o[md][1] * rs * nwv[md][1]); wv.y = pkb(o[md][2] * rs * nwv[md][2], o[md][3] * rs * nwv[md][3]);
            *(u32x2*)(C.XN + rowq[gi] * 1024 + 256 + h * 64 + d) = wv; }
    }
}

__device__ __forceinline__ void phase_ssdnorm(const Ctx& C, int l) {
    TIDS
    const int gw = C.bid * 8 + wave, NGW = C.G * 8; const float* nw = C.in[18] + l * 512 + lane * 8;
    for (int m = gw; m < MTOK; m += NGW) { const int g = lane >> 5; const f32x4 q = *(const f32x4*)(C.SSQ + (size_t)m * 8 + g * 4);
        const float rs = rsq_(((q.x + q.y) + (q.z + q.w)) * (1.f / 256.f) + EPS);
        h16* p = C.XN + (size_t)m * 1024 + 512 + lane * 8; const h16x8 v = *(const h16x8*)p;
        u32x4 o; o.x = pkh((float)v[0] * rs * nw[0], (float)v[1] * rs * nw[1]); o.y = pkh((float)v[2] * rs * nw[2], (float)v[3] * rs * nw[3]);
        o.z = pkh((float)v[4] * rs * nw[4], (float)v[5] * rs * nw[5]); o.w = pkh((float)v[6] * rs * nw[6], (float)v[7] * rs * nw[7]); *(u32x4*)p = o; }
}
__device__ __forceinline__ void phase_norm(const Ctx& C, const float* src, h16* dst) {
    TIDS
    const int gw = C.bid * 8 + wave, NGW = C.G * 8;
    for (int m = gw; m < MTOK; m += NGW) rms_row_to_h16(src + (size_t)m * DM, dst + (size_t)m * DM, lane);
}
__device__ __forceinline__ void phase_final(const Ctx& C) {
    TIDS
    const int gw = C.bid * 8 + wave, NGW = C.G * 8; const unsigned long long* ssq = C.RSS + (size_t)(2 * DEPTH - 1) * MTOK;
    f32x4 fw[4];
#pragma unroll
    for (int j = 0; j < 4; ++j) fw[j] = *((const f32x4*)C.in[23] + lane + 64 * j);
    for (int m0 = gw * 4; m0 < MTOK; m0 += NGW * 4) { u32x2 v[4][4]; float rs[4];
#pragma unroll
        for (int r = 0; r < 4; ++r) { rs[r] = (float)ssq[m0 + r] * RSS_INV; const u32x2* hr = (const u32x2*)(C.H16 + (size_t)(m0 + r) * DM) + lane;
#pragma unroll
            for (int j = 0; j < 4; ++j) v[r][j] = hr[64 * j]; }
#pragma unroll
        for (int r = 0; r < 4; ++r) { const float sc = rsq_(rs[r] * (1.f / DM) + EPS); f32x4* xr = (f32x4*)(C.out + (size_t)(m0 + r) * DM) + lane;
#pragma unroll
            for (int j = 0; j < 4; ++j) xr[64 * j] = unpk_bf4(v[r][j]) * sc * fw[j]; } }
}

constexpr int N_PHASES_DECL = 0;
#ifndef PHM
#define PHM 0xffffffffu
#endif
#define EN(k) ((PHM >> (k)) & 1u)
#ifndef PROBE_PH
#define PROBE_PH -1
#define PROBE_REPS 1
#endif
#define REPN(ph) ((ph) == PROBE_PH ? PROBE_REPS : 1)
#ifndef TS_PROBE
#define TS_PROBE 0
#define TS_A 0
#define TS_B 1
#define TS_DIV 4.0f
#endif
#ifndef PROBE_BIT
#define PROBE_BIT -1
#endif
#define RB(k) for (int rb_ = 0; rb_ < ((k) == PROBE_BIT && l == 0 ? 2 : 1); ++rb_)
template <int ph> __device__ __forceinline__ void run_phase(const Params* kp, int rep, int wv) {
    Ctx C; make_ctx(C, kp, wv);
    LAS unsigned char* ldsl = (LAS unsigned char*)g_lds;
    if constexpr (ph == 0) { if (EN(0)) phase_prep(C); return; }
    if constexpr (ph == 1 + 8 * DEPTH) { if (EN(15)) phase_final(C); return; }
    constexpr int l = (ph - 1) / 8, s = (ph - 1) % 8;
    if (s == 0) { if (EN(1)) { pg8::Gemm g{(const pg8::bf16_t*)(l == 0 ? C.XN : C.H16), (const pg8::bf16_t*)(C.WIN + (size_t)l * PN * DM), MTOK, PN, DM}; pg8::StaticOrder S; S.init(MTOK, PN, C.G, C.bid);
        pg8::EpiProj E{C.PROJ, C.PSM, l == 0 ? (const unsigned long long*)nullptr : C.RSS + (size_t)(2 * (l - 1) + 1) * MTOK}; pg8::gemm_phase<pg8::EpiProj, true>(ldsl, g, S, E, C.wv); } }
    else if (s == 1) { if (EN(2)) phase_tok(C, l); }
    else if (s == 2) { RB(3) for (int u = C.bid; u < 256; u += C.G) nsa_compress_unit(C, l, u);
#if TS_PROBE
        if (l == 0 && blockIdx.x == 0) { __syncthreads(); if (C.wv == 0 && opaque_lane() == 0) ((volatile LAS unsigned long long*)((LAS unsigned char*)g_lds + LDS_MISC + 64))[27] = __builtin_amdgcn_s_memrealtime(); }
#endif
        RB(4) ssd_states_phase(C, l, C.bid, C.G);
#if TS_PROBE
        if (l == 0 && blockIdx.x == 0) { __syncthreads(); if (C.wv == 0 && opaque_lane() == 0) ((volatile LAS unsigned long long*)((LAS unsigned char*)g_lds + LDS_MISC + 64))[28] = __builtin_amdgcn_s_memrealtime(); }
#endif
        RB(5) for (int u = C.bid; u < 256; u += C.G) gla_block_unit<0>(C, l, u); }
    else if (s == 3) { if (EN(6) && rep == 0) phase_scans(C);
#if TS_PROBE
        if (l == 0 && blockIdx.x == 0) { __syncthreads(); if (C.wv == 0 && opaque_lane() == 0) ((volatile LAS unsigned long long*)((LAS unsigned char*)g_lds + LDS_MISC + 64))[30] = __builtin_amdgcn_s_memrealtime(); }
#endif
        if (EN(7)) for (int v = C.bid; v < 512; v += C.G) { const int bg = (v & 255) >> 5, sidx = v & 31, k = v >> 8;
            const int qq = (k == 0) ? sidx : 63 - sidx; nsa_attn_unit(C, l, bg >> 1, bg & 1, qq); } }
    else if (s == 4) { RB(8) ssd_y_phase(C, l, C.bid, C.G);
#if TS_PROBE
        if (l == 0 && blockIdx.x == 0) { __syncthreads(); if (C.wv == 0 && opaque_lane() == 0) ((volatile LAS unsigned long long*)((LAS unsigned char*)g_lds + LDS_MISC + 64))[29] = __builtin_amdgcn_s_memrealtime(); }
#endif
        RB(9) for (int u = C.bid; u < 256; u += C.G) gla_block_unit<1>(C, l, u); }
    else if (s == 5) { if (EN(11)) { pg8::Gemm g{(const pg8::bf16_t*)C.XN, (const pg8::bf16_t*)(C.WOUT + (size_t)l * DM * DM), MTOK, DM, DM}; pg8::StaticOrder S; S.init(MTOK, DM, C.G, C.bid);
        pg8::EpiRes E{l == 0 ? C.in[0] : (const float*)nullptr, C.H16, C.RSS + (size_t)(2 * l) * MTOK}; pg8::gemm_phase<pg8::EpiRes, true>(ldsl, g, S, E, C.wv); } }
    else if (s == 6) { if (EN(13)) { pg8::Gemm g{(const pg8::bf16_t*)C.H16, (const pg8::bf16_t*)(C.WUP + (size_t)l * DFF * DM), MTOK, DFF, DM}; pg8::StaticOrder S; S.init(MTOK, DFF, C.G, C.bid);
        pg8::EpiHid E{C.HID, C.RSS + (size_t)(2 * l) * MTOK}; pg8::gemm_phase<pg8::EpiHid, true>(ldsl, g, S, E, C.wv); } }
    else if (s == 7) { if (EN(14)) { pg8::Gemm g{(const pg8::bf16_t*)C.HID, (const pg8::bf16_t*)(C.WDN + (size_t)l * DM * DFF), MTOK, DM, DFF}; pg8::StaticOrder S; S.init(MTOK, DM, C.G, C.bid);
        pg8::EpiRes E{(const float*)nullptr, C.H16, C.RSS + (size_t)(2 * l + 1) * MTOK}; pg8::gemm_phase<pg8::EpiRes, true>(ldsl, g, S, E, C.wv); } }
}
constexpr int PH_PER_L = 8;
constexpr int N_PHASES = 1 + PH_PER_L * DEPTH + 1;
template <int PH> __device__ __forceinline__ void phase_seq(const Params* kp, int lo, int hi, cg::grid_group& grid, const XcdBarrier& bar, int wv) {
    if constexpr (PH < N_PHASES) {
        if (lo <= PH && PH < hi) {
            for (int rep = 0; rep < REPN(PH); ++rep) run_phase<PH>(kp, rep, wv);
            if (PH + 1 < hi) { if (MK_COOP && PH == 0) grid.sync(); else xcd_barrier(bar); }
#if TS_PROBE
            if (blockIdx.x == 0 && wv == 0 && opaque_lane() == 0) ((volatile LAS unsigned long long*)((LAS unsigned char*)g_lds + LDS_MISC + 64))[PH + 1] = __builtin_amdgcn_s_memrealtime();
#endif
        }
        phase_seq<PH + 1>(kp, lo, hi, grid, bar, wv);
    }
}
__global__ void __launch_bounds__(512, 2) fwd_kernel(Params P) {
    const Params* kp = &P;
    cg::grid_group grid = cg::this_grid();
    volatile LAS unsigned* st = (volatile LAS unsigned*)((LAS unsigned char*)g_lds + LDS_MISC);
    const int wv = __builtin_amdgcn_readfirstlane((int)threadIdx.x >> 6);
    if (threadIdx.x < 2) st[threadIdx.x] = 0u;
    __syncthreads();
    const XcdBarrier bar = xcd_barrier_post((unsigned*)P.ws, st, wv);
#if TS_PROBE
    if (blockIdx.x == 0 && wv == 0 && opaque_lane() == 0) ((volatile LAS unsigned long long*)((LAS unsigned char*)g_lds + LDS_MISC + 64))[0] = __builtin_amdgcn_s_memrealtime();
#endif
    phase_seq<0>(kp, P.ph_lo, P.ph_hi, grid, bar, wv);
#if TS_PROBE
    if (blockIdx.x == 0 && wv == 0 && opaque_lane() == 0) { volatile LAS unsigned long long* ts = (volatile LAS unsigned long long*)((LAS unsigned char*)g_lds + LDS_MISC + 64);
        const float us = (float)(ts[TS_B] - ts[TS_A]) * 0.01f; P.out[0] = us * (1.0f / TS_DIV); }
#endif
}

extern "C" void kernel_launch(void* const* d_in, const int* in_sizes, int n_in, void* d_out, int out_size, void* d_ws, size_t ws_size, hipStream_t stream) {
    static int grid = 0;
    if (grid == 0) {
        if (n_in != 24 || in_sizes[0] != MTOK * DM || out_size != MTOK * DM || ws_size < WS_END) { fprintf(stderr, "kernel_launch: unexpected shapes (n_in %d, ws %zu)\n", n_in, ws_size); grid = -1; return; }
        int dev = 0, cus = 0, per_cu = 0;
        hipGetDevice(&dev); hipDeviceGetAttribute(&cus, hipDeviceAttributeMultiprocessorCount, dev);
        hipFuncSetAttribute((const void*)fwd_kernel, hipFuncAttributeMaxDynamicSharedMemorySize, LDS_BYTES);
        hipOccupancyMaxActiveBlocksPerMultiprocessor(&per_cu, (const void*)fwd_kernel, 512, LDS_BYTES);
        (void)hipGetLastError();
        if (per_cu < 1) { fprintf(stderr, "kernel_launch: occupancy query says %d blocks/CU\n", per_cu); grid = -1; return; }
        grid = cus;
    }
    if (grid < 0) return;
    (void)hipMemsetAsync(d_ws, 0, 32768, stream);
    Params p{};
    for (int i = 0; i < 24; ++i) p.in[i] = (const float*)d_in[i];
    p.out = (float*)d_out; p.ws = (unsigned char*)d_ws;
#if MK_MULTI_LAUNCH
    for (int ph = 0; ph < N_PHASES; ++ph) { p.ph_lo = ph; p.ph_hi = ph + 1; hipLaunchKernelGGL(fwd_kernel, dim3(grid), dim3(512), LDS_BYTES, stream, p); }
#else
    p.ph_lo = 0; p.ph_hi = N_PHASES;
#if MK_COOP
    void* args[] = {&p};
    hipError_t e = hipLaunchCooperativeKernel((const void*)fwd_kernel, dim3(grid), dim3(512), args, LDS_BYTES, stream);
    if (e != hipSuccess) fprintf(stderr, "cooperative launch failed: %s (grid %d)\n", hipGetErrorString(e), grid);
#else
    hipLaunchKernelGGL(fwd_kernel, dim3(grid), dim3(512), LDS_BYTES, stream, p);
#endif
#endif
}
```
